# Optimizing an MI355X kernel written in HIP

```python
import math
import jax
import jax.numpy as jnp
from jax import lax
import numpy as np

D_MODEL = 2048
BATCH = 2
SEQ = 16384
DEPTH = 1
DEC_BATCH = 16
DEC_SEQ = 2048
PAST_LEN = 128

D_S5 = D_MODEL // 2
S5_GROUP = 16
S5_GROUPS = D_S5 // S5_GROUP
S5_STATE = 64
DT_MIN = 1e-3
DT_MAX = 1e-1
D_RWKV = D_MODEL // 2
RWKV_HEAD = 64
RWKV_HEADS = D_RWKV // RWKV_HEAD
LORA_RANK = 64
D_RW_IN = 3 * D_RWKV + 4 * LORA_RANK
N_IN = 2 * D_S5 + D_RW_IN + D_RWKV + 2 * D_MODEL
IN_SPLITS = (D_S5, 2 * D_S5, 2 * D_S5 + D_RW_IN, 2 * D_S5 + D_RW_IN + D_RWKV)
RW_SPLITS = (D_RWKV, 2 * D_RWKV, 3 * D_RWKV, 3 * D_RWKV + LORA_RANK, 3 * D_RWKV + 2 * LORA_RANK, 3 * D_RWKV + 3 * LORA_RANK)
RMS_EPS = 1e-6
GN_EPS = 64e-5
L2_EPS = 1e-12

kernel_name = 'bidir_s5_rwkv7_gated_hybrid'


def rms_norm(x, g):
    x32 = x.astype(jnp.float32)
    return x32 * lax.rsqrt(jnp.mean(jnp.square(x32), axis=-1, keepdims=True) + RMS_EPS) * g.astype(jnp.float32)


def centred_shift_mix(z, mu):
    zero = jnp.zeros_like(z[:, :1])
    prev = jnp.concatenate([zero, z[:, :-1]], axis=1)
    nxt = jnp.concatenate([z[:, 1:], zero], axis=1)
    return z + (0.5 * (prev + nxt) - z) * mu


def _ssm_combine(e_i, e_j):
    a_i, b_i = e_i
    a_j, b_j = e_j
    return a_j * a_i, a_j * b_i + b_j


def s5_direction(u, lam_re, lam_im, log_dt, b_re, b_im, c_re, c_im, reverse):
    f32 = jnp.float32
    lam = lax.complex(lam_re.astype(f32), lam_im.astype(f32))
    dt = jnp.exp(log_dt.astype(f32))[:, None]
    lam_bar = jnp.exp(lam * dt)
    b_bar = ((lam_bar - 1.0) / lam)[..., None] * lax.complex(b_re.astype(f32), b_im.astype(f32))
    c = lax.complex(c_re.astype(f32), c_im.astype(f32))

    def one_sequence(u_seq):
        bu = jnp.einsum('gph,lgh->lgp', b_bar, u_seq.astype(jnp.complex64))
        a = jnp.broadcast_to(lam_bar, bu.shape)
        _, states = lax.associative_scan(_ssm_combine, (a, bu), axis=0, reverse=reverse)
        return jnp.einsum('ghp,lgp->lgh', c, states).real

    return lax.map(one_sequence, u)


def s5_branch(u_flat, gate, lam_re, lam_im, log_dt, b_re, b_im, c_re, c_im, d, w_glu, w_out):
    bsz, seq, _ = u_flat.shape
    u = u_flat.astype(jnp.float32).reshape(bsz, seq, S5_GROUPS, S5_GROUP)
    y = d.astype(jnp.float32).reshape(S5_GROUPS, S5_GROUP) * u
    for dirn, rev in ((0, False), (1, True)):
        y = y + s5_direction(u, lam_re[dirn], lam_im[dirn], log_dt[dirn], b_re[dirn], b_im[dirn],
                             c_re[dirn], c_im[dirn], rev)
    z = jax.nn.gelu(y.reshape(bsz, seq, D_S5))
    z = z * jax.nn.sigmoid(z @ w_glu)
    z = z * jax.nn.silu(gate.astype(jnp.float32))
    return z @ w_out


def wkv7_scan(r, w, kk, a, k, v, reverse):
    bsz = r.shape[0]
    xs = tuple(jnp.moveaxis(t, 1, 0) for t in (r, w, kk, a, k, v))

    def step(s, inp):
        r_t, w_t, kk_t, a_t, k_t, v_t = inp
        sa = jnp.einsum('bhvk,bhk->bhv', s, -kk_t)
        s = (s * w_t[:, :, None, :] + sa[..., None] * (kk_t * a_t)[:, :, None, :]
             + v_t[..., None] * k_t[:, :, None, :])
        return s, jnp.einsum('bhvk,bhk->bhv', s, r_t)

    s0 = jnp.zeros((bsz, RWKV_HEADS, RWKV_HEAD, RWKV_HEAD), jnp.float32)
    _, ys = lax.scan(step, s0, xs, reverse=reverse)
    return jnp.moveaxis(ys, 0, 1)


def rwkv7_branch(rw_in, gate, mu, w0, w_up, a0, a_up, k_k, k_a, r_k, ln_w, ln_b, w_out):
    bsz, seq, _ = rw_in.shape
    z = centred_shift_mix(rw_in.astype(jnp.float32), mu)
    r, k, v, xw_f, xw_b, xa_f, xa_b = jnp.split(z, RW_SPLITS, axis=-1)

    def heads(t):
        return t.reshape(bsz, seq, RWKV_HEADS, RWKV_HEAD)

    kk = heads(k * k_k)
    kk = kk * lax.rsqrt(jnp.sum(kk * kk, axis=-1, keepdims=True) + L2_EPS)
    rh, vh = heads(r), heads(v)
    bonus = jnp.sum(rh * heads(k) * r_k, axis=-1, keepdims=True) * vh
    y = jnp.zeros_like(vh)
    for dirn, (xw, xa, rev) in enumerate(((xw_f, xa_f, False), (xw_b, xa_b, True))):
        logw = -jax.nn.softplus(-(w0[dirn] + jnp.tanh(xw) @ w_up[dirn])) - 0.5
        decay = jnp.exp(-jnp.exp(logw))
        a = jax.nn.sigmoid(a0[dirn] + xa @ a_up[dirn])
        kd = k * (1.0 + (a - 1.0) * k_a)
        y = y + wkv7_scan(rh, heads(decay), kk, heads(a), heads(kd), vh, rev)
    mean = jnp.mean(y, axis=-1, keepdims=True)
    var = jnp.mean(jnp.square(y - mean), axis=-1, keepdims=True)
    y = (y - mean) * lax.rsqrt(var + GN_EPS)
    y = y.reshape(bsz, seq, D_RWKV) * ln_w + ln_b + bonus.reshape(bsz, seq, D_RWKV)
    y = y * jax.nn.silu(gate.astype(jnp.float32))
    return y @ w_out


def hybrid_layer(x, pre_norm_g, post_norm_g, w_in, s5_lam_re, s5_lam_im, s5_log_dt, s5_b_re, s5_b_im,
                 s5_c_re, s5_c_im, s5_d, s5_w_glu, s5_w_out, rw_mu, rw_w0, rw_w_up, rw_a0, rw_a_up,
                 rw_k_k, rw_k_a, rw_r_k, rw_ln_w, rw_ln_b, rw_w_out, w_o):
    hn = rms_norm(x, pre_norm_g).astype(x.dtype)
    proj = hn @ w_in
    s5_u, s5_gate, rw_in, rw_gate, merge_logits = jnp.split(proj, IN_SPLITS, axis=-1)
    p_s5 = s5_branch(s5_u, s5_gate, s5_lam_re, s5_lam_im, s5_log_dt, s5_b_re, s5_b_im,
                     s5_c_re, s5_c_im, s5_d, s5_w_glu, s5_w_out)
    p_rw = rwkv7_branch(rw_in, rw_gate, rw_mu, rw_w0, rw_w_up, rw_a0, rw_a_up, rw_k_k, rw_k_a,
                        rw_r_k, rw_ln_w, rw_ln_b, rw_w_out)
    g_s5, g_rw = jnp.split(merge_logits.astype(jnp.float32), 2, axis=-1)
    h = jax.nn.sigmoid(g_s5) * p_s5 + jax.nn.sigmoid(g_rw) * p_rw
    out = h.astype(x.dtype) @ w_o
    return (x.astype(jnp.float32) + rms_norm(out, post_norm_g)).astype(x.dtype)


def encoder(x, params):
    for layer_idx in range(DEPTH):
        x = hybrid_layer(x, *[p[layer_idx] for p in params])
    return x


def setup_inputs(seed: int = 0) -> dict:
    key = jax.random.key(seed)
    ks = jax.random.split(key, 27)
    f32 = jnp.float32

    def nrm(k, shape, scale):
        return scale * jax.random.normal(k, shape, f32)

    s5_lam_shape = (DEPTH, 2, S5_GROUPS, S5_STATE)
    n_idx = jnp.arange(S5_STATE, dtype=f32)
    return {
        'x_prompt': nrm(ks[0], (BATCH, SEQ, D_MODEL), 1.0),
        'x_sample': nrm(ks[1], (DEC_BATCH, DEC_SEQ, D_MODEL), 1.0),
        'pre_norm_g': 1.0 + nrm(ks[2], (DEPTH, D_MODEL), 0.02),
        'post_norm_g': 1.0 + nrm(ks[3], (DEPTH, D_MODEL), 0.02),
        'w_in': nrm(ks[4], (DEPTH, D_MODEL, N_IN), D_MODEL ** -0.5),
        's5_lam_re': -0.5 + nrm(ks[5], s5_lam_shape, 0.01),
        's5_lam_im': math.pi * n_idx + nrm(ks[6], s5_lam_shape, 0.01),
        's5_log_dt': jax.random.uniform(ks[7], (DEPTH, 2, S5_GROUPS), f32, math.log(DT_MIN), math.log(DT_MAX)),
        's5_b_re': nrm(ks[8], (DEPTH, 2, S5_GROUPS, S5_STATE, S5_GROUP), (2 * S5_GROUP) ** -0.5),
        's5_b_im': nrm(ks[9], (DEPTH, 2, S5_GROUPS, S5_STATE, S5_GROUP), (2 * S5_GROUP) ** -0.5),
        's5_c_re': nrm(ks[10], (DEPTH, 2, S5_GROUPS, S5_GROUP, S5_STATE), S5_STATE ** -0.5),
        's5_c_im': nrm(ks[11], (DEPTH, 2, S5_GROUPS, S5_GROUP, S5_STATE), S5_STATE ** -0.5),
        's5_d': nrm(ks[12], (DEPTH, D_S5), 1.0),
        's5_w_glu': nrm(ks[13], (DEPTH, D_S5, D_S5), D_S5 ** -0.5),
        's5_w_out': nrm(ks[14], (DEPTH, D_S5, D_MODEL), D_S5 ** -0.5),
        'rw_mu': jax.random.uniform(ks[15], (DEPTH, D_RW_IN), f32),
        'rw_w0': jax.random.uniform(ks[16], (DEPTH, 2, D_RWKV), f32, -6.0, -1.0),
        'rw_w_up': nrm(ks[17], (DEPTH, 2, LORA_RANK, D_RWKV), 0.5 * LORA_RANK ** -0.5),
        'rw_a0': nrm(ks[18], (DEPTH, 2, D_RWKV), 0.5),
        'rw_a_up': nrm(ks[19], (DEPTH, 2, LORA_RANK, D_RWKV), 0.5 * LORA_RANK ** -0.5),
        'rw_k_k': 0.85 + nrm(ks[20], (DEPTH, D_RWKV), 0.05),
        'rw_k_a': 1.0 + nrm(ks[21], (DEPTH, D_RWKV), 0.05),
        'rw_r_k': nrm(ks[22], (DEPTH, RWKV_HEADS, RWKV_HEAD), 0.1),
        'rw_ln_w': 1.0 + nrm(ks[23], (DEPTH, D_RWKV), 0.02),
        'rw_ln_b': nrm(ks[24], (DEPTH, D_RWKV), 0.02),
        'rw_w_out': nrm(ks[25], (DEPTH, D_RWKV, D_MODEL), D_RWKV ** -0.5),
        'w_o': nrm(ks[26], (DEPTH, D_MODEL, D_MODEL), D_MODEL ** -0.5),
    }


def reference(x_prompt, x_sample, pre_norm_g, post_norm_g, w_in, s5_lam_re, s5_lam_im, s5_log_dt,
              s5_b_re, s5_b_im, s5_c_re, s5_c_im, s5_d, s5_w_glu, s5_w_out, rw_mu, rw_w0, rw_w_up,
              rw_a0, rw_a_up, rw_k_k, rw_k_a, rw_r_k, rw_ln_w, rw_ln_b, rw_w_out, w_o):
    params = (pre_norm_g, post_norm_g, w_in, s5_lam_re, s5_lam_im, s5_log_dt, s5_b_re, s5_b_im,
              s5_c_re, s5_c_im, s5_d, s5_w_glu, s5_w_out, rw_mu, rw_w0, rw_w_up, rw_a0, rw_a_up,
              rw_k_k, rw_k_a, rw_r_k, rw_ln_w, rw_ln_b, rw_w_out, w_o)
    y_prompt = encoder(x_prompt, params)
    y_sample = encoder(x_sample, params)
    return (y_prompt, y_sample)
```

```cpp
#include <hip/hip_runtime.h>
#include <cstdio>
#include <cstdint>
#define MK_N_LAUNCHES 13
namespace pg8 {
#define PG8_LAS __attribute__((address_space(3)))
typedef unsigned short bf16_t;
typedef short bf16x8 __attribute__((ext_vector_type(8)));
typedef float f32x4 __attribute__((ext_vector_type(4)));
typedef unsigned u32x4 __attribute__((ext_vector_type(4)));
constexpr int BM = 256, BK = 64, HALF = 128, HTB = HALF * BK * 2  , STAGE_BYTES = 8 * HTB, NXCD = 8, WGM = 8;

__host__ __device__ __forceinline__ int lds_byte(int r, int c) { const int st = (r >> 4) * 2 + (c >> 5), rr = r & 15, cc = c & 31, ob = rr * 64 + cc * 2; return st * 1024 + (ob ^ (((ob >> 9) & 1) << 5)); }
__host__ __device__ __forceinline__ void stage_rc(int b, int& R, int& C) { const int st = b / 1024, sb = b % 1024, swz = sb ^ (((sb >> 9) & 1) << 5); R = (st >> 1) * 16 + swz / 64; C = (st & 1) * 32 + (swz % 64) / 2; }
__host__ __device__ __forceinline__ int perm32(int rho) { const int n = rho >> 4, i = rho & 15; return 8 * (i >> 2) + 4 * n + (i & 3); }

struct Unit { int pm, pn; };
struct Gemm { const bf16_t* A; const bf16_t* Bt; int M, N, K; };

struct StaticOrder {
    int nM, nN, nwg, G, c;
    __host__ __device__ void init(int M, int N, int G_, int c_) { nM = M / BM; nN = N / BM; nwg = nM * nN; G = G_; c = c_; }
    __host__ __device__ bool next(int i, Unit& u) const {
        const long L = (long)i * G + c; if (L >= nwg) return false;
        int wgid = (int)L; { const int q = nwg / NXCD, r = nwg % NXCD, xcd = wgid % NXCD, off = wgid / NXCD; wgid = (xcd < r ? xcd * (q + 1) : r * (q + 1) + (xcd - r) * q) + off; }
        const int nig = WGM * nN, gid = wgid / nig, fm = gid * WGM, gsz = (nM - fm) < WGM ? (nM - fm) : WGM;
        u.pm = fm + ((wgid % nig) % gsz); u.pn = (wgid % nig) / gsz; return true;
    }
    __device__ __forceinline__ void a_ready(const Unit&) const {}
    __device__ __forceinline__ void done(const Unit&) const {}
};

__device__ __forceinline__ unsigned cvt_pk_bf16(float lo, float hi) { unsigned r; asm volatile("v_cvt_pk_bf16_f32 %0, %1, %2" : "=v"(r) : "v"(lo), "v"(hi)); return r; }

__device__ __forceinline__ float bf_lo(unsigned u) { return __uint_as_float(u << 16); }
__device__ __forceinline__ float bf_hi(unsigned u) { return __uint_as_float(u & 0xffff0000u); }
__device__ __forceinline__ float sigmoid_f(float v) { return __builtin_amdgcn_rcpf(1.0f + __expf(-v)); }

struct EpiG1 {
    static constexpr bool PERM = true, AFTER_DRAIN = false;
    bf16_t* s5u; bf16_t* rwin;
    __device__ __forceinline__ void operator()(const f32x4 (&acc)[2][2][4][2], const Unit& u, int wr, int wc, int fr, int fq) const {
        const int row0 = u.pm * BM + wr * 64 + fr; int colt = u.pn * BM; bf16_t* base; int ld;
        if (colt < 1024) { base = s5u; ld = 1024; } else { base = rwin; ld = 3328; colt -= 1024; }
        const int col0 = colt + wc * 32 + 8 * fq;
#pragma unroll
        for (int ai = 0; ai < 2; ++ai)
#pragma unroll
            for (int m = 0; m < 4; ++m) { bf16_t* rowp = base + (size_t)(row0 + ai * HALF + m * 16) * ld + col0;
#pragma unroll
                for (int bj = 0; bj < 2; ++bj) { const f32x4 v0 = acc[ai][bj][m][0], v1 = acc[ai][bj][m][1];
                    u32x4 w; w.x = cvt_pk_bf16(v0[0], v0[1]); w.y = cvt_pk_bf16(v0[2], v0[3]); w.z = cvt_pk_bf16(v1[0], v1[1]); w.w = cvt_pk_bf16(v1[2], v1[3]);
                    *(u32x4*)(rowp + bj * HALF) = w; } }
    }
};
template <int MODE> struct EpiMix {
    static constexpr bool PERM = true, AFTER_DRAIN = false;
    bf16_t* O; const bf16_t* S; const bf16_t* Add; int ld;
    __device__ __forceinline__ void operator()(const f32x4 (&acc)[2][2][4][2], const Unit& u, int wr, int wc, int fr, int fq) const {
        const int row0 = u.pm * BM + wr * 64 + fr, col0 = u.pn * BM + wc * 32 + 8 * fq;
#pragma unroll
        for (int ai = 0; ai < 2; ++ai)
#pragma unroll
            for (int m = 0; m < 4; ++m) {
#pragma unroll
                for (int bj = 0; bj < 2; ++bj) {
                    const size_t off = (size_t)(row0 + ai * HALF + m * 16) * ld + col0 + bj * HALF;
                    float v[8];
#pragma unroll
                    for (int j = 0; j < 4; ++j) { v[j] = acc[ai][bj][m][0][j]; v[4 + j] = acc[ai][bj][m][1][j]; }
                    if (MODE >= 1) {
                        const u32x4 s = *(const u32x4*)(S + off);
                        const float sv[8] = {bf_lo(s.x), bf_hi(s.x), bf_lo(s.y), bf_hi(s.y), bf_lo(s.z), bf_hi(s.z), bf_lo(s.w), bf_hi(s.w)};
#pragma unroll
                        for (int j = 0; j < 8; ++j) { const float sg = sigmoid_f(v[j]); v[j] = (MODE == 2) ? sv[j] * v[j] * sg : sv[j] * sg; }
                    }
                    if (MODE == 3) {
                        const u32x4 a = *(const u32x4*)(Add + off);
                        const float av[8] = {bf_lo(a.x), bf_hi(a.x), bf_lo(a.y), bf_hi(a.y), bf_lo(a.z), bf_hi(a.z), bf_lo(a.w), bf_hi(a.w)};
#pragma unroll
                        for (int j = 0; j < 8; ++j) v[j] += av[j];
                    }
                    u32x4 w; w.x = cvt_pk_bf16(v[0], v[1]); w.y = cvt_pk_bf16(v[2], v[3]); w.z = cvt_pk_bf16(v[4], v[5]); w.w = cvt_pk_bf16(v[6], v[7]);
                    *(u32x4*)(O + off) = w;
                }
            }
    }
};
struct EpiF32 {
    static constexpr bool PERM = false, AFTER_DRAIN = false;
    float* C; int ldc;
    __device__ __forceinline__ void operator()(const f32x4 (&acc)[2][2][4][2], const Unit& u, int wr, int wc, int fr, int fq) const {
        const int row0 = u.pm * BM + wr * 64 + fr, col0 = u.pn * BM + wc * 32 + 4 * fq;
#pragma unroll
        for (int ai = 0; ai < 2; ++ai)
#pragma unroll
            for (int m = 0; m < 4; ++m) { float* rowp = C + (size_t)(row0 + ai * HALF + m * 16) * ldc + col0;
#pragma unroll
                for (int bj = 0; bj < 2; ++bj)
#pragma unroll
                    for (int n = 0; n < 2; ++n) *(f32x4*)(rowp + bj * HALF + n * 16) = acc[ai][bj][m][n]; }
    }
};
template <class Epi, class Sched, bool ALIGN_EPI = false, bool SP2 = false>
__device__ __forceinline__ void gemm_phase(PG8_LAS unsigned char* lds, const Gemm g, const Sched& S, const Epi& E) {
    const int tid = threadIdx.x, wid = __builtin_amdgcn_readfirstlane(tid >> 6), lane = tid & 63, wr = wid >> 2, wc = wid & 3, fr = lane & 15, fq = lane >> 4;
    const int K = g.K, nt = K / BK;
    unsigned voffA[2], voffB[2];
#pragma unroll
    for (int i = 0; i < 2; ++i) { int R, C; stage_rc(tid * 16 + i * 8192, R, C); const int Rb = Epi::PERM ? ((R & ~31) + perm32(R & 31)) : R;
        voffA[i] = (unsigned)(R * K + C) * 2u; voffB[i] = (unsigned)(Rb * K + C) * 2u; }
    const size_t kstep = (size_t)(BK * 2);
    const size_t hstep = (size_t)HALF * K * 2;
    const size_t tstep = 2 * hstep;
    const unsigned ldsw = (unsigned)wid * 1024u;
    const int aoff = lds_byte(wr * 64 + fr, fq * 8), boff = lds_byte(wc * 32 + fr, fq * 8);
#define PG8_SA(b, h) (((b) * 2 + (h)) * HTB)
#define PG8_SB(b, h) ((4 + (b) * 2 + (h)) * HTB)
#define PG8_STAGE(bufoff, gbase, voff) do { _Pragma("unroll") for (int _i = 0; _i < 2; ++_i) \
        __builtin_amdgcn_global_load_lds((const unsigned*)((const char*)(gbase) + (voff)[_i]), (PG8_LAS unsigned*)(lds + (bufoff) + ldsw + _i * 8192), 16, 0, 0); } while (0)
#define PG8_LDA(dst, b, h) do { _Pragma("unroll") for (int m = 0; m < 4; ++m) _Pragma("unroll") for (int k = 0; k < 2; ++k) dst[m][k] = *(const PG8_LAS bf16x8*)(lds + PG8_SA(b, h) + aoff + m * 2048 + k * 1024); } while (0)
#define PG8_LDB(dst, b, h) do { _Pragma("unroll") for (int n = 0; n < 2; ++n) _Pragma("unroll") for (int k = 0; k < 2; ++k) dst[n][k] = *(const PG8_LAS bf16x8*)(lds + PG8_SB(b, h) + boff + n * 2048 + k * 1024); } while (0)
#define PG8_MMA(ai, bj, At, Bt) do { __builtin_amdgcn_s_setprio(1); _Pragma("unroll") for (int m = 0; m < 4; ++m) _Pragma("unroll") for (int n = 0; n < 2; ++n) _Pragma("unroll") for (int k = 0; k < 2; ++k) \
        acc[ai][bj][m][n] = __builtin_amdgcn_mfma_f32_16x16x32_bf16(Bt[n][k], At[m][k], acc[ai][bj][m][n], 0, 0, 0); __builtin_amdgcn_s_setprio(0); } while (0)
#define PG8_WAIT_V(n) asm volatile("s_waitcnt vmcnt(" #n ")" ::: "memory")
#define PG8_WAIT_L(n) asm volatile("s_waitcnt lgkmcnt(" #n ")" ::: "memory")
#define PG8_BAR __builtin_amdgcn_s_barrier()
#define PG8_SCHED __builtin_amdgcn_sched_barrier(0)
    Unit cur, nxt; int ui = 0;
    if (!S.next(0, cur)) return;
    f32x4 acc[2][2][4][2];
#pragma unroll
    for (int a = 0; a < 2; ++a)
#pragma unroll
        for (int b = 0; b < 2; ++b)
#pragma unroll
            for (int m = 0; m < 4; ++m)
#pragma unroll
                for (int n = 0; n < 2; ++n) acc[a][b][m][n] = (f32x4){0.f, 0.f, 0.f, 0.f};
    bf16x8 At[4][2], B0[2][2], B1[2][2];
    const char* cA = (const char*)g.A + (size_t)cur.pm * tstep; const char* cB = (const char*)g.Bt + (size_t)cur.pn * tstep;
    S.a_ready(cur);
    if constexpr (SP2) {
        PG8_STAGE(PG8_SB(0, 0), cB, voffB); PG8_STAGE(PG8_SB(0, 1), cB + hstep, voffB); PG8_STAGE(PG8_SA(0, 0), cA, voffA); PG8_STAGE(PG8_SA(0, 1), cA + hstep, voffA);
        if (wr == 1) PG8_BAR;
        PG8_WAIT_V(2); PG8_BAR;
        PG8_STAGE(PG8_SB(1, 0), cB + kstep, voffB); PG8_STAGE(PG8_SA(1, 0), cA + kstep, voffA); PG8_STAGE(PG8_SB(1, 1), cB + hstep + kstep, voffB);
        PG8_WAIT_V(6); PG8_BAR;
    } else {
        PG8_STAGE(PG8_SB(0, 0), cB, voffB); PG8_STAGE(PG8_SA(0, 0), cA, voffA); PG8_STAGE(PG8_SB(0, 1), cB + hstep, voffB); PG8_STAGE(PG8_SA(0, 1), cA + hstep, voffA);
        if (wr == 1) PG8_BAR;
        PG8_WAIT_V(4); PG8_BAR;
        PG8_STAGE(PG8_SB(1, 0), cB + kstep, voffB); PG8_STAGE(PG8_SA(1, 0), cA + kstep, voffA); PG8_STAGE(PG8_SB(1, 1), cB + hstep + kstep, voffB);
        PG8_WAIT_V(6); PG8_BAR;
    }
    for (;;) {
        const bool has_next = S.next(ui + 1, nxt);
        const char* nA = has_next ? (const char*)g.A + (size_t)nxt.pm * tstep : cA; const char* nB = has_next ? (const char*)g.Bt + (size_t)nxt.pn * tstep : cB;
        for (int t = 0; t < nt; t += 2) {
            const bool last = (t == nt - 2);
            const char* a1 = cA + (size_t)(t + 1) * kstep;
            const char* a2 = last ? nA : cA + (size_t)(t + 2) * kstep; const char* b2 = last ? nB : cB + (size_t)(t + 2) * kstep;
            const char* a3 = a2 + kstep; const char* b3 = b2 + kstep;
            if (last && has_next) S.a_ready(nxt);
            if constexpr (SP2) {
            PG8_LDB(B0, 0, 0); PG8_LDB(B1, 0, 1); PG8_SCHED; PG8_LDA(At, 0, 0); PG8_STAGE(PG8_SA(1, 1), a1 + hstep, voffA);
            PG8_WAIT_V(8); PG8_WAIT_L(0); PG8_BAR; PG8_MMA(0, 0, At, B0); PG8_MMA(0, 1, At, B1); PG8_BAR; PG8_SCHED;
            PG8_LDA(At, 0, 1); PG8_STAGE(PG8_SB(0, 0), b2, voffB); PG8_STAGE(PG8_SB(0, 1), b2 + hstep, voffB); PG8_STAGE(PG8_SA(0, 0), a2, voffA);
            PG8_WAIT_V(8); PG8_WAIT_L(0); PG8_BAR; PG8_MMA(1, 0, At, B0); PG8_MMA(1, 1, At, B1); PG8_BAR; PG8_SCHED;
            PG8_LDB(B0, 1, 0); PG8_LDB(B1, 1, 1); PG8_SCHED; PG8_LDA(At, 1, 0); PG8_STAGE(PG8_SA(0, 1), a2 + hstep, voffA);
            PG8_WAIT_V(8); PG8_WAIT_L(0); PG8_BAR; PG8_MMA(0, 0, At, B0); PG8_MMA(0, 1, At, B1); PG8_BAR; PG8_SCHED;
            PG8_LDA(At, 1, 1); PG8_STAGE(PG8_SB(1, 0), b3, voffB); PG8_STAGE(PG8_SB(1, 1), b3 + hstep, voffB); PG8_STAGE(PG8_SA(1, 0), a3, voffA);
            PG8_WAIT_V(8); PG8_WAIT_L(0); PG8_BAR; PG8_MMA(1, 0, At, B0); PG8_MMA(1, 1, At, B1); PG8_BAR; PG8_SCHED;
            } else {
            PG8_LDB(B0, 0, 0); PG8_SCHED; PG8_LDA(At, 0, 0); PG8_STAGE(PG8_SA(1, 1), a1 + hstep, voffA);
            PG8_WAIT_L(8); PG8_BAR; PG8_WAIT_L(0); PG8_MMA(0, 0, At, B0); PG8_BAR; PG8_SCHED;
            PG8_LDB(B1, 0, 1); PG8_STAGE(PG8_SB(0, 0), b2, voffB);
            PG8_BAR; PG8_WAIT_L(0); PG8_MMA(0, 1, At, B1); PG8_BAR;
            PG8_LDA(At, 0, 1); PG8_STAGE(PG8_SA(0, 0), a2, voffA);
            PG8_BAR; PG8_WAIT_L(0); PG8_MMA(1, 0, At, B0); PG8_BAR; PG8_SCHED;
            PG8_STAGE(PG8_SB(0, 1), b2 + hstep, voffB);
            PG8_WAIT_V(6); PG8_BAR; PG8_MMA(1, 1, At, B1); PG8_BAR;
            PG8_LDB(B0, 1, 0); PG8_SCHED; PG8_LDA(At, 1, 0); PG8_STAGE(PG8_SA(0, 1), a2 + hstep, voffA);
            PG8_WAIT_L(8); PG8_BAR; PG8_WAIT_L(0); PG8_MMA(0, 0, At, B0); PG8_BAR; PG8_SCHED;
            PG8_LDB(B1, 1, 1); PG8_STAGE(PG8_SB(1, 0), b3, voffB);
            PG8_BAR; PG8_WAIT_L(0); PG8_MMA(0, 1, At, B1); PG8_BAR;
            PG8_LDA(At, 1, 1); PG8_STAGE(PG8_SA(1, 0), a3, voffA);
            PG8_BAR; PG8_WAIT_L(0); PG8_MMA(1, 0, At, B0); PG8_BAR; PG8_SCHED;
            PG8_STAGE(PG8_SB(1, 1), b3 + hstep, voffB);
            PG8_WAIT_V(6); PG8_BAR; PG8_MMA(1, 1, At, B1); PG8_BAR;
            }
        }
        if constexpr (ALIGN_EPI) { if (wr == 0) PG8_BAR; }
        if constexpr (!Epi::AFTER_DRAIN) { E(acc, cur, wr, wc, fr, fq); S.done(cur); }
        if (!has_next) break;
#pragma unroll
        for (int a = 0; a < 2; ++a)
#pragma unroll
            for (int b = 0; b < 2; ++b)
#pragma unroll
                for (int m = 0; m < 4; ++m)
#pragma unroll
                    for (int n = 0; n < 2; ++n) acc[a][b][m][n] = (f32x4){0.f, 0.f, 0.f, 0.f};
        cur = nxt; cA = nA; cB = nB; ++ui;
        if constexpr (ALIGN_EPI) { if (wr == 1) PG8_BAR; }
    }
    PG8_WAIT_V(0);
    if constexpr (!ALIGN_EPI) { if (wr == 0) PG8_BAR; }
    PG8_BAR;
    if constexpr (Epi::AFTER_DRAIN) { E.fused(acc, cur, wr, wc, fr, fq, lds, wid, lane); S.done(cur); }
#undef PG8_SA
#undef PG8_SB
#undef PG8_STAGE
#undef PG8_LDA
#undef PG8_LDB
#undef PG8_MMA
#undef PG8_WAIT_V
#undef PG8_WAIT_L
#undef PG8_BAR
#undef PG8_SCHED
}
}

#ifndef PG8_SP2
#define PG8_SP2 true
#endif
#ifndef PG8_ALIGN
#define PG8_ALIGN true
#endif

constexpr int NWAVES = 8;
constexpr int N_PHASES = 13;
#ifndef MK_N_LAUNCHES
#define MK_N_LAUNCHES 1
#endif
constexpr int N_LAUNCHES = MK_N_LAUNCHES;

constexpr int D = 2048, M = 65536, NIN = 10496;
constexpr int LP = 16384, LS = 2048;
constexpr int DS5 = 1024, DRW = 1024, DRWIN = 3328;
constexpr float RMS_EPS = 1e-6f, GN_EPS = 64e-5f, L2_EPS = 1e-12f;

constexpr size_t MiB = 1u << 20;
constexpr size_t WS_CTL = 0, CTL_ZERO_BYTES = 1 * MiB;
constexpr size_t WS_WT = 1 * MiB;
constexpr size_t WS_GLUT = 42 * MiB;
constexpr size_t WS_S5OT = 44 * MiB;
constexpr size_t WS_RWOT = 48 * MiB;
constexpr size_t WS_WOT = 52 * MiB;
constexpr size_t WS_HN = 60 * MiB;
constexpr size_t WS_S5U = 316 * MiB;
constexpr size_t WS_RWIN = 444 * MiB;
constexpr size_t WS_Z = 860 * MiB;
constexpr size_t WS_END = 988 * MiB;
constexpr size_t DO_YF = 0, DO_YB = 128 * MiB, DO_SF = 256 * MiB, DO_SB = 384 * MiB, DO_Q = 256 * MiB;
constexpr int CW_BAR = 4096;

constexpr int LDS_BYTES = 147456;
constexpr int MISC_OFF = LDS_BYTES - 512;
constexpr int WAVE_SCR = 18176;
static_assert(NWAVES * WAVE_SCR <= MISC_OFF && pg8::STAGE_BYTES <= MISC_OFF, "LDS map");

#define GAS __attribute__((address_space(1)))
#define LAS __attribute__((address_space(3)))
typedef unsigned short bf16;
typedef unsigned v4u __attribute__((ext_vector_type(4)));
typedef unsigned v2u __attribute__((ext_vector_type(2)));
typedef float f32x4 __attribute__((ext_vector_type(4)));
#define LDS_WAIT() asm volatile("s_waitcnt lgkmcnt(0)" ::: "memory")
#define VM_WAIT() asm volatile("s_waitcnt vmcnt(0)" ::: "memory")
__device__ __forceinline__ unsigned f2bf(float f) { unsigned u = __builtin_bit_cast(unsigned, f); return (u + 0x7fffu + ((u >> 16) & 1u)) >> 16; }
__device__ __forceinline__ unsigned pk2(float lo, float hi) { return f2bf(lo) | (f2bf(hi) << 16); }
__device__ __forceinline__ float bf2f(bf16 b) { return __uint_as_float(((unsigned)b) << 16); }
__device__ __forceinline__ float blo(unsigned u) { return __uint_as_float(u << 16); }
__device__ __forceinline__ float bhi(unsigned u) { return __uint_as_float(u & 0xffff0000u); }
__device__ __forceinline__ float wave_sum(float v) {
#pragma unroll
    for (int o = 1; o < 64; o <<= 1) v += __shfl_xor(v, o);
    return v;
}
__device__ __forceinline__ float sigm(float v) { return 1.0f / (1.0f + __expf(-v)); }
__device__ __forceinline__ float gelu_tanh(float x) { const float u = 0.7978845608028654f * (x + 0.044715f * x * x * x); return 0.5f * x * (1.0f + tanhf(u)); }

#define XB_TMO      128
#define XB_XCNT(j)  (256  + 64 * (j))
#define XB_XSUB(j)  (1280 + 64 * (j))
#define XB_XGEN(j)  (2304 + 64 * (j))
#define XB_TOP      3328
#define XB_TOPGEN   3392
#define XCD_BAR_WORDS 3456
#define XB_SPIN_CAP (1u << 18)

__device__ __forceinline__ unsigned xb_ld(unsigned* p)              { return __hip_atomic_load(p, __ATOMIC_RELAXED, __HIP_MEMORY_SCOPE_AGENT); }
__device__ __forceinline__ unsigned xb_add(unsigned* p, unsigned v) { return __hip_atomic_fetch_add(p, v, __ATOMIC_RELAXED, __HIP_MEMORY_SCOPE_AGENT); }
__device__ __forceinline__ unsigned xb_xcc_id() { return (unsigned)__builtin_amdgcn_s_getreg((3 << 11) | 20) & 0xFu; }
#define XB_SPIN(cond, bar) do { unsigned _sp = 0; while (cond) { __builtin_amdgcn_s_sleep(1); \
    if ((++_sp & 255u) == 0u) { if (xb_ld(&(bar)[XB_TMO])) break; if (_sp > XB_SPIN_CAP) { atomicAdd(&(bar)[XB_TMO], 1u); break; } } } } while (0)

struct XcdBarrier {
    unsigned* bar; unsigned x;
    volatile LAS unsigned* st;
};

__device__ __forceinline__ XcdBarrier xcd_barrier_post(unsigned* bar, volatile LAS unsigned* st) {
    XcdBarrier b; b.bar = bar; b.x = xb_xcc_id(); b.st = st;
    if (threadIdx.x == 0) (void)xb_add(&bar[XB_XCNT(b.x)], 1u);
    return b;
}
__device__ __forceinline__ void xcd_barrier_complete(unsigned* bar, unsigned x, unsigned& nloc, unsigned& nx) {
    const unsigned G = gridDim.x * gridDim.y * gridDim.z;
    unsigned sum, cnt, mine, sp = 0u;
    for (;;) {
        sum = 0u; cnt = 0u; mine = 0u;
#pragma unroll
        for (unsigned j = 0; j < 16; ++j) { const unsigned c = xb_ld(&bar[XB_XCNT(j)]); sum += c; cnt += (c > 0u) ? 1u : 0u; mine = (j == x) ? c : mine; }
        if (sum == G) break;
        __builtin_amdgcn_s_sleep(1);
        if ((++sp & 255u) == 0u) { if (xb_ld(&bar[XB_TMO])) break; if (sp > XB_SPIN_CAP) { atomicAdd(&bar[XB_TMO], 1u); break; } }
    }
    nloc = mine > 0u ? mine : 1u; nx = cnt > 0u ? cnt : 1u;
}

__device__ __forceinline__ void xcd_barrier(const XcdBarrier& b) {
    asm volatile("s_waitcnt vmcnt(0)" ::: "memory");
    __syncthreads();
    if (threadIdx.x == 0) {
        unsigned* bar = b.bar;
        __builtin_amdgcn_s_waitcnt(0);
        unsigned nloc = b.st[0], nx = b.st[1];
        if (nloc == 0u) { xcd_barrier_complete(bar, b.x, nloc, nx); b.st[0] = nloc; b.st[1] = nx; }
        const unsigned old = xb_add(&bar[XB_XSUB(b.x)], 1u);
        const unsigned gen = old / nloc;
        if (old + 1u == (gen + 1u) * nloc) {
            __builtin_amdgcn_fence(__ATOMIC_RELEASE, "agent");
            asm volatile("s_waitcnt vmcnt(0)" ::: "memory");
            const unsigned og = xb_add(&bar[XB_TOP], 1u);
            const unsigned tg = og / nx;
            if (og + 1u == (tg + 1u) * nx) xb_add(&bar[XB_TOPGEN], 1u);
            else XB_SPIN(xb_ld(&bar[XB_TOPGEN]) == tg, bar);
            __builtin_amdgcn_fence(__ATOMIC_ACQUIRE, "agent");
            xb_add(&bar[XB_XGEN(b.x)], 1u);
            asm volatile("s_waitcnt vmcnt(0)" ::: "memory");
        } else {
            XB_SPIN(xb_ld(&bar[XB_XGEN(b.x)]) == gen, bar);
            __builtin_amdgcn_fence(__ATOMIC_ACQUIRE, "agent");
            asm volatile("s_waitcnt vmcnt(0)" ::: "memory");
        }
    }
    __syncthreads();
}


struct Args { const float* in[27]; float* out; unsigned char* ws; int ph_lo, ph_hi, li, pad; };

__device__ __forceinline__ void transpose_item(const float* W, int ldw, int K, bf16* WT, int drow0, LAS float* scr, int k0, int n0, int lane) {
#pragma unroll 8
    for (int i = 0; i < 32; ++i) { const int kk = 2 * i + (lane >> 5); scr[kk * 33 + (lane & 31)] = W[(size_t)(k0 + kk) * ldw + n0 + (lane & 31)]; }
    LDS_WAIT();
    const int c = lane & 7;
#pragma unroll
    for (int j = 0; j < 4; ++j) { const int n = (lane >> 3) + 8 * j; const LAS float* s = scr + (8 * c) * 33 + n;
        v4u o; o.x = pk2(s[0 * 33], s[1 * 33]); o.y = pk2(s[2 * 33], s[3 * 33]); o.z = pk2(s[4 * 33], s[5 * 33]); o.w = pk2(s[6 * 33], s[7 * 33]);
        *(v4u*)(WT + (size_t)(drow0 + n) * K + k0 + 8 * c) = o; }
    LDS_WAIT();
}
__device__ __forceinline__ int win_dest_row(int n) { return n < 1024 ? n : (n < 2048 ? n + 3328 : (n < 5376 ? n - 1024 : n)); }
__device__ __forceinline__ const float* xrow_ptr(const float* xp, const float* xs, int m) { return m < 32768 ? xp + (size_t)m * D : xs + (size_t)(m - 32768) * D; }

__device__ __forceinline__ void p0_prologue(const Args& a, unsigned char* ws, LAS unsigned char* lds, int gw, int NGW, int wave, int lane) {
    LAS float* scr = (LAS float*)(lds + wave * 16384);
    constexpr int I_IN = (D / 64) * (NIN / 32), I_GLU = (1024 / 64) * (1024 / 32), I_SO = (1024 / 64) * (2048 / 32), I_WO = (2048 / 64) * (2048 / 32);
    constexpr int NITEMS = I_IN + I_GLU + 2 * I_SO + I_WO;
    for (int it = gw; it < NITEMS; it += NGW) {
        int r = it;
        if (r < I_IN) { const int nblk = NIN / 32, kb = r / nblk, nb = r % nblk; transpose_item(a.in[4], NIN, D, (bf16*)(ws + WS_WT), win_dest_row(32 * nb), scr, 64 * kb, 32 * nb, lane); continue; } r -= I_IN;
        if (r < I_GLU) { const int nblk = 1024 / 32, kb = r / nblk, nb = r % nblk; transpose_item(a.in[13], 1024, 1024, (bf16*)(ws + WS_GLUT), 32 * nb, scr, 64 * kb, 32 * nb, lane); continue; } r -= I_GLU;
        if (r < I_SO) { const int nblk = 2048 / 32, kb = r / nblk, nb = r % nblk; transpose_item(a.in[14], 2048, 1024, (bf16*)(ws + WS_S5OT), 32 * nb, scr, 64 * kb, 32 * nb, lane); continue; } r -= I_SO;
        if (r < I_SO) { const int nblk = 2048 / 32, kb = r / nblk, nb = r % nblk; transpose_item(a.in[25], 2048, 1024, (bf16*)(ws + WS_RWOT), 32 * nb, scr, 64 * kb, 32 * nb, lane); continue; } r -= I_SO;
        { const int nblk = 2048 / 32, kb = r / nblk, nb = r % nblk; transpose_item(a.in[26], 2048, 2048, (bf16*)(ws + WS_WOT), 32 * nb, scr, 64 * kb, 32 * nb, lane); }
    }
    const float* g = a.in[2];
    f32x4 gv[8];
#pragma unroll
    for (int j = 0; j < 8; ++j) gv[j] = ((const f32x4*)g)[lane + 64 * j];
    bf16* HN = (bf16*)(ws + WS_HN);
    for (int m = gw; m < M; m += NGW) {
        const f32x4* xr = (const f32x4*)xrow_ptr(a.in[0], a.in[1], m) + lane;
        f32x4 v[8]; float s = 0.f;
#pragma unroll
        for (int j = 0; j < 8; ++j) { v[j] = xr[64 * j]; s += (v[j].x * v[j].x + v[j].y * v[j].y) + (v[j].z * v[j].z + v[j].w * v[j].w); }
        const float rstd = 1.0f / sqrtf(wave_sum(s) * (1.0f / D) + RMS_EPS);
        v2u* o8 = (v2u*)(HN + (size_t)m * D) + lane;
#pragma unroll
        for (int j = 0; j < 8; ++j) { v2u o; o.x = pk2(v[j].x * rstd * gv[j].x, v[j].y * rstd * gv[j].y); o.y = pk2(v[j].z * rstd * gv[j].z, v[j].w * rstd * gv[j].w); o8[64 * j] = o; }
    }
}

struct Row5 { float r, k, v, w, a; };
__device__ __forceinline__ Row5 rw_load_row(const bf16* RWIN, int base, int L, int t, int c_r, int c_w, int c_a) {
    Row5 o; o.r = o.k = o.v = o.w = o.a = 0.f;
    if (t >= 0 && t < L) { const bf16* p = RWIN + (size_t)(base + t) * DRWIN; o.r = bf2f(p[c_r]); o.k = bf2f(p[1024 + c_r]); o.v = bf2f(p[2048 + c_r]); o.w = bf2f(p[c_w]); o.a = bf2f(p[c_a]); }
    return o;
}
__device__ __forceinline__ void rwkv_naive_job(const Args& a, unsigned char* ws, int job, LAS float* scr, int lane) {
    int s, rem; if (job < 64) { s = job / 32; rem = job % 32; } else { s = 2 + (job - 64) / 32; rem = (job - 64) % 32; }
    const int h = rem >> 1, d = rem & 1;
    const int base = s < 2 ? s * LP : 32768 + (s - 2) * LS, L = s < 2 ? LP : LS;
    const int i = lane, c_r = h * 64 + i, c_w = 3072 + d * 64 + i, c_a = 3200 + d * 64 + i;
    const float* mu = a.in[15];
    const float mu_r = mu[c_r], mu_k = mu[1024 + c_r], mu_v = mu[2048 + c_r], mu_w = mu[c_w], mu_a = mu[c_a];
    const float w0v = a.in[16][d * 1024 + c_r], a0v = a.in[18][d * 1024 + c_r], kkv = a.in[20][c_r], kav = a.in[21][c_r];
    LAS unsigned* wup = (LAS unsigned*)(scr + 448); LAS unsigned* aup = wup + 2048;
    for (int j = 0; j < 32; ++j) {
        wup[j * 64 + i] = pk2(a.in[17][(size_t)(d * 64 + 2 * j) * 1024 + c_r], a.in[17][(size_t)(d * 64 + 2 * j + 1) * 1024 + c_r]);
        aup[j * 64 + i] = pk2(a.in[19][(size_t)(d * 64 + 2 * j) * 1024 + c_r], a.in[19][(size_t)(d * 64 + 2 * j + 1) * 1024 + c_r]);
    }
    LDS_WAIT();
    const bf16* RWIN = (const bf16*)(ws + WS_RWIN);
    bf16* Y = (bf16*)((unsigned char*)a.out + (d ? DO_YB : DO_YF));
    float S[64];
#pragma unroll
    for (int j = 0; j < 64; ++j) S[j] = 0.f;
    const int dstep = d ? -1 : 1;
    int t = d ? L - 1 : 0;
    Row5 beh = rw_load_row(RWIN, base, L, t - dstep, c_r, c_w, c_a), cur = rw_load_row(RWIN, base, L, t, c_r, c_w, c_a), ahd = rw_load_row(RWIN, base, L, t + dstep, c_r, c_w, c_a);
    for (int n = 0; n < L; ++n, t += dstep) {
        const Row5 nx2 = rw_load_row(RWIN, base, L, t + 2 * dstep, c_r, c_w, c_a);
        const float zr = cur.r + (0.5f * (beh.r + ahd.r) - cur.r) * mu_r;
        const float zk = cur.k + (0.5f * (beh.k + ahd.k) - cur.k) * mu_k;
        const float zv = cur.v + (0.5f * (beh.v + ahd.v) - cur.v) * mu_v;
        const float zw = cur.w + (0.5f * (beh.w + ahd.w) - cur.w) * mu_w;
        const float za = cur.a + (0.5f * (beh.a + ahd.a) - cur.a) * mu_a;
        scr[i] = tanhf(zw); scr[64 + i] = za;
        LDS_WAIT();
        float accw = w0v, acca = a0v;
#pragma unroll
        for (int j = 0; j < 16; ++j) {
            const f32x4 tw = *(const LAS f32x4*)(scr + 4 * j), ta = *(const LAS f32x4*)(scr + 64 + 4 * j);
            const unsigned w0p = wup[(2 * j) * 64 + i], w1p = wup[(2 * j + 1) * 64 + i], a0p = aup[(2 * j) * 64 + i], a1p = aup[(2 * j + 1) * 64 + i];
            accw += tw.x * blo(w0p) + tw.y * bhi(w0p) + tw.z * blo(w1p) + tw.w * bhi(w1p);
            acca += ta.x * blo(a0p) + ta.y * bhi(a0p) + ta.z * blo(a1p) + ta.w * bhi(a1p);
        }
        const float dec = __expf(-0.6065306597126334f * sigm(accw));
        const float av = sigm(acca);
        float kk = zk * kkv; const float n2 = wave_sum(kk * kk); kk *= 1.0f / sqrtf(n2 + L2_EPS);
        const float kd = zk * (1.0f + (av - 1.0f) * kav);
        scr[128 + i] = kk; scr[192 + i] = dec; scr[256 + i] = kk * av; scr[320 + i] = kd; scr[384 + i] = zr;
        LDS_WAIT();
        float sa = 0.f;
#pragma unroll
        for (int j = 0; j < 16; ++j) { const f32x4 q = *(const LAS f32x4*)(scr + 128 + 4 * j); sa += S[4 * j] * q.x + S[4 * j + 1] * q.y + S[4 * j + 2] * q.z + S[4 * j + 3] * q.w; }
        sa = -sa;
        float y = 0.f;
#pragma unroll
        for (int j = 0; j < 16; ++j) {
            const f32x4 wq = *(const LAS f32x4*)(scr + 192 + 4 * j), bq = *(const LAS f32x4*)(scr + 256 + 4 * j), kq = *(const LAS f32x4*)(scr + 320 + 4 * j), rq = *(const LAS f32x4*)(scr + 384 + 4 * j);
            S[4 * j + 0] = S[4 * j + 0] * wq.x + sa * bq.x + zv * kq.x; y += S[4 * j + 0] * rq.x;
            S[4 * j + 1] = S[4 * j + 1] * wq.y + sa * bq.y + zv * kq.y; y += S[4 * j + 1] * rq.y;
            S[4 * j + 2] = S[4 * j + 2] * wq.z + sa * bq.z + zv * kq.z; y += S[4 * j + 2] * rq.z;
            S[4 * j + 3] = S[4 * j + 3] * wq.w + sa * bq.w + zv * kq.w; y += S[4 * j + 3] * rq.w;
        }
        Y[(size_t)(base + t) * DRW + c_r] = (bf16)f2bf(y);
        LDS_WAIT();
        beh = cur; cur = ahd; ahd = nx2;
    }
}
__device__ __forceinline__ void s5_naive_job(const Args& a, unsigned char* ws, int job, LAS float* scr, int lane) {
    int s, rem; if (job < 256) { s = job / 128; rem = job % 128; } else { s = 2 + (job - 256) / 128; rem = (job - 256) % 128; }
    const int g = rem >> 1, d = rem & 1, p = lane;
    const int base = s < 2 ? s * LP : 32768 + (s - 2) * LS, L = s < 2 ? LP : LS;
    const int gi = d * 64 + g;
    const float lre = a.in[5][gi * 64 + p], lim = a.in[6][gi * 64 + p], dt = expf(a.in[7][gi]);
    const float er = expf(lre * dt); float sn, cs; sincosf(lim * dt, &sn, &cs);
    const float lbr = er * cs, lbi = er * sn;
    const float nr = lbr - 1.0f, ni = lbi, den = lre * lre + lim * lim;
    const float cfr = (nr * lre + ni * lim) / den, cfi = (ni * lre - nr * lim) / den;
    float Bre[16], Bim[16], Cre[16], Cim[16];
#pragma unroll
    for (int h = 0; h < 16; ++h) {
        const float br = a.in[8][((size_t)gi * 64 + p) * 16 + h], bi = a.in[9][((size_t)gi * 64 + p) * 16 + h];
        Bre[h] = cfr * br - cfi * bi; Bim[h] = cfr * bi + cfi * br;
        Cre[h] = a.in[10][((size_t)gi * 16 + h) * 64 + p]; Cim[h] = a.in[11][((size_t)gi * 16 + h) * 64 + p];
    }
    const bf16* U = (const bf16*)(ws + WS_S5U);
    bf16* Y = (bf16*)((unsigned char*)a.out + (d ? DO_SB : DO_SF));
    float xr = 0.f, xi = 0.f;
    for (int n = 0; n < L; n += 4) {
        float part[64];
#pragma unroll
        for (int tk = 0; tk < 4; ++tk) {
            const int t = d ? L - 1 - (n + tk) : n + tk;
            const v4u* up = (const v4u*)(U + (size_t)(base + t) * DS5 + g * 16);
            const v4u u0 = up[0], u1 = up[1];
            const float u[16] = {blo(u0.x), bhi(u0.x), blo(u0.y), bhi(u0.y), blo(u0.z), bhi(u0.z), blo(u0.w), bhi(u0.w), blo(u1.x), bhi(u1.x), blo(u1.y), bhi(u1.y), blo(u1.z), bhi(u1.z), blo(u1.w), bhi(u1.w)};
            float bur = 0.f, bui = 0.f;
#pragma unroll
            for (int h = 0; h < 16; ++h) { bur += Bre[h] * u[h]; bui += Bim[h] * u[h]; }
            const float nxr = lbr * xr - lbi * xi + bur, nxi = lbr * xi + lbi * xr + bui; xr = nxr; xi = nxi;
#pragma unroll
            for (int h = 0; h < 16; ++h) part[tk * 16 + h] = Cre[h] * xr - Cim[h] * xi;
        }
#pragma unroll
        for (int j = 0; j < 64; ++j) scr[p * 65 + j] = part[j];
        LDS_WAIT();
        float sum = 0.f;
#pragma unroll
        for (int l = 0; l < 64; ++l) sum += scr[l * 65 + p];
        const int tk = p >> 4, h = p & 15, t = d ? L - 1 - (n + tk) : n + tk;
        Y[(size_t)(base + t) * DS5 + g * 16 + h] = (bf16)f2bf(sum);
        LDS_WAIT();
    }
}

__device__ __forceinline__ void unpack8(const bf16* p, float (&o)[8]) {
    const v4u a = *(const v4u*)p;
    o[0] = blo(a.x); o[1] = bhi(a.x); o[2] = blo(a.y); o[3] = bhi(a.y); o[4] = blo(a.z); o[5] = bhi(a.z); o[6] = blo(a.w); o[7] = bhi(a.w);
}
__device__ __forceinline__ void pack8(bf16* p, const float (&v)[8]) {
    v4u a; a.x = pk2(v[0], v[1]); a.y = pk2(v[2], v[3]); a.z = pk2(v[4], v[5]); a.w = pk2(v[6], v[7]); *(v4u*)p = a;
}
__device__ __forceinline__ void p3_finalize(const Args& a, unsigned char* ws, int gw, int NGW, int lane) {
    const bf16* U = (const bf16*)(ws + WS_S5U); const bf16* RWIN = (const bf16*)(ws + WS_RWIN); bf16* Z = (bf16*)(ws + WS_Z);
    unsigned char* ob = (unsigned char*)a.out;
    const bf16* SF = (const bf16*)(ob + DO_SF); const bf16* SB = (const bf16*)(ob + DO_SB); bf16* YF = (bf16*)(ob + DO_YF); const bf16* YB = (const bf16*)(ob + DO_YB);
    const int half = gw & 1, c0 = half * 512 + lane * 8;
    float dv[8], lnw[8], lnb[8], rk[8], mur[8], muk[8], muv[8];
#pragma unroll
    for (int j = 0; j < 8; ++j) { dv[j] = a.in[12][c0 + j]; lnw[j] = a.in[23][c0 + j]; lnb[j] = a.in[24][c0 + j]; rk[j] = a.in[22][c0 + j]; mur[j] = a.in[15][c0 + j]; muk[j] = a.in[15][1024 + c0 + j]; muv[j] = a.in[15][2048 + c0 + j]; }
    for (int m = gw >> 1; m < M; m += NGW >> 1) {
        const int t = m < 32768 ? (m & (LP - 1)) : ((m - 32768) & (LS - 1)), L = m < 32768 ? LP : LS;
        const bool hp = t > 0, hn = t < L - 1;
        float o[8];
        {
            float u[8], f[8], b[8];
            unpack8(U + (size_t)m * DS5 + c0, u); unpack8(SF + (size_t)m * DS5 + c0, f); unpack8(SB + (size_t)m * DS5 + c0, b);
#pragma unroll
            for (int j = 0; j < 8; ++j) o[j] = gelu_tanh(dv[j] * u[j] + f[j] + b[j]);
            pack8(Z + (size_t)m * DS5 + c0, o);
        }
        float y[8];
        {
            float yf[8], yb[8];
            unpack8(YF + (size_t)m * DRW + c0, yf); unpack8(YB + (size_t)m * DRW + c0, yb);
#pragma unroll
            for (int j = 0; j < 8; ++j) y[j] = yf[j] + yb[j];
        }
        float s1 = 0.f;
#pragma unroll
        for (int j = 0; j < 8; ++j) s1 += y[j];
        s1 += __shfl_xor(s1, 1); s1 += __shfl_xor(s1, 2); s1 += __shfl_xor(s1, 4);
        const float mean = s1 * (1.0f / 64.0f);
        float s2 = 0.f;
#pragma unroll
        for (int j = 0; j < 8; ++j) { const float dd = y[j] - mean; s2 += dd * dd; }
        s2 += __shfl_xor(s2, 1); s2 += __shfl_xor(s2, 2); s2 += __shfl_xor(s2, 4);
        const float rstd = 1.0f / sqrtf(s2 * (1.0f / 64.0f) + GN_EPS);
        float zr[8], zk[8], zv[8];
        const bf16* pc = RWIN + (size_t)m * DRWIN + c0;
#pragma unroll
        for (int comp = 0; comp < 3; ++comp) {
            float cc[8], pp[8], nn[8];
            unpack8(pc + comp * 1024, cc);
            if (hp) unpack8(pc - DRWIN + comp * 1024, pp); else {
#pragma unroll
                for (int j = 0; j < 8; ++j) pp[j] = 0.f; }
            if (hn) unpack8(pc + DRWIN + comp * 1024, nn); else {
#pragma unroll
                for (int j = 0; j < 8; ++j) nn[j] = 0.f; }
#pragma unroll
            for (int j = 0; j < 8; ++j) {
                const float muc = comp == 0 ? mur[j] : (comp == 1 ? muk[j] : muv[j]);
                const float zz = cc[j] + (0.5f * (pp[j] + nn[j]) - cc[j]) * muc;
                if (comp == 0) zr[j] = zz; else if (comp == 1) zk[j] = zz; else zv[j] = zz;
            }
        }
        float dot = 0.f;
#pragma unroll
        for (int j = 0; j < 8; ++j) dot += zr[j] * zk[j] * rk[j];
        dot += __shfl_xor(dot, 1); dot += __shfl_xor(dot, 2); dot += __shfl_xor(dot, 4);
#pragma unroll
        for (int j = 0; j < 8; ++j) o[j] = (y[j] - mean) * rstd * lnw[j] + lnb[j] + dot * zv[j];
        pack8(YF + (size_t)m * DRW + c0, o);
    }
}

__device__ __forceinline__ void p12_final(const Args& a, int gw, int NGW, int lane) {
    const float* g = a.in[3];
    f32x4 gv[8];
#pragma unroll
    for (int j = 0; j < 8; ++j) gv[j] = ((const f32x4*)g)[lane + 64 * j];
    for (int m = gw; m < M; m += NGW) {
        const f32x4* xr = (const f32x4*)xrow_ptr(a.in[0], a.in[1], m) + lane;
        f32x4* orow = (f32x4*)(a.out + (size_t)m * D) + lane;
        f32x4 v[8]; float s = 0.f;
#pragma unroll
        for (int j = 0; j < 8; ++j) { v[j] = orow[64 * j]; s += (v[j].x * v[j].x + v[j].y * v[j].y) + (v[j].z * v[j].z + v[j].w * v[j].w); }
        const float rstd = 1.0f / sqrtf(wave_sum(s) * (1.0f / D) + RMS_EPS);
#pragma unroll
        for (int j = 0; j < 8; ++j) { const f32x4 xv = xr[64 * j]; orow[64 * j] = xv + v[j] * rstd * gv[j]; }
    }
}

__global__ void __launch_bounds__(NWAVES * 64, 2) mk_fwd(Args args) {
    extern __shared__ __attribute__((aligned(16))) unsigned char lds_raw[];
    LAS unsigned char* lds = (LAS unsigned char*)lds_raw;
    volatile LAS unsigned* MISC = (volatile LAS unsigned*)(lds + MISC_OFF);
    const int tid = threadIdx.x, lane = tid & 63, wave = __builtin_amdgcn_readfirstlane(tid >> 6);
    const int G = gridDim.x; const int bx = blockIdx.x; const int vcu = (G % 8 == 0) ? (bx % 8) * (G / 8) + bx / 8 : bx;
    unsigned char* ws = args.ws;
    unsigned* ctl = (unsigned*)(ws + WS_CTL);
    for (int u = tid; u < (LDS_BYTES - MISC_OFF) / 4; u += NWAVES * 64) ((LAS unsigned*)(lds + MISC_OFF))[u] = 0u;
    __syncthreads();
    XcdBarrier bar; bar.bar = ctl + CW_BAR; bar.x = 0; bar.st = nullptr;
    if (N_LAUNCHES == 1) bar = xcd_barrier_post(ctl + CW_BAR, MISC + 8);
#define GRID_BAR() do { if (N_LAUNCHES == 1) xcd_barrier(bar); } while (0)
    const int lo = args.ph_lo, hi = args.ph_hi;
#ifndef ONLY_PHASE
#define ONLY_PHASE -1
#endif
#define IN(k) ((ONLY_PHASE < 0 || ONLY_PHASE == (k)) && lo <= (k) && (k) < hi)
#define BOTH(k) (IN(k) && IN((k) + 1))
    const int gw = vcu * NWAVES + wave, NGW = G * NWAVES;
    bf16* WT = (bf16*)(ws + WS_WT); bf16* HN = (bf16*)(ws + WS_HN); bf16* S5U = (bf16*)(ws + WS_S5U); bf16* RWIN = (bf16*)(ws + WS_RWIN); bf16* Z = (bf16*)(ws + WS_Z);
    bf16* YN = (bf16*)((unsigned char*)args.out + DO_YF); bf16* Q = (bf16*)((unsigned char*)args.out + DO_Q); bf16* P = RWIN;

    if (IN(0)) { p0_prologue(args, ws, lds, gw, NGW, wave, lane); if (BOTH(0)) GRID_BAR(); }
    if (IN(1)) {
        pg8::Gemm g{HN, WT, M, 4352, D}; pg8::StaticOrder S; S.init(M, 4352, G, bx);
        pg8::EpiG1 E{S5U, RWIN};
        pg8::gemm_phase<pg8::EpiG1, pg8::StaticOrder, PG8_ALIGN, PG8_SP2>(lds, g, S, E);
        if (BOTH(1)) GRID_BAR();
    }
    if (IN(2)) {
        LAS float* scr = (LAS float*)(lds + wave * WAVE_SCR);
        const int gwt = wave * G + vcu;
#ifndef NO_RWJOB
        if (gwt < 576) rwkv_naive_job(args, ws, gwt, scr, lane);
#endif
        const int q = (gwt - 576 + NGW) % NGW;
        for (int rnd = 0; rnd < 2; ++rnd) {
            const int j = rnd == 0 ? q : ((q >= 1024 && q < 1280) ? 2048 + (q - 1024) : -1);
#ifndef NO_S5JOB
            if (j >= 0 && j < 2304) s5_naive_job(args, ws, j, scr, lane);
#endif
        }
        if (BOTH(2)) GRID_BAR();
    }
    if (IN(3)) { p3_finalize(args, ws, gw, NGW, lane); if (BOTH(3)) GRID_BAR(); }
    if (IN(4)) {
        pg8::Gemm g{Z, (const bf16*)(ws + WS_GLUT), M, 1024, 1024}; pg8::StaticOrder S; S.init(M, 1024, G, bx);
        pg8::EpiMix<1> E{S5U, Z, nullptr, 1024};
        pg8::gemm_phase<pg8::EpiMix<1>, pg8::StaticOrder, PG8_ALIGN, PG8_SP2>(lds, g, S, E);
        if (BOTH(4)) GRID_BAR();
    }
    if (IN(5)) {
        pg8::Gemm g{HN, WT + (size_t)4352 * D, M, 1024, D}; pg8::StaticOrder S; S.init(M, 1024, G, bx);
        pg8::EpiMix<2> E{S5U, S5U, nullptr, 1024};
        pg8::gemm_phase<pg8::EpiMix<2>, pg8::StaticOrder, PG8_ALIGN, PG8_SP2>(lds, g, S, E);
        if (BOTH(5)) GRID_BAR();
    }
    if (IN(6)) {
        pg8::Gemm g{HN, WT + (size_t)5376 * D, M, 1024, D}; pg8::StaticOrder S; S.init(M, 1024, G, bx);
        pg8::EpiMix<2> E{YN, YN, nullptr, 1024};
        pg8::gemm_phase<pg8::EpiMix<2>, pg8::StaticOrder, PG8_ALIGN, PG8_SP2>(lds, g, S, E);
        if (BOTH(6)) GRID_BAR();
    }
    if (IN(7)) {
        pg8::Gemm g{S5U, (const bf16*)(ws + WS_S5OT), M, 2048, 1024}; pg8::StaticOrder S; S.init(M, 2048, G, bx);
        pg8::EpiMix<0> E{P, nullptr, nullptr, 2048};
        pg8::gemm_phase<pg8::EpiMix<0>, pg8::StaticOrder, PG8_ALIGN, PG8_SP2>(lds, g, S, E);
        if (BOTH(7)) GRID_BAR();
    }
    if (IN(8)) {
        pg8::Gemm g{HN, WT + (size_t)6400 * D, M, 2048, D}; pg8::StaticOrder S; S.init(M, 2048, G, bx);
        pg8::EpiMix<1> E{P, P, nullptr, 2048};
        pg8::gemm_phase<pg8::EpiMix<1>, pg8::StaticOrder, PG8_ALIGN, PG8_SP2>(lds, g, S, E);
        if (BOTH(8)) GRID_BAR();
    }
    if (IN(9)) {
        pg8::Gemm g{YN, (const bf16*)(ws + WS_RWOT), M, 2048, 1024}; pg8::StaticOrder S; S.init(M, 2048, G, bx);
        pg8::EpiMix<0> E{Q, nullptr, nullptr, 2048};
        pg8::gemm_phase<pg8::EpiMix<0>, pg8::StaticOrder, PG8_ALIGN, PG8_SP2>(lds, g, S, E);
        if (BOTH(9)) GRID_BAR();
    }
    if (IN(10)) {
        pg8::Gemm g{HN, WT + (size_t)8448 * D, M, 2048, D}; pg8::StaticOrder S; S.init(M, 2048, G, bx);
        pg8::EpiMix<3> E{P, Q, P, 2048};
        pg8::gemm_phase<pg8::EpiMix<3>, pg8::StaticOrder, PG8_ALIGN, PG8_SP2>(lds, g, S, E);
        if (BOTH(10)) GRID_BAR();
    }
    if (IN(11)) {
        pg8::Gemm g{P, (const bf16*)(ws + WS_WOT), M, 2048, D}; pg8::StaticOrder S; S.init(M, 2048, G, bx);
        pg8::EpiF32 E{args.out, 2048};
        pg8::gemm_phase<pg8::EpiF32, pg8::StaticOrder, PG8_ALIGN, PG8_SP2>(lds, g, S, E);
        if (BOTH(11)) GRID_BAR();
    }
    if (IN(12)) { p12_final(args, gw, NGW, lane); }
#undef IN
#undef BOTH
}

extern "C" void kernel_launch(void* const* d_in, const int* in_sizes, int n_in, void* d_out, int out_size, void* d_ws, size_t ws_size, hipStream_t stream) {
    static int grid = 0;
    if (grid == 0) {
        if (n_in != 27 || out_size != 2 * 32768 * D || ws_size < WS_END) { fprintf(stderr, "kernel_launch: unexpected shapes (n_in %d out %d ws %zu)\n", n_in, out_size, ws_size); grid = -1; return; }
        int dev = 0, cus = 0, per_cu = 0;
        if (hipGetDevice(&dev) != hipSuccess || hipDeviceGetAttribute(&cus, hipDeviceAttributeMultiprocessorCount, dev) != hipSuccess) { grid = -1; return; }
        if (hipFuncSetAttribute((const void*)mk_fwd, hipFuncAttributeMaxDynamicSharedMemorySize, LDS_BYTES) != hipSuccess) { fprintf(stderr, "kernel_launch: hipFuncSetAttribute failed\n"); grid = -1; return; }
        if (hipOccupancyMaxActiveBlocksPerMultiprocessor(&per_cu, (const void*)mk_fwd, NWAVES * 64, LDS_BYTES) != hipSuccess || per_cu < 1)
            fprintf(stderr, "kernel_launch: note: occupancy query reports %d workgroups per CU\n", per_cu);
        (void)hipGetLastError();
        grid = cus;
    }
    if (grid < 0) return;
    if (hipMemsetAsync((char*)d_ws + WS_CTL, 0, CTL_ZERO_BYTES, stream) != hipSuccess) return;
    Args a{};
    for (int i = 0; i < 27; ++i) a.in[i] = (const float*)d_in[i];
    a.out = (float*)d_out; a.ws = (unsigned char*)d_ws; a.pad = 0;
    for (int li = 0; li < N_LAUNCHES; ++li) {
        if (N_LAUNCHES == 1) { a.ph_lo = 0; a.ph_hi = N_PHASES; } else { a.ph_lo = li * N_PHASES / N_LAUNCHES; a.ph_hi = (li + 1) * N_PHASES / N_LAUNCHES; }
        a.li = li;
        hipLaunchKernelGGL(mk_fwd, dim3(grid), dim3(NWAVES * 64), LDS_BYTES, stream, a);
        const hipError_t le = hipPeekAtLastError();
        if (le != hipSuccess) { fprintf(stderr, "kernel_launch: launch %d failed: %s\n", li, hipGetErrorName(le)); break; }
    }
}
```

```cpp
#include <hip/hip_runtime.h>
#include <cstdio>
#include <cstdint>
#define MK_N_LAUNCHES 1
__device__ __forceinline__ int mk_lane() { int l; asm volatile("v_mbcnt_lo_u32_b32 %0, -1, 0\n\tv_mbcnt_hi_u32_b32 %0, -1, %0" : "=v"(l)); return l; }
namespace pg8 {
#define PG8_LAS __attribute__((address_space(3)))
typedef unsigned short bf16_t;
typedef short bf16x8 __attribute__((ext_vector_type(8)));
typedef float f32x4 __attribute__((ext_vector_type(4)));
typedef unsigned u32x4 __attribute__((ext_vector_type(4)));
constexpr int BM = 256, BK = 64, HALF = 128, HTB = HALF * BK * 2  , STAGE_BYTES = 8 * HTB, NXCD = 8, WGM = 8;

__host__ __device__ __forceinline__ int lds_byte(int r, int c) { const int st = (r >> 4) * 2 + (c >> 5), rr = r & 15, cc = c & 31, ob = rr * 64 + cc * 2; return st * 1024 + (ob ^ (((ob >> 9) & 1) << 5)); }
__host__ __device__ __forceinline__ void stage_rc(int b, int& R, int& C) { const int st = b / 1024, sb = b % 1024, swz = sb ^ (((sb >> 9) & 1) << 5); R = (st >> 1) * 16 + swz / 64; C = (st & 1) * 32 + (swz % 64) / 2; }
__host__ __device__ __forceinline__ int perm32(int rho) { const int n = rho >> 4, i = rho & 15; return 8 * (i >> 2) + 4 * n + (i & 3); }

struct Unit { int pm, pn; };
struct Gemm { const bf16_t* A; const bf16_t* Bt; int M, N, K; };

struct StaticOrder {
    int nM, nN, nwg, G, c;
    __host__ __device__ void init(int M, int N, int G_, int c_) { nM = M / BM; nN = N / BM; nwg = nM * nN; G = G_; c = c_; }
    __host__ __device__ bool next(int i, Unit& u) const {
        const long L = (long)i * G + c; if (L >= nwg) return false;
        int wgid = (int)L; { const int q = nwg / NXCD, r = nwg % NXCD, xcd = wgid % NXCD, off = wgid / NXCD; wgid = (xcd < r ? xcd * (q + 1) : r * (q + 1) + (xcd - r) * q) + off; }
        const int nig = WGM * nN, gid = wgid / nig, fm = gid * WGM, gsz = (nM - fm) < WGM ? (nM - fm) : WGM;
        u.pm = fm + ((wgid % nig) % gsz); u.pn = (wgid % nig) / gsz; return true;
    }
    __device__ __forceinline__ void a_ready(const Unit&) const {}
    __device__ __forceinline__ void done(const Unit&) const {}
};

__device__ __forceinline__ unsigned cvt_pk_bf16(float lo, float hi) { unsigned r; asm volatile("v_cvt_pk_bf16_f32 %0, %1, %2" : "=v"(r) : "v"(lo), "v"(hi)); return r; }

__device__ __forceinline__ float bf_lo(unsigned u) { return __uint_as_float(u << 16); }
__device__ __forceinline__ float bf_hi(unsigned u) { return __uint_as_float(u & 0xffff0000u); }
__device__ __forceinline__ float sigmoid_f(float v) { return __builtin_amdgcn_rcpf(1.0f + __expf(-v)); }

struct EpiG1 {
    static constexpr bool PERM = true, AFTER_DRAIN = false;
    bf16_t* s5u; bf16_t* rwin;
    __device__ __forceinline__ void operator()(const f32x4 (&acc)[2][2][4][2], const Unit& u, int wr, int wc, int fr, int fq) const {
        const int row0 = u.pm * BM + wr * 64 + fr; int colt = u.pn * BM; bf16_t* base; int ld;
        if (colt < 1024) { base = s5u; ld = 1024; } else { base = rwin; ld = 3328; colt -= 1024; }
        const int col0 = colt + wc * 32 + 8 * fq;
#pragma unroll
        for (int ai = 0; ai < 2; ++ai)
#pragma unroll
            for (int m = 0; m < 4; ++m) { bf16_t* rowp = base + (size_t)(row0 + ai * HALF + m * 16) * ld + col0;
#pragma unroll
                for (int bj = 0; bj < 2; ++bj) { const f32x4 v0 = acc[ai][bj][m][0], v1 = acc[ai][bj][m][1];
                    u32x4 w; w.x = cvt_pk_bf16(v0[0], v0[1]); w.y = cvt_pk_bf16(v0[2], v0[3]); w.z = cvt_pk_bf16(v1[0], v1[1]); w.w = cvt_pk_bf16(v1[2], v1[3]);
                    *(u32x4*)(rowp + bj * HALF) = w; } }
    }
};
template <int MODE> struct EpiMix {
    static constexpr bool PERM = true, AFTER_DRAIN = false;
    bf16_t* O; const bf16_t* S; const bf16_t* Add; int ld;
    __device__ __forceinline__ void operator()(const f32x4 (&acc)[2][2][4][2], const Unit& u, int wr, int wc, int fr, int fq) const {
        const int row0 = u.pm * BM + wr * 64 + fr, col0 = u.pn * BM + wc * 32 + 8 * fq;
#pragma unroll
        for (int ai = 0; ai < 2; ++ai)
#pragma unroll
            for (int m = 0; m < 4; ++m) {
#pragma unroll
                for (int bj = 0; bj < 2; ++bj) {
                    const size_t off = (size_t)(row0 + ai * HALF + m * 16) * ld + col0 + bj * HALF;
                    float v[8];
#pragma unroll
                    for (int j = 0; j < 4; ++j) { v[j] = acc[ai][bj][m][0][j]; v[4 + j] = acc[ai][bj][m][1][j]; }
                    if (MODE >= 1) {
                        const u32x4 s = *(const u32x4*)(S + off);
                        const float sv[8] = {bf_lo(s.x), bf_hi(s.x), bf_lo(s.y), bf_hi(s.y), bf_lo(s.z), bf_hi(s.z), bf_lo(s.w), bf_hi(s.w)};
#pragma unroll
                        for (int j = 0; j < 8; ++j) { const float sg = sigmoid_f(v[j]); v[j] = (MODE == 2) ? sv[j] * v[j] * sg : sv[j] * sg; }
                    }
                    if (MODE == 3) {
                        const u32x4 a = *(const u32x4*)(Add + off);
                        const float av[8] = {bf_lo(a.x), bf_hi(a.x), bf_lo(a.y), bf_hi(a.y), bf_lo(a.z), bf_hi(a.z), bf_lo(a.w), bf_hi(a.w)};
#pragma unroll
                        for (int j = 0; j < 8; ++j) v[j] += av[j];
                    }
                    u32x4 w; w.x = cvt_pk_bf16(v[0], v[1]); w.y = cvt_pk_bf16(v[2], v[3]); w.z = cvt_pk_bf16(v[4], v[5]); w.w = cvt_pk_bf16(v[6], v[7]);
                    *(u32x4*)(O + off) = w;
                }
            }
    }
};
struct EpiF32 {
    static constexpr bool PERM = false, AFTER_DRAIN = false;
    float* C; int ldc;
    __device__ __forceinline__ void operator()(const f32x4 (&acc)[2][2][4][2], const Unit& u, int wr, int wc, int fr, int fq) const {
        const int row0 = u.pm * BM + wr * 64 + fr, col0 = u.pn * BM + wc * 32 + 4 * fq;
#pragma unroll
        for (int ai = 0; ai < 2; ++ai)
#pragma unroll
            for (int m = 0; m < 4; ++m) { float* rowp = C + (size_t)(row0 + ai * HALF + m * 16) * ldc + col0;
#pragma unroll
                for (int bj = 0; bj < 2; ++bj)
#pragma unroll
                    for (int n = 0; n < 2; ++n) *(f32x4*)(rowp + bj * HALF + n * 16) = acc[ai][bj][m][n]; }
    }
};
template <class Epi, class Sched, bool ALIGN_EPI = false, bool SP2 = false>
__device__ __forceinline__ void gemm_phase(PG8_LAS unsigned char* lds, const Gemm g, const Sched& S, const Epi& E, const int mk_wave) {
    const int lane = mk_lane(), wid = mk_wave, tid = wid * 64 + lane, wr = wid >> 2, wc = wid & 3, fr = lane & 15, fq = lane >> 4;
    const int K = g.K, nt = K / BK;
    unsigned voffA[2], voffB[2];
#pragma unroll
    for (int i = 0; i < 2; ++i) { int R, C; stage_rc(tid * 16 + i * 8192, R, C); const int Rb = Epi::PERM ? ((R & ~31) + perm32(R & 31)) : R;
        voffA[i] = (unsigned)(R * K + C) * 2u; voffB[i] = (unsigned)(Rb * K + C) * 2u; }
    const size_t kstep = (size_t)(BK * 2);
    const size_t hstep = (size_t)HALF * K * 2;
    const size_t tstep = 2 * hstep;
    const unsigned ldsw = (unsigned)wid * 1024u;
    const int aoff = lds_byte(wr * 64 + fr, fq * 8), boff = lds_byte(wc * 32 + fr, fq * 8);
#define PG8_SA(b, h) (((b) * 2 + (h)) * HTB)
#define PG8_SB(b, h) ((4 + (b) * 2 + (h)) * HTB)
#define PG8_STAGE(bufoff, gbase, voff) do { _Pragma("unroll") for (int _i = 0; _i < 2; ++_i) \
        __builtin_amdgcn_global_load_lds((const unsigned*)((const char*)(gbase) + (voff)[_i]), (PG8_LAS unsigned*)(lds + (bufoff) + ldsw + _i * 8192), 16, 0, 0); } while (0)
#define PG8_LDA(dst, b, h) do { _Pragma("unroll") for (int m = 0; m < 4; ++m) _Pragma("unroll") for (int k = 0; k < 2; ++k) dst[m][k] = *(const PG8_LAS bf16x8*)(lds + PG8_SA(b, h) + aoff + m * 2048 + k * 1024); } while (0)
#define PG8_LDB(dst, b, h) do { _Pragma("unroll") for (int n = 0; n < 2; ++n) _Pragma("unroll") for (int k = 0; k < 2; ++k) dst[n][k] = *(const PG8_LAS bf16x8*)(lds + PG8_SB(b, h) + boff + n * 2048 + k * 1024); } while (0)
#define PG8_MMA(ai, bj, At, Bt) do { __builtin_amdgcn_s_setprio(1); _Pragma("unroll") for (int m = 0; m < 4; ++m) _Pragma("unroll") for (int n = 0; n < 2; ++n) _Pragma("unroll") for (int k = 0; k < 2; ++k) \
        acc[ai][bj][m][n] = __builtin_amdgcn_mfma_f32_16x16x32_bf16(Bt[n][k], At[m][k], acc[ai][bj][m][n], 0, 0, 0); __builtin_amdgcn_s_setprio(0); } while (0)
#define PG8_WAIT_V(n) asm volatile("s_waitcnt vmcnt(" #n ")" ::: "memory")
#define PG8_WAIT_L(n) asm volatile("s_waitcnt lgkmcnt(" #n ")" ::: "memory")
#define PG8_BAR __builtin_amdgcn_s_barrier()
#define PG8_SCHED __builtin_amdgcn_sched_barrier(0)
    Unit cur, nxt; int ui = 0;
    if (!S.next(0, cur)) return;
    f32x4 acc[2][2][4][2];
#pragma unroll
    for (int a = 0; a < 2; ++a)
#pragma unroll
        for (int b = 0; b < 2; ++b)
#pragma unroll
            for (int m = 0; m < 4; ++m)
#pragma unroll
                for (int n = 0; n < 2; ++n) acc[a][b][m][n] = (f32x4){0.f, 0.f, 0.f, 0.f};
    bf16x8 At[4][2], B0[2][2], B1[2][2];
    const char* cA = (const char*)g.A + (size_t)cur.pm * tstep; const char* cB = (const char*)g.Bt + (size_t)cur.pn * tstep;
    S.a_ready(cur);
    if constexpr (SP2) {
        PG8_STAGE(PG8_SB(0, 0), cB, voffB); PG8_STAGE(PG8_SB(0, 1), cB + hstep, voffB); PG8_STAGE(PG8_SA(0, 0), cA, voffA); PG8_STAGE(PG8_SA(0, 1), cA + hstep, voffA);
        if (wr == 1) PG8_BAR;
        PG8_WAIT_V(2); PG8_BAR;
        PG8_STAGE(PG8_SB(1, 0), cB + kstep, voffB); PG8_STAGE(PG8_SA(1, 0), cA + kstep, voffA); PG8_STAGE(PG8_SB(1, 1), cB + hstep + kstep, voffB);
        PG8_WAIT_V(6); PG8_BAR;
    } else {
        PG8_STAGE(PG8_SB(0, 0), cB, voffB); PG8_STAGE(PG8_SA(0, 0), cA, voffA); PG8_STAGE(PG8_SB(0, 1), cB + hstep, voffB); PG8_STAGE(PG8_SA(0, 1), cA + hstep, voffA);
        if (wr == 1) PG8_BAR;
        PG8_WAIT_V(4); PG8_BAR;
        PG8_STAGE(PG8_SB(1, 0), cB + kstep, voffB); PG8_STAGE(PG8_SA(1, 0), cA + kstep, voffA); PG8_STAGE(PG8_SB(1, 1), cB + hstep + kstep, voffB);
        PG8_WAIT_V(6); PG8_BAR;
    }
    for (;;) {
        const bool has_next = S.next(ui + 1, nxt);
        const char* nA = has_next ? (const char*)g.A + (size_t)nxt.pm * tstep : cA; const char* nB = has_next ? (const char*)g.Bt + (size_t)nxt.pn * tstep : cB;
        for (int t = 0; t < nt; t += 2) {
            const bool last = (t == nt - 2);
            const char* a1 = cA + (size_t)(t + 1) * kstep;
            const char* a2 = last ? nA : cA + (size_t)(t + 2) * kstep; const char* b2 = last ? nB : cB + (size_t)(t + 2) * kstep;
            const char* a3 = a2 + kstep; const char* b3 = b2 + kstep;
            if (last && has_next) S.a_ready(nxt);
            if constexpr (SP2) {
            PG8_LDB(B0, 0, 0); PG8_LDB(B1, 0, 1); PG8_SCHED; PG8_LDA(At, 0, 0); PG8_STAGE(PG8_SA(1, 1), a1 + hstep, voffA);
            PG8_WAIT_V(8); PG8_WAIT_L(0); PG8_BAR; PG8_MMA(0, 0, At, B0); PG8_MMA(0, 1, At, B1); PG8_BAR; PG8_SCHED;
            PG8_LDA(At, 0, 1); PG8_STAGE(PG8_SB(0, 0), b2, voffB); PG8_STAGE(PG8_SB(0, 1), b2 + hstep, voffB); PG8_STAGE(PG8_SA(0, 0), a2, voffA);
            PG8_WAIT_V(8); PG8_WAIT_L(0); PG8_BAR; PG8_MMA(1, 0, At, B0); PG8_MMA(1, 1, At, B1); PG8_BAR; PG8_SCHED;
            PG8_LDB(B0, 1, 0); PG8_LDB(B1, 1, 1); PG8_SCHED; PG8_LDA(At, 1, 0); PG8_STAGE(PG8_SA(0, 1), a2 + hstep, voffA);
            PG8_WAIT_V(8); PG8_WAIT_L(0); PG8_BAR; PG8_MMA(0, 0, At, B0); PG8_MMA(0, 1, At, B1); PG8_BAR; PG8_SCHED;
            PG8_LDA(At, 1, 1); PG8_STAGE(PG8_SB(1, 0), b3, voffB); PG8_STAGE(PG8_SB(1, 1), b3 + hstep, voffB); PG8_STAGE(PG8_SA(1, 0), a3, voffA);
            PG8_WAIT_V(8); PG8_WAIT_L(0); PG8_BAR; PG8_MMA(1, 0, At, B0); PG8_MMA(1, 1, At, B1); PG8_BAR; PG8_SCHED;
            } else {
            PG8_LDB(B0, 0, 0); PG8_SCHED; PG8_LDA(At, 0, 0); PG8_STAGE(PG8_SA(1, 1), a1 + hstep, voffA);
            PG8_WAIT_L(8); PG8_BAR; PG8_WAIT_L(0); PG8_MMA(0, 0, At, B0); PG8_BAR; PG8_SCHED;
            PG8_LDB(B1, 0, 1); PG8_STAGE(PG8_SB(0, 0), b2, voffB);
            PG8_BAR; PG8_WAIT_L(0); PG8_MMA(0, 1, At, B1); PG8_BAR;
            PG8_LDA(At, 0, 1); PG8_STAGE(PG8_SA(0, 0), a2, voffA);
            PG8_BAR; PG8_WAIT_L(0); PG8_MMA(1, 0, At, B0); PG8_BAR; PG8_SCHED;
            PG8_STAGE(PG8_SB(0, 1), b2 + hstep, voffB);
            PG8_WAIT_V(6); PG8_BAR; PG8_MMA(1, 1, At, B1); PG8_BAR;
            PG8_LDB(B0, 1, 0); PG8_SCHED; PG8_LDA(At, 1, 0); PG8_STAGE(PG8_SA(0, 1), a2 + hstep, voffA);
            PG8_WAIT_L(8); PG8_BAR; PG8_WAIT_L(0); PG8_MMA(0, 0, At, B0); PG8_BAR; PG8_SCHED;
            PG8_LDB(B1, 1, 1); PG8_STAGE(PG8_SB(1, 0), b3, voffB);
            PG8_BAR; PG8_WAIT_L(0); PG8_MMA(0, 1, At, B1); PG8_BAR;
            PG8_LDA(At, 1, 1); PG8_STAGE(PG8_SA(1, 0), a3, voffA);
            PG8_BAR; PG8_WAIT_L(0); PG8_MMA(1, 0, At, B0); PG8_BAR; PG8_SCHED;
            PG8_STAGE(PG8_SB(1, 1), b3 + hstep, voffB);
            PG8_WAIT_V(6); PG8_BAR; PG8_MMA(1, 1, At, B1); PG8_BAR;
            }
        }
        if constexpr (ALIGN_EPI) { if (wr == 0) PG8_BAR; }
        if constexpr (!Epi::AFTER_DRAIN) { E(acc, cur, wr, wc, fr, fq); S.done(cur); }
        if (!has_next) break;
#pragma unroll
        for (int a = 0; a < 2; ++a)
#pragma unroll
            for (int b = 0; b < 2; ++b)
#pragma unroll
                for (int m = 0; m < 4; ++m)
#pragma unroll
                    for (int n = 0; n < 2; ++n) acc[a][b][m][n] = (f32x4){0.f, 0.f, 0.f, 0.f};
        cur = nxt; cA = nA; cB = nB; ++ui;
        if constexpr (ALIGN_EPI) { if (wr == 1) PG8_BAR; }
    }
    PG8_WAIT_V(0);
    if constexpr (!ALIGN_EPI) { if (wr == 0) PG8_BAR; }
    PG8_BAR;
    if constexpr (Epi::AFTER_DRAIN) { E.fused(acc, cur, wr, wc, fr, fq, lds, wid, lane); S.done(cur); }
#undef PG8_SA
#undef PG8_SB
#undef PG8_STAGE
#undef PG8_LDA
#undef PG8_LDB
#undef PG8_MMA
#undef PG8_WAIT_V
#undef PG8_WAIT_L
#undef PG8_BAR
#undef PG8_SCHED
}
}

#ifndef PG8_SP2
#define PG8_SP2 true
#endif
#ifndef PG8_ALIGN
#define PG8_ALIGN true
#endif

constexpr int NWAVES = 8;
constexpr int N_PHASES = 13;
#ifndef MK_N_LAUNCHES
#define MK_N_LAUNCHES 1
#endif
constexpr int N_LAUNCHES = MK_N_LAUNCHES;

constexpr int D = 2048, M = 65536, NIN = 10496;
constexpr int LP = 16384, LS = 2048;
constexpr int DS5 = 1024, DRW = 1024, DRWIN = 3328;
constexpr float RMS_EPS = 1e-6f, GN_EPS = 64e-5f, L2_EPS = 1e-12f;

constexpr size_t MiB = 1u << 20;
constexpr size_t WS_CTL = 0, CTL_ZERO_BYTES = 1 * MiB;
constexpr size_t WS_WT = 1 * MiB;
constexpr size_t WS_GLUT = 42 * MiB;
constexpr size_t WS_S5OT = 44 * MiB;
constexpr size_t WS_RWOT = 48 * MiB;
constexpr size_t WS_WOT = 52 * MiB;
constexpr size_t WS_HN = 60 * MiB;
constexpr size_t WS_S5U = 316 * MiB;
constexpr size_t WS_RWIN = 444 * MiB;
constexpr size_t WS_Z = 860 * MiB;
constexpr size_t WS_END = 988 * MiB;
constexpr size_t DO_YF = 0, DO_YB = 128 * MiB, DO_SF = 256 * MiB, DO_SB = 384 * MiB, DO_Q = 256 * MiB;
constexpr int CW_BAR = 4096;

constexpr int LDS_BYTES = 147456;
constexpr int MISC_OFF = LDS_BYTES - 512;
constexpr int WAVE_SCR = 18176;
static_assert(NWAVES * WAVE_SCR <= MISC_OFF && pg8::STAGE_BYTES <= MISC_OFF, "LDS map");

#define GAS __attribute__((address_space(1)))
#define LAS __attribute__((address_space(3)))
typedef unsigned short bf16;
typedef unsigned v4u __attribute__((ext_vector_type(4)));
typedef unsigned v2u __attribute__((ext_vector_type(2)));
typedef float f32x4 __attribute__((ext_vector_type(4)));
#define LDS_WAIT() asm volatile("s_waitcnt lgkmcnt(0)" ::: "memory")
#define VM_WAIT() asm volatile("s_waitcnt vmcnt(0)" ::: "memory")
__device__ __forceinline__ unsigned f2bf(float f) { unsigned u = __builtin_bit_cast(unsigned, f); return (u + 0x7fffu + ((u >> 16) & 1u)) >> 16; }
__device__ __forceinline__ unsigned pk2(float lo, float hi) { return f2bf(lo) | (f2bf(hi) << 16); }
__device__ __forceinline__ float bf2f(bf16 b) { return __uint_as_float(((unsigned)b) << 16); }
__device__ __forceinline__ float blo(unsigned u) { return __uint_as_float(u << 16); }
__device__ __forceinline__ float bhi(unsigned u) { return __uint_as_float(u & 0xffff0000u); }
__device__ __forceinline__ float wave_sum(float v) {
#pragma unroll
    for (int o = 1; o < 64; o <<= 1) v += __shfl_xor(v, o);
    return v;
}
__device__ __forceinline__ float sigm(float v) { return 1.0f / (1.0f + __expf(-v)); }
__device__ __forceinline__ float gelu_tanh(float x) { const float u = 0.7978845608028654f * (x + 0.044715f * x * x * x); return 0.5f * x * (1.0f + tanhf(u)); }

#define XB_TMO      128
#define XB_XCNT(j)  (256  + 64 * (j))
#define XB_XSUB(j)  (1280 + 64 * (j))
#define XB_XGEN(j)  (2304 + 64 * (j))
#define XB_TOP      3328
#define XB_TOPGEN   3392
#define XCD_BAR_WORDS 3456
#define XB_SPIN_CAP (1u << 18)

__device__ __forceinline__ unsigned xb_ld(unsigned* p)              { return __hip_atomic_load(p, __ATOMIC_RELAXED, __HIP_MEMORY_SCOPE_AGENT); }
__device__ __forceinline__ unsigned xb_add(unsigned* p, unsigned v) { return __hip_atomic_fetch_add(p, v, __ATOMIC_RELAXED, __HIP_MEMORY_SCOPE_AGENT); }
__device__ __forceinline__ unsigned xb_xcc_id() { return (unsigned)__builtin_amdgcn_s_getreg((3 << 11) | 20) & 0xFu; }
#define XB_SPIN(cond, bar) do { unsigned _sp = 0; while (cond) { __builtin_amdgcn_s_sleep(1); \
    if ((++_sp & 255u) == 0u) { if (xb_ld(&(bar)[XB_TMO])) break; if (_sp > XB_SPIN_CAP) { atomicAdd(&(bar)[XB_TMO], 1u); break; } } } } while (0)

struct XcdBarrier {
    unsigned* bar; unsigned x;
    volatile LAS unsigned* st;
};

__device__ __forceinline__ XcdBarrier xcd_barrier_post(unsigned* bar, volatile LAS unsigned* st, const int mk_wave) {
    XcdBarrier b; b.bar = bar; b.x = xb_xcc_id(); b.st = st;
    if (mk_wave == 0 && mk_lane() == 0) (void)xb_add(&bar[XB_XCNT(b.x)], 1u);
    return b;
}
__device__ __forceinline__ void xcd_barrier_complete(unsigned* bar, unsigned x, unsigned& nloc, unsigned& nx) {
    const unsigned G = gridDim.x * gridDim.y * gridDim.z;
    unsigned sum, cnt, mine, sp = 0u;
    for (;;) {
        sum = 0u; cnt = 0u; mine = 0u;
#pragma unroll
        for (unsigned j = 0; j < 16; ++j) { const unsigned c = xb_ld(&bar[XB_XCNT(j)]); sum += c; cnt += (c > 0u) ? 1u : 0u; mine = (j == x) ? c : mine; }
        if (sum == G) break;
        __builtin_amdgcn_s_sleep(1);
        if ((++sp & 255u) == 0u) { if (xb_ld(&bar[XB_TMO])) break; if (sp > XB_SPIN_CAP) { atomicAdd(&bar[XB_TMO], 1u); break; } }
    }
    nloc = mine > 0u ? mine : 1u; nx = cnt > 0u ? cnt : 1u;
}

__device__ __forceinline__ void xcd_barrier(const XcdBarrier& b, const int mk_wave) {
    asm volatile("s_waitcnt vmcnt(0)" ::: "memory");
    __syncthreads();
    if (mk_wave == 0 && mk_lane() == 0) {
        unsigned* bar = b.bar;
        __builtin_amdgcn_s_waitcnt(0);
        unsigned nloc = b.st[0], nx = b.st[1];
        if (nloc == 0u) { xcd_barrier_complete(bar, b.x, nloc, nx); b.st[0] = nloc; b.st[1] = nx; }
        const unsigned old = xb_add(&bar[XB_XSUB(b.x)], 1u);
        const unsigned gen = old / nloc;
        if (old + 1u == (gen + 1u) * nloc) {
            __builtin_amdgcn_fence(__ATOMIC_RELEASE, "agent");
            asm volatile("s_waitcnt vmcnt(0)" ::: "memory");
            const unsigned og = xb_add(&bar[XB_TOP], 1u);
            const unsigned tg = og / nx;
            if (og + 1u == (tg + 1u) * nx) xb_add(&bar[XB_TOPGEN], 1u);
            else XB_SPIN(xb_ld(&bar[XB_TOPGEN]) == tg, bar);
            __builtin_amdgcn_fence(__ATOMIC_ACQUIRE, "agent");
            xb_add(&bar[XB_XGEN(b.x)], 1u);
            asm volatile("s_waitcnt vmcnt(0)" ::: "memory");
        } else {
            XB_SPIN(xb_ld(&bar[XB_XGEN(b.x)]) == gen, bar);
            __builtin_amdgcn_fence(__ATOMIC_ACQUIRE, "agent");
            asm volatile("s_waitcnt vmcnt(0)" ::: "memory");
        }
    }
    __syncthreads();
}


struct Args { const float* in[27]; float* out; unsigned char* ws; int ph_lo, ph_hi, li, pad; };

__device__ __forceinline__ void transpose_item(const float* W, int ldw, int K, bf16* WT, int drow0, LAS float* scr, int k0, int n0, int lane) {
#pragma unroll 8
    for (int i = 0; i < 32; ++i) { const int kk = 2 * i + (lane >> 5); scr[kk * 33 + (lane & 31)] = W[(size_t)(k0 + kk) * ldw + n0 + (lane & 31)]; }
    LDS_WAIT();
    const int c = lane & 7;
#pragma unroll
    for (int j = 0; j < 4; ++j) { const int n = (lane >> 3) + 8 * j; const LAS float* s = scr + (8 * c) * 33 + n;
        v4u o; o.x = pk2(s[0 * 33], s[1 * 33]); o.y = pk2(s[2 * 33], s[3 * 33]); o.z = pk2(s[4 * 33], s[5 * 33]); o.w = pk2(s[6 * 33], s[7 * 33]);
        *(v4u*)(WT + (size_t)(drow0 + n) * K + k0 + 8 * c) = o; }
    LDS_WAIT();
}
__device__ __forceinline__ int win_dest_row(int n) { return n < 1024 ? n : (n < 2048 ? n + 3328 : (n < 5376 ? n - 1024 : n)); }
__device__ __forceinline__ const float* xrow_ptr(const float* xp, const float* xs, int m) { return m < 32768 ? xp + (size_t)m * D : xs + (size_t)(m - 32768) * D; }

__device__ __forceinline__ void p0_prologue(const Args& a, unsigned char* ws, LAS unsigned char* lds, int gw, int NGW, int wave, int lane) {
    LAS float* scr = (LAS float*)(lds + wave * 16384);
    constexpr int I_IN = (D / 64) * (NIN / 32), I_GLU = (1024 / 64) * (1024 / 32), I_SO = (1024 / 64) * (2048 / 32), I_WO = (2048 / 64) * (2048 / 32);
    constexpr int NITEMS = I_IN + I_GLU + 2 * I_SO + I_WO;
    for (int it = gw; it < NITEMS; it += NGW) {
        int r = it;
        if (r < I_IN) { const int nblk = NIN / 32, kb = r / nblk, nb = r % nblk; transpose_item(a.in[4], NIN, D, (bf16*)(ws + WS_WT), win_dest_row(32 * nb), scr, 64 * kb, 32 * nb, lane); continue; } r -= I_IN;
        if (r < I_GLU) { const int nblk = 1024 / 32, kb = r / nblk, nb = r % nblk; transpose_item(a.in[13], 1024, 1024, (bf16*)(ws + WS_GLUT), 32 * nb, scr, 64 * kb, 32 * nb, lane); continue; } r -= I_GLU;
        if (r < I_SO) { const int nblk = 2048 / 32, kb = r / nblk, nb = r % nblk; transpose_item(a.in[14], 2048, 1024, (bf16*)(ws + WS_S5OT), 32 * nb, scr, 64 * kb, 32 * nb, lane); continue; } r -= I_SO;
        if (r < I_SO) { const int nblk = 2048 / 32, kb = r / nblk, nb = r % nblk; transpose_item(a.in[25], 2048, 1024, (bf16*)(ws + WS_RWOT), 32 * nb, scr, 64 * kb, 32 * nb, lane); continue; } r -= I_SO;
        { const int nblk = 2048 / 32, kb = r / nblk, nb = r % nblk; transpose_item(a.in[26], 2048, 2048, (bf16*)(ws + WS_WOT), 32 * nb, scr, 64 * kb, 32 * nb, lane); }
    }
    const float* g = a.in[2];
    f32x4 gv[8];
#pragma unroll
    for (int j = 0; j < 8; ++j) gv[j] = ((const f32x4*)g)[lane + 64 * j];
    bf16* HN = (bf16*)(ws + WS_HN);
    for (int m = gw; m < M; m += NGW) {
        const f32x4* xr = (const f32x4*)xrow_ptr(a.in[0], a.in[1], m) + lane;
        f32x4 v[8]; float s = 0.f;
#pragma unroll
        for (int j = 0; j < 8; ++j) { v[j] = xr[64 * j]; s += (v[j].x * v[j].x + v[j].y * v[j].y) + (v[j].z * v[j].z + v[j].w * v[j].w); }
        const float rstd = 1.0f / sqrtf(wave_sum(s) * (1.0f / D) + RMS_EPS);
        v2u* o8 = (v2u*)(HN + (size_t)m * D) + lane;
#pragma unroll
        for (int j = 0; j < 8; ++j) { v2u o; o.x = pk2(v[j].x * rstd * gv[j].x, v[j].y * rstd * gv[j].y); o.y = pk2(v[j].z * rstd * gv[j].z, v[j].w * rstd * gv[j].w); o8[64 * j] = o; }
    }
}

struct Row5 { unsigned rk, vw, a; };
__device__ __forceinline__ Row5 rw_load_row(const bf16* RWIN, int base, int L, int t, int c_r, int c_w, int c_a) {
    Row5 o; o.rk = o.vw = o.a = 0u;
    if (t >= 0 && t < L) { const bf16* p = RWIN + (size_t)(base + t) * DRWIN; o.rk = (unsigned)p[c_r] | ((unsigned)p[1024 + c_r] << 16); o.vw = (unsigned)p[2048 + c_r] | ((unsigned)p[c_w] << 16); o.a = (unsigned)p[c_a] << 16; }
    return o;
}
__device__ __forceinline__ void rwkv_naive_job(const Args& a, unsigned char* ws, int job2, LAS float* scr, int lane) {
    const int job = job2 >> 1, rhalf = job2 & 1;
    int s, rem; if (job < 64) { s = job / 32; rem = job % 32; } else { s = 2 + (job - 64) / 32; rem = (job - 64) % 32; }
    const int h = rem >> 1, d = rem & 1;
    const int base = s < 2 ? s * LP : 32768 + (s - 2) * LS, L = s < 2 ? LP : LS;
    const int i = lane, c_r = h * 64 + i, c_w = 3072 + d * 64 + i, c_a = 3200 + d * 64 + i;
    const int vrow = rhalf * 32 + (i & 31), kh = i >> 5;
    const float* mu = a.in[15];
    const float mu_r = mu[c_r], mu_k = mu[1024 + c_r], mu_v = mu[2048 + c_r], mu_w = mu[c_w], mu_a = mu[c_a];
    const float w0v = a.in[16][d * 1024 + c_r], a0v = a.in[18][d * 1024 + c_r], kkv = a.in[20][c_r], kav = a.in[21][c_r];
    LAS unsigned* wup = (LAS unsigned*)(scr + 448); LAS unsigned* aup = wup + 2048;
    for (int j = 0; j < 32; ++j) {
        wup[j * 64 + i] = pk2(a.in[17][(size_t)(d * 64 + 2 * j) * 1024 + c_r], a.in[17][(size_t)(d * 64 + 2 * j + 1) * 1024 + c_r]);
        aup[j * 64 + i] = pk2(a.in[19][(size_t)(d * 64 + 2 * j) * 1024 + c_r], a.in[19][(size_t)(d * 64 + 2 * j + 1) * 1024 + c_r]);
    }
    LDS_WAIT();
    const bf16* RWIN = (const bf16*)(ws + WS_RWIN);
    bf16* Y = (bf16*)((unsigned char*)a.out + (d ? DO_YB : DO_YF));
    float S[32];
#pragma unroll
    for (int j = 0; j < 32; ++j) S[j] = 0.f;
    const int dstep = d ? -1 : 1;
    int t = d ? L - 1 : 0;
    Row5 beh = rw_load_row(RWIN, base, L, t - dstep, c_r, c_w, c_a), cur = rw_load_row(RWIN, base, L, t, c_r, c_w, c_a), ahd = rw_load_row(RWIN, base, L, t + dstep, c_r, c_w, c_a);
    for (int n = 0; n < L; ++n, t += dstep) {
        const Row5 nx2 = rw_load_row(RWIN, base, L, t + 2 * dstep, c_r, c_w, c_a);
        const float zr = blo(cur.rk) + (0.5f * (blo(beh.rk) + blo(ahd.rk)) - blo(cur.rk)) * mu_r;
        const float zk = bhi(cur.rk) + (0.5f * (bhi(beh.rk) + bhi(ahd.rk)) - bhi(cur.rk)) * mu_k;
        const float zv = blo(cur.vw) + (0.5f * (blo(beh.vw) + blo(ahd.vw)) - blo(cur.vw)) * mu_v;
        const float zw = bhi(cur.vw) + (0.5f * (bhi(beh.vw) + bhi(ahd.vw)) - bhi(cur.vw)) * mu_w;
        const float za = bhi(cur.a) + (0.5f * (bhi(beh.a) + bhi(ahd.a)) - bhi(cur.a)) * mu_a;
        scr[i] = tanhf(zw); scr[64 + i] = za;
        LDS_WAIT();
        float accw = w0v, acca = a0v;
#pragma unroll
        for (int j = 0; j < 16; ++j) {
            const f32x4 tw = *(const LAS f32x4*)(scr + 4 * j), ta = *(const LAS f32x4*)(scr + 64 + 4 * j);
            const unsigned w0p = wup[(2 * j) * 64 + i], w1p = wup[(2 * j + 1) * 64 + i], a0p = aup[(2 * j) * 64 + i], a1p = aup[(2 * j + 1) * 64 + i];
            accw += tw.x * blo(w0p) + tw.y * bhi(w0p) + tw.z * blo(w1p) + tw.w * bhi(w1p);
            acca += ta.x * blo(a0p) + ta.y * bhi(a0p) + ta.z * blo(a1p) + ta.w * bhi(a1p);
        }
        const float dec = __expf(-0.6065306597126334f * sigm(accw));
        const float av = sigm(acca);
        float kk = zk * kkv; const float n2 = wave_sum(kk * kk); kk *= 1.0f / sqrtf(n2 + L2_EPS);
        const float kd = zk * (1.0f + (av - 1.0f) * kav);
        scr[128 + i] = kk; scr[192 + i] = dec; scr[256 + i] = kk * av; scr[320 + i] = kd; scr[384 + i] = zr;
        const float zvr = __shfl(zv, vrow);
        LDS_WAIT();
        float sa = 0.f;
#pragma unroll
        for (int j = 0; j < 8; ++j) { const f32x4 q = *(const LAS f32x4*)(scr + 128 + kh * 32 + 4 * j); sa += S[4 * j] * q.x + S[4 * j + 1] * q.y + S[4 * j + 2] * q.z + S[4 * j + 3] * q.w; }
        sa += __shfl_xor(sa, 32);
        sa = -sa;
        float y = 0.f;
#pragma unroll
        for (int j = 0; j < 8; ++j) {
            const f32x4 wq = *(const LAS f32x4*)(scr + 192 + kh * 32 + 4 * j), bq = *(const LAS f32x4*)(scr + 256 + kh * 32 + 4 * j), kq = *(const LAS f32x4*)(scr + 320 + kh * 32 + 4 * j), rq = *(const LAS f32x4*)(scr + 384 + kh * 32 + 4 * j);
            S[4 * j + 0] = S[4 * j + 0] * wq.x + sa * bq.x + zvr * kq.x; y += S[4 * j + 0] * rq.x;
            S[4 * j + 1] = S[4 * j + 1] * wq.y + sa * bq.y + zvr * kq.y; y += S[4 * j + 1] * rq.y;
            S[4 * j + 2] = S[4 * j + 2] * wq.z + sa * bq.z + zvr * kq.z; y += S[4 * j + 2] * rq.z;
            S[4 * j + 3] = S[4 * j + 3] * wq.w + sa * bq.w + zvr * kq.w; y += S[4 * j + 3] * rq.w;
        }
        y += __shfl_xor(y, 32);
        if (kh == 0) Y[(size_t)(base + t) * DRW + h * 64 + vrow] = (bf16)f2bf(y);
        LDS_WAIT();
        beh = cur; cur = ahd; ahd = nx2;
    }
}
__device__ __forceinline__ void s5_naive_job(const Args& a, unsigned char* ws, int job, LAS float* scr, int lane) {
    int s, rem; if (job < 256) { s = job / 128; rem = job % 128; } else { s = 2 + (job - 256) / 128; rem = (job - 256) % 128; }
    const int g = rem >> 1, d = rem & 1, p = lane;
    const int base = s < 2 ? s * LP : 32768 + (s - 2) * LS, L = s < 2 ? LP : LS;
    const int gi = d * 64 + g;
    const float lre = a.in[5][gi * 64 + p], lim = a.in[6][gi * 64 + p], dt = expf(a.in[7][gi]);
    const float er = expf(lre * dt); float sn, cs; sincosf(lim * dt, &sn, &cs);
    const float lbr = er * cs, lbi = er * sn;
    const float nr = lbr - 1.0f, ni = lbi, den = lre * lre + lim * lim;
    const float cfr = (nr * lre + ni * lim) / den, cfi = (ni * lre - nr * lim) / den;
    float Bre[16], Bim[16], Cre[16], Cim[16];
#pragma unroll
    for (int h = 0; h < 16; ++h) {
        const float br = a.in[8][((size_t)gi * 64 + p) * 16 + h], bi = a.in[9][((size_t)gi * 64 + p) * 16 + h];
        Bre[h] = cfr * br - cfi * bi; Bim[h] = cfr * bi + cfi * br;
        Cre[h] = a.in[10][((size_t)gi * 16 + h) * 64 + p]; Cim[h] = a.in[11][((size_t)gi * 16 + h) * 64 + p];
    }
    const bf16* U = (const bf16*)(ws + WS_S5U);
    bf16* Y = (bf16*)((unsigned char*)a.out + (d ? DO_SB : DO_SF));
    float xr = 0.f, xi = 0.f;
    for (int n = 0; n < L; n += 4) {
        float part[64];
#pragma unroll
        for (int tk = 0; tk < 4; ++tk) {
            const int t = d ? L - 1 - (n + tk) : n + tk;
            const v4u* up = (const v4u*)(U + (size_t)(base + t) * DS5 + g * 16);
            const v4u u0 = up[0], u1 = up[1];
            const float u[16] = {blo(u0.x), bhi(u0.x), blo(u0.y), bhi(u0.y), blo(u0.z), bhi(u0.z), blo(u0.w), bhi(u0.w), blo(u1.x), bhi(u1.x), blo(u1.y), bhi(u1.y), blo(u1.z), bhi(u1.z), blo(u1.w), bhi(u1.w)};
            float bur = 0.f, bui = 0.f;
#pragma unroll
            for (int h = 0; h < 16; ++h) { bur += Bre[h] * u[h]; bui += Bim[h] * u[h]; }
            const float nxr = lbr * xr - lbi * xi + bur, nxi = lbr * xi + lbi * xr + bui; xr = nxr; xi = nxi;
#pragma unroll
            for (int h = 0; h < 16; ++h) part[tk * 16 + h] = Cre[h] * xr - Cim[h] * xi;
        }
#pragma unroll
        for (int j = 0; j < 64; ++j) scr[p * 65 + j] = part[j];
        LDS_WAIT();
        float sum = 0.f;
#pragma unroll
        for (int l = 0; l < 64; ++l) sum += scr[l * 65 + p];
        const int tk = p >> 4, h = p & 15, t = d ? L - 1 - (n + tk) : n + tk;
        Y[(size_t)(base + t) * DS5 + g * 16 + h] = (bf16)f2bf(sum);
        LDS_WAIT();
    }
}

__device__ __forceinline__ void unpack8(const bf16* p, float (&o)[8]) {
    const v4u a = *(const v4u*)p;
    o[0] = blo(a.x); o[1] = bhi(a.x); o[2] = blo(a.y); o[3] = bhi(a.y); o[4] = blo(a.z); o[5] = bhi(a.z); o[6] = blo(a.w); o[7] = bhi(a.w);
}
__device__ __forceinline__ void pack8(bf16* p, const float (&v)[8]) {
    v4u a; a.x = pk2(v[0], v[1]); a.y = pk2(v[2], v[3]); a.z = pk2(v[4], v[5]); a.w = pk2(v[6], v[7]); *(v4u*)p = a;
}
__device__ __forceinline__ void p3_finalize(const Args& a, unsigned char* ws, int gw, int NGW, int lane) {
    const bf16* U = (const bf16*)(ws + WS_S5U); const bf16* RWIN = (const bf16*)(ws + WS_RWIN); bf16* Z = (bf16*)(ws + WS_Z);
    unsigned char* ob = (unsigned char*)a.out;
    const bf16* SF = (const bf16*)(ob + DO_SF); const bf16* SB = (const bf16*)(ob + DO_SB); bf16* YF = (bf16*)(ob + DO_YF); const bf16* YB = (const bf16*)(ob + DO_YB);
    const int half = gw & 1, c0 = half * 512 + lane * 8;
    float dv[8], lnw[8], lnb[8], rk[8], mur[8], muk[8], muv[8];
#pragma unroll
    for (int j = 0; j < 8; ++j) { dv[j] = a.in[12][c0 + j]; lnw[j] = a.in[23][c0 + j]; lnb[j] = a.in[24][c0 + j]; rk[j] = a.in[22][c0 + j]; mur[j] = a.in[15][c0 + j]; muk[j] = a.in[15][1024 + c0 + j]; muv[j] = a.in[15][2048 + c0 + j]; }
    for (int m = gw >> 1; m < M; m += NGW >> 1) {
        const int t = m < 32768 ? (m & (LP - 1)) : ((m - 32768) & (LS - 1)), L = m < 32768 ? LP : LS;
        const bool hp = t > 0, hn = t < L - 1;
        float o[8];
        {
            float u[8], f[8], b[8];
            unpack8(U + (size_t)m * DS5 + c0, u); unpack8(SF + (size_t)m * DS5 + c0, f); unpack8(SB + (size_t)m * DS5 + c0, b);
#pragma unroll
            for (int j = 0; j < 8; ++j) o[j] = gelu_tanh(dv[j] * u[j] + f[j] + b[j]);
            pack8(Z + (size_t)m * DS5 + c0, o);
        }
        float y[8];
        {
            float yf[8], yb[8];
            unpack8(YF + (size_t)m * DRW + c0, yf); unpack8(YB + (size_t)m * DRW + c0, yb);
#pragma unroll
            for (int j = 0; j < 8; ++j) y[j] = yf[j] + yb[j];
        }
        float s1 = 0.f;
#pragma unroll
        for (int j = 0; j < 8; ++j) s1 += y[j];
        s1 += __shfl_xor(s1, 1); s1 += __shfl_xor(s1, 2); s1 += __shfl_xor(s1, 4);
        const float mean = s1 * (1.0f / 64.0f);
        float s2 = 0.f;
#pragma unroll
        for (int j = 0; j < 8; ++j) { const float dd = y[j] - mean; s2 += dd * dd; }
        s2 += __shfl_xor(s2, 1); s2 += __shfl_xor(s2, 2); s2 += __shfl_xor(s2, 4);
        const float rstd = 1.0f / sqrtf(s2 * (1.0f / 64.0f) + GN_EPS);
        float zr[8], zk[8], zv[8];
        const bf16* pc = RWIN + (size_t)m * DRWIN + c0;
#pragma unroll
        for (int comp = 0; comp < 3; ++comp) {
            float cc[8], pp[8], nn[8];
            unpack8(pc + comp * 1024, cc);
            if (hp) unpack8(pc - DRWIN + comp * 1024, pp); else {
#pragma unroll
                for (int j = 0; j < 8; ++j) pp[j] = 0.f; }
            if (hn) unpack8(pc + DRWIN + comp * 1024, nn); else {
#pragma unroll
                for (int j = 0; j < 8; ++j) nn[j] = 0.f; }
#pragma unroll
            for (int j = 0; j < 8; ++j) {
                const float muc = comp == 0 ? mur[j] : (comp == 1 ? muk[j] : muv[j]);
                const float zz = cc[j] + (0.5f * (pp[j] + nn[j]) - cc[j]) * muc;
                if (comp == 0) zr[j] = zz; else if (comp == 1) zk[j] = zz; else zv[j] = zz;
            }
        }
        float dot = 0.f;
#pragma unroll
        for (int j = 0; j < 8; ++j) dot += zr[j] * zk[j] * rk[j];
        dot += __shfl_xor(dot, 1); dot += __shfl_xor(dot, 2); dot += __shfl_xor(dot, 4);
#pragma unroll
        for (int j = 0; j < 8; ++j) o[j] = (y[j] - mean) * rstd * lnw[j] + lnb[j] + dot * zv[j];
        pack8(YF + (size_t)m * DRW + c0, o);
    }
}

__device__ __forceinline__ void p12_final(const Args& a, int gw, int NGW, int lane) {
    const float* g = a.in[3];
    f32x4 gv[8];
#pragma unroll
    for (int j = 0; j < 8; ++j) gv[j] = ((const f32x4*)g)[lane + 64 * j];
    for (int m = gw; m < M; m += NGW) {
        const f32x4* xr = (const f32x4*)xrow_ptr(a.in[0], a.in[1], m) + lane;
        f32x4* orow = (f32x4*)(a.out + (size_t)m * D) + lane;
        f32x4 v[8]; float s = 0.f;
#pragma unroll
        for (int j = 0; j < 8; ++j) { v[j] = orow[64 * j]; s += (v[j].x * v[j].x + v[j].y * v[j].y) + (v[j].z * v[j].z + v[j].w * v[j].w); }
        const float rstd = 1.0f / sqrtf(wave_sum(s) * (1.0f / D) + RMS_EPS);
#pragma unroll
        for (int j = 0; j < 8; ++j) { const f32x4 xv = xr[64 * j]; orow[64 * j] = xv + v[j] * rstd * gv[j]; }
    }
}

__global__ void __launch_bounds__(NWAVES * 64, 2) mk_fwd(Args args) {
    extern __shared__ __attribute__((aligned(16))) unsigned char lds_raw[];
    LAS unsigned char* lds = (LAS unsigned char*)lds_raw;
    volatile LAS unsigned* MISC = (volatile LAS unsigned*)(lds + MISC_OFF);
    const int wave = __builtin_amdgcn_readfirstlane((int)threadIdx.x >> 6);
#define lane mk_lane()
    const int tid0 = threadIdx.x;
    const int G = gridDim.x; const int bx = blockIdx.x; const int vcu = (G % 8 == 0) ? (bx % 8) * (G / 8) + bx / 8 : bx;
    unsigned char* ws = args.ws;
    unsigned* ctl = (unsigned*)(ws + WS_CTL);
    for (int u = tid0; u < (LDS_BYTES - MISC_OFF) / 4; u += NWAVES * 64) ((LAS unsigned*)(lds + MISC_OFF))[u] = 0u;
    __syncthreads();
    XcdBarrier bar; bar.bar = ctl + CW_BAR; bar.x = 0; bar.st = nullptr;
    if (N_LAUNCHES == 1) bar = xcd_barrier_post(ctl + CW_BAR, MISC + 8, wave);
#define GRID_BAR() do { if (N_LAUNCHES == 1) xcd_barrier(bar, wave); } while (0)
    const int lo = args.ph_lo, hi = args.ph_hi;
#ifndef ONLY_PHASE
#define ONLY_PHASE -1
#endif
#define IN(k) ((ONLY_PHASE < 0 || ONLY_PHASE == (k)) && lo <= (k) && (k) < hi)
#define BOTH(k) (IN(k) && IN((k) + 1))
    const int gw = vcu * NWAVES + wave, NGW = G * NWAVES;
    bf16* WT = (bf16*)(ws + WS_WT); bf16* HN = (bf16*)(ws + WS_HN); bf16* S5U = (bf16*)(ws + WS_S5U); bf16* RWIN = (bf16*)(ws + WS_RWIN); bf16* Z = (bf16*)(ws + WS_Z);
    bf16* YN = (bf16*)((unsigned char*)args.out + DO_YF); bf16* Q = (bf16*)((unsigned char*)args.out + DO_Q); bf16* P = RWIN;

    if (IN(0)) { p0_prologue(args, ws, lds, gw, NGW, wave, lane); if (BOTH(0)) GRID_BAR(); }
    if (IN(1)) {
        pg8::Gemm g{HN, WT, M, 4352, D}; pg8::StaticOrder S; S.init(M, 4352, G, bx);
        pg8::EpiG1 E{S5U, RWIN};
        pg8::gemm_phase<pg8::EpiG1, pg8::StaticOrder, PG8_ALIGN, PG8_SP2>(lds, g, S, E, wave);
        if (BOTH(1)) GRID_BAR();
    }
    if (IN(2)) {
        LAS float* scr = (LAS float*)(lds + wave * WAVE_SCR);
        const int gwt = wave * G + vcu;
#ifndef NO_RWJOB
        if (gwt < 1152) rwkv_naive_job(args, ws, gwt, scr, lane);
#endif
        const int q = (gwt - 1152 + NGW) % NGW;
        for (int rnd = 0; rnd < 2; ++rnd) {
            const int j = rnd == 0 ? q : ((q >= 512 && q < 768) ? 2048 + (q - 512) : -1);
#ifndef NO_S5JOB
            if (j >= 0 && j < 2304) s5_naive_job(args, ws, j, scr, lane);
#endif
        }
        if (BOTH(2)) GRID_BAR();
    }
    if (IN(3)) { p3_finalize(args, ws, gw, NGW, lane); if (BOTH(3)) GRID_BAR(); }
    if (IN(4)) {
        pg8::Gemm g{Z, (const bf16*)(ws + WS_GLUT), M, 1024, 1024}; pg8::StaticOrder S; S.init(M, 1024, G, bx);
        pg8::EpiMix<1> E{S5U, Z, nullptr, 1024};
        pg8::gemm_phase<pg8::EpiMix<1>, pg8::StaticOrder, PG8_ALIGN, PG8_SP2>(lds, g, S, E, wave);
        if (BOTH(4)) GRID_BAR();
    }
    if (IN(5)) {
        pg8::Gemm g{HN, WT + (size_t)4352 * D, M, 1024, D}; pg8::StaticOrder S; S.init(M, 1024, G, bx);
        pg8::EpiMix<2> E{S5U, S5U, nullptr, 1024};
        pg8::gemm_phase<pg8::EpiMix<2>, pg8::StaticOrder, PG8_ALIGN, PG8_SP2>(lds, g, S, E, wave);
        if (BOTH(5)) GRID_BAR();
    }
    if (IN(6)) {
        pg8::Gemm g{HN, WT + (size_t)5376 * D, M, 1024, D}; pg8::StaticOrder S; S.init(M, 1024, G, bx);
        pg8::EpiMix<2> E{YN, YN, nullptr, 1024};
        pg8::gemm_phase<pg8::EpiMix<2>, pg8::StaticOrder, PG8_ALIGN, PG8_SP2>(lds, g, S, E, wave);
        if (BOTH(6)) GRID_BAR();
    }
    if (IN(7)) {
        pg8::Gemm g{S5U, (const bf16*)(ws + WS_S5OT), M, 2048, 1024}; pg8::StaticOrder S; S.init(M, 2048, G, bx);
        pg8::EpiMix<0> E{P, nullptr, nullptr, 2048};
        pg8::gemm_phase<pg8::EpiMix<0>, pg8::StaticOrder, PG8_ALIGN, PG8_SP2>(lds, g, S, E, wave);
        if (BOTH(7)) GRID_BAR();
    }
    if (IN(8)) {
        pg8::Gemm g{HN, WT + (size_t)6400 * D, M, 2048, D}; pg8::StaticOrder S; S.init(M, 2048, G, bx);
        pg8::EpiMix<1> E{P, P, nullptr, 2048};
        pg8::gemm_phase<pg8::EpiMix<1>, pg8::StaticOrder, PG8_ALIGN, PG8_SP2>(lds, g, S, E, wave);
        if (BOTH(8)) GRID_BAR();
    }
    if (IN(9)) {
        pg8::Gemm g{YN, (const bf16*)(ws + WS_RWOT), M, 2048, 1024}; pg8::StaticOrder S; S.init(M, 2048, G, bx);
        pg8::EpiMix<0> E{Q, nullptr, nullptr, 2048};
        pg8::gemm_phase<pg8::EpiMix<0>, pg8::StaticOrder, PG8_ALIGN, PG8_SP2>(lds, g, S, E, wave);
        if (BOTH(9)) GRID_BAR();
    }
    if (IN(10)) {
        pg8::Gemm g{HN, WT + (size_t)8448 * D, M, 2048, D}; pg8::StaticOrder S; S.init(M, 2048, G, bx);
        pg8::EpiMix<3> E{P, Q, P, 2048};
        pg8::gemm_phase<pg8::EpiMix<3>, pg8::StaticOrder, PG8_ALIGN, PG8_SP2>(lds, g, S, E, wave);
        if (BOTH(10)) GRID_BAR();
    }
    if (IN(11)) {
        pg8::Gemm g{P, (const bf16*)(ws + WS_WOT), M, 2048, D}; pg8::StaticOrder S; S.init(M, 2048, G, bx);
        pg8::EpiF32 E{args.out, 2048};
        pg8::gemm_phase<pg8::EpiF32, pg8::StaticOrder, PG8_ALIGN, PG8_SP2>(lds, g, S, E, wave);
        if (BOTH(11)) GRID_BAR();
    }
    if (IN(12)) { p12_final(args, gw, NGW, lane); }
#undef IN
#undef BOTH
#undef lane
}

extern "C" void kernel_launch(void* const* d_in, const int* in_sizes, int n_in, void* d_out, int out_size, void* d_ws, size_t ws_size, hipStream_t stream) {
    static int grid = 0;
    if (grid == 0) {
        if (n_in != 27 || out_size != 2 * 32768 * D || ws_size < WS_END) { fprintf(stderr, "kernel_launch: unexpected shapes (n_in %d out %d ws %zu)\n", n_in, out_size, ws_size); grid = -1; return; }
        int dev = 0, cus = 0, per_cu = 0;
        if (hipGetDevice(&dev) != hipSuccess || hipDeviceGetAttribute(&cus, hipDeviceAttributeMultiprocessorCount, dev) != hipSuccess) { grid = -1; return; }
        if (hipFuncSetAttribute((const void*)mk_fwd, hipFuncAttributeMaxDynamicSharedMemorySize, LDS_BYTES) != hipSuccess) { fprintf(stderr, "kernel_launch: hipFuncSetAttribute failed\n"); grid = -1; return; }
        if (hipOccupancyMaxActiveBlocksPerMultiprocessor(&per_cu, (const void*)mk_fwd, NWAVES * 64, LDS_BYTES) != hipSuccess || per_cu < 1)
            fprintf(stderr, "kernel_launch: note: occupancy query reports %d workgroups per CU\n", per_cu);
        (void)hipGetLastError();
        grid = cus;
    }
    if (grid < 0) return;
    if (hipMemsetAsync((char*)d_ws + WS_CTL, 0, CTL_ZERO_BYTES, stream) != hipSuccess) return;
    Args a{};
    for (int i = 0; i < 27; ++i) a.in[i] = (const float*)d_in[i];
    a.out = (float*)d_out; a.ws = (unsigned char*)d_ws; a.pad = 0;
    for (int li = 0; li < N_LAUNCHES; ++li) {
        if (N_LAUNCHES == 1) { a.ph_lo = 0; a.ph_hi = N_PHASES; } else { a.ph_lo = li * N_PHASES / N_LAUNCHES; a.ph_hi = (li + 1) * N_PHASES / N_LAUNCHES; }
        a.li = li;
        hipLaunchKernelGGL(mk_fwd, dim3(grid), dim3(NWAVES * 64), LDS_BYTES, stream, a);
        const hipError_t le = hipPeekAtLastError();
        if (le != hipSuccess) { fprintf(stderr, "kernel_launch: launch %d failed: %s\n", li, hipGetErrorName(le)); break; }
    }
}
```

```cpp
#include <hip/hip_runtime.h>
#include <cstdio>
#include <cstdint>
#define MK_N_LAUNCHES 1
__device__ __forceinline__ int mk_lane() { int l; asm volatile("v_mbcnt_lo_u32_b32 %0, -1, 0\n\tv_mbcnt_hi_u32_b32 %0, -1, %0" : "=v"(l)); return l; }
namespace pg8 {
#define PG8_LAS __attribute__((address_space(3)))
typedef unsigned short bf16_t;
typedef short bf16x8 __attribute__((ext_vector_type(8)));
typedef float f32x4 __attribute__((ext_vector_type(4)));
typedef unsigned u32x4 __attribute__((ext_vector_type(4)));
constexpr int BM = 256, BK = 64, HALF = 128, HTB = HALF * BK * 2  , STAGE_BYTES = 8 * HTB, NXCD = 8, WGM = 8;

__host__ __device__ __forceinline__ int lds_byte(int r, int c) { const int st = (r >> 4) * 2 + (c >> 5), rr = r & 15, cc = c & 31, ob = rr * 64 + cc * 2; return st * 1024 + (ob ^ (((ob >> 9) & 1) << 5)); }
__host__ __device__ __forceinline__ void stage_rc(int b, int& R, int& C) { const int st = b / 1024, sb = b % 1024, swz = sb ^ (((sb >> 9) & 1) << 5); R = (st >> 1) * 16 + swz / 64; C = (st & 1) * 32 + (swz % 64) / 2; }
__host__ __device__ __forceinline__ int perm32(int rho) { const int n = rho >> 4, i = rho & 15; return 8 * (i >> 2) + 4 * n + (i & 3); }

struct Unit { int pm, pn; };
struct Gemm { const bf16_t* A; const bf16_t* Bt; int M, N, K; };

struct StaticOrder {
    int nM, nN, nwg, G, c;
    __host__ __device__ void init(int M, int N, int G_, int c_) { nM = M / BM; nN = N / BM; nwg = nM * nN; G = G_; c = c_; }
    __host__ __device__ bool next(int i, Unit& u) const {
        const long L = (long)i * G + c; if (L >= nwg) return false;
        int wgid = (int)L; { const int q = nwg / NXCD, r = nwg % NXCD, xcd = wgid % NXCD, off = wgid / NXCD; wgid = (xcd < r ? xcd * (q + 1) : r * (q + 1) + (xcd - r) * q) + off; }
        const int nig = WGM * nN, gid = wgid / nig, fm = gid * WGM, gsz = (nM - fm) < WGM ? (nM - fm) : WGM;
        u.pm = fm + ((wgid % nig) % gsz); u.pn = (wgid % nig) / gsz; return true;
    }
    __device__ __forceinline__ void a_ready(const Unit&) const {}
    __device__ __forceinline__ void done(const Unit&) const {}
};

__device__ __forceinline__ unsigned cvt_pk_bf16(float lo, float hi) { unsigned r; asm volatile("v_cvt_pk_bf16_f32 %0, %1, %2" : "=v"(r) : "v"(lo), "v"(hi)); return r; }

__device__ __forceinline__ float bf_lo(unsigned u) { return __uint_as_float(u << 16); }
__device__ __forceinline__ float bf_hi(unsigned u) { return __uint_as_float(u & 0xffff0000u); }
__device__ __forceinline__ float sigmoid_f(float v) { return __builtin_amdgcn_rcpf(1.0f + __expf(-v)); }

struct EpiG1 {
    static constexpr bool PERM = true, AFTER_DRAIN = false;
    bf16_t* s5u; bf16_t* rwin;
    __device__ __forceinline__ void operator()(const f32x4 (&acc)[2][2][4][2], const Unit& u, int wr, int wc, int fr, int fq) const {
        const int row0 = u.pm * BM + wr * 64 + fr; int colt = u.pn * BM; bf16_t* base; int ld;
        if (colt < 1024) { base = s5u; ld = 1024; } else { base = rwin; ld = 3328; colt -= 1024; }
        const int col0 = colt + wc * 32 + 8 * fq;
#pragma unroll
        for (int ai = 0; ai < 2; ++ai)
#pragma unroll
            for (int m = 0; m < 4; ++m) { bf16_t* rowp = base + (size_t)(row0 + ai * HALF + m * 16) * ld + col0;
#pragma unroll
                for (int bj = 0; bj < 2; ++bj) { const f32x4 v0 = acc[ai][bj][m][0], v1 = acc[ai][bj][m][1];
                    u32x4 w; w.x = cvt_pk_bf16(v0[0], v0[1]); w.y = cvt_pk_bf16(v0[2], v0[3]); w.z = cvt_pk_bf16(v1[0], v1[1]); w.w = cvt_pk_bf16(v1[2], v1[3]);
                    *(u32x4*)(rowp + bj * HALF) = w; } }
    }
};
template <int MODE> struct EpiMix {
    static constexpr bool PERM = true, AFTER_DRAIN = false;
    bf16_t* O; const bf16_t* S; const bf16_t* Add; int ld;
    __device__ __forceinline__ void operator()(const f32x4 (&acc)[2][2][4][2], const Unit& u, int wr, int wc, int fr, int fq) const {
        const int row0 = u.pm * BM + wr * 64 + fr, col0 = u.pn * BM + wc * 32 + 8 * fq;
#pragma unroll
        for (int ai = 0; ai < 2; ++ai)
#pragma unroll
            for (int m = 0; m < 4; ++m) {
#pragma unroll
                for (int bj = 0; bj < 2; ++bj) {
                    const size_t off = (size_t)(row0 + ai * HALF + m * 16) * ld + col0 + bj * HALF;
                    float v[8];
#pragma unroll
                    for (int j = 0; j < 4; ++j) { v[j] = acc[ai][bj][m][0][j]; v[4 + j] = acc[ai][bj][m][1][j]; }
                    if (MODE >= 1) {
                        const u32x4 s = *(const u32x4*)(S + off);
                        const float sv[8] = {bf_lo(s.x), bf_hi(s.x), bf_lo(s.y), bf_hi(s.y), bf_lo(s.z), bf_hi(s.z), bf_lo(s.w), bf_hi(s.w)};
#pragma unroll
                        for (int j = 0; j < 8; ++j) { const float sg = sigmoid_f(v[j]); v[j] = (MODE == 2) ? sv[j] * v[j] * sg : sv[j] * sg; }
                    }
                    if (MODE == 3) {
                        const u32x4 a = *(const u32x4*)(Add + off);
                        const float av[8] = {bf_lo(a.x), bf_hi(a.x), bf_lo(a.y), bf_hi(a.y), bf_lo(a.z), bf_hi(a.z), bf_lo(a.w), bf_hi(a.w)};
#pragma unroll
                        for (int j = 0; j < 8; ++j) v[j] += av[j];
                    }
                    u32x4 w; w.x = cvt_pk_bf16(v[0], v[1]); w.y = cvt_pk_bf16(v[2], v[3]); w.z = cvt_pk_bf16(v[4], v[5]); w.w = cvt_pk_bf16(v[6], v[7]);
                    *(u32x4*)(O + off) = w;
                }
            }
    }
};
struct EpiF32 {
    static constexpr bool PERM = false, AFTER_DRAIN = false;
    float* C; int ldc;
    __device__ __forceinline__ void operator()(const f32x4 (&acc)[2][2][4][2], const Unit& u, int wr, int wc, int fr, int fq) const {
        const int row0 = u.pm * BM + wr * 64 + fr, col0 = u.pn * BM + wc * 32 + 4 * fq;
#pragma unroll
        for (int ai = 0; ai < 2; ++ai)
#pragma unroll
            for (int m = 0; m < 4; ++m) { float* rowp = C + (size_t)(row0 + ai * HALF + m * 16) * ldc + col0;
#pragma unroll
                for (int bj = 0; bj < 2; ++bj)
#pragma unroll
                    for (int n = 0; n < 2; ++n) *(f32x4*)(rowp + bj * HALF + n * 16) = acc[ai][bj][m][n]; }
    }
};
template <class Epi, class Sched, bool ALIGN_EPI = false, bool SP2 = false>
__device__ __forceinline__ void gemm_phase(PG8_LAS unsigned char* lds, const Gemm g, const Sched& S, const Epi& E, const int mk_wave) {
    const int lane = mk_lane(), wid = mk_wave, tid = wid * 64 + lane, wr = wid >> 2, wc = wid & 3, fr = lane & 15, fq = lane >> 4;
    const int K = g.K, nt = K / BK;
    unsigned voffA[2], voffB[2];
#pragma unroll
    for (int i = 0; i < 2; ++i) { int R, C; stage_rc(tid * 16 + i * 8192, R, C); const int Rb = Epi::PERM ? ((R & ~31) + perm32(R & 31)) : R;
        voffA[i] = (unsigned)(R * K + C) * 2u; voffB[i] = (unsigned)(Rb * K + C) * 2u; }
    const size_t kstep = (size_t)(BK * 2);
    const size_t hstep = (size_t)HALF * K * 2;
    const size_t tstep = 2 * hstep;
    const unsigned ldsw = (unsigned)wid * 1024u;
    const int aoff = lds_byte(wr * 64 + fr, fq * 8), boff = lds_byte(wc * 32 + fr, fq * 8);
#define PG8_SA(b, h) (((b) * 2 + (h)) * HTB)
#define PG8_SB(b, h) ((4 + (b) * 2 + (h)) * HTB)
#define PG8_STAGE(bufoff, gbase, voff) do { _Pragma("unroll") for (int _i = 0; _i < 2; ++_i) \
        __builtin_amdgcn_global_load_lds((const unsigned*)((const char*)(gbase) + (voff)[_i]), (PG8_LAS unsigned*)(lds + (bufoff) + ldsw + _i * 8192), 16, 0, 0); } while (0)
#define PG8_LDA(dst, b, h) do { _Pragma("unroll") for (int m = 0; m < 4; ++m) _Pragma("unroll") for (int k = 0; k < 2; ++k) dst[m][k] = *(const PG8_LAS bf16x8*)(lds + PG8_SA(b, h) + aoff + m * 2048 + k * 1024); } while (0)
#define PG8_LDB(dst, b, h) do { _Pragma("unroll") for (int n = 0; n < 2; ++n) _Pragma("unroll") for (int k = 0; k < 2; ++k) dst[n][k] = *(const PG8_LAS bf16x8*)(lds + PG8_SB(b, h) + boff + n * 2048 + k * 1024); } while (0)
#define PG8_MMA(ai, bj, At, Bt) do { __builtin_amdgcn_s_setprio(1); _Pragma("unroll") for (int m = 0; m < 4; ++m) _Pragma("unroll") for (int n = 0; n < 2; ++n) _Pragma("unroll") for (int k = 0; k < 2; ++k) \
        acc[ai][bj][m][n] = __builtin_amdgcn_mfma_f32_16x16x32_bf16(Bt[n][k], At[m][k], acc[ai][bj][m][n], 0, 0, 0); __builtin_amdgcn_s_setprio(0); } while (0)
#define PG8_WAIT_V(n) asm volatile("s_waitcnt vmcnt(" #n ")" ::: "memory")
#define PG8_WAIT_L(n) asm volatile("s_waitcnt lgkmcnt(" #n ")" ::: "memory")
#define PG8_BAR __builtin_amdgcn_s_barrier()
#define PG8_SCHED __builtin_amdgcn_sched_barrier(0)
    Unit cur, nxt; int ui = 0;
    if (!S.next(0, cur)) return;
    f32x4 acc[2][2][4][2];
#pragma unroll
    for (int a = 0; a < 2; ++a)
#pragma unroll
        for (int b = 0; b < 2; ++b)
#pragma unroll
            for (int m = 0; m < 4; ++m)
#pragma unroll
                for (int n = 0; n < 2; ++n) acc[a][b][m][n] = (f32x4){0.f, 0.f, 0.f, 0.f};
    bf16x8 At[4][2], B0[2][2], B1[2][2];
    const char* cA = (const char*)g.A + (size_t)cur.pm * tstep; const char* cB = (const char*)g.Bt + (size_t)cur.pn * tstep;
    S.a_ready(cur);
    if constexpr (SP2) {
        PG8_STAGE(PG8_SB(0, 0), cB, voffB); PG8_STAGE(PG8_SB(0, 1), cB + hstep, voffB); PG8_STAGE(PG8_SA(0, 0), cA, voffA); PG8_STAGE(PG8_SA(0, 1), cA + hstep, voffA);
        if (wr == 1) PG8_BAR;
        PG8_WAIT_V(2); PG8_BAR;
        PG8_STAGE(PG8_SB(1, 0), cB + kstep, voffB); PG8_STAGE(PG8_SA(1, 0), cA + kstep, voffA); PG8_STAGE(PG8_SB(1, 1), cB + hstep + kstep, voffB);
        PG8_WAIT_V(6); PG8_BAR;
    } else {
        PG8_STAGE(PG8_SB(0, 0), cB, voffB); PG8_STAGE(PG8_SA(0, 0), cA, voffA); PG8_STAGE(PG8_SB(0, 1), cB + hstep, voffB); PG8_STAGE(PG8_SA(0, 1), cA + hstep, voffA);
        if (wr == 1) PG8_BAR;
        PG8_WAIT_V(4); PG8_BAR;
        PG8_STAGE(PG8_SB(1, 0), cB + kstep, voffB); PG8_STAGE(PG8_SA(1, 0), cA + kstep, voffA); PG8_STAGE(PG8_SB(1, 1), cB + hstep + kstep, voffB);
        PG8_WAIT_V(6); PG8_BAR;
    }
    for (;;) {
        const bool has_next = S.next(ui + 1, nxt);
        const char* nA = has_next ? (const char*)g.A + (size_t)nxt.pm * tstep : cA; const char* nB = has_next ? (const char*)g.Bt + (size_t)nxt.pn * tstep : cB;
        for (int t = 0; t < nt; t += 2) {
            const bool last = (t == nt - 2);
            const char* a1 = cA + (size_t)(t + 1) * kstep;
            const char* a2 = last ? nA : cA + (size_t)(t + 2) * kstep; const char* b2 = last ? nB : cB + (size_t)(t + 2) * kstep;
            const char* a3 = a2 + kstep; const char* b3 = b2 + kstep;
            if (last && has_next) S.a_ready(nxt);
            if constexpr (SP2) {
            PG8_LDB(B0, 0, 0); PG8_LDB(B1, 0, 1); PG8_SCHED; PG8_LDA(At, 0, 0); PG8_STAGE(PG8_SA(1, 1), a1 + hstep, voffA);
            PG8_WAIT_V(8); PG8_WAIT_L(0); PG8_BAR; PG8_MMA(0, 0, At, B0); PG8_MMA(0, 1, At, B1); PG8_BAR; PG8_SCHED;
            PG8_LDA(At, 0, 1); PG8_STAGE(PG8_SB(0, 0), b2, voffB); PG8_STAGE(PG8_SB(0, 1), b2 + hstep, voffB); PG8_STAGE(PG8_SA(0, 0), a2, voffA);
            PG8_WAIT_V(8); PG8_WAIT_L(0); PG8_BAR; PG8_MMA(1, 0, At, B0); PG8_MMA(1, 1, At, B1); PG8_BAR; PG8_SCHED;
            PG8_LDB(B0, 1, 0); PG8_LDB(B1, 1, 1); PG8_SCHED; PG8_LDA(At, 1, 0); PG8_STAGE(PG8_SA(0, 1), a2 + hstep, voffA);
            PG8_WAIT_V(8); PG8_WAIT_L(0); PG8_BAR; PG8_MMA(0, 0, At, B0); PG8_MMA(0, 1, At, B1); PG8_BAR; PG8_SCHED;
            PG8_LDA(At, 1, 1); PG8_STAGE(PG8_SB(1, 0), b3, voffB); PG8_STAGE(PG8_SB(1, 1), b3 + hstep, voffB); PG8_STAGE(PG8_SA(1, 0), a3, voffA);
            PG8_WAIT_V(8); PG8_WAIT_L(0); PG8_BAR; PG8_MMA(1, 0, At, B0); PG8_MMA(1, 1, At, B1); PG8_BAR; PG8_SCHED;
            } else {
            PG8_LDB(B0, 0, 0); PG8_SCHED; PG8_LDA(At, 0, 0); PG8_STAGE(PG8_SA(1, 1), a1 + hstep, voffA);
            PG8_WAIT_L(8); PG8_BAR; PG8_WAIT_L(0); PG8_MMA(0, 0, At, B0); PG8_BAR; PG8_SCHED;
            PG8_LDB(B1, 0, 1); PG8_STAGE(PG8_SB(0, 0), b2, voffB);
            PG8_BAR; PG8_WAIT_L(0); PG8_MMA(0, 1, At, B1); PG8_BAR;
            PG8_LDA(At, 0, 1); PG8_STAGE(PG8_SA(0, 0), a2, voffA);
            PG8_BAR; PG8_WAIT_L(0); PG8_MMA(1, 0, At, B0); PG8_BAR; PG8_SCHED;
            PG8_STAGE(PG8_SB(0, 1), b2 + hstep, voffB);
            PG8_WAIT_V(6); PG8_BAR; PG8_MMA(1, 1, At, B1); PG8_BAR;
            PG8_LDB(B0, 1, 0); PG8_SCHED; PG8_LDA(At, 1, 0); PG8_STAGE(PG8_SA(0, 1), a2 + hstep, voffA);
            PG8_WAIT_L(8); PG8_BAR; PG8_WAIT_L(0); PG8_MMA(0, 0, At, B0); PG8_BAR; PG8_SCHED;
            PG8_LDB(B1, 1, 1); PG8_STAGE(PG8_SB(1, 0), b3, voffB);
            PG8_BAR; PG8_WAIT_L(0); PG8_MMA(0, 1, At, B1); PG8_BAR;
            PG8_LDA(At, 1, 1); PG8_STAGE(PG8_SA(1, 0), a3, voffA);
            PG8_BAR; PG8_WAIT_L(0); PG8_MMA(1, 0, At, B0); PG8_BAR; PG8_SCHED;
            PG8_STAGE(PG8_SB(1, 1), b3 + hstep, voffB);
            PG8_WAIT_V(6); PG8_BAR; PG8_MMA(1, 1, At, B1); PG8_BAR;
            }
        }
        if constexpr (ALIGN_EPI) { if (wr == 0) PG8_BAR; }
        if constexpr (!Epi::AFTER_DRAIN) { E(acc, cur, wr, wc, fr, fq); S.done(cur); }
        if (!has_next) break;
#pragma unroll
        for (int a = 0; a < 2; ++a)
#pragma unroll
            for (int b = 0; b < 2; ++b)
#pragma unroll
                for (int m = 0; m < 4; ++m)
#pragma unroll
                    for (int n = 0; n < 2; ++n) acc[a][b][m][n] = (f32x4){0.f, 0.f, 0.f, 0.f};
        cur = nxt; cA = nA; cB = nB; ++ui;
        if constexpr (ALIGN_EPI) { if (wr == 1) PG8_BAR; }
    }
    PG8_WAIT_V(0);
    if constexpr (!ALIGN_EPI) { if (wr == 0) PG8_BAR; }
    PG8_BAR;
    if constexpr (Epi::AFTER_DRAIN) { E.fused(acc, cur, wr, wc, fr, fq, lds, wid, lane); S.done(cur); }
#undef PG8_SA
#undef PG8_SB
#undef PG8_STAGE
#undef PG8_LDA
#undef PG8_LDB
#undef PG8_MMA
#undef PG8_WAIT_V
#undef PG8_WAIT_L
#undef PG8_BAR
#undef PG8_SCHED
}
}

#ifndef PG8_SP2
#define PG8_SP2 true
#endif
#ifndef PG8_ALIGN
#define PG8_ALIGN true
#endif

constexpr int NWAVES = 8;
constexpr int N_PHASES = 13;
#ifndef MK_N_LAUNCHES
#define MK_N_LAUNCHES 1
#endif
constexpr int N_LAUNCHES = MK_N_LAUNCHES;

constexpr int D = 2048, M = 65536, NIN = 10496;
constexpr int LP = 16384, LS = 2048;
constexpr int DS5 = 1024, DRW = 1024, DRWIN = 3328;
constexpr float RMS_EPS = 1e-6f, GN_EPS = 64e-5f, L2_EPS = 1e-12f;

constexpr size_t MiB = 1u << 20;
constexpr size_t WS_CTL = 0, CTL_ZERO_BYTES = 1 * MiB;
constexpr size_t WS_WT = 1 * MiB;
constexpr size_t WS_GLUT = 42 * MiB;
constexpr size_t WS_S5OT = 44 * MiB;
constexpr size_t WS_RWOT = 48 * MiB;
constexpr size_t WS_WOT = 52 * MiB;
constexpr size_t WS_HN = 60 * MiB;
constexpr size_t WS_S5U = 316 * MiB;
constexpr size_t WS_RWIN = 444 * MiB;
constexpr size_t WS_Z = 860 * MiB;
constexpr size_t WS_LUT = 988 * MiB;
constexpr size_t WS_STATE = 990 * MiB;
constexpr size_t WS_END = 1000 * MiB;
constexpr size_t DO_YF = 0, DO_YB = 128 * MiB, DO_SF = 256 * MiB, DO_SB = 384 * MiB, DO_Q = 256 * MiB;
constexpr int CW_BAR = 4096;

constexpr int LDS_BYTES = 147456;
constexpr int MISC_OFF = LDS_BYTES - 512;
constexpr int WAVE_SCR = 18176;
static_assert(NWAVES * WAVE_SCR <= MISC_OFF && pg8::STAGE_BYTES <= MISC_OFF, "LDS map");

#define GAS __attribute__((address_space(1)))
#define LAS __attribute__((address_space(3)))
typedef unsigned short bf16;
typedef unsigned v4u __attribute__((ext_vector_type(4)));
typedef unsigned v2u __attribute__((ext_vector_type(2)));
typedef float f32x4 __attribute__((ext_vector_type(4)));
#define LDS_WAIT() asm volatile("s_waitcnt lgkmcnt(0)" ::: "memory")
#define VM_WAIT() asm volatile("s_waitcnt vmcnt(0)" ::: "memory")
__device__ __forceinline__ unsigned f2bf(float f) { unsigned u = __builtin_bit_cast(unsigned, f); return (u + 0x7fffu + ((u >> 16) & 1u)) >> 16; }
__device__ __forceinline__ unsigned pk2(float lo, float hi) { return f2bf(lo) | (f2bf(hi) << 16); }
__device__ __forceinline__ float bf2f(bf16 b) { return __uint_as_float(((unsigned)b) << 16); }
__device__ __forceinline__ float blo(unsigned u) { return __uint_as_float(u << 16); }
__device__ __forceinline__ float bhi(unsigned u) { return __uint_as_float(u & 0xffff0000u); }
__device__ __forceinline__ float wave_sum(float v) {
#pragma unroll
    for (int o = 1; o < 64; o <<= 1) v += __shfl_xor(v, o);
    return v;
}
__device__ __forceinline__ float sigm(float v) { return 1.0f / (1.0f + __expf(-v)); }
__device__ __forceinline__ float gelu_tanh(float x) { const float u = 0.7978845608028654f * (x + 0.044715f * x * x * x); return 0.5f * x * (1.0f + tanhf(u)); }

#define XB_TMO      128
#define XB_XCNT(j)  (256  + 64 * (j))
#define XB_XSUB(j)  (1280 + 64 * (j))
#define XB_XGEN(j)  (2304 + 64 * (j))
#define XB_TOP      3328
#define XB_TOPGEN   3392
#define XCD_BAR_WORDS 3456
#define XB_SPIN_CAP (1u << 18)

__device__ __forceinline__ unsigned xb_ld(unsigned* p)              { return __hip_atomic_load(p, __ATOMIC_RELAXED, __HIP_MEMORY_SCOPE_AGENT); }
__device__ __forceinline__ unsigned xb_add(unsigned* p, unsigned v) { return __hip_atomic_fetch_add(p, v, __ATOMIC_RELAXED, __HIP_MEMORY_SCOPE_AGENT); }
__device__ __forceinline__ unsigned xb_xcc_id() { return (unsigned)__builtin_amdgcn_s_getreg((3 << 11) | 20) & 0xFu; }
#define XB_SPIN(cond, bar) do { unsigned _sp = 0; while (cond) { __builtin_amdgcn_s_sleep(1); \
    if ((++_sp & 255u) == 0u) { if (xb_ld(&(bar)[XB_TMO])) break; if (_sp > XB_SPIN_CAP) { atomicAdd(&(bar)[XB_TMO], 1u); break; } } } } while (0)

struct XcdBarrier {
    unsigned* bar; unsigned x;
    volatile LAS unsigned* st;
};

__device__ __forceinline__ XcdBarrier xcd_barrier_post(unsigned* bar, volatile LAS unsigned* st, const int mk_wave) {
    XcdBarrier b; b.bar = bar; b.x = xb_xcc_id(); b.st = st;
    if (mk_wave == 0 && mk_lane() == 0) (void)xb_add(&bar[XB_XCNT(b.x)], 1u);
    return b;
}
__device__ __forceinline__ void xcd_barrier_complete(unsigned* bar, unsigned x, unsigned& nloc, unsigned& nx) {
    const unsigned G = gridDim.x * gridDim.y * gridDim.z;
    unsigned sum, cnt, mine, sp = 0u;
    for (;;) {
        sum = 0u; cnt = 0u; mine = 0u;
#pragma unroll
        for (unsigned j = 0; j < 16; ++j) { const unsigned c = xb_ld(&bar[XB_XCNT(j)]); sum += c; cnt += (c > 0u) ? 1u : 0u; mine = (j == x) ? c : mine; }
        if (sum == G) break;
        __builtin_amdgcn_s_sleep(1);
        if ((++sp & 255u) == 0u) { if (xb_ld(&bar[XB_TMO])) break; if (sp > XB_SPIN_CAP) { atomicAdd(&bar[XB_TMO], 1u); break; } }
    }
    nloc = mine > 0u ? mine : 1u; nx = cnt > 0u ? cnt : 1u;
}

__device__ __forceinline__ void xcd_barrier(const XcdBarrier& b, const int mk_wave) {
    asm volatile("s_waitcnt vmcnt(0)" ::: "memory");
    __syncthreads();
    if (mk_wave == 0 && mk_lane() == 0) {
        unsigned* bar = b.bar;
        __builtin_amdgcn_s_waitcnt(0);
        unsigned nloc = b.st[0], nx = b.st[1];
        if (nloc == 0u) { xcd_barrier_complete(bar, b.x, nloc, nx); b.st[0] = nloc; b.st[1] = nx; }
        const unsigned old = xb_add(&bar[XB_XSUB(b.x)], 1u);
        const unsigned gen = old / nloc;
        if (old + 1u == (gen + 1u) * nloc) {
            __builtin_amdgcn_fence(__ATOMIC_RELEASE, "agent");
            asm volatile("s_waitcnt vmcnt(0)" ::: "memory");
            const unsigned og = xb_add(&bar[XB_TOP], 1u);
            const unsigned tg = og / nx;
            if (og + 1u == (tg + 1u) * nx) xb_add(&bar[XB_TOPGEN], 1u);
            else XB_SPIN(xb_ld(&bar[XB_TOPGEN]) == tg, bar);
            __builtin_amdgcn_fence(__ATOMIC_ACQUIRE, "agent");
            xb_add(&bar[XB_XGEN(b.x)], 1u);
            asm volatile("s_waitcnt vmcnt(0)" ::: "memory");
        } else {
            XB_SPIN(xb_ld(&bar[XB_XGEN(b.x)]) == gen, bar);
            __builtin_amdgcn_fence(__ATOMIC_ACQUIRE, "agent");
            asm volatile("s_waitcnt vmcnt(0)" ::: "memory");
        }
    }
    __syncthreads();
}


struct Args { const float* in[27]; float* out; unsigned char* ws; int ph_lo, ph_hi, li, pad; };

__device__ __forceinline__ void transpose_item(const float* W, int ldw, int K, bf16* WT, int drow0, LAS float* scr, int k0, int n0, int lane) {
#pragma unroll 8
    for (int i = 0; i < 32; ++i) { const int kk = 2 * i + (lane >> 5); scr[kk * 33 + (lane & 31)] = W[(size_t)(k0 + kk) * ldw + n0 + (lane & 31)]; }
    LDS_WAIT();
    const int c = lane & 7;
#pragma unroll
    for (int j = 0; j < 4; ++j) { const int n = (lane >> 3) + 8 * j; const LAS float* s = scr + (8 * c) * 33 + n;
        v4u o; o.x = pk2(s[0 * 33], s[1 * 33]); o.y = pk2(s[2 * 33], s[3 * 33]); o.z = pk2(s[4 * 33], s[5 * 33]); o.w = pk2(s[6 * 33], s[7 * 33]);
        *(v4u*)(WT + (size_t)(drow0 + n) * K + k0 + 8 * c) = o; }
    LDS_WAIT();
}
__device__ __forceinline__ int win_dest_row(int n) { return n < 1024 ? n : (n < 2048 ? n + 3328 : (n < 5376 ? n - 1024 : n)); }
__device__ __forceinline__ const float* xrow_ptr(const float* xp, const float* xs, int m) { return m < 32768 ? xp + (size_t)m * D : xs + (size_t)(m - 32768) * D; }

__device__ __forceinline__ void p0_prologue(const Args& a, unsigned char* ws, LAS unsigned char* lds, int gw, int NGW, int wave, int lane) {
    LAS float* scr = (LAS float*)(lds + wave * 16384);
    constexpr int I_IN = (D / 64) * (NIN / 32), I_GLU = (1024 / 64) * (1024 / 32), I_SO = (1024 / 64) * (2048 / 32), I_WO = (2048 / 64) * (2048 / 32);
    constexpr int NITEMS = I_IN + I_GLU + 2 * I_SO + I_WO;
    for (int it = gw; it < NITEMS; it += NGW) {
        int r = it;
        if (r < I_IN) { const int nblk = NIN / 32, kb = r / nblk, nb = r % nblk; transpose_item(a.in[4], NIN, D, (bf16*)(ws + WS_WT), win_dest_row(32 * nb), scr, 64 * kb, 32 * nb, lane); continue; } r -= I_IN;
        if (r < I_GLU) { const int nblk = 1024 / 32, kb = r / nblk, nb = r % nblk; transpose_item(a.in[13], 1024, 1024, (bf16*)(ws + WS_GLUT), 32 * nb, scr, 64 * kb, 32 * nb, lane); continue; } r -= I_GLU;
        if (r < I_SO) { const int nblk = 2048 / 32, kb = r / nblk, nb = r % nblk; transpose_item(a.in[14], 2048, 1024, (bf16*)(ws + WS_S5OT), 32 * nb, scr, 64 * kb, 32 * nb, lane); continue; } r -= I_SO;
        if (r < I_SO) { const int nblk = 2048 / 32, kb = r / nblk, nb = r % nblk; transpose_item(a.in[25], 2048, 1024, (bf16*)(ws + WS_RWOT), 32 * nb, scr, 64 * kb, 32 * nb, lane); continue; } r -= I_SO;
        { const int nblk = 2048 / 32, kb = r / nblk, nb = r % nblk; transpose_item(a.in[26], 2048, 2048, (bf16*)(ws + WS_WOT), 32 * nb, scr, 64 * kb, 32 * nb, lane); }
    }
    { bf16* LUT = (bf16*)(ws + WS_LUT);
      for (int e = gw * 64 + lane; e < 4 * 16 * 64 * 64; e += NGW * 64) {
          const int j = e & 63, c = (e >> 6) & 63, h = (e >> 12) & 15, rd = e >> 16, role = rd >> 1, d = rd & 1;
          LUT[e] = (bf16)f2bf((role ? a.in[19] : a.in[17])[(size_t)(d * 64 + j) * 1024 + h * 64 + c]); } }
    const float* g = a.in[2];
    f32x4 gv[8];
#pragma unroll
    for (int j = 0; j < 8; ++j) gv[j] = ((const f32x4*)g)[lane + 64 * j];
    bf16* HN = (bf16*)(ws + WS_HN);
    for (int m = gw; m < M; m += NGW) {
        const f32x4* xr = (const f32x4*)xrow_ptr(a.in[0], a.in[1], m) + lane;
        f32x4 v[8]; float s = 0.f;
#pragma unroll
        for (int j = 0; j < 8; ++j) { v[j] = xr[64 * j]; s += (v[j].x * v[j].x + v[j].y * v[j].y) + (v[j].z * v[j].z + v[j].w * v[j].w); }
        const float rstd = 1.0f / sqrtf(wave_sum(s) * (1.0f / D) + RMS_EPS);
        v2u* o8 = (v2u*)(HN + (size_t)m * D) + lane;
#pragma unroll
        for (int j = 0; j < 8; ++j) { v2u o; o.x = pk2(v[j].x * rstd * gv[j].x, v[j].y * rstd * gv[j].y); o.y = pk2(v[j].z * rstd * gv[j].z, v[j].w * rstd * gv[j].w); o8[64 * j] = o; }
    }
}

__device__ __forceinline__ void s5_naive_job(const Args& a, unsigned char* ws, int job, LAS float* scr, int lane) {
    int s, rem; if (job < 256) { s = job / 128; rem = job % 128; } else { s = 2 + (job - 256) / 128; rem = (job - 256) % 128; }
    const int g = rem >> 1, d = rem & 1, p = lane;
    const int base = s < 2 ? s * LP : 32768 + (s - 2) * LS, L = s < 2 ? LP : LS;
    const int gi = d * 64 + g;
    const float lre = a.in[5][gi * 64 + p], lim = a.in[6][gi * 64 + p], dt = expf(a.in[7][gi]);
    const float er = expf(lre * dt); float sn, cs; sincosf(lim * dt, &sn, &cs);
    const float lbr = er * cs, lbi = er * sn;
    const float nr = lbr - 1.0f, ni = lbi, den = lre * lre + lim * lim;
    const float cfr = (nr * lre + ni * lim) / den, cfi = (ni * lre - nr * lim) / den;
    float Bre[16], Bim[16], Cre[16], Cim[16];
#pragma unroll
    for (int h = 0; h < 16; ++h) {
        const float br = a.in[8][((size_t)gi * 64 + p) * 16 + h], bi = a.in[9][((size_t)gi * 64 + p) * 16 + h];
        Bre[h] = cfr * br - cfi * bi; Bim[h] = cfr * bi + cfi * br;
        Cre[h] = a.in[10][((size_t)gi * 16 + h) * 64 + p]; Cim[h] = a.in[11][((size_t)gi * 16 + h) * 64 + p];
    }
    const bf16* U = (const bf16*)(ws + WS_S5U);
    bf16* Y = (bf16*)((unsigned char*)a.out + (d ? DO_SB : DO_SF));
    float xr = 0.f, xi = 0.f;
    for (int n = 0; n < L; n += 4) {
        float part[64];
#pragma unroll
        for (int tk = 0; tk < 4; ++tk) {
            const int t = d ? L - 1 - (n + tk) : n + tk;
            const v4u* up = (const v4u*)(U + (size_t)(base + t) * DS5 + g * 16);
            const v4u u0 = up[0], u1 = up[1];
            const float u[16] = {blo(u0.x), bhi(u0.x), blo(u0.y), bhi(u0.y), blo(u0.z), bhi(u0.z), blo(u0.w), bhi(u0.w), blo(u1.x), bhi(u1.x), blo(u1.y), bhi(u1.y), blo(u1.z), bhi(u1.z), blo(u1.w), bhi(u1.w)};
            float bur = 0.f, bui = 0.f;
#pragma unroll
            for (int h = 0; h < 16; ++h) { bur += Bre[h] * u[h]; bui += Bim[h] * u[h]; }
            const float nxr = lbr * xr - lbi * xi + bur, nxi = lbr * xi + lbi * xr + bui; xr = nxr; xi = nxi;
#pragma unroll
            for (int h = 0; h < 16; ++h) part[tk * 16 + h] = Cre[h] * xr - Cim[h] * xi;
        }
#pragma unroll
        for (int j = 0; j < 64; ++j) scr[p * 65 + j] = part[j];
        LDS_WAIT();
        float sum = 0.f;
#pragma unroll
        for (int l = 0; l < 64; ++l) sum += scr[l * 65 + p];
        const int tk = p >> 4, h = p & 15, t = d ? L - 1 - (n + tk) : n + tk;
        Y[(size_t)(base + t) * DS5 + g * 16 + h] = (bf16)f2bf(sum);
        LDS_WAIT();
    }
}

__device__ __forceinline__ void unpack8(const bf16* p, float (&o)[8]) {
    const v4u a = *(const v4u*)p;
    o[0] = blo(a.x); o[1] = bhi(a.x); o[2] = blo(a.y); o[3] = bhi(a.y); o[4] = blo(a.z); o[5] = bhi(a.z); o[6] = blo(a.w); o[7] = bhi(a.w);
}
__device__ __forceinline__ void pack8(bf16* p, const float (&v)[8]) {
    v4u a; a.x = pk2(v[0], v[1]); a.y = pk2(v[2], v[3]); a.z = pk2(v[4], v[5]); a.w = pk2(v[6], v[7]); *(v4u*)p = a;
}
__device__ __forceinline__ void p3_finalize(const Args& a, unsigned char* ws, int gw, int NGW, int lane) {
    const bf16* U = (const bf16*)(ws + WS_S5U); const bf16* RWIN = (const bf16*)(ws + WS_RWIN); bf16* Z = (bf16*)(ws + WS_Z);
    unsigned char* ob = (unsigned char*)a.out;
    const bf16* SF = (const bf16*)(ob + DO_SF); const bf16* SB = (const bf16*)(ob + DO_SB); bf16* YF = (bf16*)(ob + DO_YF); const bf16* YB = (const bf16*)(ob + DO_YB);
    const int half = gw & 1, c0 = half * 512 + lane * 8;
    float dv[8], lnw[8], lnb[8], rk[8], mur[8], muk[8], muv[8];
#pragma unroll
    for (int j = 0; j < 8; ++j) { dv[j] = a.in[12][c0 + j]; lnw[j] = a.in[23][c0 + j]; lnb[j] = a.in[24][c0 + j]; rk[j] = a.in[22][c0 + j]; mur[j] = a.in[15][c0 + j]; muk[j] = a.in[15][1024 + c0 + j]; muv[j] = a.in[15][2048 + c0 + j]; }
    for (int m = gw >> 1; m < M; m += NGW >> 1) {
        const int t = m < 32768 ? (m & (LP - 1)) : ((m - 32768) & (LS - 1)), L = m < 32768 ? LP : LS;
        const bool hp = t > 0, hn = t < L - 1;
        float o[8];
        {
            float u[8], f[8], b[8];
            unpack8(U + (size_t)m * DS5 + c0, u); unpack8(SF + (size_t)m * DS5 + c0, f); unpack8(SB + (size_t)m * DS5 + c0, b);
#pragma unroll
            for (int j = 0; j < 8; ++j) o[j] = gelu_tanh(dv[j] * u[j] + f[j] + b[j]);
            pack8(Z + (size_t)m * DS5 + c0, o);
        }
        float y[8];
        {
            float yf[8], yb[8];
            unpack8(YF + (size_t)m * DRW + c0, yf); unpack8(YB + (size_t)m * DRW + c0, yb);
#pragma unroll
            for (int j = 0; j < 8; ++j) y[j] = yf[j] + yb[j];
        }
        float s1 = 0.f;
#pragma unroll
        for (int j = 0; j < 8; ++j) s1 += y[j];
        s1 += __shfl_xor(s1, 1); s1 += __shfl_xor(s1, 2); s1 += __shfl_xor(s1, 4);
        const float mean = s1 * (1.0f / 64.0f);
        float s2 = 0.f;
#pragma unroll
        for (int j = 0; j < 8; ++j) { const float dd = y[j] - mean; s2 += dd * dd; }
        s2 += __shfl_xor(s2, 1); s2 += __shfl_xor(s2, 2); s2 += __shfl_xor(s2, 4);
        const float rstd = 1.0f / sqrtf(s2 * (1.0f / 64.0f) + GN_EPS);
        float zr[8], zk[8], zv[8];
        const bf16* pc = RWIN + (size_t)m * DRWIN + c0;
#pragma unroll
        for (int comp = 0; comp < 3; ++comp) {
            float cc[8], pp[8], nn[8];
            unpack8(pc + comp * 1024, cc);
            if (hp) unpack8(pc - DRWIN + comp * 1024, pp); else {
#pragma unroll
                for (int j = 0; j < 8; ++j) pp[j] = 0.f; }
            if (hn) unpack8(pc + DRWIN + comp * 1024, nn); else {
#pragma unroll
                for (int j = 0; j < 8; ++j) nn[j] = 0.f; }
#pragma unroll
            for (int j = 0; j < 8; ++j) {
                const float muc = comp == 0 ? mur[j] : (comp == 1 ? muk[j] : muv[j]);
                const float zz = cc[j] + (0.5f * (pp[j] + nn[j]) - cc[j]) * muc;
                if (comp == 0) zr[j] = zz; else if (comp == 1) zk[j] = zz; else zv[j] = zz;
            }
        }
        float dot = 0.f;
#pragma unroll
        for (int j = 0; j < 8; ++j) dot += zr[j] * zk[j] * rk[j];
        dot += __shfl_xor(dot, 1); dot += __shfl_xor(dot, 2); dot += __shfl_xor(dot, 4);
#pragma unroll
        for (int j = 0; j < 8; ++j) o[j] = (y[j] - mean) * rstd * lnw[j] + lnb[j] + dot * zv[j];
        pack8(YF + (size_t)m * DRW + c0, o);
    }
}

__device__ __forceinline__ void p12_final(const Args& a, int gw, int NGW, int lane) {
    const float* g = a.in[3];
    f32x4 gv[8];
#pragma unroll
    for (int j = 0; j < 8; ++j) gv[j] = ((const f32x4*)g)[lane + 64 * j];
    for (int m = gw; m < M; m += NGW) {
        const f32x4* xr = (const f32x4*)xrow_ptr(a.in[0], a.in[1], m) + lane;
        f32x4* orow = (f32x4*)(a.out + (size_t)m * D) + lane;
        f32x4 v[8]; float s = 0.f;
#pragma unroll
        for (int j = 0; j < 8; ++j) { v[j] = orow[64 * j]; s += (v[j].x * v[j].x + v[j].y * v[j].y) + (v[j].z * v[j].z + v[j].w * v[j].w); }
        const float rstd = 1.0f / sqrtf(wave_sum(s) * (1.0f / D) + RMS_EPS);
#pragma unroll
        for (int j = 0; j < 8; ++j) { const f32x4 xv = xr[64 * j]; orow[64 * j] = xv + v[j] * rstd * gv[j]; }
    }
}


namespace rwk {
typedef short s16x4 __attribute__((ext_vector_type(4)));
typedef short s16x8 __attribute__((ext_vector_type(8)));
constexpr int NSEG = 8;
constexpr int UNITS_PER_SEG = 4096;
constexpr int LDW = 72;
constexpr int MATB = 64 * LDW * 2;
constexpr int O_AB = 0, O_BT = 1 * MATB, O_KT = 2 * MATB, O_RB = 3 * MATB, O_BHT = 4 * MATB, O_KHT = 5 * MATB, O_VT = 6 * MATB;
constexpr int O_MAB = 7 * MATB, O_MAK = 8 * MATB, O_NRB = 9 * MATB, O_NRK = 10 * MATB, O_XT = 11 * MATB  , O_NP = 13 * MATB, O_GT = 14 * MATB;
constexpr int O_TW = O_XT, O_XA = O_XT + MATB;
constexpr int LDC = 68;
constexpr int O_CL = O_MAB, O_AS = O_MAB + 64 * LDC * 4;
constexpr int NPS = 24;
static_assert(O_AS + 64 * LDC * 4 <= O_XT && O_GT + 256 <= 146944, "rwkv LDS map");
constexpr size_t UNIT_ELEMS = 16384;

__device__ __forceinline__ f32x4 mfma32(s16x8 a, s16x8 b, f32x4 c) { return __builtin_amdgcn_mfma_f32_16x16x32_bf16(a, b, c, 0, 0, 0); }
__device__ __forceinline__ f32x4 mfma16(s16x4 a, s16x4 b, f32x4 c) { return __builtin_amdgcn_mfma_f32_16x16x16bf16_1k(a, b, c, 0, 0, 0); }
__device__ __forceinline__ s16x4 pack4(f32x4 v) { v2u p; p.x = pk2(v[0], v[1]); p.y = pk2(v[2], v[3]); return __builtin_bit_cast(s16x4, p); }
__device__ __forceinline__ f32x4 unpack4(v2u p) { return (f32x4){blo(p.x), bhi(p.x), blo(p.y), bhi(p.y)}; }
__device__ __forceinline__ void up8(v4u a, float (&o)[8]) { o[0] = blo(a.x); o[1] = bhi(a.x); o[2] = blo(a.y); o[3] = bhi(a.y); o[4] = blo(a.z); o[5] = bhi(a.z); o[6] = blo(a.w); o[7] = bhi(a.w); }
__device__ __forceinline__ v4u pk8(const float (&v)[8]) { v4u a; a.x = pk2(v[0], v[1]); a.y = pk2(v[2], v[3]); a.z = pk2(v[4], v[5]); a.w = pk2(v[6], v[7]); return a; }

struct UnitId { int h, d, base, L, gchunk, chain; };
__device__ __forceinline__ UnitId decode_unit(int seg, int u) {
    UnitId o; int c, jc, nch;
    if (u < 2048) { c = u >> 5; jc = u & 31; nch = 32; } else { c = 64 + ((u - 2048) >> 2); jc = (u - 2048) & 3; nch = 4; }
    int s, rem; if (c < 64) { s = c >> 5; rem = c & 31; } else { s = 2 + ((c - 64) >> 5); rem = (c - 64) & 31; }
    o.h = rem >> 1; o.d = rem & 1; o.base = s < 2 ? s * LP : 32768 + (s - 2) * LS; o.L = s < 2 ? LP : LS; o.gchunk = seg * nch + jc; o.chain = c;
    return o;
}
__device__ __forceinline__ int unit_of(int chain, int jc) { return chain < 64 ? chain * 32 + jc : 2048 + (chain - 64) * 4 + jc; }

__device__ __forceinline__ void rw_precompute_unit(const Args& a, unsigned char* ws, LAS unsigned char* lds, int seg, int u, int wave, int lane) {
    const UnitId id = decode_unit(seg, u);
    const int h = id.h, d = id.d;
    const int tid = wave * 64 + lane;
    const bf16* RWIN = (const bf16*)(ws + WS_RWIN);
    const int r = lane & 15, g = lane >> 4;
    const int t = tid >> 3, cg = tid & 7, c8 = h * 64 + 8 * cg;
    float zr[8], zk[8], kk[8], zv[8];
    {
        const int lp = 64 * id.gchunk + t, pos = d ? id.L - 1 - lp : lp;
        const bf16* prow = RWIN + (size_t)(id.base + pos) * DRWIN;
        const bool hp = pos > 0, hn = pos < id.L - 1;
        const float* mu = a.in[15];
        float zw[8], za[8];
#pragma unroll
        for (int comp = 0; comp < 5; ++comp) {
            const int col = comp < 3 ? comp * 1024 + c8 : (comp == 3 ? 3072 + d * 64 + 8 * cg : 3200 + d * 64 + 8 * cg);
            float cc[8], pp[8], nn[8];
            up8(*(const v4u*)(prow + col), cc);
            if (hp) up8(*(const v4u*)(prow - DRWIN + col), pp); else {
#pragma unroll
                for (int j = 0; j < 8; ++j) pp[j] = 0.f; }
            if (hn) up8(*(const v4u*)(prow + DRWIN + col), nn); else {
#pragma unroll
                for (int j = 0; j < 8; ++j) nn[j] = 0.f; }
            const f32x4 m0 = *(const f32x4*)(mu + col), m1 = *(const f32x4*)(mu + col + 4);
            const float mv[8] = {m0[0], m0[1], m0[2], m0[3], m1[0], m1[1], m1[2], m1[3]};
#pragma unroll
            for (int j = 0; j < 8; ++j) {
                const float zz = cc[j] + (0.5f * (pp[j] + nn[j]) - cc[j]) * mv[j];
                if (comp == 0) zr[j] = zz; else if (comp == 1) zk[j] = zz; else if (comp == 2) zv[j] = zz; else if (comp == 3) zw[j] = tanhf(zz); else za[j] = zz;
            }
        }
        float ss = 0.f;
        const f32x4 k0 = *(const f32x4*)(a.in[20] + c8), k1 = *(const f32x4*)(a.in[20] + c8 + 4);
        const float kkw[8] = {k0[0], k0[1], k0[2], k0[3], k1[0], k1[1], k1[2], k1[3]};
#pragma unroll
        for (int j = 0; j < 8; ++j) { kk[j] = zk[j] * kkw[j]; ss += kk[j] * kk[j]; }
        ss += __shfl_xor(ss, 1); ss += __shfl_xor(ss, 2); ss += __shfl_xor(ss, 4);
        const float inv = 1.0f / sqrtf(ss + L2_EPS);
#pragma unroll
        for (int j = 0; j < 8; ++j) kk[j] *= inv;
        *(LAS v4u*)(lds + O_TW + (t * LDW + 8 * cg) * 2) = pk8(zw);
        *(LAS v4u*)(lds + O_XA + (t * LDW + 8 * cg) * 2) = pk8(za);
    }
    __syncthreads();
    {
        const int ct = wave & 3, role = wave >> 2;
        const bf16* lut = (const bf16*)(ws + WS_LUT) + ((size_t)((role * 2 + d) * 16 + h) * 64 + 16 * ct + r) * 64 + 8 * g;
        const s16x8 b0 = *(const s16x8*)(lut), b1 = *(const s16x8*)(lut + 32);
        const int aoff = (role ? O_XA : O_TW) + (r * LDW + 8 * g) * 2;
        f32x4 acc[4];
#pragma unroll
        for (int mt = 0; mt < 4; ++mt) {
            const s16x8 a0 = *(const LAS s16x8*)(lds + aoff + mt * 16 * LDW * 2), a1 = *(const LAS s16x8*)(lds + aoff + mt * 16 * LDW * 2 + 64);
            acc[mt] = mfma32(a0, b0, (f32x4){0.f, 0.f, 0.f, 0.f}); acc[mt] = mfma32(a1, b1, acc[mt]);
        }
        const int cch = 16 * ct + r;
        if (role == 0) {
            const float w0v = a.in[16][d * 1024 + h * 64 + cch];
            float carry = 0.f;
#pragma unroll
            for (int mt = 0; mt < 4; ++mt) {
                float s[4];
#pragma unroll
                for (int i = 0; i < 4; ++i) { const float lw = -0.6065306597126334f * sigm(acc[mt][i] + w0v); s[i] = (i ? s[i - 1] : 0.f) + lw; }
                const float tot = s[3];
                const float e1 = __shfl(tot, (lane + 48) & 63), e2 = __shfl(tot, (lane + 32) & 63), e3 = __shfl(tot, (lane + 16) & 63);
                const float excl = (g >= 1 ? e1 : 0.f) + (g >= 2 ? e2 : 0.f) + (g >= 3 ? e3 : 0.f);
                const float all = __shfl(tot + excl, 48 + r);
#pragma unroll
                for (int i = 0; i < 4; ++i) *(LAS float*)(lds + O_CL + ((16 * mt + 4 * g + i) * LDC + cch) * 4) = carry + excl + s[i];
                carry += all;
            }
        } else {
            const float a0v = a.in[18][d * 1024 + h * 64 + cch];
#pragma unroll
            for (int mt = 0; mt < 4; ++mt)
#pragma unroll
                for (int i = 0; i < 4; ++i) *(LAS float*)(lds + O_AS + ((16 * mt + 4 * g + i) * LDC + cch) * 4) = sigm(acc[mt][i] + a0v);
        }
    }
    __syncthreads();
    {
        float cl[8], clp[8], cle[8], as[8];
        { const f32x4 x0 = *(const LAS f32x4*)(lds + O_CL + (t * LDC + 8 * cg) * 4), x1 = *(const LAS f32x4*)(lds + O_CL + (t * LDC + 8 * cg + 4) * 4);
          const f32x4 e0 = *(const LAS f32x4*)(lds + O_CL + (63 * LDC + 8 * cg) * 4), e1 = *(const LAS f32x4*)(lds + O_CL + (63 * LDC + 8 * cg + 4) * 4);
          const f32x4 s0 = *(const LAS f32x4*)(lds + O_AS + (t * LDC + 8 * cg) * 4), s1 = *(const LAS f32x4*)(lds + O_AS + (t * LDC + 8 * cg + 4) * 4);
          f32x4 p0 = (f32x4){0.f, 0.f, 0.f, 0.f}, p1 = p0;
          if (t > 0) { p0 = *(const LAS f32x4*)(lds + O_CL + ((t - 1) * LDC + 8 * cg) * 4); p1 = *(const LAS f32x4*)(lds + O_CL + ((t - 1) * LDC + 8 * cg + 4) * 4); }
#pragma unroll
          for (int j = 0; j < 4; ++j) { cl[j] = x0[j]; cl[4 + j] = x1[j]; cle[j] = e0[j]; cle[4 + j] = e1[j]; as[j] = s0[j]; as[4 + j] = s1[j]; clp[j] = p0[j]; clp[4 + j] = p1[j]; } }
        const f32x4 q0 = *(const f32x4*)(a.in[21] + c8), q1 = *(const f32x4*)(a.in[21] + c8 + 4);
        const float kaw[8] = {q0[0], q0[1], q0[2], q0[3], q1[0], q1[1], q1[2], q1[3]};
        float ab[8], bt[8], kt[8], rb[8], bh[8], kh[8];
#pragma unroll
        for (int j = 0; j < 8; ++j) {
            const float gt = __expf(cl[j]), gi = __expf(-cl[j]), gp = __expf(clp[j]), ge = __expf(cle[j] - cl[j]);
            const float kd = zk[j] * (1.0f + (as[j] - 1.0f) * kaw[j]), kb = kk[j] * as[j];
            ab[j] = -kk[j] * gp; bt[j] = kb * gi; kt[j] = kd * gi; rb[j] = zr[j] * gt; bh[j] = kb * ge; kh[j] = kd * ge;
            if (t == 63) *(LAS float*)(lds + O_GT + (8 * cg + j) * 4) = __expf(cle[j]);
        }
        *(LAS v4u*)(lds + O_AB + (t * LDW + 8 * cg) * 2) = pk8(ab);
        *(LAS v4u*)(lds + O_BT + (t * LDW + 8 * cg) * 2) = pk8(bt);
        *(LAS v4u*)(lds + O_KT + (t * LDW + 8 * cg) * 2) = pk8(kt);
        *(LAS v4u*)(lds + O_RB + (t * LDW + 8 * cg) * 2) = pk8(rb);
#pragma unroll
        for (int j = 0; j < 8; ++j) {
            *(LAS bf16*)(lds + O_BHT + ((8 * cg + j) * LDW + t) * 2) = (bf16)f2bf(bh[j]);
            *(LAS bf16*)(lds + O_KHT + ((8 * cg + j) * LDW + t) * 2) = (bf16)f2bf(kh[j]);
            *(LAS bf16*)(lds + O_VT + ((8 * cg + j) * LDW + t) * 2) = (bf16)f2bf(zv[j]);
        }
    }
    __syncthreads();
    {
        const int nt = wave >> 1, pr = wave & 1;
        const int boff = ((16 * nt + r) * LDW + 8 * g) * 2;
        const s16x8 ab0 = *(const LAS s16x8*)(lds + O_AB + boff), ab1 = *(const LAS s16x8*)(lds + O_AB + boff + 64);
        const s16x8 rb0 = *(const LAS s16x8*)(lds + O_RB + boff), rb1 = *(const LAS s16x8*)(lds + O_RB + boff + 64);
        const int asrc = (pr ? O_KT : O_BT) + (r * LDW + 8 * g) * 2;
        const int tt = 16 * nt + r;
#pragma unroll
        for (int mt = 0; mt < 4; ++mt) {
            const s16x8 x0 = *(const LAS s16x8*)(lds + asrc + mt * 16 * LDW * 2), x1 = *(const LAS s16x8*)(lds + asrc + mt * 16 * LDW * 2 + 64);
            f32x4 m = mfma32(x0, ab0, (f32x4){0.f, 0.f, 0.f, 0.f}); m = mfma32(x1, ab1, m);
            f32x4 n = mfma32(x0, rb0, (f32x4){0.f, 0.f, 0.f, 0.f}); n = mfma32(x1, rb1, n);
#pragma unroll
            for (int i = 0; i < 4; ++i) { const int j = 16 * mt + 4 * g + i; m[i] = j < tt ? m[i] : 0.f; n[i] = j <= tt ? n[i] : 0.f; }
            const int so = (tt * LDW + 16 * mt + 4 * g) * 2;
            *(LAS s16x4*)(lds + (pr ? O_MAK : O_MAB) + so) = pack4(m);
            *(LAS s16x4*)(lds + (pr ? O_NRK : O_NRB) + so) = pack4(n);
        }
    }
    __syncthreads();
    f32x4 rhs[4];
    if (wave < 4) {
        const int bi = wave;
        const s16x4 aN = *(const LAS s16x4*)(lds + O_MAB + ((16 * bi + r) * LDW + 16 * bi + 4 * g) * 2);
        s16x4 bN;
#pragma unroll
        for (int i = 0; i < 4; ++i) bN[i] = *(const LAS short*)(lds + O_MAB + ((16 * bi + 4 * g + i) * LDW + 16 * bi + r) * 2);
        f32x4 c2 = mfma16(aN, bN, (f32x4){0.f, 0.f, 0.f, 0.f});
        const int npb = O_NP + bi * 3 * 16 * NPS * 2;
#pragma unroll
        for (int p = 0; p < 3; ++p) {
#pragma unroll
            for (int i = 0; i < 4; ++i) *(LAS bf16*)(lds + npb + p * 16 * NPS * 2 + ((4 * g + i) * NPS + r) * 2) = (bf16)f2bf(c2[i]);
            LDS_WAIT();
            if (p < 2) { const s16x4 aP = *(const LAS s16x4*)(lds + npb + p * 16 * NPS * 2 + (r * NPS + 4 * g) * 2); c2 = mfma16(aP, pack4(c2), (f32x4){0.f, 0.f, 0.f, 0.f}); }
        }
#pragma unroll
        for (int mt = 0; mt < 4; ++mt)
#pragma unroll
            for (int i = 0; i < 4; ++i) rhs[mt][i] = bf2f(*(const LAS bf16*)(lds + O_AB + ((16 * mt + 4 * g + i) * LDW + 16 * wave + r) * 2));
    } else {
        const int vt = wave - 4;
        const int boff = ((16 * vt + r) * LDW + 8 * g) * 2;
        const s16x8 v0 = *(const LAS s16x8*)(lds + O_VT + boff), v1 = *(const LAS s16x8*)(lds + O_VT + boff + 64);
#pragma unroll
        for (int mt = 0; mt < 4; ++mt) {
            const int ao = O_MAK + ((16 * mt + r) * LDW + 8 * g) * 2;
            const s16x8 x0 = *(const LAS s16x8*)(lds + ao), x1 = *(const LAS s16x8*)(lds + ao + 64);
            rhs[mt] = mfma32(x0, v0, (f32x4){0.f, 0.f, 0.f, 0.f}); rhs[mt] = mfma32(x1, v1, rhs[mt]);
        }
    }
    __syncthreads();
    {
        f32x4 xb[4];
#pragma unroll
        for (int bi = 0; bi < 4; ++bi) {
            f32x4 acc = rhs[bi];
#pragma unroll
            for (int bj = 0; bj < 4; ++bj) if (bj < bi) {
                const s16x4 am = *(const LAS s16x4*)(lds + O_MAB + ((16 * bi + r) * LDW + 16 * bj + 4 * g) * 2);
                acc = mfma16(am, pack4(xb[bj]), acc);
            }
#pragma unroll
            for (int p = 0; p < 4; ++p) {
                const s16x4 ap = p == 0 ? *(const LAS s16x4*)(lds + O_MAB + ((16 * bi + r) * LDW + 16 * bi + 4 * g) * 2)
                                        : *(const LAS s16x4*)(lds + O_NP + (bi * 3 + (p - 1)) * 16 * NPS * 2 + (r * NPS + 4 * g) * 2);
                acc = mfma16(ap, pack4(acc), acc);
            }
            xb[bi] = acc;
            *(LAS s16x4*)(lds + O_XT + ((16 * wave + r) * LDW + 16 * bi + 4 * g) * 2) = pack4(acc);
        }
    }
    __syncthreads();
    {
        const int nt = wave & 3;
        bf16* ug = (bf16*)(ws + WS_Z) + (size_t)u * UNIT_ELEMS;
        const int boff = ((16 * nt + r) * LDW + 8 * g) * 2;
        if (wave < 4) {
            const s16x8 bh0 = *(const LAS s16x8*)(lds + O_BHT + boff), bh1 = *(const LAS s16x8*)(lds + O_BHT + boff + 64);
            const s16x8 nb0 = *(const LAS s16x8*)(lds + O_NRB + boff), nb1 = *(const LAS s16x8*)(lds + O_NRB + boff + 64);
            v2u po[4], ro[4];
#pragma unroll
            for (int mt = 0; mt < 4; ++mt) {
                const int ao = O_XT + ((16 * mt + r) * LDW + 8 * g) * 2;
                const s16x8 x0 = *(const LAS s16x8*)(lds + ao), x1 = *(const LAS s16x8*)(lds + ao + 64);
                f32x4 p = mfma32(x0, bh0, (f32x4){0.f, 0.f, 0.f, 0.f}); p = mfma32(x1, bh1, p);
                if (mt == nt) { const float gt = *(const LAS float*)(lds + O_GT + (16 * mt + r) * 4);
#pragma unroll
                    for (int i = 0; i < 4; ++i) p[i] += (4 * g + i == r) ? gt : 0.f; }
                const f32x4 rbv = unpack4(*(const LAS v2u*)(lds + O_RB + ((16 * nt + r) * LDW + 16 * mt + 4 * g) * 2));
                f32x4 q = mfma32(x0, nb0, rbv); q = mfma32(x1, nb1, q);
                po[mt] = __builtin_bit_cast(v2u, pack4(p)); ro[mt] = __builtin_bit_cast(v2u, pack4(q));
            }
            v4u* pg = (v4u*)(ug + (size_t)(nt * 64 + lane) * 16);
            pg[0] = (v4u){po[0].x, po[0].y, po[1].x, po[1].y}; pg[1] = (v4u){po[2].x, po[2].y, po[3].x, po[3].y};
            v4u* rg = (v4u*)(ug + 4096 + (size_t)(nt * 64 + lane) * 16);
            rg[0] = (v4u){ro[0].x, ro[0].y, ro[1].x, ro[1].y}; rg[1] = (v4u){ro[2].x, ro[2].y, ro[3].x, ro[3].y};
        } else {
            const s16x8 u0 = *(const LAS s16x8*)(lds + O_XT + 64 * LDW * 2 + boff), u1 = *(const LAS s16x8*)(lds + O_XT + 64 * LDW * 2 + boff + 64);
            const s16x8 v0 = *(const LAS s16x8*)(lds + O_VT + boff), v1 = *(const LAS s16x8*)(lds + O_VT + boff + 64);
            v2u qo[4], yo[4];
#pragma unroll
            for (int mt = 0; mt < 4; ++mt) {
                const int ro_ = ((16 * mt + r) * LDW + 8 * g) * 2;
                const s16x8 b0 = *(const LAS s16x8*)(lds + O_BHT + ro_), b1 = *(const LAS s16x8*)(lds + O_BHT + ro_ + 64);
                const s16x8 k0 = *(const LAS s16x8*)(lds + O_KHT + ro_), k1 = *(const LAS s16x8*)(lds + O_KHT + ro_ + 64);
                f32x4 q = mfma32(b0, u0, (f32x4){0.f, 0.f, 0.f, 0.f}); q = mfma32(b1, u1, q); q = mfma32(k0, v0, q); q = mfma32(k1, v1, q);
                const s16x8 n0 = *(const LAS s16x8*)(lds + O_NRB + ro_), n1 = *(const LAS s16x8*)(lds + O_NRB + ro_ + 64);
                const s16x8 m0 = *(const LAS s16x8*)(lds + O_NRK + ro_), m1 = *(const LAS s16x8*)(lds + O_NRK + ro_ + 64);
                f32x4 y = mfma32(n0, u0, (f32x4){0.f, 0.f, 0.f, 0.f}); y = mfma32(n1, u1, y); y = mfma32(m0, v0, y); y = mfma32(m1, v1, y);
                qo[mt] = __builtin_bit_cast(v2u, pack4(q)); yo[mt] = __builtin_bit_cast(v2u, pack4(y));
            }
            v4u* qg = (v4u*)(ug + 8192 + (size_t)(nt * 64 + lane) * 16);
            qg[0] = (v4u){qo[0].x, qo[0].y, qo[1].x, qo[1].y}; qg[1] = (v4u){qo[2].x, qo[2].y, qo[3].x, qo[3].y};
            v4u* yg = (v4u*)(ug + 12288 + (size_t)(nt * 64 + lane) * 16);
            yg[0] = (v4u){yo[0].x, yo[0].y, yo[1].x, yo[1].y}; yg[1] = (v4u){yo[2].x, yo[2].y, yo[3].x, yo[3].y};
        }
    }
    __syncthreads();
}

__device__ __forceinline__ void rw_chain_job(const Args& a, unsigned char* ws, int seg, int chain, int vt, int lane) {
    int s, rem; if (chain < 64) { s = chain >> 5; rem = chain & 31; } else { s = 2 + ((chain - 64) >> 5); rem = (chain - 64) & 31; }
    const int h = rem >> 1, d = rem & 1, base = s < 2 ? s * LP : 32768 + (s - 2) * LS, L = s < 2 ? LP : LS, nch = chain < 64 ? 32 : 4;
    const int r = lane & 15, g = lane >> 4;
    f32x4* stp = (f32x4*)(ws + WS_STATE) + ((size_t)(chain * 4 + vt) * 4) * 64 + lane;
    f32x4 st[4];
#pragma unroll
    for (int i = 0; i < 4; ++i) st[i] = seg == 0 ? (f32x4){0.f, 0.f, 0.f, 0.f} : stp[i * 64];
    bf16* Y = (bf16*)((unsigned char*)a.out + (d ? DO_YB : DO_YF));
    const bf16* ub = (const bf16*)(ws + WS_Z);
    for (int jc = 0; jc < nch; ++jc) {
        const bf16* ug = ub + (size_t)unit_of(chain, jc) * UNIT_ELEMS;
        v4u pf[4][2], rf[4][2];
#pragma unroll
        for (int i = 0; i < 4; ++i) { const v4u* p = (const v4u*)(ug + (size_t)(i * 64 + lane) * 16); pf[i][0] = p[0]; pf[i][1] = p[1];
                                      const v4u* q = (const v4u*)(ug + 4096 + (size_t)(i * 64 + lane) * 16); rf[i][0] = q[0]; rf[i][1] = q[1]; }
        const v4u* qp = (const v4u*)(ug + 8192 + (size_t)(vt * 64 + lane) * 16); const v4u qf0 = qp[0], qf1 = qp[1];
        const v4u* yp = (const v4u*)(ug + 12288 + (size_t)(vt * 64 + lane) * 16); const v4u yf0 = yp[0], yf1 = yp[1];
        s16x4 sb[4];
#pragma unroll
        for (int kt = 0; kt < 4; ++kt) sb[kt] = pack4(st[kt]);
        const int gchunk = seg * nch + jc;
#pragma unroll
        for (int tt = 0; tt < 4; ++tt) {
            const v2u yi = tt == 0 ? (v2u){yf0.x, yf0.y} : tt == 1 ? (v2u){yf0.z, yf0.w} : tt == 2 ? (v2u){yf1.x, yf1.y} : (v2u){yf1.z, yf1.w};
            f32x4 acc = unpack4(yi);
            acc = mfma16(__builtin_bit_cast(s16x4, (v2u){rf[tt][0].x, rf[tt][0].y}), sb[0], acc);
            acc = mfma16(__builtin_bit_cast(s16x4, (v2u){rf[tt][0].z, rf[tt][0].w}), sb[1], acc);
            acc = mfma16(__builtin_bit_cast(s16x4, (v2u){rf[tt][1].x, rf[tt][1].y}), sb[2], acc);
            acc = mfma16(__builtin_bit_cast(s16x4, (v2u){rf[tt][1].z, rf[tt][1].w}), sb[3], acc);
#pragma unroll
            for (int i = 0; i < 4; ++i) { const int lp = 64 * gchunk + 16 * tt + 4 * g + i, pos = d ? L - 1 - lp : lp;
                Y[(size_t)(base + pos) * DRW + h * 64 + 16 * vt + r] = (bf16)f2bf(acc[i]); }
        }
        f32x4 sn[4];
#pragma unroll
        for (int i = 0; i < 4; ++i) {
            const v2u qi = i == 0 ? (v2u){qf0.x, qf0.y} : i == 1 ? (v2u){qf0.z, qf0.w} : i == 2 ? (v2u){qf1.x, qf1.y} : (v2u){qf1.z, qf1.w};
            f32x4 acc = unpack4(qi);
            acc = mfma16(__builtin_bit_cast(s16x4, (v2u){pf[i][0].x, pf[i][0].y}), sb[0], acc);
            acc = mfma16(__builtin_bit_cast(s16x4, (v2u){pf[i][0].z, pf[i][0].w}), sb[1], acc);
            acc = mfma16(__builtin_bit_cast(s16x4, (v2u){pf[i][1].x, pf[i][1].y}), sb[2], acc);
            acc = mfma16(__builtin_bit_cast(s16x4, (v2u){pf[i][1].z, pf[i][1].w}), sb[3], acc);
            sn[i] = acc;
        }
#pragma unroll
        for (int i = 0; i < 4; ++i) st[i] = sn[i];
    }
#pragma unroll
    for (int i = 0; i < 4; ++i) stp[i * 64] = st[i];
}
}

__global__ void __launch_bounds__(NWAVES * 64, 2) mk_fwd(Args args) {
    extern __shared__ __attribute__((aligned(16))) unsigned char lds_raw[];
    LAS unsigned char* lds = (LAS unsigned char*)lds_raw;
    volatile LAS unsigned* MISC = (volatile LAS unsigned*)(lds + MISC_OFF);
    const int wave = __builtin_amdgcn_readfirstlane((int)threadIdx.x >> 6);
#define lane mk_lane()
    const int tid0 = threadIdx.x;
    const int G = gridDim.x; const int bx = blockIdx.x; const int vcu = (G % 8 == 0) ? (bx % 8) * (G / 8) + bx / 8 : bx;
    unsigned char* ws = args.ws;
    unsigned* ctl = (unsigned*)(ws + WS_CTL);
    for (int u = tid0; u < (LDS_BYTES - MISC_OFF) / 4; u += NWAVES * 64) ((LAS unsigned*)(lds + MISC_OFF))[u] = 0u;
    __syncthreads();
    XcdBarrier bar; bar.bar = ctl + CW_BAR; bar.x = 0; bar.st = nullptr;
    if (N_LAUNCHES == 1) bar = xcd_barrier_post(ctl + CW_BAR, MISC + 8, wave);
#define GRID_BAR() do { if (N_LAUNCHES == 1) xcd_barrier(bar, wave); } while (0)
    const int lo = args.ph_lo, hi = args.ph_hi;
#ifndef ONLY_PHASE
#define ONLY_PHASE -1
#endif
#define IN(k) ((ONLY_PHASE < 0 || ONLY_PHASE == (k)) && lo <= (k) && (k) < hi)
#define BOTH(k) (IN(k) && IN((k) + 1))
    const int gw = vcu * NWAVES + wave, NGW = G * NWAVES;
    bf16* WT = (bf16*)(ws + WS_WT); bf16* HN = (bf16*)(ws + WS_HN); bf16* S5U = (bf16*)(ws + WS_S5U); bf16* RWIN = (bf16*)(ws + WS_RWIN); bf16* Z = (bf16*)(ws + WS_Z);
    bf16* YN = (bf16*)((unsigned char*)args.out + DO_YF); bf16* Q = (bf16*)((unsigned char*)args.out + DO_Q); bf16* P = RWIN;

    if (IN(0)) { p0_prologue(args, ws, lds, gw, NGW, wave, lane); if (BOTH(0)) GRID_BAR(); }
    if (IN(1)) {
        pg8::Gemm g{HN, WT, M, 4352, D}; pg8::StaticOrder S; S.init(M, 4352, G, bx);
        pg8::EpiG1 E{S5U, RWIN};
        pg8::gemm_phase<pg8::EpiG1, pg8::StaticOrder, PG8_ALIGN, PG8_SP2>(lds, g, S, E, wave);
        if (BOTH(1)) GRID_BAR();
    }
    if (IN(2)) {
        for (int seg = 0; seg < rwk::NSEG; ++seg) {
            for (int u = bx; u < rwk::UNITS_PER_SEG; u += G) rwk::rw_precompute_unit(args, ws, lds, seg, u, wave, lane);
            GRID_BAR();
            {
                int J, Jstride;
                if (bx < 64 && wave < 4) { J = bx * 4 + wave; Jstride = 1 << 20; }
                else { const int fw = bx < 64 ? bx * 4 + (wave - 4) : 256 + (bx - 64) * 8 + wave; J = 256 + fw; Jstride = 1792; }
                for (; J < 2304; J += Jstride) {
                    const int chain = J < 256 ? (J >> 2) : 64 + ((J - 256) >> 2), vt = J & 3;
                    rwk::rw_chain_job(args, ws, seg, chain, vt, lane);
                }
            }
            GRID_BAR();
        }
        LAS float* scr = (LAS float*)(lds + wave * WAVE_SCR);
        const int gwt = wave * G + vcu;
        for (int j = gwt; j < 2304; j += NGW) {
#ifndef NO_S5JOB
            s5_naive_job(args, ws, j, scr, lane);
#endif
        }
        if (BOTH(2)) GRID_BAR();
    }
    if (IN(3)) { p3_finalize(args, ws, gw, NGW, lane); if (BOTH(3)) GRID_BAR(); }
    if (IN(4)) {
        pg8::Gemm g{Z, (const bf16*)(ws + WS_GLUT), M, 1024, 1024}; pg8::StaticOrder S; S.init(M, 1024, G, bx);
        pg8::EpiMix<1> E{S5U, Z, nullptr, 1024};
        pg8::gemm_phase<pg8::EpiMix<1>, pg8::StaticOrder, PG8_ALIGN, PG8_SP2>(lds, g, S, E, wave);
        if (BOTH(4)) GRID_BAR();
    }
    if (IN(5)) {
        pg8::Gemm g{HN, WT + (size_t)4352 * D, M, 1024, D}; pg8::StaticOrder S; S.init(M, 1024, G, bx);
        pg8::EpiMix<2> E{S5U, S5U, nullptr, 1024};
        pg8::gemm_phase<pg8::EpiMix<2>, pg8::StaticOrder, PG8_ALIGN, PG8_SP2>(lds, g, S, E, wave);
        if (BOTH(5)) GRID_BAR();
    }
    if (IN(6)) {
        pg8::Gemm g{HN, WT + (size_t)5376 * D, M, 1024, D}; pg8::StaticOrder S; S.init(M, 1024, G, bx);
        pg8::EpiMix<2> E{YN, YN, nullptr, 1024};
        pg8::gemm_phase<pg8::EpiMix<2>, pg8::StaticOrder, PG8_ALIGN, PG8_SP2>(lds, g, S, E, wave);
        if (BOTH(6)) GRID_BAR();
    }
    if (IN(7)) {
        pg8::Gemm g{S5U, (const bf16*)(ws + WS_S5OT), M, 2048, 1024}; pg8::StaticOrder S; S.init(M, 2048, G, bx);
        pg8::EpiMix<0> E{P, nullptr, nullptr, 2048};
        pg8::gemm_phase<pg8::EpiMix<0>, pg8::StaticOrder, PG8_ALIGN, PG8_SP2>(lds, g, S, E, wave);
        if (BOTH(7)) GRID_BAR();
    }
    if (IN(8)) {
        pg8::Gemm g{HN, WT + (size_t)6400 * D, M, 2048, D}; pg8::StaticOrder S; S.init(M, 2048, G, bx);
        pg8::EpiMix<1> E{P, P, nullptr, 2048};
        pg8::gemm_phase<pg8::EpiMix<1>, pg8::StaticOrder, PG8_ALIGN, PG8_SP2>(lds, g, S, E, wave);
        if (BOTH(8)) GRID_BAR();
    }
    if (IN(9)) {
        pg8::Gemm g{YN, (const bf16*)(ws + WS_RWOT), M, 2048, 1024}; pg8::StaticOrder S; S.init(M, 2048, G, bx);
        pg8::EpiMix<0> E{Q, nullptr, nullptr, 2048};
        pg8::gemm_phase<pg8::EpiMix<0>, pg8::StaticOrder, PG8_ALIGN, PG8_SP2>(lds, g, S, E, wave);
        if (BOTH(9)) GRID_BAR();
    }
    if (IN(10)) {
        pg8::Gemm g{HN, WT + (size_t)8448 * D, M, 2048, D}; pg8::StaticOrder S; S.init(M, 2048, G, bx);
        pg8::EpiMix<3> E{P, Q, P, 2048};
        pg8::gemm_phase<pg8::EpiMix<3>, pg8::StaticOrder, PG8_ALIGN, PG8_SP2>(lds, g, S, E, wave);
        if (BOTH(10)) GRID_BAR();
    }
    if (IN(11)) {
        pg8::Gemm g{P, (const bf16*)(ws + WS_WOT), M, 2048, D}; pg8::StaticOrder S; S.init(M, 2048, G, bx);
        pg8::EpiF32 E{args.out, 2048};
        pg8::gemm_phase<pg8::EpiF32, pg8::StaticOrder, PG8_ALIGN, PG8_SP2>(lds, g, S, E, wave);
        if (BOTH(11)) GRID_BAR();
    }
    if (IN(12)) { p12_final(args, gw, NGW, lane); }
#undef IN
#undef BOTH
#undef lane
}

extern "C" void kernel_launch(void* const* d_in, const int* in_sizes, int n_in, void* d_out, int out_size, void* d_ws, size_t ws_size, hipStream_t stream) {
    static int grid = 0;
    if (grid == 0) {
        if (n_in != 27 || out_size != 2 * 32768 * D || ws_size < WS_END) { fprintf(stderr, "kernel_launch: unexpected shapes (n_in %d out %d ws %zu)\n", n_in, out_size, ws_size); grid = -1; return; }
        int dev = 0, cus = 0, per_cu = 0;
        if (hipGetDevice(&dev) != hipSuccess || hipDeviceGetAttribute(&cus, hipDeviceAttributeMultiprocessorCount, dev) != hipSuccess) { grid = -1; return; }
        if (hipFuncSetAttribute((const void*)mk_fwd, hipFuncAttributeMaxDynamicSharedMemorySize, LDS_BYTES) != hipSuccess) { fprintf(stderr, "kernel_launch: hipFuncSetAttribute failed\n"); grid = -1; return; }
        if (hipOccupancyMaxActiveBlocksPerMultiprocessor(&per_cu, (const void*)mk_fwd, NWAVES * 64, LDS_BYTES) != hipSuccess || per_cu < 1)
            fprintf(stderr, "kernel_launch: note: occupancy query reports %d workgroups per CU\n", per_cu);
        (void)hipGetLastError();
        grid = cus;
    }
    if (grid < 0) return;
    if (hipMemsetAsync((char*)d_ws + WS_CTL, 0, CTL_ZERO_BYTES, stream) != hipSuccess) return;
    Args a{};
    for (int i = 0; i < 27; ++i) a.in[i] = (const float*)d_in[i];
    a.out = (float*)d_out; a.ws = (unsigned char*)d_ws; a.pad = 0;
    for (int li = 0; li < N_LAUNCHES; ++li) {
        if (N_LAUNCHES == 1) { a.ph_lo = 0; a.ph_hi = N_PHASES; } else { a.ph_lo = li * N_PHASES / N_LAUNCHES; a.ph_hi = (li + 1) * N_PHASES / N_LAUNCHES; }
        a.li = li;
        hipLaunchKernelGGL(mk_fwd, dim3(grid), dim3(NWAVES * 64), LDS_BYTES, stream, a);
        const hipError_t le = hipPeekAtLastError();
        if (le != hipSuccess) { fprintf(stderr, "kernel_launch: launch %d failed: %s\n", li, hipGetErrorName(le)); break; }
    }
}
```

```cpp
#include <hip/hip_runtime.h>
#include <cstdio>
#include <cstdint>
#define MK_N_LAUNCHES 1
__device__ __forceinline__ int mk_lane() { int l; asm volatile("v_mbcnt_lo_u32_b32 %0, -1, 0\n\tv_mbcnt_hi_u32_b32 %0, -1, %0" : "=v"(l)); return l; }
namespace pg8 {
#define PG8_LAS __attribute__((address_space(3)))
typedef unsigned short bf16_t;
typedef short bf16x8 __attribute__((ext_vector_type(8)));
typedef float f32x4 __attribute__((ext_vector_type(4)));
typedef unsigned u32x4 __attribute__((ext_vector_type(4)));
constexpr int BM = 256, BK = 64, HALF = 128, HTB = HALF * BK * 2  , STAGE_BYTES = 8 * HTB, NXCD = 8, WGM = 8;

__host__ __device__ __forceinline__ int lds_byte(int r, int c) { const int st = (r >> 4) * 2 + (c >> 5), rr = r & 15, cc = c & 31, ob = rr * 64 + cc * 2; return st * 1024 + (ob ^ (((ob >> 9) & 1) << 5)); }
__host__ __device__ __forceinline__ void stage_rc(int b, int& R, int& C) { const int st = b / 1024, sb = b % 1024, swz = sb ^ (((sb >> 9) & 1) << 5); R = (st >> 1) * 16 + swz / 64; C = (st & 1) * 32 + (swz % 64) / 2; }
__host__ __device__ __forceinline__ int perm32(int rho) { const int n = rho >> 4, i = rho & 15; return 8 * (i >> 2) + 4 * n + (i & 3); }

struct Unit { int pm, pn; };
struct Gemm { const bf16_t* A; const bf16_t* Bt; int M, N, K, lda; };

struct StaticOrder {
    int nM, nN, nwg, G, c;
    __host__ __device__ void init(int M, int N, int G_, int c_) { nM = M / BM; nN = N / BM; nwg = nM * nN; G = G_; c = c_; }
    __host__ __device__ bool next(int i, Unit& u) const {
        const long L = (long)i * G + c; if (L >= nwg) return false;
        int wgid = (int)L; { const int q = nwg / NXCD, r = nwg % NXCD, xcd = wgid % NXCD, off = wgid / NXCD; wgid = (xcd < r ? xcd * (q + 1) : r * (q + 1) + (xcd - r) * q) + off; }
        const int nig = WGM * nN, gid = wgid / nig, fm = gid * WGM, gsz = (nM - fm) < WGM ? (nM - fm) : WGM;
        u.pm = fm + ((wgid % nig) % gsz); u.pn = (wgid % nig) / gsz; return true;
    }
    __device__ __forceinline__ void a_ready(const Unit&) const {}
    __device__ __forceinline__ void done(const Unit&) const {}
};

__device__ __forceinline__ unsigned cvt_pk_bf16(float lo, float hi) { unsigned r; asm volatile("v_cvt_pk_bf16_f32 %0, %1, %2" : "=v"(r) : "v"(lo), "v"(hi)); return r; }

__device__ __forceinline__ float bf_lo(unsigned u) { return __uint_as_float(u << 16); }
__device__ __forceinline__ float bf_hi(unsigned u) { return __uint_as_float(u & 0xffff0000u); }
__device__ __forceinline__ float sigmoid_f(float v) { return __builtin_amdgcn_rcpf(1.0f + __expf(-v)); }

struct EpiG1 {
    static constexpr bool PERM = true, AFTER_DRAIN = false;
    bf16_t* a2; bf16_t* rwin;
    __device__ __forceinline__ void operator()(const f32x4 (&acc)[2][2][4][2], const Unit& u, int wr, int wc, int fr, int fq) const {
        const int row0 = u.pm * BM + wr * 64 + fr; const int colt = u.pn * BM; const bool s5 = colt < 1024;
        const int col0 = colt + wc * 32 + 8 * fq;
#pragma unroll
        for (int ai = 0; ai < 2; ++ai)
#pragma unroll
            for (int m = 0; m < 4; ++m) { const int row = row0 + ai * HALF + m * 16;
#pragma unroll
                for (int bj = 0; bj < 2; ++bj) { const f32x4 v0 = acc[ai][bj][m][0], v1 = acc[ai][bj][m][1]; const int col = col0 + bj * HALF;
                    u32x4 w; w.x = cvt_pk_bf16(v0[0], v0[1]); w.y = cvt_pk_bf16(v0[2], v0[3]); w.z = cvt_pk_bf16(v1[0], v1[1]); w.w = cvt_pk_bf16(v1[2], v1[3]);
                    bf16_t* dst = s5 ? a2 + ((size_t)((col >> 4) * 2048 + (row >> 5)) * 768 + (row & 31) * 16 + (col & 15))
                                     : rwin + (size_t)row * 3328 + (col - 1024);
                    *(u32x4*)dst = w; } }
    }
};
template <int MODE> struct EpiMix {
    static constexpr bool PERM = true, AFTER_DRAIN = false;
    bf16_t* O; const bf16_t* S; const bf16_t* Add; int ld;
    __device__ __forceinline__ void operator()(const f32x4 (&acc)[2][2][4][2], const Unit& u, int wr, int wc, int fr, int fq) const {
        const int row0 = u.pm * BM + wr * 64 + fr, col0 = u.pn * BM + wc * 32 + 8 * fq;
#pragma unroll
        for (int ai = 0; ai < 2; ++ai)
#pragma unroll
            for (int m = 0; m < 4; ++m) {
#pragma unroll
                for (int bj = 0; bj < 2; ++bj) {
                    const size_t off = (size_t)(row0 + ai * HALF + m * 16) * ld + col0 + bj * HALF;
                    float v[8];
#pragma unroll
                    for (int j = 0; j < 4; ++j) { v[j] = acc[ai][bj][m][0][j]; v[4 + j] = acc[ai][bj][m][1][j]; }
                    if (MODE >= 1) {
                        const u32x4 s = *(const u32x4*)(S + off);
                        const float sv[8] = {bf_lo(s.x), bf_hi(s.x), bf_lo(s.y), bf_hi(s.y), bf_lo(s.z), bf_hi(s.z), bf_lo(s.w), bf_hi(s.w)};
#pragma unroll
                        for (int j = 0; j < 8; ++j) { const float sg = sigmoid_f(v[j]); v[j] = (MODE == 2) ? sv[j] * v[j] * sg : sv[j] * sg; }
                    }
                    if (MODE == 3) {
                        const u32x4 a = *(const u32x4*)(Add + off);
                        const float av[8] = {bf_lo(a.x), bf_hi(a.x), bf_lo(a.y), bf_hi(a.y), bf_lo(a.z), bf_hi(a.z), bf_lo(a.w), bf_hi(a.w)};
#pragma unroll
                        for (int j = 0; j < 8; ++j) v[j] += av[j];
                    }
                    u32x4 w; w.x = cvt_pk_bf16(v[0], v[1]); w.y = cvt_pk_bf16(v[2], v[3]); w.z = cvt_pk_bf16(v[4], v[5]); w.w = cvt_pk_bf16(v[6], v[7]);
                    *(u32x4*)(O + off) = w;
                }
            }
    }
};
struct EpiF32 {
    static constexpr bool PERM = false, AFTER_DRAIN = false;
    float* C; int ldc;
    __device__ __forceinline__ void operator()(const f32x4 (&acc)[2][2][4][2], const Unit& u, int wr, int wc, int fr, int fq) const {
        const int row0 = u.pm * BM + wr * 64 + fr, col0 = u.pn * BM + wc * 32 + 4 * fq;
#pragma unroll
        for (int ai = 0; ai < 2; ++ai)
#pragma unroll
            for (int m = 0; m < 4; ++m) { float* rowp = C + (size_t)(row0 + ai * HALF + m * 16) * ldc + col0;
#pragma unroll
                for (int bj = 0; bj < 2; ++bj)
#pragma unroll
                    for (int n = 0; n < 2; ++n) *(f32x4*)(rowp + bj * HALF + n * 16) = acc[ai][bj][m][n]; }
    }
};
template <class Epi, class Sched, bool ALIGN_EPI = false, bool SP2 = false>
__device__ __forceinline__ void gemm_phase(PG8_LAS unsigned char* lds, const Gemm g, const Sched& S, const Epi& E, const int mk_wave) {
    const int lane = mk_lane(), wid = mk_wave, tid = wid * 64 + lane, wr = wid >> 2, wc = wid & 3, fr = lane & 15, fq = lane >> 4;
    const int K = g.K, nt = K / BK;
    unsigned voffA[2], voffB[2];
#pragma unroll
    for (int i = 0; i < 2; ++i) { int R, C; stage_rc(tid * 16 + i * 8192, R, C); const int Rb = Epi::PERM ? ((R & ~31) + perm32(R & 31)) : R;
        voffA[i] = (unsigned)(R * g.lda + C) * 2u; voffB[i] = (unsigned)(Rb * K + C) * 2u; }
    const size_t kstep = (size_t)(BK * 2);
    const size_t hstep = (size_t)HALF * K * 2;
    const size_t tstep = 2 * hstep;
    const size_t hstepA = (size_t)HALF * g.lda * 2, tstepA = 2 * hstepA;
    const unsigned ldsw = (unsigned)wid * 1024u;
    const int aoff = lds_byte(wr * 64 + fr, fq * 8), boff = lds_byte(wc * 32 + fr, fq * 8);
#define PG8_SA(b, h) (((b) * 2 + (h)) * HTB)
#define PG8_SB(b, h) ((4 + (b) * 2 + (h)) * HTB)
#define PG8_STAGE(bufoff, gbase, voff) do { _Pragma("unroll") for (int _i = 0; _i < 2; ++_i) \
        __builtin_amdgcn_global_load_lds((const unsigned*)((const char*)(gbase) + (voff)[_i]), (PG8_LAS unsigned*)(lds + (bufoff) + ldsw + _i * 8192), 16, 0, 0); } while (0)
#define PG8_LDA(dst, b, h) do { _Pragma("unroll") for (int m = 0; m < 4; ++m) _Pragma("unroll") for (int k = 0; k < 2; ++k) dst[m][k] = *(const PG8_LAS bf16x8*)(lds + PG8_SA(b, h) + aoff + m * 2048 + k * 1024); } while (0)
#define PG8_LDB(dst, b, h) do { _Pragma("unroll") for (int n = 0; n < 2; ++n) _Pragma("unroll") for (int k = 0; k < 2; ++k) dst[n][k] = *(const PG8_LAS bf16x8*)(lds + PG8_SB(b, h) + boff + n * 2048 + k * 1024); } while (0)
#define PG8_MMA(ai, bj, At, Bt) do { __builtin_amdgcn_s_setprio(1); _Pragma("unroll") for (int m = 0; m < 4; ++m) _Pragma("unroll") for (int n = 0; n < 2; ++n) _Pragma("unroll") for (int k = 0; k < 2; ++k) \
        acc[ai][bj][m][n] = __builtin_amdgcn_mfma_f32_16x16x32_bf16(Bt[n][k], At[m][k], acc[ai][bj][m][n], 0, 0, 0); __builtin_amdgcn_s_setprio(0); } while (0)
#define PG8_WAIT_V(n) asm volatile("s_waitcnt vmcnt(" #n ")" ::: "memory")
#define PG8_WAIT_L(n) asm volatile("s_waitcnt lgkmcnt(" #n ")" ::: "memory")
#define PG8_BAR __builtin_amdgcn_s_barrier()
#define PG8_SCHED __builtin_amdgcn_sched_barrier(0)
    Unit cur, nxt; int ui = 0;
    if (!S.next(0, cur)) return;
    f32x4 acc[2][2][4][2];
#pragma unroll
    for (int a = 0; a < 2; ++a)
#pragma unroll
        for (int b = 0; b < 2; ++b)
#pragma unroll
            for (int m = 0; m < 4; ++m)
#pragma unroll
                for (int n = 0; n < 2; ++n) acc[a][b][m][n] = (f32x4){0.f, 0.f, 0.f, 0.f};
    bf16x8 At[4][2], B0[2][2], B1[2][2];
    const char* cA = (const char*)g.A + (size_t)cur.pm * tstepA; const char* cB = (const char*)g.Bt + (size_t)cur.pn * tstep;
    S.a_ready(cur);
    if constexpr (SP2) {
        PG8_STAGE(PG8_SB(0, 0), cB, voffB); PG8_STAGE(PG8_SB(0, 1), cB + hstep, voffB); PG8_STAGE(PG8_SA(0, 0), cA, voffA); PG8_STAGE(PG8_SA(0, 1), cA + hstepA, voffA);
        if (wr == 1) PG8_BAR;
        PG8_WAIT_V(2); PG8_BAR;
        PG8_STAGE(PG8_SB(1, 0), cB + kstep, voffB); PG8_STAGE(PG8_SA(1, 0), cA + kstep, voffA); PG8_STAGE(PG8_SB(1, 1), cB + hstep + kstep, voffB);
        PG8_WAIT_V(6); PG8_BAR;
    } else {
        PG8_STAGE(PG8_SB(0, 0), cB, voffB); PG8_STAGE(PG8_SA(0, 0), cA, voffA); PG8_STAGE(PG8_SB(0, 1), cB + hstep, voffB); PG8_STAGE(PG8_SA(0, 1), cA + hstepA, voffA);
        if (wr == 1) PG8_BAR;
        PG8_WAIT_V(4); PG8_BAR;
        PG8_STAGE(PG8_SB(1, 0), cB + kstep, voffB); PG8_STAGE(PG8_SA(1, 0), cA + kstep, voffA); PG8_STAGE(PG8_SB(1, 1), cB + hstep + kstep, voffB);
        PG8_WAIT_V(6); PG8_BAR;
    }
    for (;;) {
        const bool has_next = S.next(ui + 1, nxt);
        const char* nA = has_next ? (const char*)g.A + (size_t)nxt.pm * tstepA : cA; const char* nB = has_next ? (const char*)g.Bt + (size_t)nxt.pn * tstep : cB;
        for (int t = 0; t < nt; t += 2) {
            const bool last = (t == nt - 2);
            const char* a1 = cA + (size_t)(t + 1) * kstep;
            const char* a2 = last ? nA : cA + (size_t)(t + 2) * kstep; const char* b2 = last ? nB : cB + (size_t)(t + 2) * kstep;
            const char* a3 = a2 + kstep; const char* b3 = b2 + kstep;
            if (last && has_next) S.a_ready(nxt);
            if constexpr (SP2) {
            PG8_LDB(B0, 0, 0); PG8_LDB(B1, 0, 1); PG8_SCHED; PG8_LDA(At, 0, 0); PG8_STAGE(PG8_SA(1, 1), a1 + hstepA, voffA);
            PG8_WAIT_V(8); PG8_WAIT_L(0); PG8_BAR; PG8_MMA(0, 0, At, B0); PG8_MMA(0, 1, At, B1); PG8_BAR; PG8_SCHED;
            PG8_LDA(At, 0, 1); PG8_STAGE(PG8_SB(0, 0), b2, voffB); PG8_STAGE(PG8_SB(0, 1), b2 + hstep, voffB); PG8_STAGE(PG8_SA(0, 0), a2, voffA);
            PG8_WAIT_V(8); PG8_WAIT_L(0); PG8_BAR; PG8_MMA(1, 0, At, B0); PG8_MMA(1, 1, At, B1); PG8_BAR; PG8_SCHED;
            PG8_LDB(B0, 1, 0); PG8_LDB(B1, 1, 1); PG8_SCHED; PG8_LDA(At, 1, 0); PG8_STAGE(PG8_SA(0, 1), a2 + hstepA, voffA);
            PG8_WAIT_V(8); PG8_WAIT_L(0); PG8_BAR; PG8_MMA(0, 0, At, B0); PG8_MMA(0, 1, At, B1); PG8_BAR; PG8_SCHED;
            PG8_LDA(At, 1, 1); PG8_STAGE(PG8_SB(1, 0), b3, voffB); PG8_STAGE(PG8_SB(1, 1), b3 + hstep, voffB); PG8_STAGE(PG8_SA(1, 0), a3, voffA);
            PG8_WAIT_V(8); PG8_WAIT_L(0); PG8_BAR; PG8_MMA(1, 0, At, B0); PG8_MMA(1, 1, At, B1); PG8_BAR; PG8_SCHED;
            } else {
            PG8_LDB(B0, 0, 0); PG8_SCHED; PG8_LDA(At, 0, 0); PG8_STAGE(PG8_SA(1, 1), a1 + hstepA, voffA);
            PG8_WAIT_L(8); PG8_BAR; PG8_WAIT_L(0); PG8_MMA(0, 0, At, B0); PG8_BAR; PG8_SCHED;
            PG8_LDB(B1, 0, 1); PG8_STAGE(PG8_SB(0, 0), b2, voffB);
            PG8_BAR; PG8_WAIT_L(0); PG8_MMA(0, 1, At, B1); PG8_BAR;
            PG8_LDA(At, 0, 1); PG8_STAGE(PG8_SA(0, 0), a2, voffA);
            PG8_BAR; PG8_WAIT_L(0); PG8_MMA(1, 0, At, B0); PG8_BAR; PG8_SCHED;
            PG8_STAGE(PG8_SB(0, 1), b2 + hstep, voffB);
            PG8_WAIT_V(6); PG8_BAR; PG8_MMA(1, 1, At, B1); PG8_BAR;
            PG8_LDB(B0, 1, 0); PG8_SCHED; PG8_LDA(At, 1, 0); PG8_STAGE(PG8_SA(0, 1), a2 + hstepA, voffA);
            PG8_WAIT_L(8); PG8_BAR; PG8_WAIT_L(0); PG8_MMA(0, 0, At, B0); PG8_BAR; PG8_SCHED;
            PG8_LDB(B1, 1, 1); PG8_STAGE(PG8_SB(1, 0), b3, voffB);
            PG8_BAR; PG8_WAIT_L(0); PG8_MMA(0, 1, At, B1); PG8_BAR;
            PG8_LDA(At, 1, 1); PG8_STAGE(PG8_SA(1, 0), a3, voffA);
            PG8_BAR; PG8_WAIT_L(0); PG8_MMA(1, 0, At, B0); PG8_BAR; PG8_SCHED;
            PG8_STAGE(PG8_SB(1, 1), b3 + hstep, voffB);
            PG8_WAIT_V(6); PG8_BAR; PG8_MMA(1, 1, At, B1); PG8_BAR;
            }
        }
        if constexpr (ALIGN_EPI) { if (wr == 0) PG8_BAR; }
        if constexpr (!Epi::AFTER_DRAIN) { E(acc, cur, wr, wc, fr, fq); S.done(cur); }
        if (!has_next) break;
#pragma unroll
        for (int a = 0; a < 2; ++a)
#pragma unroll
            for (int b = 0; b < 2; ++b)
#pragma unroll
                for (int m = 0; m < 4; ++m)
#pragma unroll
                    for (int n = 0; n < 2; ++n) acc[a][b][m][n] = (f32x4){0.f, 0.f, 0.f, 0.f};
        cur = nxt; cA = nA; cB = nB; ++ui;
        if constexpr (ALIGN_EPI) { if (wr == 1) PG8_BAR; }
    }
    PG8_WAIT_V(0);
    if constexpr (!ALIGN_EPI) { if (wr == 0) PG8_BAR; }
    PG8_BAR;
    if constexpr (Epi::AFTER_DRAIN) { E.fused(acc, cur, wr, wc, fr, fq, lds, wid, lane); S.done(cur); }
#undef PG8_SA
#undef PG8_SB
#undef PG8_STAGE
#undef PG8_LDA
#undef PG8_LDB
#undef PG8_MMA
#undef PG8_WAIT_V
#undef PG8_WAIT_L
#undef PG8_BAR
#undef PG8_SCHED
}
}

#ifndef PG8_SP2
#define PG8_SP2 true
#endif
#ifndef PG8_ALIGN
#define PG8_ALIGN true
#endif

constexpr int NWAVES = 8;
constexpr int N_PHASES = 16;
#ifndef MK_N_LAUNCHES
#define MK_N_LAUNCHES 1
#endif
constexpr int N_LAUNCHES = MK_N_LAUNCHES;

constexpr int D = 2048, M = 65536, NIN = 10496;
constexpr int LP = 16384, LS = 2048;
constexpr int DS5 = 1024, DRW = 1024, DRWIN = 3328;
constexpr float RMS_EPS = 1e-6f, GN_EPS = 64e-5f, L2_EPS = 1e-12f;

constexpr size_t MiB = 1u << 20;
constexpr size_t WS_CTL = 0, CTL_ZERO_BYTES = 1 * MiB;
constexpr size_t WS_WT = 1 * MiB;
constexpr size_t WS_GLUT = 42 * MiB;
constexpr size_t WS_S5OT = 44 * MiB;
constexpr size_t WS_RWOT = 48 * MiB;
constexpr size_t WS_WOT = 52 * MiB;
constexpr size_t WS_HN = 60 * MiB;
constexpr size_t WS_RWIN = 316 * MiB;
constexpr size_t WS_Z = 732 * MiB;
constexpr size_t WS_LUT = 860 * MiB;
constexpr size_t WS_STATE = 862 * MiB;
constexpr size_t WS_S5TAB = 872 * MiB;
constexpr size_t WS_S5XL = 882 * MiB;
constexpr size_t WS_S5W2 = 946 * MiB;
constexpr size_t WS_S5E = 994 * MiB;
constexpr size_t WS_ZG = 882 * MiB;
constexpr size_t WS_END = 1010 * MiB;
constexpr size_t DO_YF = 0, DO_YB = 128 * MiB, DO_A2 = 256 * MiB, DO_INT = 256 * MiB, DO_Q = 256 * MiB;
constexpr int CW_BAR = 4096;

constexpr int LDS_BYTES = 147456;
constexpr int MISC_OFF = LDS_BYTES - 512;
constexpr int WAVE_SCR = 18176;
static_assert(NWAVES * WAVE_SCR <= MISC_OFF && pg8::STAGE_BYTES <= MISC_OFF, "LDS map");

#define GAS __attribute__((address_space(1)))
#define LAS __attribute__((address_space(3)))
typedef unsigned short bf16;
typedef unsigned v4u __attribute__((ext_vector_type(4)));
typedef unsigned v2u __attribute__((ext_vector_type(2)));
typedef float f32x4 __attribute__((ext_vector_type(4)));
#define LDS_WAIT() asm volatile("s_waitcnt lgkmcnt(0)" ::: "memory")
#define VM_WAIT() asm volatile("s_waitcnt vmcnt(0)" ::: "memory")
__device__ __forceinline__ unsigned f2bf(float f) { unsigned u = __builtin_bit_cast(unsigned, f); return (u + 0x7fffu + ((u >> 16) & 1u)) >> 16; }
__device__ __forceinline__ unsigned pk2(float lo, float hi) { return f2bf(lo) | (f2bf(hi) << 16); }
__device__ __forceinline__ float bf2f(bf16 b) { return __uint_as_float(((unsigned)b) << 16); }
__device__ __forceinline__ float blo(unsigned u) { return __uint_as_float(u << 16); }
__device__ __forceinline__ float bhi(unsigned u) { return __uint_as_float(u & 0xffff0000u); }
__device__ __forceinline__ float wave_sum(float v) {
#pragma unroll
    for (int o = 1; o < 64; o <<= 1) v += __shfl_xor(v, o);
    return v;
}
__device__ __forceinline__ float sigm(float v) { return 1.0f / (1.0f + __expf(-v)); }
__device__ __forceinline__ float gelu_tanh(float x) { const float u = 0.7978845608028654f * (x + 0.044715f * x * x * x); return 0.5f * x * (1.0f + tanhf(u)); }

#define XB_TMO      128
#define XB_XCNT(j)  (256  + 64 * (j))
#define XB_XSUB(j)  (1280 + 64 * (j))
#define XB_XGEN(j)  (2304 + 64 * (j))
#define XB_TOP      3328
#define XB_TOPGEN   3392
#define XCD_BAR_WORDS 3456
#define XB_SPIN_CAP (1u << 18)

__device__ __forceinline__ unsigned xb_ld(unsigned* p)              { return __hip_atomic_load(p, __ATOMIC_RELAXED, __HIP_MEMORY_SCOPE_AGENT); }
__device__ __forceinline__ unsigned xb_add(unsigned* p, unsigned v) { return __hip_atomic_fetch_add(p, v, __ATOMIC_RELAXED, __HIP_MEMORY_SCOPE_AGENT); }
__device__ __forceinline__ unsigned xb_xcc_id() { return (unsigned)__builtin_amdgcn_s_getreg((3 << 11) | 20) & 0xFu; }
#define XB_SPIN(cond, bar) do { unsigned _sp = 0; while (cond) { __builtin_amdgcn_s_sleep(1); \
    if ((++_sp & 255u) == 0u) { if (xb_ld(&(bar)[XB_TMO])) break; if (_sp > XB_SPIN_CAP) { atomicAdd(&(bar)[XB_TMO], 1u); break; } } } } while (0)

struct XcdBarrier {
    unsigned* bar; unsigned x;
    volatile LAS unsigned* st;
};

__device__ __forceinline__ XcdBarrier xcd_barrier_post(unsigned* bar, volatile LAS unsigned* st, const int mk_wave) {
    XcdBarrier b; b.bar = bar; b.x = xb_xcc_id(); b.st = st;
    if (mk_wave == 0 && mk_lane() == 0) (void)xb_add(&bar[XB_XCNT(b.x)], 1u);
    return b;
}
__device__ __forceinline__ void xcd_barrier_complete(unsigned* bar, unsigned x, unsigned& nloc, unsigned& nx) {
    const unsigned G = gridDim.x * gridDim.y * gridDim.z;
    unsigned sum, cnt, mine, sp = 0u;
    for (;;) {
        sum = 0u; cnt = 0u; mine = 0u;
#pragma unroll
        for (unsigned j = 0; j < 16; ++j) { const unsigned c = xb_ld(&bar[XB_XCNT(j)]); sum += c; cnt += (c > 0u) ? 1u : 0u; mine = (j == x) ? c : mine; }
        if (sum == G) break;
        __builtin_amdgcn_s_sleep(1);
        if ((++sp & 255u) == 0u) { if (xb_ld(&bar[XB_TMO])) break; if (sp > XB_SPIN_CAP) { atomicAdd(&bar[XB_TMO], 1u); break; } }
    }
    nloc = mine > 0u ? mine : 1u; nx = cnt > 0u ? cnt : 1u;
}

__device__ __forceinline__ void xcd_barrier(const XcdBarrier& b, const int mk_wave) {
    asm volatile("s_waitcnt vmcnt(0)" ::: "memory");
    __syncthreads();
    if (mk_wave == 0 && mk_lane() == 0) {
        unsigned* bar = b.bar;
        __builtin_amdgcn_s_waitcnt(0);
        unsigned nloc = b.st[0], nx = b.st[1];
        if (nloc == 0u) { xcd_barrier_complete(bar, b.x, nloc, nx); b.st[0] = nloc; b.st[1] = nx; }
        const unsigned old = xb_add(&bar[XB_XSUB(b.x)], 1u);
        const unsigned gen = old / nloc;
        if (old + 1u == (gen + 1u) * nloc) {
            __builtin_amdgcn_fence(__ATOMIC_RELEASE, "agent");
            asm volatile("s_waitcnt vmcnt(0)" ::: "memory");
            const unsigned og = xb_add(&bar[XB_TOP], 1u);
            const unsigned tg = og / nx;
            if (og + 1u == (tg + 1u) * nx) xb_add(&bar[XB_TOPGEN], 1u);
            else XB_SPIN(xb_ld(&bar[XB_TOPGEN]) == tg, bar);
            __builtin_amdgcn_fence(__ATOMIC_ACQUIRE, "agent");
            xb_add(&bar[XB_XGEN(b.x)], 1u);
            asm volatile("s_waitcnt vmcnt(0)" ::: "memory");
        } else {
            XB_SPIN(xb_ld(&bar[XB_XGEN(b.x)]) == gen, bar);
            __builtin_amdgcn_fence(__ATOMIC_ACQUIRE, "agent");
            asm volatile("s_waitcnt vmcnt(0)" ::: "memory");
        }
    }
    __syncthreads();
}


struct Args { const float* in[27]; float* out; unsigned char* ws; int ph_lo, ph_hi, li, pad; };

namespace rwk {
typedef short s16x4 __attribute__((ext_vector_type(4)));
typedef short s16x8 __attribute__((ext_vector_type(8)));
constexpr int NSEG = 8;
constexpr int UNITS_PER_SEG = 4096;
constexpr int LDW = 72;
constexpr int MATB = 64 * LDW * 2;
constexpr int O_AB = 0, O_BT = 1 * MATB, O_KT = 2 * MATB, O_RB = 3 * MATB, O_BHT = 4 * MATB, O_KHT = 5 * MATB, O_VT = 6 * MATB;
constexpr int O_MAB = 7 * MATB, O_MAK = 8 * MATB, O_NRB = 9 * MATB, O_NRK = 10 * MATB, O_XT = 11 * MATB  , O_NP = 13 * MATB, O_GT = 14 * MATB;
constexpr int O_TW = O_XT, O_XA = O_XT + MATB;
constexpr int LDC = 68;
constexpr int O_CL = O_MAB, O_AS = O_MAB + 64 * LDC * 4;
constexpr int NPS = 24;
static_assert(O_AS + 64 * LDC * 4 <= O_XT && O_GT + 256 <= 146944, "rwkv LDS map");
constexpr size_t UNIT_ELEMS = 16384;

__device__ __forceinline__ f32x4 mfma32(s16x8 a, s16x8 b, f32x4 c) { return __builtin_amdgcn_mfma_f32_16x16x32_bf16(a, b, c, 0, 0, 0); }
__device__ __forceinline__ f32x4 mfma16(s16x4 a, s16x4 b, f32x4 c) { return __builtin_amdgcn_mfma_f32_16x16x16bf16_1k(a, b, c, 0, 0, 0); }
__device__ __forceinline__ s16x4 pack4(f32x4 v) { v2u p; p.x = pk2(v[0], v[1]); p.y = pk2(v[2], v[3]); return __builtin_bit_cast(s16x4, p); }
__device__ __forceinline__ f32x4 unpack4(v2u p) { return (f32x4){blo(p.x), bhi(p.x), blo(p.y), bhi(p.y)}; }
__device__ __forceinline__ void up8(v4u a, float (&o)[8]) { o[0] = blo(a.x); o[1] = bhi(a.x); o[2] = blo(a.y); o[3] = bhi(a.y); o[4] = blo(a.z); o[5] = bhi(a.z); o[6] = blo(a.w); o[7] = bhi(a.w); }
__device__ __forceinline__ v4u pk8(const float (&v)[8]) { v4u a; a.x = pk2(v[0], v[1]); a.y = pk2(v[2], v[3]); a.z = pk2(v[4], v[5]); a.w = pk2(v[6], v[7]); return a; }

struct UnitId { int h, d, base, L, gchunk, chain; };
__device__ __forceinline__ UnitId decode_unit(int seg, int u) {
    UnitId o; int c, jc, nch;
    if (u < 2048) { c = u >> 5; jc = u & 31; nch = 32; } else { c = 64 + ((u - 2048) >> 2); jc = (u - 2048) & 3; nch = 4; }
    int s, rem; if (c < 64) { s = c >> 5; rem = c & 31; } else { s = 2 + ((c - 64) >> 5); rem = (c - 64) & 31; }
    o.h = rem >> 1; o.d = rem & 1; o.base = s < 2 ? s * LP : 32768 + (s - 2) * LS; o.L = s < 2 ? LP : LS; o.gchunk = seg * nch + jc; o.chain = c;
    return o;
}
__device__ __forceinline__ int unit_of(int chain, int jc) { return chain < 64 ? chain * 32 + jc : 2048 + (chain - 64) * 4 + jc; }

__device__ __forceinline__ void rw_precompute_unit(const Args& a, unsigned char* ws, LAS unsigned char* lds, int seg, int u, int wave, int lane) {
    const UnitId id = decode_unit(seg, u);
    const int h = id.h, d = id.d;
    const int tid = wave * 64 + lane;
    const bf16* RWIN = (const bf16*)(ws + WS_RWIN);
    const int r = lane & 15, g = lane >> 4;
    const int t = tid >> 3, cg = tid & 7, c8 = h * 64 + 8 * cg;
    float zr[8], zk[8], kk[8], zv[8];
    {
        const int lp = 64 * id.gchunk + t, pos = d ? id.L - 1 - lp : lp;
        const bf16* prow = RWIN + (size_t)(id.base + pos) * DRWIN;
        const bool hp = pos > 0, hn = pos < id.L - 1;
        const float* mu = a.in[15];
        float zw[8], za[8];
#pragma unroll
        for (int comp = 0; comp < 5; ++comp) {
            const int col = comp < 3 ? comp * 1024 + c8 : (comp == 3 ? 3072 + d * 64 + 8 * cg : 3200 + d * 64 + 8 * cg);
            float cc[8], pp[8], nn[8];
            up8(*(const v4u*)(prow + col), cc);
            if (hp) up8(*(const v4u*)(prow - DRWIN + col), pp); else {
#pragma unroll
                for (int j = 0; j < 8; ++j) pp[j] = 0.f; }
            if (hn) up8(*(const v4u*)(prow + DRWIN + col), nn); else {
#pragma unroll
                for (int j = 0; j < 8; ++j) nn[j] = 0.f; }
            const f32x4 m0 = *(const f32x4*)(mu + col), m1 = *(const f32x4*)(mu + col + 4);
            const float mv[8] = {m0[0], m0[1], m0[2], m0[3], m1[0], m1[1], m1[2], m1[3]};
#pragma unroll
            for (int j = 0; j < 8; ++j) {
                const float zz = cc[j] + (0.5f * (pp[j] + nn[j]) - cc[j]) * mv[j];
                if (comp == 0) zr[j] = zz; else if (comp == 1) zk[j] = zz; else if (comp == 2) zv[j] = zz; else if (comp == 3) zw[j] = tanhf(zz); else za[j] = zz;
            }
        }
        float ss = 0.f;
        const f32x4 k0 = *(const f32x4*)(a.in[20] + c8), k1 = *(const f32x4*)(a.in[20] + c8 + 4);
        const float kkw[8] = {k0[0], k0[1], k0[2], k0[3], k1[0], k1[1], k1[2], k1[3]};
#pragma unroll
        for (int j = 0; j < 8; ++j) { kk[j] = zk[j] * kkw[j]; ss += kk[j] * kk[j]; }
        ss += __shfl_xor(ss, 1); ss += __shfl_xor(ss, 2); ss += __shfl_xor(ss, 4);
        const float inv = 1.0f / sqrtf(ss + L2_EPS);
#pragma unroll
        for (int j = 0; j < 8; ++j) kk[j] *= inv;
        *(LAS v4u*)(lds + O_TW + (t * LDW + 8 * cg) * 2) = pk8(zw);
        *(LAS v4u*)(lds + O_XA + (t * LDW + 8 * cg) * 2) = pk8(za);
    }
    __syncthreads();
    {
        const int ct = wave & 3, role = wave >> 2;
        const bf16* lut = (const bf16*)(ws + WS_LUT) + ((size_t)((role * 2 + d) * 16 + h) * 64 + 16 * ct + r) * 64 + 8 * g;
        const s16x8 b0 = *(const s16x8*)(lut), b1 = *(const s16x8*)(lut + 32);
        const int aoff = (role ? O_XA : O_TW) + (r * LDW + 8 * g) * 2;
        f32x4 acc[4];
#pragma unroll
        for (int mt = 0; mt < 4; ++mt) {
            const s16x8 a0 = *(const LAS s16x8*)(lds + aoff + mt * 16 * LDW * 2), a1 = *(const LAS s16x8*)(lds + aoff + mt * 16 * LDW * 2 + 64);
            acc[mt] = mfma32(a0, b0, (f32x4){0.f, 0.f, 0.f, 0.f}); acc[mt] = mfma32(a1, b1, acc[mt]);
        }
        const int cch = 16 * ct + r;
        if (role == 0) {
            const float w0v = a.in[16][d * 1024 + h * 64 + cch];
            float carry = 0.f;
#pragma unroll
            for (int mt = 0; mt < 4; ++mt) {
                float s[4];
#pragma unroll
                for (int i = 0; i < 4; ++i) { const float lw = -0.6065306597126334f * sigm(acc[mt][i] + w0v); s[i] = (i ? s[i - 1] : 0.f) + lw; }
                const float tot = s[3];
                const float e1 = __shfl(tot, (lane + 48) & 63), e2 = __shfl(tot, (lane + 32) & 63), e3 = __shfl(tot, (lane + 16) & 63);
                const float excl = (g >= 1 ? e1 : 0.f) + (g >= 2 ? e2 : 0.f) + (g >= 3 ? e3 : 0.f);
                const float all = __shfl(tot + excl, 48 + r);
#pragma unroll
                for (int i = 0; i < 4; ++i) *(LAS float*)(lds + O_CL + ((16 * mt + 4 * g + i) * LDC + cch) * 4) = carry + excl + s[i];
                carry += all;
            }
        } else {
            const float a0v = a.in[18][d * 1024 + h * 64 + cch];
#pragma unroll
            for (int mt = 0; mt < 4; ++mt)
#pragma unroll
                for (int i = 0; i < 4; ++i) *(LAS float*)(lds + O_AS + ((16 * mt + 4 * g + i) * LDC + cch) * 4) = sigm(acc[mt][i] + a0v);
        }
    }
    __syncthreads();
    {
        float cl[8], clp[8], cle[8], as[8];
        { const f32x4 x0 = *(const LAS f32x4*)(lds + O_CL + (t * LDC + 8 * cg) * 4), x1 = *(const LAS f32x4*)(lds + O_CL + (t * LDC + 8 * cg + 4) * 4);
          const f32x4 e0 = *(const LAS f32x4*)(lds + O_CL + (63 * LDC + 8 * cg) * 4), e1 = *(const LAS f32x4*)(lds + O_CL + (63 * LDC + 8 * cg + 4) * 4);
          const f32x4 s0 = *(const LAS f32x4*)(lds + O_AS + (t * LDC + 8 * cg) * 4), s1 = *(const LAS f32x4*)(lds + O_AS + (t * LDC + 8 * cg + 4) * 4);
          f32x4 p0 = (f32x4){0.f, 0.f, 0.f, 0.f}, p1 = p0;
          if (t > 0) { p0 = *(const LAS f32x4*)(lds + O_CL + ((t - 1) * LDC + 8 * cg) * 4); p1 = *(const LAS f32x4*)(lds + O_CL + ((t - 1) * LDC + 8 * cg + 4) * 4); }
#pragma unroll
          for (int j = 0; j < 4; ++j) { cl[j] = x0[j]; cl[4 + j] = x1[j]; cle[j] = e0[j]; cle[4 + j] = e1[j]; as[j] = s0[j]; as[4 + j] = s1[j]; clp[j] = p0[j]; clp[4 + j] = p1[j]; } }
        const f32x4 q0 = *(const f32x4*)(a.in[21] + c8), q1 = *(const f32x4*)(a.in[21] + c8 + 4);
        const float kaw[8] = {q0[0], q0[1], q0[2], q0[3], q1[0], q1[1], q1[2], q1[3]};
        float ab[8], bt[8], kt[8], rb[8], bh[8], kh[8];
#pragma unroll
        for (int j = 0; j < 8; ++j) {
            const float gt = __expf(cl[j]), gi = __expf(-cl[j]), gp = __expf(clp[j]), ge = __expf(cle[j] - cl[j]);
            const float kd = zk[j] * (1.0f + (as[j] - 1.0f) * kaw[j]), kb = kk[j] * as[j];
            ab[j] = -kk[j] * gp; bt[j] = kb * gi; kt[j] = kd * gi; rb[j] = zr[j] * gt; bh[j] = kb * ge; kh[j] = kd * ge;
            if (t == 63) *(LAS float*)(lds + O_GT + (8 * cg + j) * 4) = __expf(cle[j]);
        }
        *(LAS v4u*)(lds + O_AB + (t * LDW + 8 * cg) * 2) = pk8(ab);
        *(LAS v4u*)(lds + O_BT + (t * LDW + 8 * cg) * 2) = pk8(bt);
        *(LAS v4u*)(lds + O_KT + (t * LDW + 8 * cg) * 2) = pk8(kt);
        *(LAS v4u*)(lds + O_RB + (t * LDW + 8 * cg) * 2) = pk8(rb);
#pragma unroll
        for (int j = 0; j < 8; ++j) {
            *(LAS bf16*)(lds + O_BHT + ((8 * cg + j) * LDW + t) * 2) = (bf16)f2bf(bh[j]);
            *(LAS bf16*)(lds + O_KHT + ((8 * cg + j) * LDW + t) * 2) = (bf16)f2bf(kh[j]);
            *(LAS bf16*)(lds + O_VT + ((8 * cg + j) * LDW + t) * 2) = (bf16)f2bf(zv[j]);
        }
    }
    __syncthreads();
    {
        const int nt = wave >> 1, pr = wave & 1;
        const int boff = ((16 * nt + r) * LDW + 8 * g) * 2;
        const s16x8 ab0 = *(const LAS s16x8*)(lds + O_AB + boff), ab1 = *(const LAS s16x8*)(lds + O_AB + boff + 64);
        const s16x8 rb0 = *(const LAS s16x8*)(lds + O_RB + boff), rb1 = *(const LAS s16x8*)(lds + O_RB + boff + 64);
        const int asrc = (pr ? O_KT : O_BT) + (r * LDW + 8 * g) * 2;
        const int tt = 16 * nt + r;
#pragma unroll
        for (int mt = 0; mt < 4; ++mt) {
            const s16x8 x0 = *(const LAS s16x8*)(lds + asrc + mt * 16 * LDW * 2), x1 = *(const LAS s16x8*)(lds + asrc + mt * 16 * LDW * 2 + 64);
            f32x4 m = mfma32(x0, ab0, (f32x4){0.f, 0.f, 0.f, 0.f}); m = mfma32(x1, ab1, m);
            f32x4 n = mfma32(x0, rb0, (f32x4){0.f, 0.f, 0.f, 0.f}); n = mfma32(x1, rb1, n);
#pragma unroll
            for (int i = 0; i < 4; ++i) { const int j = 16 * mt + 4 * g + i; m[i] = j < tt ? m[i] : 0.f; n[i] = j <= tt ? n[i] : 0.f; }
            const int so = (tt * LDW + 16 * mt + 4 * g) * 2;
            *(LAS s16x4*)(lds + (pr ? O_MAK : O_MAB) + so) = pack4(m);
            *(LAS s16x4*)(lds + (pr ? O_NRK : O_NRB) + so) = pack4(n);
        }
    }
    __syncthreads();
    f32x4 rhs[4];
    if (wave < 4) {
        const int bi = wave;
        const s16x4 aN = *(const LAS s16x4*)(lds + O_MAB + ((16 * bi + r) * LDW + 16 * bi + 4 * g) * 2);
        s16x4 bN;
#pragma unroll
        for (int i = 0; i < 4; ++i) bN[i] = *(const LAS short*)(lds + O_MAB + ((16 * bi + 4 * g + i) * LDW + 16 * bi + r) * 2);
        f32x4 c2 = mfma16(aN, bN, (f32x4){0.f, 0.f, 0.f, 0.f});
        const int npb = O_NP + bi * 3 * 16 * NPS * 2;
#pragma unroll
        for (int p = 0; p < 3; ++p) {
#pragma unroll
            for (int i = 0; i < 4; ++i) *(LAS bf16*)(lds + npb + p * 16 * NPS * 2 + ((4 * g + i) * NPS + r) * 2) = (bf16)f2bf(c2[i]);
            LDS_WAIT();
            if (p < 2) { const s16x4 aP = *(const LAS s16x4*)(lds + npb + p * 16 * NPS * 2 + (r * NPS + 4 * g) * 2); c2 = mfma16(aP, pack4(c2), (f32x4){0.f, 0.f, 0.f, 0.f}); }
        }
#pragma unroll
        for (int mt = 0; mt < 4; ++mt)
#pragma unroll
            for (int i = 0; i < 4; ++i) rhs[mt][i] = bf2f(*(const LAS bf16*)(lds + O_AB + ((16 * mt + 4 * g + i) * LDW + 16 * wave + r) * 2));
    } else {
        const int vt = wave - 4;
        const int boff = ((16 * vt + r) * LDW + 8 * g) * 2;
        const s16x8 v0 = *(const LAS s16x8*)(lds + O_VT + boff), v1 = *(const LAS s16x8*)(lds + O_VT + boff + 64);
#pragma unroll
        for (int mt = 0; mt < 4; ++mt) {
            const int ao = O_MAK + ((16 * mt + r) * LDW + 8 * g) * 2;
            const s16x8 x0 = *(const LAS s16x8*)(lds + ao), x1 = *(const LAS s16x8*)(lds + ao + 64);
            rhs[mt] = mfma32(x0, v0, (f32x4){0.f, 0.f, 0.f, 0.f}); rhs[mt] = mfma32(x1, v1, rhs[mt]);
        }
    }
    __syncthreads();
    {
        f32x4 xb[4];
#pragma unroll
        for (int bi = 0; bi < 4; ++bi) {
            f32x4 acc = rhs[bi];
#pragma unroll
            for (int bj = 0; bj < 4; ++bj) if (bj < bi) {
                const s16x4 am = *(const LAS s16x4*)(lds + O_MAB + ((16 * bi + r) * LDW + 16 * bj + 4 * g) * 2);
                acc = mfma16(am, pack4(xb[bj]), acc);
            }
#pragma unroll
            for (int p = 0; p < 4; ++p) {
                const s16x4 ap = p == 0 ? *(const LAS s16x4*)(lds + O_MAB + ((16 * bi + r) * LDW + 16 * bi + 4 * g) * 2)
                                        : *(const LAS s16x4*)(lds + O_NP + (bi * 3 + (p - 1)) * 16 * NPS * 2 + (r * NPS + 4 * g) * 2);
                acc = mfma16(ap, pack4(acc), acc);
            }
            xb[bi] = acc;
            *(LAS s16x4*)(lds + O_XT + ((16 * wave + r) * LDW + 16 * bi + 4 * g) * 2) = pack4(acc);
        }
    }
    __syncthreads();
    {
        const int nt = wave & 3;
        bf16* ug = (bf16*)((unsigned char*)a.out + DO_INT) + (size_t)u * UNIT_ELEMS;
        const int boff = ((16 * nt + r) * LDW + 8 * g) * 2;
        if (wave < 4) {
            const s16x8 bh0 = *(const LAS s16x8*)(lds + O_BHT + boff), bh1 = *(const LAS s16x8*)(lds + O_BHT + boff + 64);
            const s16x8 nb0 = *(const LAS s16x8*)(lds + O_NRB + boff), nb1 = *(const LAS s16x8*)(lds + O_NRB + boff + 64);
            v2u po[4], ro[4];
#pragma unroll
            for (int mt = 0; mt < 4; ++mt) {
                const int ao = O_XT + ((16 * mt + r) * LDW + 8 * g) * 2;
                const s16x8 x0 = *(const LAS s16x8*)(lds + ao), x1 = *(const LAS s16x8*)(lds + ao + 64);
                f32x4 p = mfma32(x0, bh0, (f32x4){0.f, 0.f, 0.f, 0.f}); p = mfma32(x1, bh1, p);
                if (mt == nt) { const float gt = *(const LAS float*)(lds + O_GT + (16 * mt + r) * 4);
#pragma unroll
                    for (int i = 0; i < 4; ++i) p[i] += (4 * g + i == r) ? gt : 0.f; }
                const f32x4 rbv = unpack4(*(const LAS v2u*)(lds + O_RB + ((16 * nt + r) * LDW + 16 * mt + 4 * g) * 2));
                f32x4 q = mfma32(x0, nb0, rbv); q = mfma32(x1, nb1, q);
                po[mt] = __builtin_bit_cast(v2u, pack4(p)); ro[mt] = __builtin_bit_cast(v2u, pack4(q));
            }
            v4u* pg = (v4u*)(ug + (size_t)(nt * 64 + lane) * 16);
            pg[0] = (v4u){po[0].x, po[0].y, po[1].x, po[1].y}; pg[1] = (v4u){po[2].x, po[2].y, po[3].x, po[3].y};
            v4u* rg = (v4u*)(ug + 4096 + (size_t)(nt * 64 + lane) * 16);
            rg[0] = (v4u){ro[0].x, ro[0].y, ro[1].x, ro[1].y}; rg[1] = (v4u){ro[2].x, ro[2].y, ro[3].x, ro[3].y};
        } else {
            const s16x8 u0 = *(const LAS s16x8*)(lds + O_XT + 64 * LDW * 2 + boff), u1 = *(const LAS s16x8*)(lds + O_XT + 64 * LDW * 2 + boff + 64);
            const s16x8 v0 = *(const LAS s16x8*)(lds + O_VT + boff), v1 = *(const LAS s16x8*)(lds + O_VT + boff + 64);
            v2u qo[4], yo[4];
#pragma unroll
            for (int mt = 0; mt < 4; ++mt) {
                const int ro_ = ((16 * mt + r) * LDW + 8 * g) * 2;
                const s16x8 b0 = *(const LAS s16x8*)(lds + O_BHT + ro_), b1 = *(const LAS s16x8*)(lds + O_BHT + ro_ + 64);
                const s16x8 k0 = *(const LAS s16x8*)(lds + O_KHT + ro_), k1 = *(const LAS s16x8*)(lds + O_KHT + ro_ + 64);
                f32x4 q = mfma32(b0, u0, (f32x4){0.f, 0.f, 0.f, 0.f}); q = mfma32(b1, u1, q); q = mfma32(k0, v0, q); q = mfma32(k1, v1, q);
                const s16x8 n0 = *(const LAS s16x8*)(lds + O_NRB + ro_), n1 = *(const LAS s16x8*)(lds + O_NRB + ro_ + 64);
                const s16x8 m0 = *(const LAS s16x8*)(lds + O_NRK + ro_), m1 = *(const LAS s16x8*)(lds + O_NRK + ro_ + 64);
                f32x4 y = mfma32(n0, u0, (f32x4){0.f, 0.f, 0.f, 0.f}); y = mfma32(n1, u1, y); y = mfma32(m0, v0, y); y = mfma32(m1, v1, y);
                qo[mt] = __builtin_bit_cast(v2u, pack4(q)); yo[mt] = __builtin_bit_cast(v2u, pack4(y));
            }
            v4u* qg = (v4u*)(ug + 8192 + (size_t)(nt * 64 + lane) * 16);
            qg[0] = (v4u){qo[0].x, qo[0].y, qo[1].x, qo[1].y}; qg[1] = (v4u){qo[2].x, qo[2].y, qo[3].x, qo[3].y};
            v4u* yg = (v4u*)(ug + 12288 + (size_t)(nt * 64 + lane) * 16);
            yg[0] = (v4u){yo[0].x, yo[0].y, yo[1].x, yo[1].y}; yg[1] = (v4u){yo[2].x, yo[2].y, yo[3].x, yo[3].y};
        }
    }
    __syncthreads();
}

__device__ __forceinline__ void rw_chain_job(const Args& a, unsigned char* ws, int seg, int chain, int vt, int lane) {
    int s, rem; if (chain < 64) { s = chain >> 5; rem = chain & 31; } else { s = 2 + ((chain - 64) >> 5); rem = (chain - 64) & 31; }
    const int h = rem >> 1, d = rem & 1, base = s < 2 ? s * LP : 32768 + (s - 2) * LS, L = s < 2 ? LP : LS, nch = chain < 64 ? 32 : 4;
    const int r = lane & 15, g = lane >> 4;
    f32x4* stp = (f32x4*)(ws + WS_STATE) + ((size_t)(chain * 4 + vt) * 4) * 64 + lane;
    f32x4 st[4];
#pragma unroll
    for (int i = 0; i < 4; ++i) st[i] = seg == 0 ? (f32x4){0.f, 0.f, 0.f, 0.f} : stp[i * 64];
    bf16* Y = (bf16*)((unsigned char*)a.out + (d ? DO_YB : DO_YF));
    const bf16* ub = (const bf16*)((unsigned char*)a.out + DO_INT);
    for (int jc = 0; jc < nch; ++jc) {
        const bf16* ug = ub + (size_t)unit_of(chain, jc) * UNIT_ELEMS;
        v4u pf[4][2], rf[4][2];
#pragma unroll
        for (int i = 0; i < 4; ++i) { const v4u* p = (const v4u*)(ug + (size_t)(i * 64 + lane) * 16); pf[i][0] = p[0]; pf[i][1] = p[1];
                                      const v4u* q = (const v4u*)(ug + 4096 + (size_t)(i * 64 + lane) * 16); rf[i][0] = q[0]; rf[i][1] = q[1]; }
        const v4u* qp = (const v4u*)(ug + 8192 + (size_t)(vt * 64 + lane) * 16); const v4u qf0 = qp[0], qf1 = qp[1];
        const v4u* yp = (const v4u*)(ug + 12288 + (size_t)(vt * 64 + lane) * 16); const v4u yf0 = yp[0], yf1 = yp[1];
        s16x4 sb[4];
#pragma unroll
        for (int kt = 0; kt < 4; ++kt) sb[kt] = pack4(st[kt]);
        const int gchunk = seg * nch + jc;
#pragma unroll
        for (int tt = 0; tt < 4; ++tt) {
            const v2u yi = tt == 0 ? (v2u){yf0.x, yf0.y} : tt == 1 ? (v2u){yf0.z, yf0.w} : tt == 2 ? (v2u){yf1.x, yf1.y} : (v2u){yf1.z, yf1.w};
            f32x4 acc = unpack4(yi);
            acc = mfma16(__builtin_bit_cast(s16x4, (v2u){rf[tt][0].x, rf[tt][0].y}), sb[0], acc);
            acc = mfma16(__builtin_bit_cast(s16x4, (v2u){rf[tt][0].z, rf[tt][0].w}), sb[1], acc);
            acc = mfma16(__builtin_bit_cast(s16x4, (v2u){rf[tt][1].x, rf[tt][1].y}), sb[2], acc);
            acc = mfma16(__builtin_bit_cast(s16x4, (v2u){rf[tt][1].z, rf[tt][1].w}), sb[3], acc);
#pragma unroll
            for (int i = 0; i < 4; ++i) { const int lp = 64 * gchunk + 16 * tt + 4 * g + i, pos = d ? L - 1 - lp : lp;
                Y[(size_t)(base + pos) * DRW + h * 64 + 16 * vt + r] = (bf16)f2bf(acc[i]); }
        }
        f32x4 sn[4];
#pragma unroll
        for (int i = 0; i < 4; ++i) {
            const v2u qi = i == 0 ? (v2u){qf0.x, qf0.y} : i == 1 ? (v2u){qf0.z, qf0.w} : i == 2 ? (v2u){qf1.x, qf1.y} : (v2u){qf1.z, qf1.w};
            f32x4 acc = unpack4(qi);
            acc = mfma16(__builtin_bit_cast(s16x4, (v2u){pf[i][0].x, pf[i][0].y}), sb[0], acc);
            acc = mfma16(__builtin_bit_cast(s16x4, (v2u){pf[i][0].z, pf[i][0].w}), sb[1], acc);
            acc = mfma16(__builtin_bit_cast(s16x4, (v2u){pf[i][1].x, pf[i][1].y}), sb[2], acc);
            acc = mfma16(__builtin_bit_cast(s16x4, (v2u){pf[i][1].z, pf[i][1].w}), sb[3], acc);
            sn[i] = acc;
        }
#pragma unroll
        for (int i = 0; i < 4; ++i) st[i] = sn[i];
    }
#pragma unroll
    for (int i = 0; i < 4; ++i) stp[i * 64] = st[i];
}
}


namespace s5k {
constexpr int ST = 32, NCH = M / ST, K2 = 768, KU = 512;
constexpr size_t POW_ELEMS = (size_t)128 * 33 * 64 * 2, BB_ELEMS = (size_t)128 * 64 * 16 * 2, KTAB_ELEMS = (size_t)64 * 63 * 256;
__device__ __forceinline__ void tables_group(const Args& a, unsigned char* ws, LAS unsigned char* lds, int g, int tid) {
    float* POW = (float*)(ws + WS_S5TAB); float* BB = POW + POW_ELEMS; float* KTAB = BB + BB_ELEMS;
    LAS float* lam = (LAS float*)lds;
    LAS float* bbl = lam + 256;
    LAS float* cl = bbl + 4096;
    LAS float* pwl = cl + 4096;
    if (tid < 128) {
        const int d = tid >> 6, p = tid & 63, gi = d * 64 + g;
        const float lre = a.in[5][gi * 64 + p], lim = a.in[6][gi * 64 + p], dt = expf(a.in[7][gi]);
        const float er = expf(lre * dt); float sn, cs; sincosf(lim * dt, &sn, &cs);
        const float lbr = er * cs, lbi = er * sn;
        const float nr = lbr - 1.0f, ni = lbi, den = lre * lre + lim * lim;
        const float cfr = (nr * lre + ni * lim) / den, cfi = (ni * lre - nr * lim) / den;
        lam[(d * 64 + p) * 2] = lre * dt; lam[(d * 64 + p) * 2 + 1] = lim * dt;
        for (int h = 0; h < 16; ++h) {
            const float br = a.in[8][((size_t)gi * 64 + p) * 16 + h], bi = a.in[9][((size_t)gi * 64 + p) * 16 + h];
            const float xr = cfr * br - cfi * bi, xi = cfr * bi + cfi * br;
            bbl[((d * 64 + p) * 16 + h) * 2] = xr; bbl[((d * 64 + p) * 16 + h) * 2 + 1] = xi;
            BB[(((size_t)gi * 64 + p) * 16 + h) * 2] = xr; BB[(((size_t)gi * 64 + p) * 16 + h) * 2 + 1] = xi;
            cl[((d * 16 + h) * 64 + p) * 2] = a.in[10][((size_t)gi * 16 + h) * 64 + p]; cl[((d * 16 + h) * 64 + p) * 2 + 1] = a.in[11][((size_t)gi * 16 + h) * 64 + p];
        }
    }
    __syncthreads();
    for (int e = tid; e < 2 * 33 * 64; e += NWAVES * 64) {
        const int p = e & 63, tau = (e >> 6) % 33, d = e / (33 * 64), gi = d * 64 + g;
        const float er = expf(lam[(d * 64 + p) * 2] * (float)tau); float sn, cs; sincosf(lam[(d * 64 + p) * 2 + 1] * (float)tau, &sn, &cs);
        pwl[e * 2] = er * cs; pwl[e * 2 + 1] = er * sn;
        POW[(((size_t)gi * 33 + tau) * 64 + p) * 2] = er * cs; POW[(((size_t)gi * 33 + tau) * 64 + p) * 2 + 1] = er * sn;
    }
    __syncthreads();
    for (int o = tid; o < 63 * 256; o += NWAVES * 64) {
        const int hh = o & 255, h = hh >> 4, h2 = hh & 15, lag = (o >> 8) - 31;
        float acc = 0.f;
#pragma unroll
        for (int d = 0; d < 2; ++d) {
            if ((d == 0 && lag >= 0) || (d == 1 && lag <= 0)) {
                const int tau = lag >= 0 ? lag : -lag;
                for (int p = 0; p < 64; ++p) {
                    const float cr = cl[((d * 16 + h) * 64 + p) * 2], ci = cl[((d * 16 + h) * 64 + p) * 2 + 1];
                    const float pr = pwl[((d * 33 + tau) * 64 + p) * 2], pi = pwl[((d * 33 + tau) * 64 + p) * 2 + 1];
                    const float br = bbl[((d * 64 + p) * 16 + h2) * 2], bi = bbl[((d * 64 + p) * 16 + h2) * 2 + 1];
                    const float qr = pr * br - pi * bi, qi = pr * bi + pi * br;
                    acc += cr * qr - ci * qi;
                }
            }
        }
        KTAB[(size_t)g * 63 * 256 + o] = acc;
    }
    __syncthreads();
}
__device__ __forceinline__ void fill_weights(const Args& a, unsigned char* ws, int gw, int NGW, int lane) {
    const float* POW = (const float*)(ws + WS_S5TAB); const float* BB = POW + POW_ELEMS; const float* KTAB = BB + BB_ELEMS;
    bf16* W2 = (bf16*)(ws + WS_S5W2); bf16* E = (bf16*)(ws + WS_S5E);
    const size_t n_w2 = (size_t)64 * 512 * 96, n_e = (size_t)64 * 256 * 64, stride = (size_t)NGW * 64;
    for (size_t it = (size_t)gw * 64 + lane; it < n_w2 + n_e; it += stride) {
        float v[8];
        if (it < n_w2) {
            const int kc = (int)(it % 96), n = (int)((it / 96) % 512), g = (int)(it / (96 * 512)), t = n >> 4, h = n & 15, k0 = kc * 8;
            if (k0 < KU) {
                const int s = k0 >> 4, h0 = k0 & 15, lag = t - s;
                const float* kt = KTAB + ((size_t)(g * 63 + lag + 31) * 16 + h) * 16 + h0;
#pragma unroll
                for (int j = 0; j < 8; ++j) v[j] = kt[j] + ((lag == 0 && h0 + j == h) ? a.in[12][g * 16 + h] : 0.f);
            } else {
                const int kk = k0 - KU, d = kk >> 7, ri = (kk >> 6) & 1, p0 = kk & 63, gi = d * 64 + g, tau = d == 0 ? t + 1 : ST - t;
#pragma unroll
                for (int j = 0; j < 8; ++j) {
                    const int p = p0 + j;
                    const float cr = a.in[10][((size_t)gi * 16 + h) * 64 + p], ci = a.in[11][((size_t)gi * 16 + h) * 64 + p];
                    const float pr = POW[(((size_t)gi * 33 + tau) * 64 + p) * 2], pi = POW[(((size_t)gi * 33 + tau) * 64 + p) * 2 + 1];
                    v[j] = ri == 0 ? (cr * pr - ci * pi) : -(cr * pi + ci * pr);
                }
            }
            *(v4u*)(W2 + ((size_t)(g * 512 + n)) * K2 + k0) = rwk::pk8(v);
        } else {
            const size_t ie = it - n_w2;
            const int kc = (int)(ie % 64), n = (int)((ie / 64) % 256), g = (int)(ie / (64 * 256)), d = n >> 7, ri = (n >> 6) & 1, p = n & 63, gi = d * 64 + g;
            const int k0 = kc * 8, s = k0 >> 4, h0 = k0 & 15, tau = d == 0 ? ST - 1 - s : s;
            const float pr = POW[(((size_t)gi * 33 + tau) * 64 + p) * 2], pi = POW[(((size_t)gi * 33 + tau) * 64 + p) * 2 + 1];
#pragma unroll
            for (int j = 0; j < 8; ++j) {
                const float br = BB[(((size_t)gi * 64 + p) * 16 + h0 + j) * 2], bi = BB[(((size_t)gi * 64 + p) * 16 + h0 + j) * 2 + 1];
                v[j] = ri == 0 ? (pr * br - pi * bi) : (pr * bi + pi * br);
            }
            *(v4u*)(E + ((size_t)(g * 256 + n)) * KU + k0) = rwk::pk8(v);
        }
    }
}
__device__ __forceinline__ void chain_job(unsigned char* ws, bf16* A2, int job, int lane) {
    int s, rem; if (job < 256) { s = job / 128; rem = job % 128; } else { s = 2 + (job - 256) / 128; rem = (job - 256) % 128; }
    const int g = rem >> 1, d = rem & 1, p = lane, gi = d * 64 + g;
    const int c0 = s < 2 ? s * (LP / ST) : 2 * (LP / ST) + (s - 2) * (LS / ST), nc = s < 2 ? LP / ST : LS / ST;
    const float* POW = (const float*)(ws + WS_S5TAB);
    const float lr = POW[(((size_t)gi * 33 + 32) * 64 + p) * 2], li = POW[(((size_t)gi * 33 + 32) * 64 + p) * 2 + 1];
    const bf16* XL = (const bf16*)(ws + WS_S5XL);
    const int step = d ? -1 : 1, cfirst = d ? c0 + nc - 1 : c0;
    const int xcol = d * 128 + p, scol = KU + d * 128 + p;
    float xr = 0.f, xi = 0.f;
    { bf16* row = A2 + ((size_t)g * NCH + cfirst) * K2 + scol; row[0] = 0; row[64] = 0; }
    for (int n = 0; n < nc; n += 8) {
        float lr_[8], li_[8];
#pragma unroll
        for (int j = 0; j < 8; ++j) { const bf16* xrow = XL + ((size_t)g * NCH + cfirst + (n + j) * step) * 256 + xcol; lr_[j] = bf2f(xrow[0]); li_[j] = bf2f(xrow[64]); }
#pragma unroll
        for (int j = 0; j < 8; ++j) {
            const float nr = lr * xr - li * xi + lr_[j], ni = lr * xi + li * xr + li_[j]; xr = nr; xi = ni;
            if (n + j + 1 < nc) { bf16* row = A2 + ((size_t)g * NCH + cfirst + (n + j + 1) * step) * K2 + scol; row[0] = (bf16)f2bf(xr); row[64] = (bf16)f2bf(xi); }
        }
    }
}
}
namespace pg8 {
struct S5Order {
    int G, c, nun, mode;
    __device__ bool next(int i, Unit& u) const {
        const int L = i * G + c; if (L >= nun) return false;
        if (mode == 1) { u.pm = L; u.pn = L >> 3; } else { const int g = L >> 4; u.pm = g * 8 + ((L & 15) >> 1); u.pn = g * 2 + (L & 1); }
        return true;
    }
    __device__ __forceinline__ void a_ready(const Unit&) const {}
    __device__ __forceinline__ void done(const Unit&) const {}
};
struct EpiS5X {
    static constexpr bool PERM = true, AFTER_DRAIN = false;
    bf16_t* O;
    __device__ __forceinline__ void operator()(const f32x4 (&acc)[2][2][4][2], const Unit& u, int wr, int wc, int fr, int fq) const {
        const int row0 = u.pm * BM + wr * 64 + fr, col0 = wc * 32 + 8 * fq;
#pragma unroll
        for (int ai = 0; ai < 2; ++ai)
#pragma unroll
            for (int m = 0; m < 4; ++m) { bf16_t* rowp = O + (size_t)(row0 + ai * HALF + m * 16) * 256 + col0;
#pragma unroll
                for (int bj = 0; bj < 2; ++bj) { const f32x4 v0 = acc[ai][bj][m][0], v1 = acc[ai][bj][m][1];
                    u32x4 w; w.x = cvt_pk_bf16(v0[0], v0[1]); w.y = cvt_pk_bf16(v0[2], v0[3]); w.z = cvt_pk_bf16(v1[0], v1[1]); w.w = cvt_pk_bf16(v1[2], v1[3]);
                    *(u32x4*)(rowp + bj * HALF) = w; } }
    }
};
struct EpiS5Y {
    static constexpr bool PERM = true, AFTER_DRAIN = false;
    bf16_t* Zp;
    __device__ __forceinline__ void operator()(const f32x4 (&acc)[2][2][4][2], const Unit& u, int wr, int wc, int fr, int fq) const {
        const int row0 = u.pm * BM + wr * 64 + fr, col0 = (u.pn & 1) * BM + wc * 32 + 8 * fq;
#pragma unroll
        for (int ai = 0; ai < 2; ++ai)
#pragma unroll
            for (int m = 0; m < 4; ++m) {
                const int row = row0 + ai * HALF + m * 16, g = row >> 11, c = row & 2047;
#pragma unroll
                for (int bj = 0; bj < 2; ++bj) {
                    const int col = col0 + bj * HALF, t = col >> 4, h0 = col & 15;
                    float v[8];
#pragma unroll
                    for (int j = 0; j < 4; ++j) { v[j] = acc[ai][bj][m][0][j]; v[4 + j] = acc[ai][bj][m][1][j]; }
#pragma unroll
                    for (int j = 0; j < 8; ++j) { const float x = v[j]; v[j] = x * sigmoid_f(1.5957691216057308f * (x + 0.044715f * x * x * x)); }
                    u32x4 w; w.x = cvt_pk_bf16(v[0], v[1]); w.y = cvt_pk_bf16(v[2], v[3]); w.z = cvt_pk_bf16(v[4], v[5]); w.w = cvt_pk_bf16(v[6], v[7]);
                    *(u32x4*)(Zp + (size_t)(c * 32 + t) * 1024 + g * 16 + h0) = w;
                }
            }
    }
};
}


__device__ __forceinline__ void transpose_item(const float* W, int ldw, int K, bf16* WT, int drow0, LAS float* scr, int k0, int n0, int lane) {
#pragma unroll 8
    for (int i = 0; i < 32; ++i) { const int kk = 2 * i + (lane >> 5); scr[kk * 33 + (lane & 31)] = W[(size_t)(k0 + kk) * ldw + n0 + (lane & 31)]; }
    LDS_WAIT();
    const int c = lane & 7;
#pragma unroll
    for (int j = 0; j < 4; ++j) { const int n = (lane >> 3) + 8 * j; const LAS float* s = scr + (8 * c) * 33 + n;
        v4u o; o.x = pk2(s[0 * 33], s[1 * 33]); o.y = pk2(s[2 * 33], s[3 * 33]); o.z = pk2(s[4 * 33], s[5 * 33]); o.w = pk2(s[6 * 33], s[7 * 33]);
        *(v4u*)(WT + (size_t)(drow0 + n) * K + k0 + 8 * c) = o; }
    LDS_WAIT();
}
__device__ __forceinline__ int win_dest_row(int n) { return n < 1024 ? n : (n < 2048 ? n + 3328 : (n < 5376 ? n - 1024 : n)); }
__device__ __forceinline__ const float* xrow_ptr(const float* xp, const float* xs, int m) { return m < 32768 ? xp + (size_t)m * D : xs + (size_t)(m - 32768) * D; }

__device__ __forceinline__ void p0_prologue(const Args& a, unsigned char* ws, LAS unsigned char* lds, int gw, int NGW, int wave, int lane) {
    LAS float* scr = (LAS float*)(lds + wave * 16384);
    constexpr int I_IN = (D / 64) * (NIN / 32), I_GLU = (1024 / 64) * (1024 / 32), I_SO = (1024 / 64) * (2048 / 32), I_WO = (2048 / 64) * (2048 / 32);
    constexpr int NITEMS = I_IN + I_GLU + 2 * I_SO + I_WO;
    for (int it = gw; it < NITEMS; it += NGW) {
        int r = it;
        if (r < I_IN) { const int nblk = NIN / 32, kb = r / nblk, nb = r % nblk; transpose_item(a.in[4], NIN, D, (bf16*)(ws + WS_WT), win_dest_row(32 * nb), scr, 64 * kb, 32 * nb, lane); continue; } r -= I_IN;
        if (r < I_GLU) { const int nblk = 1024 / 32, kb = r / nblk, nb = r % nblk; transpose_item(a.in[13], 1024, 1024, (bf16*)(ws + WS_GLUT), 32 * nb, scr, 64 * kb, 32 * nb, lane); continue; } r -= I_GLU;
        if (r < I_SO) { const int nblk = 2048 / 32, kb = r / nblk, nb = r % nblk; transpose_item(a.in[14], 2048, 1024, (bf16*)(ws + WS_S5OT), 32 * nb, scr, 64 * kb, 32 * nb, lane); continue; } r -= I_SO;
        if (r < I_SO) { const int nblk = 2048 / 32, kb = r / nblk, nb = r % nblk; transpose_item(a.in[25], 2048, 1024, (bf16*)(ws + WS_RWOT), 32 * nb, scr, 64 * kb, 32 * nb, lane); continue; } r -= I_SO;
        { const int nblk = 2048 / 32, kb = r / nblk, nb = r % nblk; transpose_item(a.in[26], 2048, 2048, (bf16*)(ws + WS_WOT), 32 * nb, scr, 64 * kb, 32 * nb, lane); }
    }
    { const int bxx = gw / NWAVES; if (bxx < 64) s5k::tables_group(a, ws, lds, bxx, wave * 64 + lane); }
    { bf16* LUT = (bf16*)(ws + WS_LUT);
      for (int e = gw * 64 + lane; e < 4 * 16 * 64 * 64; e += NGW * 64) {
          const int j = e & 63, c = (e >> 6) & 63, h = (e >> 12) & 15, rd = e >> 16, role = rd >> 1, d = rd & 1;
          LUT[e] = (bf16)f2bf((role ? a.in[19] : a.in[17])[(size_t)(d * 64 + j) * 1024 + h * 64 + c]); } }
    const float* g = a.in[2];
    f32x4 gv[8];
#pragma unroll
    for (int j = 0; j < 8; ++j) gv[j] = ((const f32x4*)g)[lane + 64 * j];
    bf16* HN = (bf16*)(ws + WS_HN);
    for (int m = gw; m < M; m += NGW) {
        const f32x4* xr = (const f32x4*)xrow_ptr(a.in[0], a.in[1], m) + lane;
        f32x4 v[8]; float s = 0.f;
#pragma unroll
        for (int j = 0; j < 8; ++j) { v[j] = xr[64 * j]; s += (v[j].x * v[j].x + v[j].y * v[j].y) + (v[j].z * v[j].z + v[j].w * v[j].w); }
        const float rstd = 1.0f / sqrtf(wave_sum(s) * (1.0f / D) + RMS_EPS);
        v2u* o8 = (v2u*)(HN + (size_t)m * D) + lane;
#pragma unroll
        for (int j = 0; j < 8; ++j) { v2u o; o.x = pk2(v[j].x * rstd * gv[j].x, v[j].y * rstd * gv[j].y); o.y = pk2(v[j].z * rstd * gv[j].z, v[j].w * rstd * gv[j].w); o8[64 * j] = o; }
    }
}

__device__ __forceinline__ void unpack8(const bf16* p, float (&o)[8]) {
    const v4u a = *(const v4u*)p;
    o[0] = blo(a.x); o[1] = bhi(a.x); o[2] = blo(a.y); o[3] = bhi(a.y); o[4] = blo(a.z); o[5] = bhi(a.z); o[6] = blo(a.w); o[7] = bhi(a.w);
}
__device__ __forceinline__ void pack8(bf16* p, const float (&v)[8]) {
    v4u a; a.x = pk2(v[0], v[1]); a.y = pk2(v[2], v[3]); a.z = pk2(v[4], v[5]); a.w = pk2(v[6], v[7]); *(v4u*)p = a;
}
__device__ __forceinline__ void p3_finalize(const Args& a, unsigned char* ws, int gw, int NGW, int lane) {
    const bf16* RWIN = (const bf16*)(ws + WS_RWIN);
    unsigned char* ob = (unsigned char*)a.out;
    bf16* YF = (bf16*)(ob + DO_YF); const bf16* YB = (const bf16*)(ob + DO_YB);
    const int half = gw & 1, c0 = half * 512 + lane * 8;
    float lnw[8], lnb[8], rk[8], mur[8], muk[8], muv[8];
#pragma unroll
    for (int j = 0; j < 8; ++j) { lnw[j] = a.in[23][c0 + j]; lnb[j] = a.in[24][c0 + j]; rk[j] = a.in[22][c0 + j]; mur[j] = a.in[15][c0 + j]; muk[j] = a.in[15][1024 + c0 + j]; muv[j] = a.in[15][2048 + c0 + j]; }
    for (int m = gw >> 1; m < M; m += NGW >> 1) {
        const int t = m < 32768 ? (m & (LP - 1)) : ((m - 32768) & (LS - 1)), L = m < 32768 ? LP : LS;
        const bool hp = t > 0, hn = t < L - 1;
        float o[8];
        float y[8];
        {
            float yf[8], yb[8];
            unpack8(YF + (size_t)m * DRW + c0, yf); unpack8(YB + (size_t)m * DRW + c0, yb);
#pragma unroll
            for (int j = 0; j < 8; ++j) y[j] = yf[j] + yb[j];
        }
        float s1 = 0.f;
#pragma unroll
        for (int j = 0; j < 8; ++j) s1 += y[j];
        s1 += __shfl_xor(s1, 1); s1 += __shfl_xor(s1, 2); s1 += __shfl_xor(s1, 4);
        const float mean = s1 * (1.0f / 64.0f);
        float s2 = 0.f;
#pragma unroll
        for (int j = 0; j < 8; ++j) { const float dd = y[j] - mean; s2 += dd * dd; }
        s2 += __shfl_xor(s2, 1); s2 += __shfl_xor(s2, 2); s2 += __shfl_xor(s2, 4);
        const float rstd = 1.0f / sqrtf(s2 * (1.0f / 64.0f) + GN_EPS);
        float zr[8], zk[8], zv[8];
        const bf16* pc = RWIN + (size_t)m * DRWIN + c0;
#pragma unroll
        for (int comp = 0; comp < 3; ++comp) {
            float cc[8], pp[8], nn[8];
            unpack8(pc + comp * 1024, cc);
            if (hp) unpack8(pc - DRWIN + comp * 1024, pp); else {
#pragma unroll
                for (int j = 0; j < 8; ++j) pp[j] = 0.f; }
            if (hn) unpack8(pc + DRWIN + comp * 1024, nn); else {
#pragma unroll
                for (int j = 0; j < 8; ++j) nn[j] = 0.f; }
#pragma unroll
            for (int j = 0; j < 8; ++j) {
                const float muc = comp == 0 ? mur[j] : (comp == 1 ? muk[j] : muv[j]);
                const float zz = cc[j] + (0.5f * (pp[j] + nn[j]) - cc[j]) * muc;
                if (comp == 0) zr[j] = zz; else if (comp == 1) zk[j] = zz; else zv[j] = zz;
            }
        }
        float dot = 0.f;
#pragma unroll
        for (int j = 0; j < 8; ++j) dot += zr[j] * zk[j] * rk[j];
        dot += __shfl_xor(dot, 1); dot += __shfl_xor(dot, 2); dot += __shfl_xor(dot, 4);
#pragma unroll
        for (int j = 0; j < 8; ++j) o[j] = (y[j] - mean) * rstd * lnw[j] + lnb[j] + dot * zv[j];
        pack8(YF + (size_t)m * DRW + c0, o);
    }
}

__device__ __forceinline__ void p12_final(const Args& a, int gw, int NGW, int lane) {
    const float* g = a.in[3];
    f32x4 gv[8];
#pragma unroll
    for (int j = 0; j < 8; ++j) gv[j] = ((const f32x4*)g)[lane + 64 * j];
    for (int m = gw; m < M; m += NGW) {
        const f32x4* xr = (const f32x4*)xrow_ptr(a.in[0], a.in[1], m) + lane;
        f32x4* orow = (f32x4*)(a.out + (size_t)m * D) + lane;
        f32x4 v[8]; float s = 0.f;
#pragma unroll
        for (int j = 0; j < 8; ++j) { v[j] = orow[64 * j]; s += (v[j].x * v[j].x + v[j].y * v[j].y) + (v[j].z * v[j].z + v[j].w * v[j].w); }
        const float rstd = 1.0f / sqrtf(wave_sum(s) * (1.0f / D) + RMS_EPS);
#pragma unroll
        for (int j = 0; j < 8; ++j) { const f32x4 xv = xr[64 * j]; orow[64 * j] = xv + v[j] * rstd * gv[j]; }
    }
}

__global__ void __launch_bounds__(NWAVES * 64, 2) mk_fwd(Args args) {
    extern __shared__ __attribute__((aligned(16))) unsigned char lds_raw[];
    LAS unsigned char* lds = (LAS unsigned char*)lds_raw;
    volatile LAS unsigned* MISC = (volatile LAS unsigned*)(lds + MISC_OFF);
    const int wave = __builtin_amdgcn_readfirstlane((int)threadIdx.x >> 6);
#define lane mk_lane()
    const int tid0 = threadIdx.x;
    const int G = gridDim.x; const int bx = blockIdx.x; const int vcu = (G % 8 == 0) ? (bx % 8) * (G / 8) + bx / 8 : bx;
    unsigned char* ws = args.ws;
    unsigned* ctl = (unsigned*)(ws + WS_CTL);
    for (int u = tid0; u < (LDS_BYTES - MISC_OFF) / 4; u += NWAVES * 64) ((LAS unsigned*)(lds + MISC_OFF))[u] = 0u;
    __syncthreads();
    XcdBarrier bar = xcd_barrier_post(ctl + CW_BAR, MISC + 8, wave);
#define GRID_BAR() xcd_barrier(bar, wave)
#ifndef ONLY_PHASE
#define ONLY_PHASE -1
#endif
#define IN(k) (ONLY_PHASE < 0 || ONLY_PHASE == (k))
    const int gw = vcu * NWAVES + wave, NGW = G * NWAVES;
    bf16* WT = (bf16*)(ws + WS_WT); bf16* HN = (bf16*)(ws + WS_HN); bf16* RWIN = (bf16*)(ws + WS_RWIN); bf16* Z = (bf16*)(ws + WS_Z); bf16* ZG = (bf16*)(ws + WS_ZG);
    bf16* A2 = (bf16*)((unsigned char*)args.out + DO_A2);
    bf16* YN = (bf16*)((unsigned char*)args.out + DO_YF); bf16* Q = (bf16*)((unsigned char*)args.out + DO_Q); bf16* P = RWIN;

    if (IN(0)) { p0_prologue(args, ws, lds, gw, NGW, wave, lane); GRID_BAR(); }
    if (IN(1)) {
        s5k::fill_weights(args, ws, gw, NGW, lane);
        pg8::Gemm g{HN, WT, M, 4352, D, D}; pg8::StaticOrder S; S.init(M, 4352, G, bx);
        pg8::EpiG1 E{A2, RWIN};
        pg8::gemm_phase<pg8::EpiG1, pg8::StaticOrder, PG8_ALIGN, PG8_SP2>(lds, g, S, E, wave);
        GRID_BAR();
    }
    if (IN(2)) {
        pg8::Gemm g{A2, (const bf16*)(ws + WS_S5E), 131072, 256, s5k::KU, s5k::K2}; pg8::S5Order S{G, bx, 512, 1};
        pg8::EpiS5X E{(bf16*)(ws + WS_S5XL)};
        pg8::gemm_phase<pg8::EpiS5X, pg8::S5Order, PG8_ALIGN, PG8_SP2>(lds, g, S, E, wave);
        GRID_BAR();
    }
    if (IN(3)) {
        const int gwt = wave * G + vcu;
        for (int j = gwt; j < 2304; j += NGW) s5k::chain_job(ws, A2, j, lane);
        GRID_BAR();
    }
    if (IN(4)) {
        pg8::Gemm g{A2, (const bf16*)(ws + WS_S5W2), 131072, 512, s5k::K2, s5k::K2}; pg8::S5Order S{G, bx, 1024, 2};
        pg8::EpiS5Y E{Z};
        pg8::gemm_phase<pg8::EpiS5Y, pg8::S5Order, PG8_ALIGN, PG8_SP2>(lds, g, S, E, wave);
        GRID_BAR();
    }
    if (IN(5)) {
        for (int seg = 0; seg < rwk::NSEG; ++seg) {
            for (int u = bx; u < rwk::UNITS_PER_SEG; u += G) rwk::rw_precompute_unit(args, ws, lds, seg, u, wave, lane);
            GRID_BAR();
            {
                int J, Jstride;
                if (bx < 64 && wave < 4) { J = bx * 4 + wave; Jstride = 1 << 20; }
                else { const int fw = bx < 64 ? bx * 4 + (wave - 4) : 256 + (bx - 64) * 8 + wave; J = 256 + fw; Jstride = 1792; }
                for (; J < 2304; J += Jstride) {
                    const int chain = J < 256 ? (J >> 2) : 64 + ((J - 256) >> 2), vt = J & 3;
                    rwk::rw_chain_job(args, ws, seg, chain, vt, lane);
                }
            }
            GRID_BAR();
        }
    }
    if (IN(6)) { p3_finalize(args, ws, gw, NGW, lane); GRID_BAR(); }
    if (IN(7)) {
        pg8::Gemm g{Z, (const bf16*)(ws + WS_GLUT), M, 1024, 1024, 1024}; pg8::StaticOrder S; S.init(M, 1024, G, bx);
        pg8::EpiMix<1> E{ZG, Z, nullptr, 1024};
        pg8::gemm_phase<pg8::EpiMix<1>, pg8::StaticOrder, PG8_ALIGN, PG8_SP2>(lds, g, S, E, wave);
        GRID_BAR();
    }
    if (IN(8)) {
        pg8::Gemm g{HN, WT + (size_t)4352 * D, M, 1024, D, D}; pg8::StaticOrder S; S.init(M, 1024, G, bx);
        pg8::EpiMix<2> E{ZG, ZG, nullptr, 1024};
        pg8::gemm_phase<pg8::EpiMix<2>, pg8::StaticOrder, PG8_ALIGN, PG8_SP2>(lds, g, S, E, wave);
        GRID_BAR();
    }
    if (IN(9)) {
        pg8::Gemm g{HN, WT + (size_t)5376 * D, M, 1024, D, D}; pg8::StaticOrder S; S.init(M, 1024, G, bx);
        pg8::EpiMix<2> E{YN, YN, nullptr, 1024};
        pg8::gemm_phase<pg8::EpiMix<2>, pg8::StaticOrder, PG8_ALIGN, PG8_SP2>(lds, g, S, E, wave);
        GRID_BAR();
    }
    if (IN(10)) {
        pg8::Gemm g{ZG, (const bf16*)(ws + WS_S5OT), M, 2048, 1024, 1024}; pg8::StaticOrder S; S.init(M, 2048, G, bx);
        pg8::EpiMix<0> E{P, nullptr, nullptr, 2048};
        pg8::gemm_phase<pg8::EpiMix<0>, pg8::StaticOrder, PG8_ALIGN, PG8_SP2>(lds, g, S, E, wave);
        GRID_BAR();
    }
    if (IN(11)) {
        pg8::Gemm g{HN, WT + (size_t)6400 * D, M, 2048, D, D}; pg8::StaticOrder S; S.init(M, 2048, G, bx);
        pg8::EpiMix<1> E{P, P, nullptr, 2048};
        pg8::gemm_phase<pg8::EpiMix<1>, pg8::StaticOrder, PG8_ALIGN, PG8_SP2>(lds, g, S, E, wave);
        GRID_BAR();
    }
    if (IN(12)) {
        pg8::Gemm g{YN, (const bf16*)(ws + WS_RWOT), M, 2048, 1024, 1024}; pg8::StaticOrder S; S.init(M, 2048, G, bx);
        pg8::EpiMix<0> E{Q, nullptr, nullptr, 2048};
        pg8::gemm_phase<pg8::EpiMix<0>, pg8::StaticOrder, PG8_ALIGN, PG8_SP2>(lds, g, S, E, wave);
        GRID_BAR();
    }
    if (IN(13)) {
        pg8::Gemm g{HN, WT + (size_t)8448 * D, M, 2048, D, D}; pg8::StaticOrder S; S.init(M, 2048, G, bx);
        pg8::EpiMix<3> E{P, Q, P, 2048};
        pg8::gemm_phase<pg8::EpiMix<3>, pg8::StaticOrder, PG8_ALIGN, PG8_SP2>(lds, g, S, E, wave);
        GRID_BAR();
    }
    if (IN(14)) {
        pg8::Gemm g{P, (const bf16*)(ws + WS_WOT), M, 2048, D, D}; pg8::StaticOrder S; S.init(M, 2048, G, bx);
        pg8::EpiF32 E{args.out, 2048};
        pg8::gemm_phase<pg8::EpiF32, pg8::StaticOrder, PG8_ALIGN, PG8_SP2>(lds, g, S, E, wave);
        GRID_BAR();
    }
    if (IN(15)) { p12_final(args, gw, NGW, lane); }
#undef IN
#undef lane
}

extern "C" void kernel_launch(void* const* d_in, const int* in_sizes, int n_in, void* d_out, int out_size, void* d_ws, size_t ws_size, hipStream_t stream) {
    static int grid = 0;
    if (grid == 0) {
        if (n_in != 27 || out_size != 2 * 32768 * D || ws_size < WS_END) { fprintf(stderr, "kernel_launch: unexpected shapes (n_in %d out %d ws %zu)\n", n_in, out_size, ws_size); grid = -1; return; }
        int dev = 0, cus = 0, per_cu = 0;
        if (hipGetDevice(&dev) != hipSuccess || hipDeviceGetAttribute(&cus, hipDeviceAttributeMultiprocessorCount, dev) != hipSuccess) { grid = -1; return; }
        if (hipFuncSetAttribute((const void*)mk_fwd, hipFuncAttributeMaxDynamicSharedMemorySize, LDS_BYTES) != hipSuccess) { fprintf(stderr, "kernel_launch: hipFuncSetAttribute failed\n"); grid = -1; return; }
        if (hipOccupancyMaxActiveBlocksPerMultiprocessor(&per_cu, (const void*)mk_fwd, NWAVES * 64, LDS_BYTES) != hipSuccess || per_cu < 1)
            fprintf(stderr, "kernel_launch: note: occupancy query reports %d workgroups per CU\n", per_cu);
        (void)hipGetLastError();
        grid = cus;
    }
    if (grid < 0) return;
    if (hipMemsetAsync((char*)d_ws + WS_CTL, 0, CTL_ZERO_BYTES, stream) != hipSuccess) return;
    Args a{};
    for (int i = 0; i < 27; ++i) a.in[i] = (const float*)d_in[i];
    a.out = (float*)d_out; a.ws = (unsigned char*)d_ws; a.pad = 0;
    { const int li = 0; a.ph_lo = 0; a.ph_hi = N_PHASES; a.li = 0;
        hipLaunchKernelGGL(mk_fwd, dim3(grid), dim3(NWAVES * 64), LDS_BYTES, stream, a);
        const hipError_t le = hipPeekAtLastError();
        if (le != hipSuccess) { fprintf(stderr, "kernel_launch: launch %d failed: %s\n", li, hipGetErrorName(le)); }
    }
}
```

```cpp
#include <hip/hip_runtime.h>
#include <cstdio>
#include <cstdint>
#define MK_N_LAUNCHES 1
__device__ __forceinline__ int mk_lane() { int l; asm volatile("v_mbcnt_lo_u32_b32 %0, -1, 0\n\tv_mbcnt_hi_u32_b32 %0, -1, %0" : "=v"(l)); return l; }
namespace pg8 {
#define PG8_LAS __attribute__((address_space(3)))
typedef unsigned short bf16_t;
typedef short bf16x8 __attribute__((ext_vector_type(8)));
typedef float f32x4 __attribute__((ext_vector_type(4)));
typedef unsigned u32x4 __attribute__((ext_vector_type(4)));
constexpr int BM = 256, BK = 64, HALF = 128, HTB = HALF * BK * 2  , STAGE_BYTES = 8 * HTB, NXCD = 8, WGM = 8;

__host__ __device__ __forceinline__ int lds_byte(int r, int c) { const int st = (r >> 4) * 2 + (c >> 5), rr = r & 15, cc = c & 31, ob = rr * 64 + cc * 2; return st * 1024 + (ob ^ (((ob >> 9) & 1) << 5)); }
__host__ __device__ __forceinline__ void stage_rc(int b, int& R, int& C) { const int st = b / 1024, sb = b % 1024, swz = sb ^ (((sb >> 9) & 1) << 5); R = (st >> 1) * 16 + swz / 64; C = (st & 1) * 32 + (swz % 64) / 2; }
__host__ __device__ __forceinline__ int perm32(int rho) { const int n = rho >> 4, i = rho & 15; return 8 * (i >> 2) + 4 * n + (i & 3); }

struct Unit { int pm, pn; };
struct Gemm { const bf16_t* A; const bf16_t* Bt; int M, N, K, lda; };

struct StaticOrder {
    int nM, nN, nwg, G, c;
    __host__ __device__ void init(int M, int N, int G_, int c_) { nM = M / BM; nN = N / BM; nwg = nM * nN; G = G_; c = c_; }
    __host__ __device__ bool next(int i, Unit& u) const {
        const long L = (long)i * G + c; if (L >= nwg) return false;
        int wgid = (int)L; { const int q = nwg / NXCD, r = nwg % NXCD, xcd = wgid % NXCD, off = wgid / NXCD; wgid = (xcd < r ? xcd * (q + 1) : r * (q + 1) + (xcd - r) * q) + off; }
        const int nig = WGM * nN, gid = wgid / nig, fm = gid * WGM, gsz = (nM - fm) < WGM ? (nM - fm) : WGM;
        u.pm = fm + ((wgid % nig) % gsz); u.pn = (wgid % nig) / gsz; return true;
    }
    __device__ __forceinline__ void a_ready(const Unit&) const {}
    __device__ __forceinline__ void done(const Unit&) const {}
};

__device__ __forceinline__ unsigned cvt_pk_bf16(float lo, float hi) { unsigned r; asm volatile("v_cvt_pk_bf16_f32 %0, %1, %2" : "=v"(r) : "v"(lo), "v"(hi)); return r; }

__device__ __forceinline__ float bf_lo(unsigned u) { return __uint_as_float(u << 16); }
__device__ __forceinline__ float bf_hi(unsigned u) { return __uint_as_float(u & 0xffff0000u); }
__device__ __forceinline__ float sigmoid_f(float v) { return __builtin_amdgcn_rcpf(1.0f + __expf(-v)); }

struct EpiG1 {
    static constexpr bool PERM = true, AFTER_DRAIN = false;
    bf16_t* a2; bf16_t* rwin;
    __device__ __forceinline__ void operator()(const f32x4 (&acc)[2][2][4][2], const Unit& u, int wr, int wc, int fr, int fq) const {
        const int row0 = u.pm * BM + wr * 64 + fr; const int colt = u.pn * BM; const bool s5 = colt < 1024;
        const int col0 = colt + wc * 32 + 8 * fq;
#pragma unroll
        for (int ai = 0; ai < 2; ++ai)
#pragma unroll
            for (int m = 0; m < 4; ++m) { const int row = row0 + ai * HALF + m * 16;
#pragma unroll
                for (int bj = 0; bj < 2; ++bj) { const f32x4 v0 = acc[ai][bj][m][0], v1 = acc[ai][bj][m][1]; const int col = col0 + bj * HALF;
                    u32x4 w; w.x = cvt_pk_bf16(v0[0], v0[1]); w.y = cvt_pk_bf16(v0[2], v0[3]); w.z = cvt_pk_bf16(v1[0], v1[1]); w.w = cvt_pk_bf16(v1[2], v1[3]);
                    bf16_t* dst = s5 ? a2 + ((size_t)((col >> 4) * 2048 + (row >> 5)) * 768 + (row & 31) * 16 + (col & 15))
                                     : rwin + (size_t)row * 3328 + (col - 1024);
                    *(u32x4*)dst = w; } }
    }
};
template <int MODE> struct EpiMix {
    static constexpr bool PERM = true, AFTER_DRAIN = false;
    bf16_t* O; const bf16_t* S; const bf16_t* Add; int ld;
    __device__ __forceinline__ void operator()(const f32x4 (&acc)[2][2][4][2], const Unit& u, int wr, int wc, int fr, int fq) const {
        const int row0 = u.pm * BM + wr * 64 + fr, col0 = u.pn * BM + wc * 32 + 8 * fq;
#pragma unroll
        for (int ai = 0; ai < 2; ++ai)
#pragma unroll
            for (int m = 0; m < 4; ++m) {
#pragma unroll
                for (int bj = 0; bj < 2; ++bj) {
                    const size_t off = (size_t)(row0 + ai * HALF + m * 16) * ld + col0 + bj * HALF;
                    float v[8];
#pragma unroll
                    for (int j = 0; j < 4; ++j) { v[j] = acc[ai][bj][m][0][j]; v[4 + j] = acc[ai][bj][m][1][j]; }
                    if (MODE >= 1) {
                        const u32x4 s = *(const u32x4*)(S + off);
                        const float sv[8] = {bf_lo(s.x), bf_hi(s.x), bf_lo(s.y), bf_hi(s.y), bf_lo(s.z), bf_hi(s.z), bf_lo(s.w), bf_hi(s.w)};
#pragma unroll
                        for (int j = 0; j < 8; ++j) { const float sg = sigmoid_f(v[j]); v[j] = (MODE == 2) ? sv[j] * v[j] * sg : sv[j] * sg; }
                    }
                    if (MODE == 3) {
                        const u32x4 a = *(const u32x4*)(Add + off);
                        const float av[8] = {bf_lo(a.x), bf_hi(a.x), bf_lo(a.y), bf_hi(a.y), bf_lo(a.z), bf_hi(a.z), bf_lo(a.w), bf_hi(a.w)};
#pragma unroll
                        for (int j = 0; j < 8; ++j) v[j] += av[j];
                    }
                    u32x4 w; w.x = cvt_pk_bf16(v[0], v[1]); w.y = cvt_pk_bf16(v[2], v[3]); w.z = cvt_pk_bf16(v[4], v[5]); w.w = cvt_pk_bf16(v[6], v[7]);
                    *(u32x4*)(O + off) = w;
                }
            }
    }
};
struct EpiF32 {
    static constexpr bool PERM = false, AFTER_DRAIN = false;
    float* C; int ldc;
    __device__ __forceinline__ void operator()(const f32x4 (&acc)[2][2][4][2], const Unit& u, int wr, int wc, int fr, int fq) const {
        const int row0 = u.pm * BM + wr * 64 + fr, col0 = u.pn * BM + wc * 32 + 4 * fq;
#pragma unroll
        for (int ai = 0; ai < 2; ++ai)
#pragma unroll
            for (int m = 0; m < 4; ++m) { float* rowp = C + (size_t)(row0 + ai * HALF + m * 16) * ldc + col0;
#pragma unroll
                for (int bj = 0; bj < 2; ++bj)
#pragma unroll
                    for (int n = 0; n < 2; ++n) *(f32x4*)(rowp + bj * HALF + n * 16) = acc[ai][bj][m][n]; }
    }
};
template <class Epi, class Sched, bool ALIGN_EPI = false, bool SP2 = false>
__device__ __forceinline__ void gemm_phase(PG8_LAS unsigned char* lds, const Gemm g, const Sched& S, const Epi& E, const int mk_wave) {
    const int lane = mk_lane(), wid = mk_wave, tid = wid * 64 + lane, wr = wid >> 2, wc = wid & 3, fr = lane & 15, fq = lane >> 4;
    const int K = g.K, nt = K / BK;
    unsigned voffA[2], voffB[2];
#pragma unroll
    for (int i = 0; i < 2; ++i) { int R, C; stage_rc(tid * 16 + i * 8192, R, C); const int Rb = Epi::PERM ? ((R & ~31) + perm32(R & 31)) : R;
        voffA[i] = (unsigned)(R * g.lda + C) * 2u; voffB[i] = (unsigned)(Rb * K + C) * 2u; }
    const size_t kstep = (size_t)(BK * 2);
    const size_t hstep = (size_t)HALF * K * 2;
    const size_t tstep = 2 * hstep;
    const size_t hstepA = (size_t)HALF * g.lda * 2, tstepA = 2 * hstepA;
    const unsigned ldsw = (unsigned)wid * 1024u;
    const int aoff = lds_byte(wr * 64 + fr, fq * 8), boff = lds_byte(wc * 32 + fr, fq * 8);
#define PG8_SA(b, h) (((b) * 2 + (h)) * HTB)
#define PG8_SB(b, h) ((4 + (b) * 2 + (h)) * HTB)
#define PG8_STAGE(bufoff, gbase, voff) do { _Pragma("unroll") for (int _i = 0; _i < 2; ++_i) \
        __builtin_amdgcn_global_load_lds((const unsigned*)((const char*)(gbase) + (voff)[_i]), (PG8_LAS unsigned*)(lds + (bufoff) + ldsw + _i * 8192), 16, 0, 0); } while (0)
#define PG8_LDA(dst, b, h) do { _Pragma("unroll") for (int m = 0; m < 4; ++m) _Pragma("unroll") for (int k = 0; k < 2; ++k) dst[m][k] = *(const PG8_LAS bf16x8*)(lds + PG8_SA(b, h) + aoff + m * 2048 + k * 1024); } while (0)
#define PG8_LDB(dst, b, h) do { _Pragma("unroll") for (int n = 0; n < 2; ++n) _Pragma("unroll") for (int k = 0; k < 2; ++k) dst[n][k] = *(const PG8_LAS bf16x8*)(lds + PG8_SB(b, h) + boff + n * 2048 + k * 1024); } while (0)
#define PG8_MMA(ai, bj, At, Bt) do { __builtin_amdgcn_s_setprio(1); _Pragma("unroll") for (int m = 0; m < 4; ++m) _Pragma("unroll") for (int n = 0; n < 2; ++n) _Pragma("unroll") for (int k = 0; k < 2; ++k) \
        acc[ai][bj][m][n] = __builtin_amdgcn_mfma_f32_16x16x32_bf16(Bt[n][k], At[m][k], acc[ai][bj][m][n], 0, 0, 0); __builtin_amdgcn_s_setprio(0); } while (0)
#define PG8_WAIT_V(n) asm volatile("s_waitcnt vmcnt(" #n ")" ::: "memory")
#define PG8_WAIT_L(n) asm volatile("s_waitcnt lgkmcnt(" #n ")" ::: "memory")
#define PG8_BAR __builtin_amdgcn_s_barrier()
#define PG8_SCHED __builtin_amdgcn_sched_barrier(0)
    Unit cur, nxt; int ui = 0;
    if (!S.next(0, cur)) return;
    f32x4 acc[2][2][4][2];
#pragma unroll
    for (int a = 0; a < 2; ++a)
#pragma unroll
        for (int b = 0; b < 2; ++b)
#pragma unroll
            for (int m = 0; m < 4; ++m)
#pragma unroll
                for (int n = 0; n < 2; ++n) acc[a][b][m][n] = (f32x4){0.f, 0.f, 0.f, 0.f};
    bf16x8 At[4][2], B0[2][2], B1[2][2];
    const char* cA = (const char*)g.A + (size_t)cur.pm * tstepA; const char* cB = (const char*)g.Bt + (size_t)cur.pn * tstep;
    S.a_ready(cur);
    if constexpr (SP2) {
        PG8_STAGE(PG8_SB(0, 0), cB, voffB); PG8_STAGE(PG8_SB(0, 1), cB + hstep, voffB); PG8_STAGE(PG8_SA(0, 0), cA, voffA); PG8_STAGE(PG8_SA(0, 1), cA + hstepA, voffA);
        if (wr == 1) PG8_BAR;
        PG8_WAIT_V(2); PG8_BAR;
        PG8_STAGE(PG8_SB(1, 0), cB + kstep, voffB); PG8_STAGE(PG8_SA(1, 0), cA + kstep, voffA); PG8_STAGE(PG8_SB(1, 1), cB + hstep + kstep, voffB);
        PG8_WAIT_V(6); PG8_BAR;
    } else {
        PG8_STAGE(PG8_SB(0, 0), cB, voffB); PG8_STAGE(PG8_SA(0, 0), cA, voffA); PG8_STAGE(PG8_SB(0, 1), cB + hstep, voffB); PG8_STAGE(PG8_SA(0, 1), cA + hstepA, voffA);
        if (wr == 1) PG8_BAR;
        PG8_WAIT_V(4); PG8_BAR;
        PG8_STAGE(PG8_SB(1, 0), cB + kstep, voffB); PG8_STAGE(PG8_SA(1, 0), cA + kstep, voffA); PG8_STAGE(PG8_SB(1, 1), cB + hstep + kstep, voffB);
        PG8_WAIT_V(6); PG8_BAR;
    }
    for (;;) {
        const bool has_next = S.next(ui + 1, nxt);
        const char* nA = has_next ? (const char*)g.A + (size_t)nxt.pm * tstepA : cA; const char* nB = has_next ? (const char*)g.Bt + (size_t)nxt.pn * tstep : cB;
        for (int t = 0; t < nt; t += 2) {
            const bool last = (t == nt - 2);
            const char* a1 = cA + (size_t)(t + 1) * kstep;
            const char* a2 = last ? nA : cA + (size_t)(t + 2) * kstep; const char* b2 = last ? nB : cB + (size_t)(t + 2) * kstep;
            const char* a3 = a2 + kstep; const char* b3 = b2 + kstep;
            if (last && has_next) S.a_ready(nxt);
            if constexpr (SP2) {
            PG8_LDB(B0, 0, 0); PG8_LDB(B1, 0, 1); PG8_SCHED; PG8_LDA(At, 0, 0); PG8_STAGE(PG8_SA(1, 1), a1 + hstepA, voffA);
            PG8_WAIT_V(8); PG8_WAIT_L(0); PG8_BAR; PG8_MMA(0, 0, At, B0); PG8_MMA(0, 1, At, B1); PG8_BAR; PG8_SCHED;
            PG8_LDA(At, 0, 1); PG8_STAGE(PG8_SB(0, 0), b2, voffB); PG8_STAGE(PG8_SB(0, 1), b2 + hstep, voffB); PG8_STAGE(PG8_SA(0, 0), a2, voffA);
            PG8_WAIT_V(8); PG8_WAIT_L(0); PG8_BAR; PG8_MMA(1, 0, At, B0); PG8_MMA(1, 1, At, B1); PG8_BAR; PG8_SCHED;
            PG8_LDB(B0, 1, 0); PG8_LDB(B1, 1, 1); PG8_SCHED; PG8_LDA(At, 1, 0); PG8_STAGE(PG8_SA(0, 1), a2 + hstepA, voffA);
            PG8_WAIT_V(8); PG8_WAIT_L(0); PG8_BAR; PG8_MMA(0, 0, At, B0); PG8_MMA(0, 1, At, B1); PG8_BAR; PG8_SCHED;
            PG8_LDA(At, 1, 1); PG8_STAGE(PG8_SB(1, 0), b3, voffB); PG8_STAGE(PG8_SB(1, 1), b3 + hstep, voffB); PG8_STAGE(PG8_SA(1, 0), a3, voffA);
            PG8_WAIT_V(8); PG8_WAIT_L(0); PG8_BAR; PG8_MMA(1, 0, At, B0); PG8_MMA(1, 1, At, B1); PG8_BAR; PG8_SCHED;
            } else {
            PG8_LDB(B0, 0, 0); PG8_SCHED; PG8_LDA(At, 0, 0); PG8_STAGE(PG8_SA(1, 1), a1 + hstepA, voffA);
            PG8_WAIT_L(8); PG8_BAR; PG8_WAIT_L(0); PG8_MMA(0, 0, At, B0); PG8_BAR; PG8_SCHED;
            PG8_LDB(B1, 0, 1); PG8_STAGE(PG8_SB(0, 0), b2, voffB);
            PG8_BAR; PG8_WAIT_L(0); PG8_MMA(0, 1, At, B1); PG8_BAR;
            PG8_LDA(At, 0, 1); PG8_STAGE(PG8_SA(0, 0), a2, voffA);
            PG8_BAR; PG8_WAIT_L(0); PG8_MMA(1, 0, At, B0); PG8_BAR; PG8_SCHED;
            PG8_STAGE(PG8_SB(0, 1), b2 + hstep, voffB);
            PG8_WAIT_V(6); PG8_BAR; PG8_MMA(1, 1, At, B1); PG8_BAR;
            PG8_LDB(B0, 1, 0); PG8_SCHED; PG8_LDA(At, 1, 0); PG8_STAGE(PG8_SA(0, 1), a2 + hstepA, voffA);
            PG8_WAIT_L(8); PG8_BAR; PG8_WAIT_L(0); PG8_MMA(0, 0, At, B0); PG8_BAR; PG8_SCHED;
            PG8_LDB(B1, 1, 1); PG8_STAGE(PG8_SB(1, 0), b3, voffB);
            PG8_BAR; PG8_WAIT_L(0); PG8_MMA(0, 1, At, B1); PG8_BAR;
            PG8_LDA(At, 1, 1); PG8_STAGE(PG8_SA(1, 0), a3, voffA);
            PG8_BAR; PG8_WAIT_L(0); PG8_MMA(1, 0, At, B0); PG8_BAR; PG8_SCHED;
            PG8_STAGE(PG8_SB(1, 1), b3 + hstep, voffB);
            PG8_WAIT_V(6); PG8_BAR; PG8_MMA(1, 1, At, B1); PG8_BAR;
            }
        }
        if constexpr (ALIGN_EPI) { if (wr == 0) PG8_BAR; }
        if constexpr (!Epi::AFTER_DRAIN) { E(acc, cur, wr, wc, fr, fq); S.done(cur); }
        if (!has_next) break;
#pragma unroll
        for (int a = 0; a < 2; ++a)
#pragma unroll
            for (int b = 0; b < 2; ++b)
#pragma unroll
                for (int m = 0; m < 4; ++m)
#pragma unroll
                    for (int n = 0; n < 2; ++n) acc[a][b][m][n] = (f32x4){0.f, 0.f, 0.f, 0.f};
        cur = nxt; cA = nA; cB = nB; ++ui;
        if constexpr (ALIGN_EPI) { if (wr == 1) PG8_BAR; }
    }
    PG8_WAIT_V(0);
    if constexpr (!ALIGN_EPI) { if (wr == 0) PG8_BAR; }
    PG8_BAR;
    if constexpr (Epi::AFTER_DRAIN) { E.fused(acc, cur, wr, wc, fr, fq, lds, wid, lane); S.done(cur); }
#undef PG8_SA
#undef PG8_SB
#undef PG8_STAGE
#undef PG8_LDA
#undef PG8_LDB
#undef PG8_MMA
#undef PG8_WAIT_V
#undef PG8_WAIT_L
#undef PG8_BAR
#undef PG8_SCHED
}
}

#ifndef PG8_SP2
#define PG8_SP2 true
#endif
#ifndef PG8_ALIGN
#define PG8_ALIGN true
#endif

constexpr int NWAVES = 8;
constexpr int N_PHASES = 16;
#ifndef MK_N_LAUNCHES
#define MK_N_LAUNCHES 1
#endif
constexpr int N_LAUNCHES = MK_N_LAUNCHES;

constexpr int D = 2048, M = 65536, NIN = 10496;
constexpr int LP = 16384, LS = 2048;
constexpr int DS5 = 1024, DRW = 1024, DRWIN = 3328;
constexpr float RMS_EPS = 1e-6f, GN_EPS = 64e-5f, L2_EPS = 1e-12f;

constexpr size_t MiB = 1u << 20;
constexpr size_t WS_CTL = 0, CTL_ZERO_BYTES = 1 * MiB;
constexpr size_t WS_WT = 1 * MiB;
constexpr size_t WS_GLUT = 42 * MiB;
constexpr size_t WS_S5OT = 44 * MiB;
constexpr size_t WS_RWOT = 48 * MiB;
constexpr size_t WS_WOT = 52 * MiB;
constexpr size_t WS_HN = 60 * MiB;
constexpr size_t WS_RWIN = 316 * MiB;
constexpr size_t WS_Z = 732 * MiB;
constexpr size_t WS_LUT = 860 * MiB;
constexpr size_t WS_STATE = 862 * MiB;
constexpr size_t WS_S5TAB = 872 * MiB;
constexpr size_t WS_S5XL = 882 * MiB;
constexpr size_t WS_S5W2 = 946 * MiB;
constexpr size_t WS_S5E = 994 * MiB;
constexpr size_t WS_ZG = 882 * MiB;
constexpr size_t WS_END = 1010 * MiB;
constexpr size_t DO_YF = 0, DO_YB = 128 * MiB, DO_A2 = 256 * MiB, DO_INT = 256 * MiB, DO_Q = 256 * MiB;
constexpr int CW_BAR = 4096;

constexpr int LDS_BYTES = 147456;
constexpr int MISC_OFF = LDS_BYTES - 512;
constexpr int WAVE_SCR = 18176;
static_assert(NWAVES * WAVE_SCR <= MISC_OFF && pg8::STAGE_BYTES <= MISC_OFF, "LDS map");

#define GAS __attribute__((address_space(1)))
#define LAS __attribute__((address_space(3)))
typedef unsigned short bf16;
typedef unsigned v4u __attribute__((ext_vector_type(4)));
typedef unsigned v2u __attribute__((ext_vector_type(2)));
typedef float f32x4 __attribute__((ext_vector_type(4)));
#define LDS_WAIT() asm volatile("s_waitcnt lgkmcnt(0)" ::: "memory")
#define VM_WAIT() asm volatile("s_waitcnt vmcnt(0)" ::: "memory")
__device__ __forceinline__ unsigned f2bf(float f) { unsigned u = __builtin_bit_cast(unsigned, f); return (u + 0x7fffu + ((u >> 16) & 1u)) >> 16; }
__device__ __forceinline__ unsigned pk2(float lo, float hi) { return f2bf(lo) | (f2bf(hi) << 16); }
__device__ __forceinline__ float bf2f(bf16 b) { return __uint_as_float(((unsigned)b) << 16); }
__device__ __forceinline__ float blo(unsigned u) { return __uint_as_float(u << 16); }
__device__ __forceinline__ float bhi(unsigned u) { return __uint_as_float(u & 0xffff0000u); }
__device__ __forceinline__ float wave_sum(float v) {
#pragma unroll
    for (int o = 1; o < 64; o <<= 1) v += __shfl_xor(v, o);
    return v;
}
__device__ __forceinline__ float sigm(float v) { return 1.0f / (1.0f + __expf(-v)); }
__device__ __forceinline__ float gelu_tanh(float x) { const float u = 0.7978845608028654f * (x + 0.044715f * x * x * x); return 0.5f * x * (1.0f + tanhf(u)); }

#define XB_TMO      128
#define XB_XCNT(j)  (256  + 64 * (j))
#define XB_XSUB(j)  (1280 + 64 * (j))
#define XB_XGEN(j)  (2304 + 64 * (j))
#define XB_TOP      3328
#define XB_TOPGEN   3392
#define XCD_BAR_WORDS 3456
#define XB_SPIN_CAP (1u << 18)

__device__ __forceinline__ unsigned xb_ld(unsigned* p)              { return __hip_atomic_load(p, __ATOMIC_RELAXED, __HIP_MEMORY_SCOPE_AGENT); }
__device__ __forceinline__ unsigned xb_add(unsigned* p, unsigned v) { return __hip_atomic_fetch_add(p, v, __ATOMIC_RELAXED, __HIP_MEMORY_SCOPE_AGENT); }
__device__ __forceinline__ unsigned xb_xcc_id() { return (unsigned)__builtin_amdgcn_s_getreg((3 << 11) | 20) & 0xFu; }
#define XB_SPIN(cond, bar) do { unsigned _sp = 0; while (cond) { __builtin_amdgcn_s_sleep(1); \
    if ((++_sp & 255u) == 0u) { if (xb_ld(&(bar)[XB_TMO])) break; if (_sp > XB_SPIN_CAP) { atomicAdd(&(bar)[XB_TMO], 1u); break; } } } } while (0)

struct XcdBarrier {
    unsigned* bar; unsigned x;
    volatile LAS unsigned* st;
};

__device__ __forceinline__ XcdBarrier xcd_barrier_post(unsigned* bar, volatile LAS unsigned* st, const int mk_wave) {
    XcdBarrier b; b.bar = bar; b.x = xb_xcc_id(); b.st = st;
    if (mk_wave == 0 && mk_lane() == 0) (void)xb_add(&bar[XB_XCNT(b.x)], 1u);
    return b;
}
__device__ __forceinline__ void xcd_barrier_complete(unsigned* bar, unsigned x, unsigned& nloc, unsigned& nx) {
    const unsigned G = gridDim.x * gridDim.y * gridDim.z;
    unsigned sum, cnt, mine, sp = 0u;
    for (;;) {
        sum = 0u; cnt = 0u; mine = 0u;
#pragma unroll
        for (unsigned j = 0; j < 16; ++j) { const unsigned c = xb_ld(&bar[XB_XCNT(j)]); sum += c; cnt += (c > 0u) ? 1u : 0u; mine = (j == x) ? c : mine; }
        if (sum == G) break;
        __builtin_amdgcn_s_sleep(1);
        if ((++sp & 255u) == 0u) { if (xb_ld(&bar[XB_TMO])) break; if (sp > XB_SPIN_CAP) { atomicAdd(&bar[XB_TMO], 1u); break; } }
    }
    nloc = mine > 0u ? mine : 1u; nx = cnt > 0u ? cnt : 1u;
}

__device__ __forceinline__ void xcd_barrier(const XcdBarrier& b, const int mk_wave) {
    asm volatile("s_waitcnt vmcnt(0)" ::: "memory");
    __syncthreads();
    if (mk_wave == 0 && mk_lane() == 0) {
        unsigned* bar = b.bar;
        __builtin_amdgcn_s_waitcnt(0);
        unsigned nloc = b.st[0], nx = b.st[1];
        if (nloc == 0u) { xcd_barrier_complete(bar, b.x, nloc, nx); b.st[0] = nloc; b.st[1] = nx; }
        const unsigned old = xb_add(&bar[XB_XSUB(b.x)], 1u);
        const unsigned gen = old / nloc;
        if (old + 1u == (gen + 1u) * nloc) {
            __builtin_amdgcn_fence(__ATOMIC_RELEASE, "agent");
            asm volatile("s_waitcnt vmcnt(0)" ::: "memory");
            const unsigned og = xb_add(&bar[XB_TOP], 1u);
            const unsigned tg = og / nx;
            if (og + 1u == (tg + 1u) * nx) xb_add(&bar[XB_TOPGEN], 1u);
            else XB_SPIN(xb_ld(&bar[XB_TOPGEN]) == tg, bar);
            __builtin_amdgcn_fence(__ATOMIC_ACQUIRE, "agent");
            xb_add(&bar[XB_XGEN(b.x)], 1u);
            asm volatile("s_waitcnt vmcnt(0)" ::: "memory");
        } else {
            XB_SPIN(xb_ld(&bar[XB_XGEN(b.x)]) == gen, bar);
            __builtin_amdgcn_fence(__ATOMIC_ACQUIRE, "agent");
            asm volatile("s_waitcnt vmcnt(0)" ::: "memory");
        }
    }
    __syncthreads();
}


struct Args { const float* in[27]; float* out; unsigned char* ws; int ph_lo, ph_hi, li, pad; };

namespace rwk {
typedef short s16x4 __attribute__((ext_vector_type(4)));
typedef short s16x8 __attribute__((ext_vector_type(8)));
constexpr int NSEG = 8;
constexpr int UNITS_PER_SEG = 4096;
constexpr int LDW = 72;
constexpr int MATB = 64 * LDW * 2;
constexpr int O_AB = 0, O_BT = 1 * MATB, O_KT = 2 * MATB, O_RB = 3 * MATB, O_BHT = 4 * MATB, O_KHT = 5 * MATB, O_VT = 6 * MATB;
constexpr int O_MAB = 7 * MATB, O_MAK = 8 * MATB, O_NRB = 9 * MATB, O_NRK = 10 * MATB, O_XT = 11 * MATB  , O_NP = 13 * MATB, O_GT = 14 * MATB;
constexpr int O_TW = O_XT, O_XA = O_XT + MATB;
constexpr int LDC = 68;
constexpr int O_CL = O_MAB, O_AS = O_MAB + 64 * LDC * 4;
constexpr int NPS = 24;
static_assert(O_AS + 64 * LDC * 4 <= O_XT && O_GT + 256 <= 146944, "rwkv LDS map");
constexpr size_t UNIT_ELEMS = 16384;

__device__ __forceinline__ f32x4 mfma32(s16x8 a, s16x8 b, f32x4 c) { return __builtin_amdgcn_mfma_f32_16x16x32_bf16(a, b, c, 0, 0, 0); }
__device__ __forceinline__ f32x4 mfma16(s16x4 a, s16x4 b, f32x4 c) { return __builtin_amdgcn_mfma_f32_16x16x16bf16_1k(a, b, c, 0, 0, 0); }
__device__ __forceinline__ s16x4 pack4(f32x4 v) { v2u p; p.x = pk2(v[0], v[1]); p.y = pk2(v[2], v[3]); return __builtin_bit_cast(s16x4, p); }
__device__ __forceinline__ f32x4 unpack4(v2u p) { return (f32x4){blo(p.x), bhi(p.x), blo(p.y), bhi(p.y)}; }
__device__ __forceinline__ void up8(v4u a, float (&o)[8]) { o[0] = blo(a.x); o[1] = bhi(a.x); o[2] = blo(a.y); o[3] = bhi(a.y); o[4] = blo(a.z); o[5] = bhi(a.z); o[6] = blo(a.w); o[7] = bhi(a.w); }
__device__ __forceinline__ v4u pk8(const float (&v)[8]) { v4u a; a.x = pk2(v[0], v[1]); a.y = pk2(v[2], v[3]); a.z = pk2(v[4], v[5]); a.w = pk2(v[6], v[7]); return a; }

constexpr int O_MU = 131072;
static_assert(O_MU + 3328 * 4 <= 146944, "rwkv LDS map (mu)");
__device__ __forceinline__ int swz_chunk(int row, int tc) { return (row * LDW + ((tc ^ ((row >> 3) & 7)) << 3)) * 2; }
__device__ __forceinline__ float tanh_fast(float x) { return 1.0f - 2.0f * __builtin_amdgcn_rcpf(1.0f + __expf(2.0f * x)); }
struct RawUnit { v4u cur[5], prv[5], nxt[5]; f32x4 kk0, kk1, ka0, ka1; s16x8 lb0, lb1; float bias; };
struct UnitId { int h, d, base, L, gchunk, chain; };
__device__ __forceinline__ UnitId decode_unit(int seg, int u) {
    UnitId o; int c, jc, nch;
    if (u < 2048) { c = u >> 5; jc = u & 31; nch = 32; } else { c = 64 + ((u - 2048) >> 2); jc = (u - 2048) & 3; nch = 4; }
    int s, rem; if (c < 64) { s = c >> 5; rem = c & 31; } else { s = 2 + ((c - 64) >> 5); rem = (c - 64) & 31; }
    o.h = rem >> 1; o.d = rem & 1; o.base = s < 2 ? s * LP : 32768 + (s - 2) * LS; o.L = s < 2 ? LP : LS; o.gchunk = seg * nch + jc; o.chain = c;
    return o;
}
__device__ __forceinline__ int unit_of(int chain, int jc) { return chain < 64 ? chain * 32 + jc : 2048 + (chain - 64) * 4 + jc; }

__device__ __forceinline__ void rw_load_unit(const Args& a, unsigned char* ws, int seg, int u, int wave, int lane, RawUnit& R) {
    const UnitId id = decode_unit(seg, u);
    const int h = id.h, d = id.d, tid = wave * 64 + lane, t = tid >> 3, cg = tid & 7, c8 = h * 64 + 8 * cg;
    const int lp = 64 * id.gchunk + t, pos = d ? id.L - 1 - lp : lp;
    const bf16* prow = (const bf16*)(ws + WS_RWIN) + (size_t)(id.base + pos) * DRWIN;
    const bool hp = pos > 0, hn = pos < id.L - 1;
    const v4u z4 = (v4u){0u, 0u, 0u, 0u};
#pragma unroll
    for (int comp = 0; comp < 5; ++comp) {
        const int col = comp < 3 ? comp * 1024 + c8 : (comp == 3 ? 3072 + d * 64 + 8 * cg : 3200 + d * 64 + 8 * cg);
        R.cur[comp] = *(const v4u*)(prow + col);
        R.prv[comp] = hp ? *(const v4u*)(prow - DRWIN + col) : z4;
        R.nxt[comp] = hn ? *(const v4u*)(prow + DRWIN + col) : z4;
    }
    R.kk0 = *(const f32x4*)(a.in[20] + c8); R.kk1 = *(const f32x4*)(a.in[20] + c8 + 4);
    R.ka0 = *(const f32x4*)(a.in[21] + c8); R.ka1 = *(const f32x4*)(a.in[21] + c8 + 4);
    const int r = lane & 15, g = lane >> 4, ct = wave & 3, role = wave >> 2;
    const bf16* lut = (const bf16*)(ws + WS_LUT) + ((size_t)((role * 2 + d) * 16 + h) * 64 + 16 * ct + r) * 64 + 8 * g;
    R.lb0 = *(const s16x8*)(lut); R.lb1 = *(const s16x8*)(lut + 32);
    R.bias = (role ? a.in[18] : a.in[16])[d * 1024 + h * 64 + 16 * ct + r];
}
__device__ __forceinline__ void rw_precompute_unit(const Args& a, unsigned char* ws, LAS unsigned char* lds, int seg, int u, int wave, int lane, const RawUnit& R) {
    const UnitId id = decode_unit(seg, u);
    const int h = id.h, d = id.d;
    const int tid = wave * 64 + lane;
    const int r = lane & 15, g = lane >> 4;
    const int t = tid >> 3, cg = tid & 7, c8 = h * 64 + 8 * cg;
    float zr[8], zk[8], kk[8], zv[8];
    {
        const LAS float* mu = (const LAS float*)(lds + O_MU);
        float zw[8], za[8];
#pragma unroll
        for (int comp = 0; comp < 5; ++comp) {
            const int col = comp < 3 ? comp * 1024 + c8 : (comp == 3 ? 3072 + d * 64 + 8 * cg : 3200 + d * 64 + 8 * cg);
            float cc[8], pp[8], nn[8];
            up8(R.cur[comp], cc); up8(R.prv[comp], pp); up8(R.nxt[comp], nn);
            const f32x4 m0 = *(const LAS f32x4*)(mu + col), m1 = *(const LAS f32x4*)(mu + col + 4);
            const float mv[8] = {m0[0], m0[1], m0[2], m0[3], m1[0], m1[1], m1[2], m1[3]};
#pragma unroll
            for (int j = 0; j < 8; ++j) {
                const float zz = cc[j] + (0.5f * (pp[j] + nn[j]) - cc[j]) * mv[j];
                if (comp == 0) zr[j] = zz; else if (comp == 1) zk[j] = zz; else if (comp == 2) zv[j] = zz; else if (comp == 3) zw[j] = tanh_fast(zz); else za[j] = zz;
            }
        }
        float ss = 0.f;
        const float kkw[8] = {R.kk0[0], R.kk0[1], R.kk0[2], R.kk0[3], R.kk1[0], R.kk1[1], R.kk1[2], R.kk1[3]};
#pragma unroll
        for (int j = 0; j < 8; ++j) { kk[j] = zk[j] * kkw[j]; ss += kk[j] * kk[j]; }
        ss += __shfl_xor(ss, 1); ss += __shfl_xor(ss, 2); ss += __shfl_xor(ss, 4);
        const float inv = 1.0f / sqrtf(ss + L2_EPS);
#pragma unroll
        for (int j = 0; j < 8; ++j) kk[j] *= inv;
        *(LAS v4u*)(lds + O_TW + (t * LDW + 8 * cg) * 2) = pk8(zw);
        *(LAS v4u*)(lds + O_XA + (t * LDW + 8 * cg) * 2) = pk8(za);
    }
    __syncthreads();
    {
        const int ct = wave & 3, role = wave >> 2;
        const s16x8 b0 = R.lb0, b1 = R.lb1;
        const int aoff = (role ? O_XA : O_TW) + (r * LDW + 8 * g) * 2;
        f32x4 acc[4];
#pragma unroll
        for (int mt = 0; mt < 4; ++mt) {
            const s16x8 a0 = *(const LAS s16x8*)(lds + aoff + mt * 16 * LDW * 2), a1 = *(const LAS s16x8*)(lds + aoff + mt * 16 * LDW * 2 + 64);
            acc[mt] = mfma32(a0, b0, (f32x4){0.f, 0.f, 0.f, 0.f}); acc[mt] = mfma32(a1, b1, acc[mt]);
        }
        const int cch = 16 * ct + r;
        if (role == 0) {
            const float w0v = R.bias;
            float carry = 0.f;
#pragma unroll
            for (int mt = 0; mt < 4; ++mt) {
                float s[4];
#pragma unroll
                for (int i = 0; i < 4; ++i) { const float lw = -0.6065306597126334f * sigm(acc[mt][i] + w0v); s[i] = (i ? s[i - 1] : 0.f) + lw; }
                const float tot = s[3];
                const float e1 = __shfl(tot, (lane + 48) & 63), e2 = __shfl(tot, (lane + 32) & 63), e3 = __shfl(tot, (lane + 16) & 63);
                const float excl = (g >= 1 ? e1 : 0.f) + (g >= 2 ? e2 : 0.f) + (g >= 3 ? e3 : 0.f);
                const float all = __shfl(tot + excl, 48 + r);
#pragma unroll
                for (int i = 0; i < 4; ++i) *(LAS float*)(lds + O_CL + ((16 * mt + 4 * g + i) * LDC + cch) * 4) = carry + excl + s[i];
                carry += all;
            }
        } else {
            const float a0v = R.bias;
#pragma unroll
            for (int mt = 0; mt < 4; ++mt)
#pragma unroll
                for (int i = 0; i < 4; ++i) *(LAS float*)(lds + O_AS + ((16 * mt + 4 * g + i) * LDC + cch) * 4) = sigm(acc[mt][i] + a0v);
        }
    }
    __syncthreads();
    {
        float cl[8], clp[8], cle[8], as[8];
        { const f32x4 x0 = *(const LAS f32x4*)(lds + O_CL + (t * LDC + 8 * cg) * 4), x1 = *(const LAS f32x4*)(lds + O_CL + (t * LDC + 8 * cg + 4) * 4);
          const f32x4 e0 = *(const LAS f32x4*)(lds + O_CL + (63 * LDC + 8 * cg) * 4), e1 = *(const LAS f32x4*)(lds + O_CL + (63 * LDC + 8 * cg + 4) * 4);
          const f32x4 s0 = *(const LAS f32x4*)(lds + O_AS + (t * LDC + 8 * cg) * 4), s1 = *(const LAS f32x4*)(lds + O_AS + (t * LDC + 8 * cg + 4) * 4);
          f32x4 p0 = (f32x4){0.f, 0.f, 0.f, 0.f}, p1 = p0;
          if (t > 0) { p0 = *(const LAS f32x4*)(lds + O_CL + ((t - 1) * LDC + 8 * cg) * 4); p1 = *(const LAS f32x4*)(lds + O_CL + ((t - 1) * LDC + 8 * cg + 4) * 4); }
#pragma unroll
          for (int j = 0; j < 4; ++j) { cl[j] = x0[j]; cl[4 + j] = x1[j]; cle[j] = e0[j]; cle[4 + j] = e1[j]; as[j] = s0[j]; as[4 + j] = s1[j]; clp[j] = p0[j]; clp[4 + j] = p1[j]; } }
        const float kaw[8] = {R.ka0[0], R.ka0[1], R.ka0[2], R.ka0[3], R.ka1[0], R.ka1[1], R.ka1[2], R.ka1[3]};
        float ab[8], bt[8], kt[8], rb[8], bh[8], kh[8];
#pragma unroll
        for (int j = 0; j < 8; ++j) {
            const float gt = __expf(cl[j]), gi = __expf(-cl[j]), gp = __expf(clp[j]), ge = __expf(cle[j] - cl[j]);
            const float kd = zk[j] * (1.0f + (as[j] - 1.0f) * kaw[j]), kb = kk[j] * as[j];
            ab[j] = -kk[j] * gp; bt[j] = kb * gi; kt[j] = kd * gi; rb[j] = zr[j] * gt; bh[j] = kb * ge; kh[j] = kd * ge;
            if (t == 63) *(LAS float*)(lds + O_GT + (8 * cg + j) * 4) = __expf(cle[j]);
        }
        *(LAS v4u*)(lds + O_AB + (t * LDW + 8 * cg) * 2) = pk8(ab);
        *(LAS v4u*)(lds + O_BT + (t * LDW + 8 * cg) * 2) = pk8(bt);
        *(LAS v4u*)(lds + O_KT + (t * LDW + 8 * cg) * 2) = pk8(kt);
        *(LAS v4u*)(lds + O_RB + (t * LDW + 8 * cg) * 2) = pk8(rb);
#pragma unroll
        for (int j = 0; j < 8; ++j) {
            const int so = swz_chunk(8 * cg + j, t >> 3) + (t & 7) * 2;
            *(LAS bf16*)(lds + O_BHT + so) = (bf16)f2bf(bh[j]);
            *(LAS bf16*)(lds + O_KHT + so) = (bf16)f2bf(kh[j]);
            *(LAS bf16*)(lds + O_VT + so) = (bf16)f2bf(zv[j]);
        }
    }
    __syncthreads();
    {
        const int nt = wave >> 1, pr = wave & 1;
        const int boff = ((16 * nt + r) * LDW + 8 * g) * 2;
        const s16x8 ab0 = *(const LAS s16x8*)(lds + O_AB + boff), ab1 = *(const LAS s16x8*)(lds + O_AB + boff + 64);
        const s16x8 rb0 = *(const LAS s16x8*)(lds + O_RB + boff), rb1 = *(const LAS s16x8*)(lds + O_RB + boff + 64);
        const int asrc = (pr ? O_KT : O_BT) + (r * LDW + 8 * g) * 2;
        const int tt = 16 * nt + r;
#pragma unroll
        for (int mt = 0; mt < 4; ++mt) {
            const s16x8 x0 = *(const LAS s16x8*)(lds + asrc + mt * 16 * LDW * 2), x1 = *(const LAS s16x8*)(lds + asrc + mt * 16 * LDW * 2 + 64);
            f32x4 m = mfma32(x0, ab0, (f32x4){0.f, 0.f, 0.f, 0.f}); m = mfma32(x1, ab1, m);
            f32x4 n = mfma32(x0, rb0, (f32x4){0.f, 0.f, 0.f, 0.f}); n = mfma32(x1, rb1, n);
#pragma unroll
            for (int i = 0; i < 4; ++i) { const int j = 16 * mt + 4 * g + i; m[i] = j < tt ? m[i] : 0.f; n[i] = j <= tt ? n[i] : 0.f; }
            const int so = (tt * LDW + 16 * mt + 4 * g) * 2;
            *(LAS s16x4*)(lds + (pr ? O_MAK : O_MAB) + so) = pack4(m);
            *(LAS s16x4*)(lds + (pr ? O_NRK : O_NRB) + so) = pack4(n);
        }
    }
    __syncthreads();
    f32x4 rhs[4];
    if (wave < 4) {
        const int bi = wave;
        const s16x4 aN = *(const LAS s16x4*)(lds + O_MAB + ((16 * bi + r) * LDW + 16 * bi + 4 * g) * 2);
        s16x4 bN;
#pragma unroll
        for (int i = 0; i < 4; ++i) bN[i] = *(const LAS short*)(lds + O_MAB + ((16 * bi + 4 * g + i) * LDW + 16 * bi + r) * 2);
        f32x4 c2 = mfma16(aN, bN, (f32x4){0.f, 0.f, 0.f, 0.f});
        const int npb = O_NP + bi * 3 * 16 * NPS * 2;
#pragma unroll
        for (int p = 0; p < 3; ++p) {
#pragma unroll
            for (int i = 0; i < 4; ++i) *(LAS bf16*)(lds + npb + p * 16 * NPS * 2 + ((4 * g + i) * NPS + r) * 2) = (bf16)f2bf(c2[i]);
            LDS_WAIT();
            if (p < 2) { const s16x4 aP = *(const LAS s16x4*)(lds + npb + p * 16 * NPS * 2 + (r * NPS + 4 * g) * 2); c2 = mfma16(aP, pack4(c2), (f32x4){0.f, 0.f, 0.f, 0.f}); }
        }
#pragma unroll
        for (int mt = 0; mt < 4; ++mt)
#pragma unroll
            for (int i = 0; i < 4; ++i) rhs[mt][i] = bf2f(*(const LAS bf16*)(lds + O_AB + ((16 * mt + 4 * g + i) * LDW + 16 * wave + r) * 2));
    } else {
        const int vt = wave - 4;
        const s16x8 v0 = *(const LAS s16x8*)(lds + O_VT + swz_chunk(16 * vt + r, g)), v1 = *(const LAS s16x8*)(lds + O_VT + swz_chunk(16 * vt + r, g + 4));
#pragma unroll
        for (int mt = 0; mt < 4; ++mt) {
            const int ao = O_MAK + ((16 * mt + r) * LDW + 8 * g) * 2;
            const s16x8 x0 = *(const LAS s16x8*)(lds + ao), x1 = *(const LAS s16x8*)(lds + ao + 64);
            rhs[mt] = mfma32(x0, v0, (f32x4){0.f, 0.f, 0.f, 0.f}); rhs[mt] = mfma32(x1, v1, rhs[mt]);
        }
    }
    __syncthreads();
    {
        f32x4 xb[4];
#pragma unroll
        for (int bi = 0; bi < 4; ++bi) {
            f32x4 acc = rhs[bi];
#pragma unroll
            for (int bj = 0; bj < 4; ++bj) if (bj < bi) {
                const s16x4 am = *(const LAS s16x4*)(lds + O_MAB + ((16 * bi + r) * LDW + 16 * bj + 4 * g) * 2);
                acc = mfma16(am, pack4(xb[bj]), acc);
            }
#pragma unroll
            for (int p = 0; p < 4; ++p) {
                const s16x4 ap = p == 0 ? *(const LAS s16x4*)(lds + O_MAB + ((16 * bi + r) * LDW + 16 * bi + 4 * g) * 2)
                                        : *(const LAS s16x4*)(lds + O_NP + (bi * 3 + (p - 1)) * 16 * NPS * 2 + (r * NPS + 4 * g) * 2);
                acc = mfma16(ap, pack4(acc), acc);
            }
            xb[bi] = acc;
            *(LAS s16x4*)(lds + O_XT + ((16 * wave + r) * LDW + 16 * bi + 4 * g) * 2) = pack4(acc);
        }
    }
    __syncthreads();
    {
        const int nt = wave & 3;
        bf16* ug = (bf16*)((unsigned char*)a.out + DO_INT) + (size_t)u * UNIT_ELEMS;
        const int boff = ((16 * nt + r) * LDW + 8 * g) * 2;
        if (wave < 4) {
            const s16x8 bh0 = *(const LAS s16x8*)(lds + O_BHT + swz_chunk(16 * nt + r, g)), bh1 = *(const LAS s16x8*)(lds + O_BHT + swz_chunk(16 * nt + r, g + 4));
            const s16x8 nb0 = *(const LAS s16x8*)(lds + O_NRB + boff), nb1 = *(const LAS s16x8*)(lds + O_NRB + boff + 64);
            v2u po[4], ro[4];
#pragma unroll
            for (int mt = 0; mt < 4; ++mt) {
                const int ao = O_XT + ((16 * mt + r) * LDW + 8 * g) * 2;
                const s16x8 x0 = *(const LAS s16x8*)(lds + ao), x1 = *(const LAS s16x8*)(lds + ao + 64);
                f32x4 p = mfma32(x0, bh0, (f32x4){0.f, 0.f, 0.f, 0.f}); p = mfma32(x1, bh1, p);
                if (mt == nt) { const float gt = *(const LAS float*)(lds + O_GT + (16 * mt + r) * 4);
#pragma unroll
                    for (int i = 0; i < 4; ++i) p[i] += (4 * g + i == r) ? gt : 0.f; }
                const f32x4 rbv = unpack4(*(const LAS v2u*)(lds + O_RB + ((16 * nt + r) * LDW + 16 * mt + 4 * g) * 2));
                f32x4 q = mfma32(x0, nb0, rbv); q = mfma32(x1, nb1, q);
                po[mt] = __builtin_bit_cast(v2u, pack4(p)); ro[mt] = __builtin_bit_cast(v2u, pack4(q));
            }
            v4u* pg = (v4u*)(ug + (size_t)(nt * 64 + lane) * 16);
            pg[0] = (v4u){po[0].x, po[0].y, po[1].x, po[1].y}; pg[1] = (v4u){po[2].x, po[2].y, po[3].x, po[3].y};
            v4u* rg = (v4u*)(ug + 4096 + (size_t)(nt * 64 + lane) * 16);
            rg[0] = (v4u){ro[0].x, ro[0].y, ro[1].x, ro[1].y}; rg[1] = (v4u){ro[2].x, ro[2].y, ro[3].x, ro[3].y};
        } else {
            const s16x8 u0 = *(const LAS s16x8*)(lds + O_XT + 64 * LDW * 2 + boff), u1 = *(const LAS s16x8*)(lds + O_XT + 64 * LDW * 2 + boff + 64);
            const s16x8 v0 = *(const LAS s16x8*)(lds + O_VT + swz_chunk(16 * nt + r, g)), v1 = *(const LAS s16x8*)(lds + O_VT + swz_chunk(16 * nt + r, g + 4));
            v2u qo[4], yo[4];
#pragma unroll
            for (int mt = 0; mt < 4; ++mt) {
                const int ro_ = ((16 * mt + r) * LDW + 8 * g) * 2;
                const int sw0 = swz_chunk(16 * mt + r, g), sw1 = swz_chunk(16 * mt + r, g + 4);
                const s16x8 b0 = *(const LAS s16x8*)(lds + O_BHT + sw0), b1 = *(const LAS s16x8*)(lds + O_BHT + sw1);
                const s16x8 k0 = *(const LAS s16x8*)(lds + O_KHT + sw0), k1 = *(const LAS s16x8*)(lds + O_KHT + sw1);
                f32x4 q = mfma32(b0, u0, (f32x4){0.f, 0.f, 0.f, 0.f}); q = mfma32(b1, u1, q); q = mfma32(k0, v0, q); q = mfma32(k1, v1, q);
                const s16x8 n0 = *(const LAS s16x8*)(lds + O_NRB + ro_), n1 = *(const LAS s16x8*)(lds + O_NRB + ro_ + 64);
                const s16x8 m0 = *(const LAS s16x8*)(lds + O_NRK + ro_), m1 = *(const LAS s16x8*)(lds + O_NRK + ro_ + 64);
                f32x4 y = mfma32(n0, u0, (f32x4){0.f, 0.f, 0.f, 0.f}); y = mfma32(n1, u1, y); y = mfma32(m0, v0, y); y = mfma32(m1, v1, y);
                qo[mt] = __builtin_bit_cast(v2u, pack4(q)); yo[mt] = __builtin_bit_cast(v2u, pack4(y));
            }
            v4u* qg = (v4u*)(ug + 8192 + (size_t)(nt * 64 + lane) * 16);
            qg[0] = (v4u){qo[0].x, qo[0].y, qo[1].x, qo[1].y}; qg[1] = (v4u){qo[2].x, qo[2].y, qo[3].x, qo[3].y};
            v4u* yg = (v4u*)(ug + 12288 + (size_t)(nt * 64 + lane) * 16);
            yg[0] = (v4u){yo[0].x, yo[0].y, yo[1].x, yo[1].y}; yg[1] = (v4u){yo[2].x, yo[2].y, yo[3].x, yo[3].y};
        }
    }
    __syncthreads();
}

__device__ __forceinline__ void rw_chain_job(const Args& a, unsigned char* ws, LAS unsigned char* wlds, int seg, int chain, int vt, int lane) {
    int s, rem; if (chain < 64) { s = chain >> 5; rem = chain & 31; } else { s = 2 + ((chain - 64) >> 5); rem = (chain - 64) & 31; }
    const int h = rem >> 1, d = rem & 1, base = s < 2 ? s * LP : 32768 + (s - 2) * LS, L = s < 2 ? LP : LS, nch = chain < 64 ? 32 : 4;
    const int r = lane & 15, g = lane >> 4;
    f32x4* stp = (f32x4*)(ws + WS_STATE) + ((size_t)(chain * 4 + vt) * 4) * 64 + lane;
    f32x4 st[4];
#pragma unroll
    for (int i = 0; i < 4; ++i) st[i] = seg == 0 ? (f32x4){0.f, 0.f, 0.f, 0.f} : stp[i * 64];
    bf16* Y = (bf16*)((unsigned char*)a.out + (d ? DO_YB : DO_YF));
    const bf16* ub = (const bf16*)((unsigned char*)a.out + DO_INT);
#define RW_DMA(ug) do { _Pragma("unroll") for (int _i = 0; _i < 16; ++_i) \
        __builtin_amdgcn_global_load_lds((const unsigned*)((ug) + (size_t)((_i >> 1) * 64 + lane) * 16 + (_i & 1) * 8), (LAS unsigned*)(wlds + _i * 1024), 16, 0, 0); } while (0)
    v4u qf0, qf1, yf0, yf1;
    { const bf16* ug = ub + (size_t)unit_of(chain, 0) * UNIT_ELEMS;
      RW_DMA(ug);
      const v4u* qp = (const v4u*)(ug + 8192 + (size_t)(vt * 64 + lane) * 16); qf0 = qp[0]; qf1 = qp[1];
      const v4u* yp = (const v4u*)(ug + 12288 + (size_t)(vt * 64 + lane) * 16); yf0 = yp[0]; yf1 = yp[1]; }
    for (int jc = 0; jc < nch; ++jc) {
        VM_WAIT();
        v4u pf[4][2], rf[4][2];
#pragma unroll
        for (int i = 0; i < 4; ++i) { pf[i][0] = *(const LAS v4u*)(wlds + (2 * i) * 1024 + lane * 16); pf[i][1] = *(const LAS v4u*)(wlds + (2 * i + 1) * 1024 + lane * 16);
                                      rf[i][0] = *(const LAS v4u*)(wlds + (8 + 2 * i) * 1024 + lane * 16); rf[i][1] = *(const LAS v4u*)(wlds + (9 + 2 * i) * 1024 + lane * 16); }
        LDS_WAIT();
        const v4u cq0 = qf0, cq1 = qf1, cy0 = yf0, cy1 = yf1;
        if (jc + 1 < nch) {
            const bf16* ug = ub + (size_t)unit_of(chain, jc + 1) * UNIT_ELEMS;
            RW_DMA(ug);
            const v4u* qp = (const v4u*)(ug + 8192 + (size_t)(vt * 64 + lane) * 16); qf0 = qp[0]; qf1 = qp[1];
            const v4u* yp = (const v4u*)(ug + 12288 + (size_t)(vt * 64 + lane) * 16); yf0 = yp[0]; yf1 = yp[1];
        }
        s16x4 sb[4];
#pragma unroll
        for (int kt = 0; kt < 4; ++kt) sb[kt] = pack4(st[kt]);
        const int gchunk = seg * nch + jc;
#pragma unroll
        for (int tt = 0; tt < 4; ++tt) {
            const v2u yi = tt == 0 ? (v2u){cy0.x, cy0.y} : tt == 1 ? (v2u){cy0.z, cy0.w} : tt == 2 ? (v2u){cy1.x, cy1.y} : (v2u){cy1.z, cy1.w};
            f32x4 acc = unpack4(yi);
            acc = mfma16(__builtin_bit_cast(s16x4, (v2u){rf[tt][0].x, rf[tt][0].y}), sb[0], acc);
            acc = mfma16(__builtin_bit_cast(s16x4, (v2u){rf[tt][0].z, rf[tt][0].w}), sb[1], acc);
            acc = mfma16(__builtin_bit_cast(s16x4, (v2u){rf[tt][1].x, rf[tt][1].y}), sb[2], acc);
            acc = mfma16(__builtin_bit_cast(s16x4, (v2u){rf[tt][1].z, rf[tt][1].w}), sb[3], acc);
#pragma unroll
            for (int i = 0; i < 4; ++i) { const int lp = 64 * gchunk + 16 * tt + 4 * g + i, pos = d ? L - 1 - lp : lp;
                Y[(size_t)(base + pos) * DRW + h * 64 + 16 * vt + r] = (bf16)f2bf(acc[i]); }
        }
        f32x4 sn[4];
#pragma unroll
        for (int i = 0; i < 4; ++i) {
            const v2u qi = i == 0 ? (v2u){cq0.x, cq0.y} : i == 1 ? (v2u){cq0.z, cq0.w} : i == 2 ? (v2u){cq1.x, cq1.y} : (v2u){cq1.z, cq1.w};
            f32x4 acc = unpack4(qi);
            acc = mfma16(__builtin_bit_cast(s16x4, (v2u){pf[i][0].x, pf[i][0].y}), sb[0], acc);
            acc = mfma16(__builtin_bit_cast(s16x4, (v2u){pf[i][0].z, pf[i][0].w}), sb[1], acc);
            acc = mfma16(__builtin_bit_cast(s16x4, (v2u){pf[i][1].x, pf[i][1].y}), sb[2], acc);
            acc = mfma16(__builtin_bit_cast(s16x4, (v2u){pf[i][1].z, pf[i][1].w}), sb[3], acc);
            sn[i] = acc;
        }
#pragma unroll
        for (int i = 0; i < 4; ++i) st[i] = sn[i];
    }
#undef RW_DMA
#pragma unroll
    for (int i = 0; i < 4; ++i) stp[i * 64] = st[i];
}
}


namespace s5k {
constexpr int ST = 32, NCH = M / ST, K2 = 768, KU = 512;
constexpr size_t POW_ELEMS = (size_t)128 * 33 * 64 * 2, BB_ELEMS = (size_t)128 * 64 * 16 * 2, KTAB_ELEMS = (size_t)64 * 63 * 256;
__device__ __forceinline__ void tables_group(const Args& a, unsigned char* ws, LAS unsigned char* lds, int g, int tid) {
    float* POW = (float*)(ws + WS_S5TAB); float* BB = POW + POW_ELEMS; float* KTAB = BB + BB_ELEMS;
    LAS float* lam = (LAS float*)lds;
    LAS float* bbl = lam + 256;
    LAS float* cl = bbl + 4096;
    LAS float* pwl = cl + 4096;
    if (tid < 128) {
        const int d = tid >> 6, p = tid & 63, gi = d * 64 + g;
        const float lre = a.in[5][gi * 64 + p], lim = a.in[6][gi * 64 + p], dt = expf(a.in[7][gi]);
        const float er = expf(lre * dt); float sn, cs; sincosf(lim * dt, &sn, &cs);
        const float lbr = er * cs, lbi = er * sn;
        const float nr = lbr - 1.0f, ni = lbi, den = lre * lre + lim * lim;
        const float cfr = (nr * lre + ni * lim) / den, cfi = (ni * lre - nr * lim) / den;
        lam[(d * 64 + p) * 2] = lre * dt; lam[(d * 64 + p) * 2 + 1] = lim * dt;
        for (int h = 0; h < 16; ++h) {
            const float br = a.in[8][((size_t)gi * 64 + p) * 16 + h], bi = a.in[9][((size_t)gi * 64 + p) * 16 + h];
            const float xr = cfr * br - cfi * bi, xi = cfr * bi + cfi * br;
            bbl[((d * 64 + p) * 16 + h) * 2] = xr; bbl[((d * 64 + p) * 16 + h) * 2 + 1] = xi;
            BB[(((size_t)gi * 64 + p) * 16 + h) * 2] = xr; BB[(((size_t)gi * 64 + p) * 16 + h) * 2 + 1] = xi;
            cl[((d * 16 + h) * 64 + p) * 2] = a.in[10][((size_t)gi * 16 + h) * 64 + p]; cl[((d * 16 + h) * 64 + p) * 2 + 1] = a.in[11][((size_t)gi * 16 + h) * 64 + p];
        }
    }
    __syncthreads();
    for (int e = tid; e < 2 * 33 * 64; e += NWAVES * 64) {
        const int p = e & 63, tau = (e >> 6) % 33, d = e / (33 * 64), gi = d * 64 + g;
        const float er = expf(lam[(d * 64 + p) * 2] * (float)tau); float sn, cs; sincosf(lam[(d * 64 + p) * 2 + 1] * (float)tau, &sn, &cs);
        pwl[e * 2] = er * cs; pwl[e * 2 + 1] = er * sn;
        POW[(((size_t)gi * 33 + tau) * 64 + p) * 2] = er * cs; POW[(((size_t)gi * 33 + tau) * 64 + p) * 2 + 1] = er * sn;
    }
    __syncthreads();
    for (int o = tid; o < 63 * 256; o += NWAVES * 64) {
        const int hh = o & 255, h = hh >> 4, h2 = hh & 15, lag = (o >> 8) - 31;
        float acc = 0.f;
#pragma unroll
        for (int d = 0; d < 2; ++d) {
            if ((d == 0 && lag >= 0) || (d == 1 && lag <= 0)) {
                const int tau = lag >= 0 ? lag : -lag;
                for (int p = 0; p < 64; ++p) {
                    const float cr = cl[((d * 16 + h) * 64 + p) * 2], ci = cl[((d * 16 + h) * 64 + p) * 2 + 1];
                    const float pr = pwl[((d * 33 + tau) * 64 + p) * 2], pi = pwl[((d * 33 + tau) * 64 + p) * 2 + 1];
                    const float br = bbl[((d * 64 + p) * 16 + h2) * 2], bi = bbl[((d * 64 + p) * 16 + h2) * 2 + 1];
                    const float qr = pr * br - pi * bi, qi = pr * bi + pi * br;
                    acc += cr * qr - ci * qi;
                }
            }
        }
        KTAB[(size_t)g * 63 * 256 + o] = acc;
    }
    __syncthreads();
}
__device__ __forceinline__ void fill_weights(const Args& a, unsigned char* ws, int gw, int NGW, int lane) {
    const float* POW = (const float*)(ws + WS_S5TAB); const float* BB = POW + POW_ELEMS; const float* KTAB = BB + BB_ELEMS;
    bf16* W2 = (bf16*)(ws + WS_S5W2); bf16* E = (bf16*)(ws + WS_S5E);
    const size_t n_w2 = (size_t)64 * 512 * 96, n_e = (size_t)64 * 256 * 64, stride = (size_t)NGW * 64;
    for (size_t it = (size_t)gw * 64 + lane; it < n_w2 + n_e; it += stride) {
        float v[8];
        if (it < n_w2) {
            const int kc = (int)(it % 96), n = (int)((it / 96) % 512), g = (int)(it / (96 * 512)), t = n >> 4, h = n & 15, k0 = kc * 8;
            if (k0 < KU) {
                const int s = k0 >> 4, h0 = k0 & 15, lag = t - s;
                const float* kt = KTAB + ((size_t)(g * 63 + lag + 31) * 16 + h) * 16 + h0;
#pragma unroll
                for (int j = 0; j < 8; ++j) v[j] = kt[j] + ((lag == 0 && h0 + j == h) ? a.in[12][g * 16 + h] : 0.f);
            } else {
                const int kk = k0 - KU, d = kk >> 7, ri = (kk >> 6) & 1, p0 = kk & 63, gi = d * 64 + g, tau = d == 0 ? t + 1 : ST - t;
#pragma unroll
                for (int j = 0; j < 8; ++j) {
                    const int p = p0 + j;
                    const float cr = a.in[10][((size_t)gi * 16 + h) * 64 + p], ci = a.in[11][((size_t)gi * 16 + h) * 64 + p];
                    const float pr = POW[(((size_t)gi * 33 + tau) * 64 + p) * 2], pi = POW[(((size_t)gi * 33 + tau) * 64 + p) * 2 + 1];
                    v[j] = ri == 0 ? (cr * pr - ci * pi) : -(cr * pi + ci * pr);
                }
            }
            *(v4u*)(W2 + ((size_t)(g * 512 + n)) * K2 + k0) = rwk::pk8(v);
        } else {
            const size_t ie = it - n_w2;
            const int kc = (int)(ie % 64), n = (int)((ie / 64) % 256), g = (int)(ie / (64 * 256)), d = n >> 7, ri = (n >> 6) & 1, p = n & 63, gi = d * 64 + g;
            const int k0 = kc * 8, s = k0 >> 4, h0 = k0 & 15, tau = d == 0 ? ST - 1 - s : s;
            const float pr = POW[(((size_t)gi * 33 + tau) * 64 + p) * 2], pi = POW[(((size_t)gi * 33 + tau) * 64 + p) * 2 + 1];
#pragma unroll
            for (int j = 0; j < 8; ++j) {
                const float br = BB[(((size_t)gi * 64 + p) * 16 + h0 + j) * 2], bi = BB[(((size_t)gi * 64 + p) * 16 + h0 + j) * 2 + 1];
                v[j] = ri == 0 ? (pr * br - pi * bi) : (pr * bi + pi * br);
            }
            *(v4u*)(E + ((size_t)(g * 256 + n)) * KU + k0) = rwk::pk8(v);
        }
    }
}
__device__ __forceinline__ void chain_job(unsigned char* ws, bf16* A2, int job, int lane) {
    int s, rem; if (job < 256) { s = job / 128; rem = job % 128; } else { s = 2 + (job - 256) / 128; rem = (job - 256) % 128; }
    const int g = rem >> 1, d = rem & 1, p = lane, gi = d * 64 + g;
    const int c0 = s < 2 ? s * (LP / ST) : 2 * (LP / ST) + (s - 2) * (LS / ST), nc = s < 2 ? LP / ST : LS / ST;
    const float* POW = (const float*)(ws + WS_S5TAB);
    const float lr = POW[(((size_t)gi * 33 + 32) * 64 + p) * 2], li = POW[(((size_t)gi * 33 + 32) * 64 + p) * 2 + 1];
    const bf16* XL = (const bf16*)(ws + WS_S5XL);
    const int step = d ? -1 : 1, cfirst = d ? c0 + nc - 1 : c0;
    const int xcol = d * 128 + p, scol = KU + d * 128 + p;
    float xr = 0.f, xi = 0.f;
    { bf16* row = A2 + ((size_t)g * NCH + cfirst) * K2 + scol; row[0] = 0; row[64] = 0; }
    for (int n = 0; n < nc; n += 8) {
        float lr_[8], li_[8];
#pragma unroll
        for (int j = 0; j < 8; ++j) { const bf16* xrow = XL + ((size_t)g * NCH + cfirst + (n + j) * step) * 256 + xcol; lr_[j] = bf2f(xrow[0]); li_[j] = bf2f(xrow[64]); }
#pragma unroll
        for (int j = 0; j < 8; ++j) {
            const float nr = lr * xr - li * xi + lr_[j], ni = lr * xi + li * xr + li_[j]; xr = nr; xi = ni;
            if (n + j + 1 < nc) { bf16* row = A2 + ((size_t)g * NCH + cfirst + (n + j + 1) * step) * K2 + scol; row[0] = (bf16)f2bf(xr); row[64] = (bf16)f2bf(xi); }
        }
    }
}
}
namespace pg8 {
struct S5Order {
    int G, c, nun, mode;
    __device__ bool next(int i, Unit& u) const {
        const int L = i * G + c; if (L >= nun) return false;
        if (mode == 1) { u.pm = L; u.pn = L >> 3; } else { const int g = L >> 4; u.pm = g * 8 + ((L & 15) >> 1); u.pn = g * 2 + (L & 1); }
        return true;
    }
    __device__ __forceinline__ void a_ready(const Unit&) const {}
    __device__ __forceinline__ void done(const Unit&) const {}
};
struct EpiS5X {
    static constexpr bool PERM = true, AFTER_DRAIN = false;
    bf16_t* O;
    __device__ __forceinline__ void operator()(const f32x4 (&acc)[2][2][4][2], const Unit& u, int wr, int wc, int fr, int fq) const {
        const int row0 = u.pm * BM + wr * 64 + fr, col0 = wc * 32 + 8 * fq;
#pragma unroll
        for (int ai = 0; ai < 2; ++ai)
#pragma unroll
            for (int m = 0; m < 4; ++m) { bf16_t* rowp = O + (size_t)(row0 + ai * HALF + m * 16) * 256 + col0;
#pragma unroll
                for (int bj = 0; bj < 2; ++bj) { const f32x4 v0 = acc[ai][bj][m][0], v1 = acc[ai][bj][m][1];
                    u32x4 w; w.x = cvt_pk_bf16(v0[0], v0[1]); w.y = cvt_pk_bf16(v0[2], v0[3]); w.z = cvt_pk_bf16(v1[0], v1[1]); w.w = cvt_pk_bf16(v1[2], v1[3]);
                    *(u32x4*)(rowp + bj * HALF) = w; } }
    }
};
struct EpiS5Y {
    static constexpr bool PERM = true, AFTER_DRAIN = false;
    bf16_t* Zp;
    __device__ __forceinline__ void operator()(const f32x4 (&acc)[2][2][4][2], const Unit& u, int wr, int wc, int fr, int fq) const {
        const int row0 = u.pm * BM + wr * 64 + fr, col0 = (u.pn & 1) * BM + wc * 32 + 8 * fq;
#pragma unroll
        for (int ai = 0; ai < 2; ++ai)
#pragma unroll
            for (int m = 0; m < 4; ++m) {
                const int row = row0 + ai * HALF + m * 16, g = row >> 11, c = row & 2047;
#pragma unroll
                for (int bj = 0; bj < 2; ++bj) {
                    const int col = col0 + bj * HALF, t = col >> 4, h0 = col & 15;
                    float v[8];
#pragma unroll
                    for (int j = 0; j < 4; ++j) { v[j] = acc[ai][bj][m][0][j]; v[4 + j] = acc[ai][bj][m][1][j]; }
#pragma unroll
                    for (int j = 0; j < 8; ++j) { const float x = v[j]; v[j] = x * sigmoid_f(1.5957691216057308f * (x + 0.044715f * x * x * x)); }
                    u32x4 w; w.x = cvt_pk_bf16(v[0], v[1]); w.y = cvt_pk_bf16(v[2], v[3]); w.z = cvt_pk_bf16(v[4], v[5]); w.w = cvt_pk_bf16(v[6], v[7]);
                    *(u32x4*)(Zp + (size_t)(c * 32 + t) * 1024 + g * 16 + h0) = w;
                }
            }
    }
};
}


__device__ __forceinline__ void transpose_item(const float* W, int ldw, int K, bf16* WT, int drow0, LAS float* scr, int k0, int n0, int lane) {
#pragma unroll 8
    for (int i = 0; i < 32; ++i) { const int kk = 2 * i + (lane >> 5); scr[kk * 33 + (lane & 31)] = W[(size_t)(k0 + kk) * ldw + n0 + (lane & 31)]; }
    LDS_WAIT();
    const int c = lane & 7;
#pragma unroll
    for (int j = 0; j < 4; ++j) { const int n = (lane >> 3) + 8 * j; const LAS float* s = scr + (8 * c) * 33 + n;
        v4u o; o.x = pk2(s[0 * 33], s[1 * 33]); o.y = pk2(s[2 * 33], s[3 * 33]); o.z = pk2(s[4 * 33], s[5 * 33]); o.w = pk2(s[6 * 33], s[7 * 33]);
        *(v4u*)(WT + (size_t)(drow0 + n) * K + k0 + 8 * c) = o; }
    LDS_WAIT();
}
__device__ __forceinline__ int win_dest_row(int n) { return n < 1024 ? n : (n < 2048 ? n + 3328 : (n < 5376 ? n - 1024 : n)); }
__device__ __forceinline__ const float* xrow_ptr(const float* xp, const float* xs, int m) { return m < 32768 ? xp + (size_t)m * D : xs + (size_t)(m - 32768) * D; }

__device__ __forceinline__ void p0_prologue(const Args& a, unsigned char* ws, LAS unsigned char* lds, int gw, int NGW, int wave, int lane) {
    LAS float* scr = (LAS float*)(lds + wave * 16384);
    constexpr int I_IN = (D / 64) * (NIN / 32), I_GLU = (1024 / 64) * (1024 / 32), I_SO = (1024 / 64) * (2048 / 32), I_WO = (2048 / 64) * (2048 / 32);
    constexpr int NITEMS = I_IN + I_GLU + 2 * I_SO + I_WO;
    for (int it = gw; it < NITEMS; it += NGW) {
        int r = it;
        if (r < I_IN) { const int nblk = NIN / 32, kb = r / nblk, nb = r % nblk; transpose_item(a.in[4], NIN, D, (bf16*)(ws + WS_WT), win_dest_row(32 * nb), scr, 64 * kb, 32 * nb, lane); continue; } r -= I_IN;
        if (r < I_GLU) { const int nblk = 1024 / 32, kb = r / nblk, nb = r % nblk; transpose_item(a.in[13], 1024, 1024, (bf16*)(ws + WS_GLUT), 32 * nb, scr, 64 * kb, 32 * nb, lane); continue; } r -= I_GLU;
        if (r < I_SO) { const int nblk = 2048 / 32, kb = r / nblk, nb = r % nblk; transpose_item(a.in[14], 2048, 1024, (bf16*)(ws + WS_S5OT), 32 * nb, scr, 64 * kb, 32 * nb, lane); continue; } r -= I_SO;
        if (r < I_SO) { const int nblk = 2048 / 32, kb = r / nblk, nb = r % nblk; transpose_item(a.in[25], 2048, 1024, (bf16*)(ws + WS_RWOT), 32 * nb, scr, 64 * kb, 32 * nb, lane); continue; } r -= I_SO;
        { const int nblk = 2048 / 32, kb = r / nblk, nb = r % nblk; transpose_item(a.in[26], 2048, 2048, (bf16*)(ws + WS_WOT), 32 * nb, scr, 64 * kb, 32 * nb, lane); }
    }
    { const int bxx = gw / NWAVES; if (bxx < 64) s5k::tables_group(a, ws, lds, bxx, wave * 64 + lane); }
    { bf16* LUT = (bf16*)(ws + WS_LUT);
      for (int e = gw * 64 + lane; e < 4 * 16 * 64 * 64; e += NGW * 64) {
          const int j = e & 63, c = (e >> 6) & 63, h = (e >> 12) & 15, rd = e >> 16, role = rd >> 1, d = rd & 1;
          LUT[e] = (bf16)f2bf((role ? a.in[19] : a.in[17])[(size_t)(d * 64 + j) * 1024 + h * 64 + c]); } }
    const float* g = a.in[2];
    f32x4 gv[8];
#pragma unroll
    for (int j = 0; j < 8; ++j) gv[j] = ((const f32x4*)g)[lane + 64 * j];
    bf16* HN = (bf16*)(ws + WS_HN);
    for (int m = gw; m < M; m += NGW) {
        const f32x4* xr = (const f32x4*)xrow_ptr(a.in[0], a.in[1], m) + lane;
        f32x4 v[8]; float s = 0.f;
#pragma unroll
        for (int j = 0; j < 8; ++j) { v[j] = xr[64 * j]; s += (v[j].x * v[j].x + v[j].y * v[j].y) + (v[j].z * v[j].z + v[j].w * v[j].w); }
        const float rstd = 1.0f / sqrtf(wave_sum(s) * (1.0f / D) + RMS_EPS);
        v2u* o8 = (v2u*)(HN + (size_t)m * D) + lane;
#pragma unroll
        for (int j = 0; j < 8; ++j) { v2u o; o.x = pk2(v[j].x * rstd * gv[j].x, v[j].y * rstd * gv[j].y); o.y = pk2(v[j].z * rstd * gv[j].z, v[j].w * rstd * gv[j].w); o8[64 * j] = o; }
    }
}

__device__ __forceinline__ void unpack8(const bf16* p, float (&o)[8]) {
    const v4u a = *(const v4u*)p;
    o[0] = blo(a.x); o[1] = bhi(a.x); o[2] = blo(a.y); o[3] = bhi(a.y); o[4] = blo(a.z); o[5] = bhi(a.z); o[6] = blo(a.w); o[7] = bhi(a.w);
}
__device__ __forceinline__ void pack8(bf16* p, const float (&v)[8]) {
    v4u a; a.x = pk2(v[0], v[1]); a.y = pk2(v[2], v[3]); a.z = pk2(v[4], v[5]); a.w = pk2(v[6], v[7]); *(v4u*)p = a;
}
__device__ __forceinline__ void p3_finalize(const Args& a, unsigned char* ws, int gw, int NGW, int lane) {
    const bf16* RWIN = (const bf16*)(ws + WS_RWIN);
    unsigned char* ob = (unsigned char*)a.out;
    bf16* YF = (bf16*)(ob + DO_YF); const bf16* YB = (const bf16*)(ob + DO_YB);
    const int half = gw & 1, c0 = half * 512 + lane * 8;
    float lnw[8], lnb[8], rk[8], mur[8], muk[8], muv[8];
#pragma unroll
    for (int j = 0; j < 8; ++j) { lnw[j] = a.in[23][c0 + j]; lnb[j] = a.in[24][c0 + j]; rk[j] = a.in[22][c0 + j]; mur[j] = a.in[15][c0 + j]; muk[j] = a.in[15][1024 + c0 + j]; muv[j] = a.in[15][2048 + c0 + j]; }
    for (int m = gw >> 1; m < M; m += NGW >> 1) {
        const int t = m < 32768 ? (m & (LP - 1)) : ((m - 32768) & (LS - 1)), L = m < 32768 ? LP : LS;
        const bool hp = t > 0, hn = t < L - 1;
        float o[8];
        float y[8];
        {
            float yf[8], yb[8];
            unpack8(YF + (size_t)m * DRW + c0, yf); unpack8(YB + (size_t)m * DRW + c0, yb);
#pragma unroll
            for (int j = 0; j < 8; ++j) y[j] = yf[j] + yb[j];
        }
        float s1 = 0.f;
#pragma unroll
        for (int j = 0; j < 8; ++j) s1 += y[j];
        s1 += __shfl_xor(s1, 1); s1 += __shfl_xor(s1, 2); s1 += __shfl_xor(s1, 4);
        const float mean = s1 * (1.0f / 64.0f);
        float s2 = 0.f;
#pragma unroll
        for (int j = 0; j < 8; ++j) { const float dd = y[j] - mean; s2 += dd * dd; }
        s2 += __shfl_xor(s2, 1); s2 += __shfl_xor(s2, 2); s2 += __shfl_xor(s2, 4);
        const float rstd = 1.0f / sqrtf(s2 * (1.0f / 64.0f) + GN_EPS);
        float zr[8], zk[8], zv[8];
        const bf16* pc = RWIN + (size_t)m * DRWIN + c0;
#pragma unroll
        for (int comp = 0; comp < 3; ++comp) {
            float cc[8], pp[8], nn[8];
            unpack8(pc + comp * 1024, cc);
            if (hp) unpack8(pc - DRWIN + comp * 1024, pp); else {
#pragma unroll
                for (int j = 0; j < 8; ++j) pp[j] = 0.f; }
            if (hn) unpack8(pc + DRWIN + comp * 1024, nn); else {
#pragma unroll
                for (int j = 0; j < 8; ++j) nn[j] = 0.f; }
#pragma unroll
            for (int j = 0; j < 8; ++j) {
                const float muc = comp == 0 ? mur[j] : (comp == 1 ? muk[j] : muv[j]);
                const float zz = cc[j] + (0.5f * (pp[j] + nn[j]) - cc[j]) * muc;
                if (comp == 0) zr[j] = zz; else if (comp == 1) zk[j] = zz; else zv[j] = zz;
            }
        }
        float dot = 0.f;
#pragma unroll
        for (int j = 0; j < 8; ++j) dot += zr[j] * zk[j] * rk[j];
        dot += __shfl_xor(dot, 1); dot += __shfl_xor(dot, 2); dot += __shfl_xor(dot, 4);
#pragma unroll
        for (int j = 0; j < 8; ++j) o[j] = (y[j] - mean) * rstd * lnw[j] + lnb[j] + dot * zv[j];
        pack8(YF + (size_t)m * DRW + c0, o);
    }
}

__device__ __forceinline__ void p12_final(const Args& a, int gw, int NGW, int lane) {
    const float* g = a.in[3];
    f32x4 gv[8];
#pragma unroll
    for (int j = 0; j < 8; ++j) gv[j] = ((const f32x4*)g)[lane + 64 * j];
    for (int m = gw; m < M; m += NGW) {
        const f32x4* xr = (const f32x4*)xrow_ptr(a.in[0], a.in[1], m) + lane;
        f32x4* orow = (f32x4*)(a.out + (size_t)m * D) + lane;
        f32x4 v[8]; float s = 0.f;
#pragma unroll
        for (int j = 0; j < 8; ++j) { v[j] = orow[64 * j]; s += (v[j].x * v[j].x + v[j].y * v[j].y) + (v[j].z * v[j].z + v[j].w * v[j].w); }
        const float rstd = 1.0f / sqrtf(wave_sum(s) * (1.0f / D) + RMS_EPS);
#pragma unroll
        for (int j = 0; j < 8; ++j) { const f32x4 xv = xr[64 * j]; orow[64 * j] = xv + v[j] * rstd * gv[j]; }
    }
}

__global__ void __launch_bounds__(NWAVES * 64, 2) mk_fwd(Args args) {
    extern __shared__ __attribute__((aligned(16))) unsigned char lds_raw[];
    LAS unsigned char* lds = (LAS unsigned char*)lds_raw;
    volatile LAS unsigned* MISC = (volatile LAS unsigned*)(lds + MISC_OFF);
    const int wave = __builtin_amdgcn_readfirstlane((int)threadIdx.x >> 6);
#define lane mk_lane()
    const int tid0 = threadIdx.x;
    const int G = gridDim.x; const int bx = blockIdx.x; const int vcu = (G % 8 == 0) ? (bx % 8) * (G / 8) + bx / 8 : bx;
    unsigned char* ws = args.ws;
    unsigned* ctl = (unsigned*)(ws + WS_CTL);
    for (int u = tid0; u < (LDS_BYTES - MISC_OFF) / 4; u += NWAVES * 64) ((LAS unsigned*)(lds + MISC_OFF))[u] = 0u;
    __syncthreads();
    XcdBarrier bar = xcd_barrier_post(ctl + CW_BAR, MISC + 8, wave);
#define GRID_BAR() xcd_barrier(bar, wave)
#ifndef ONLY_PHASE
#define ONLY_PHASE -1
#endif
#define IN(k) (ONLY_PHASE < 0 || ONLY_PHASE == (k))
    const int gw = vcu * NWAVES + wave, NGW = G * NWAVES;
    bf16* WT = (bf16*)(ws + WS_WT); bf16* HN = (bf16*)(ws + WS_HN); bf16* RWIN = (bf16*)(ws + WS_RWIN); bf16* Z = (bf16*)(ws + WS_Z); bf16* ZG = (bf16*)(ws + WS_ZG);
    bf16* A2 = (bf16*)((unsigned char*)args.out + DO_A2);
    bf16* YN = (bf16*)((unsigned char*)args.out + DO_YF); bf16* Q = (bf16*)((unsigned char*)args.out + DO_Q); bf16* P = RWIN;

    if (IN(0)) { p0_prologue(args, ws, lds, gw, NGW, wave, lane); GRID_BAR(); }
    if (IN(1)) {
        s5k::fill_weights(args, ws, gw, NGW, lane);
        pg8::Gemm g{HN, WT, M, 4352, D, D}; pg8::StaticOrder S; S.init(M, 4352, G, bx);
        pg8::EpiG1 E{A2, RWIN};
        pg8::gemm_phase<pg8::EpiG1, pg8::StaticOrder, PG8_ALIGN, PG8_SP2>(lds, g, S, E, wave);
        GRID_BAR();
    }
    if (IN(2)) {
        pg8::Gemm g{A2, (const bf16*)(ws + WS_S5E), 131072, 256, s5k::KU, s5k::K2}; pg8::S5Order S{G, bx, 512, 1};
        pg8::EpiS5X E{(bf16*)(ws + WS_S5XL)};
        pg8::gemm_phase<pg8::EpiS5X, pg8::S5Order, PG8_ALIGN, PG8_SP2>(lds, g, S, E, wave);
        GRID_BAR();
    }
    if (IN(3)) {
        const int gwt = wave * G + vcu;
        for (int j = gwt; j < 2304; j += NGW) s5k::chain_job(ws, A2, j, lane);
        GRID_BAR();
    }
    if (IN(4)) {
        pg8::Gemm g{A2, (const bf16*)(ws + WS_S5W2), 131072, 512, s5k::K2, s5k::K2}; pg8::S5Order S{G, bx, 1024, 2};
        pg8::EpiS5Y E{Z};
        pg8::gemm_phase<pg8::EpiS5Y, pg8::S5Order, PG8_ALIGN, PG8_SP2>(lds, g, S, E, wave);
        GRID_BAR();
    }
    if (IN(5)) {
        for (int e = tid0; e < 3328; e += NWAVES * 64) ((LAS float*)(lds + rwk::O_MU))[e] = args.in[15][e];
        __syncthreads();
        for (int seg = 0; seg < rwk::NSEG; ++seg) {
            {
                rwk::RawUnit R;
                if (bx < rwk::UNITS_PER_SEG) rwk::rw_load_unit(args, ws, seg, bx, wave, lane, R);
                for (int u = bx; u < rwk::UNITS_PER_SEG; u += G) {
                    rwk::RawUnit Rn;
                    rwk::rw_load_unit(args, ws, seg, u + G < rwk::UNITS_PER_SEG ? u + G : u, wave, lane, Rn);
                    rwk::rw_precompute_unit(args, ws, lds, seg, u, wave, lane, R);
                    R = Rn;
                }
            }
            GRID_BAR();
            {
                int J, Jstride;
                if (bx < 64 && wave < 4) { J = bx * 4 + wave; Jstride = 1 << 20; }
                else { const int fw = bx < 64 ? bx * 4 + (wave - 4) : 256 + (bx - 64) * 8 + wave; J = 256 + fw; Jstride = 1792; }
                for (; J < 2304; J += Jstride) {
                    const int chain = J < 256 ? (J >> 2) : 64 + ((J - 256) >> 2), vt = J & 3;
                    rwk::rw_chain_job(args, ws, lds + wave * 16384, seg, chain, vt, lane);
                }
            }
            GRID_BAR();
        }
    }
    if (IN(6)) { p3_finalize(args, ws, gw, NGW, lane); GRID_BAR(); }
    if (IN(7)) {
        pg8::Gemm g{Z, (const bf16*)(ws + WS_GLUT), M, 1024, 1024, 1024}; pg8::StaticOrder S; S.init(M, 1024, G, bx);
        pg8::EpiMix<1> E{ZG, Z, nullptr, 1024};
        pg8::gemm_phase<pg8::EpiMix<1>, pg8::StaticOrder, PG8_ALIGN, PG8_SP2>(lds, g, S, E, wave);
    }
    if (IN(8)) {
        pg8::Gemm g{HN, WT + (size_t)4352 * D, M, 1024, D, D}; pg8::StaticOrder S; S.init(M, 1024, G, bx);
        pg8::EpiMix<2> E{ZG, ZG, nullptr, 1024};
        pg8::gemm_phase<pg8::EpiMix<2>, pg8::StaticOrder, PG8_ALIGN, PG8_SP2>(lds, g, S, E, wave);
    }
    if (IN(9)) {
        pg8::Gemm g{HN, WT + (size_t)5376 * D, M, 1024, D, D}; pg8::StaticOrder S; S.init(M, 1024, G, bx);
        pg8::EpiMix<2> E{YN, YN, nullptr, 1024};
        pg8::gemm_phase<pg8::EpiMix<2>, pg8::StaticOrder, PG8_ALIGN, PG8_SP2>(lds, g, S, E, wave);
        GRID_BAR();
    }
    if (IN(10)) {
        pg8::Gemm g{ZG, (const bf16*)(ws + WS_S5OT), M, 2048, 1024, 1024}; pg8::StaticOrder S; S.init(M, 2048, G, bx);
        pg8::EpiMix<0> E{P, nullptr, nullptr, 2048};
        pg8::gemm_phase<pg8::EpiMix<0>, pg8::StaticOrder, PG8_ALIGN, PG8_SP2>(lds, g, S, E, wave);
    }
    if (IN(11)) {
        pg8::Gemm g{HN, WT + (size_t)6400 * D, M, 2048, D, D}; pg8::StaticOrder S; S.init(M, 2048, G, bx);
        pg8::EpiMix<1> E{P, P, nullptr, 2048};
        pg8::gemm_phase<pg8::EpiMix<1>, pg8::StaticOrder, PG8_ALIGN, PG8_SP2>(lds, g, S, E, wave);
    }
    if (IN(12)) {
        pg8::Gemm g{YN, (const bf16*)(ws + WS_RWOT), M, 2048, 1024, 1024}; pg8::StaticOrder S; S.init(M, 2048, G, bx);
        pg8::EpiMix<0> E{Q, nullptr, nullptr, 2048};
        pg8::gemm_phase<pg8::EpiMix<0>, pg8::StaticOrder, PG8_ALIGN, PG8_SP2>(lds, g, S, E, wave);
    }
    if (IN(13)) {
        pg8::Gemm g{HN, WT + (size_t)8448 * D, M, 2048, D, D}; pg8::StaticOrder S; S.init(M, 2048, G, bx);
        pg8::EpiMix<3> E{P, Q, P, 2048};
        pg8::gemm_phase<pg8::EpiMix<3>, pg8::StaticOrder, PG8_ALIGN, PG8_SP2>(lds, g, S, E, wave);
        GRID_BAR();
    }
    if (IN(14)) {
        pg8::Gemm g{P, (const bf16*)(ws + WS_WOT), M, 2048, D, D}; pg8::StaticOrder S; S.init(M, 2048, G, bx);
        pg8::EpiF32 E{args.out, 2048};
        pg8::gemm_phase<pg8::EpiF32, pg8::StaticOrder, PG8_ALIGN, PG8_SP2>(lds, g, S, E, wave);
        GRID_BAR();
    }
    if (IN(15)) { p12_final(args, gw, NGW, lane); }
#undef IN
#undef lane
}

extern "C" void kernel_launch(void* const* d_in, const int* in_sizes, int n_in, void* d_out, int out_size, void* d_ws, size_t ws_size, hipStream_t stream) {
    static int grid = 0;
    if (grid == 0) {
        if (n_in != 27 || out_size != 2 * 32768 * D || ws_size < WS_END) { fprintf(stderr, "kernel_launch: unexpected shapes (n_in %d out %d ws %zu)\n", n_in, out_size, ws_size); grid = -1; return; }
        int dev = 0, cus = 0, per_cu = 0;
        if (hipGetDevice(&dev) != hipSuccess || hipDeviceGetAttribute(&cus, hipDeviceAttributeMultiprocessorCount, dev) != hipSuccess) { grid = -1; return; }
        if (hipFuncSetAttribute((const void*)mk_fwd, hipFuncAttributeMaxDynamicSharedMemorySize, LDS_BYTES) != hipSuccess) { fprintf(stderr, "kernel_launch: hipFuncSetAttribute failed\n"); grid = -1; return; }
        if (hipOccupancyMaxActiveBlocksPerMultiprocessor(&per_cu, (const void*)mk_fwd, NWAVES * 64, LDS_BYTES) != hipSuccess || per_cu < 1)
            fprintf(stderr, "kernel_launch: note: occupancy query reports %d workgroups per CU\n", per_cu);
        (void)hipGetLastError();
        grid = cus;
    }
    if (grid < 0) return;
    if (hipMemsetAsync((char*)d_ws + WS_CTL, 0, CTL_ZERO_BYTES, stream) != hipSuccess) return;
    Args a{};
    for (int i = 0; i < 27; ++i) a.in[i] = (const float*)d_in[i];
    a.out = (float*)d_out; a.ws = (unsigned char*)d_ws; a.pad = 0;
    { const int li = 0; a.ph_lo = 0; a.ph_hi = N_PHASES; a.li = 0;
        hipLaunchKernelGGL(mk_fwd, dim3(grid), dim3(NWAVES * 64), LDS_BYTES, stream, a);
        const hipError_t le = hipPeekAtLastError();
        if (le != hipSuccess) { fprintf(stderr, "kernel_launch: launch %d failed: %s\n", li, hipGetErrorName(le)); }
    }
}
```

```cpp
#include <hip/hip_runtime.h>
#include <cstdio>
#include <cstdint>
#define MK_N_LAUNCHES 1
__device__ __forceinline__ int mk_lane() { int l; asm volatile("v_mbcnt_lo_u32_b32 %0, -1, 0\n\tv_mbcnt_hi_u32_b32 %0, -1, %0" : "=v"(l)); return l; }
namespace pg8 {
#define PG8_LAS __attribute__((address_space(3)))
typedef unsigned short bf16_t;
typedef short bf16x8 __attribute__((ext_vector_type(8)));
typedef float f32x4 __attribute__((ext_vector_type(4)));
typedef unsigned u32x4 __attribute__((ext_vector_type(4)));
constexpr int BM = 256, BK = 64, HALF = 128, HTB = HALF * BK * 2  , STAGE_BYTES = 8 * HTB, NXCD = 8, WGM = 8;

__host__ __device__ __forceinline__ int lds_byte(int r, int c) { const int st = (r >> 4) * 2 + (c >> 5), rr = r & 15, cc = c & 31, ob = rr * 64 + cc * 2; return st * 1024 + (ob ^ (((ob >> 9) & 1) << 5)); }
__host__ __device__ __forceinline__ void stage_rc(int b, int& R, int& C) { const int st = b / 1024, sb = b % 1024, swz = sb ^ (((sb >> 9) & 1) << 5); R = (st >> 1) * 16 + swz / 64; C = (st & 1) * 32 + (swz % 64) / 2; }
__host__ __device__ __forceinline__ int perm32(int rho) { const int n = rho >> 4, i = rho & 15; return 8 * (i >> 2) + 4 * n + (i & 3); }

struct Unit { int pm, pn; };
struct Gemm { const bf16_t* A; const bf16_t* Bt; int M, N, K, lda; };

struct StaticOrder {
    int nM, nN, nwg, G, c;
    __host__ __device__ void init(int M, int N, int G_, int c_) { nM = M / BM; nN = N / BM; nwg = nM * nN; G = G_; c = c_; }
    __host__ __device__ bool next(int i, Unit& u) const {
        const long L = (long)i * G + c; if (L >= nwg) return false;
        int wgid = (int)L; { const int q = nwg / NXCD, r = nwg % NXCD, xcd = wgid % NXCD, off = wgid / NXCD; wgid = (xcd < r ? xcd * (q + 1) : r * (q + 1) + (xcd - r) * q) + off; }
        const int nig = WGM * nN, gid = wgid / nig, fm = gid * WGM, gsz = (nM - fm) < WGM ? (nM - fm) : WGM;
        u.pm = fm + ((wgid % nig) % gsz); u.pn = (wgid % nig) / gsz; return true;
    }
    __device__ __forceinline__ void a_ready(const Unit&) const {}
    __device__ __forceinline__ void done(const Unit&) const {}
};

__device__ __forceinline__ unsigned cvt_pk_bf16(float lo, float hi) { unsigned r; asm volatile("v_cvt_pk_bf16_f32 %0, %1, %2" : "=v"(r) : "v"(lo), "v"(hi)); return r; }

__device__ __forceinline__ float bf_lo(unsigned u) { return __uint_as_float(u << 16); }
__device__ __forceinline__ float bf_hi(unsigned u) { return __uint_as_float(u & 0xffff0000u); }
__device__ __forceinline__ float sigmoid_f(float v) { return __builtin_amdgcn_rcpf(1.0f + __expf(-v)); }

struct EpiG1 {
    static constexpr bool PERM = true, AFTER_DRAIN = false;
    bf16_t* a2; bf16_t* rwin;
    __device__ __forceinline__ void operator()(const f32x4 (&acc)[2][2][4][2], const Unit& u, int wr, int wc, int fr, int fq) const {
        const int row0 = u.pm * BM + wr * 64 + fr; const int colt = u.pn * BM; const bool s5 = colt < 1024;
        const int col0 = colt + wc * 32 + 8 * fq;
#pragma unroll
        for (int ai = 0; ai < 2; ++ai)
#pragma unroll
            for (int m = 0; m < 4; ++m) { const int row = row0 + ai * HALF + m * 16;
#pragma unroll
                for (int bj = 0; bj < 2; ++bj) { const f32x4 v0 = acc[ai][bj][m][0], v1 = acc[ai][bj][m][1]; const int col = col0 + bj * HALF;
                    u32x4 w; w.x = cvt_pk_bf16(v0[0], v0[1]); w.y = cvt_pk_bf16(v0[2], v0[3]); w.z = cvt_pk_bf16(v1[0], v1[1]); w.w = cvt_pk_bf16(v1[2], v1[3]);
                    bf16_t* dst = s5 ? a2 + ((size_t)((col >> 4) * 2048 + (row >> 5)) * 768 + (row & 31) * 16 + (col & 15))
                                     : rwin + (size_t)row * 3328 + (col - 1024);
                    *(u32x4*)dst = w; } }
    }
};
template <int MODE> struct EpiMix {
    static constexpr bool PERM = true, AFTER_DRAIN = false;
    bf16_t* O; const bf16_t* S; const bf16_t* Add; int ld;
    __device__ __forceinline__ void operator()(const f32x4 (&acc)[2][2][4][2], const Unit& u, int wr, int wc, int fr, int fq) const {
        const int row0 = u.pm * BM + wr * 64 + fr, col0 = u.pn * BM + wc * 32 + 8 * fq;
#pragma unroll
        for (int ai = 0; ai < 2; ++ai)
#pragma unroll
            for (int m = 0; m < 4; ++m) {
#pragma unroll
                for (int bj = 0; bj < 2; ++bj) {
                    const size_t off = (size_t)(row0 + ai * HALF + m * 16) * ld + col0 + bj * HALF;
                    float v[8];
#pragma unroll
                    for (int j = 0; j < 4; ++j) { v[j] = acc[ai][bj][m][0][j]; v[4 + j] = acc[ai][bj][m][1][j]; }
                    if (MODE >= 1) {
                        const u32x4 s = *(const u32x4*)(S + off);
                        const float sv[8] = {bf_lo(s.x), bf_hi(s.x), bf_lo(s.y), bf_hi(s.y), bf_lo(s.z), bf_hi(s.z), bf_lo(s.w), bf_hi(s.w)};
#pragma unroll
                        for (int j = 0; j < 8; ++j) { const float sg = sigmoid_f(v[j]); v[j] = (MODE == 2) ? sv[j] * v[j] * sg : sv[j] * sg; }
                    }
                    if (MODE == 3) {
                        const u32x4 a = *(const u32x4*)(Add + off);
                        const float av[8] = {bf_lo(a.x), bf_hi(a.x), bf_lo(a.y), bf_hi(a.y), bf_lo(a.z), bf_hi(a.z), bf_lo(a.w), bf_hi(a.w)};
#pragma unroll
                        for (int j = 0; j < 8; ++j) v[j] += av[j];
                    }
                    u32x4 w; w.x = cvt_pk_bf16(v[0], v[1]); w.y = cvt_pk_bf16(v[2], v[3]); w.z = cvt_pk_bf16(v[4], v[5]); w.w = cvt_pk_bf16(v[6], v[7]);
                    *(u32x4*)(O + off) = w;
                }
            }
    }
};
struct EpiF32 {
    static constexpr bool PERM = false, AFTER_DRAIN = false;
    float* C; int ldc;
    __device__ __forceinline__ void operator()(const f32x4 (&acc)[2][2][4][2], const Unit& u, int wr, int wc, int fr, int fq) const {
        const int row0 = u.pm * BM + wr * 64 + fr, col0 = u.pn * BM + wc * 32 + 4 * fq;
#pragma unroll
        for (int ai = 0; ai < 2; ++ai)
#pragma unroll
            for (int m = 0; m < 4; ++m) { float* rowp = C + (size_t)(row0 + ai * HALF + m * 16) * ldc + col0;
#pragma unroll
                for (int bj = 0; bj < 2; ++bj)
#pragma unroll
                    for (int n = 0; n < 2; ++n) *(f32x4*)(rowp + bj * HALF + n * 16) = acc[ai][bj][m][n]; }
    }
};
template <class Epi, class Sched, bool ALIGN_EPI = false, bool SP2 = false>
__device__ __forceinline__ void gemm_phase(PG8_LAS unsigned char* lds, const Gemm g, const Sched& S, const Epi& E, const int mk_wave) {
    const int lane = mk_lane(), wid = mk_wave, tid = wid * 64 + lane, wr = wid >> 2, wc = wid & 3, fr = lane & 15, fq = lane >> 4;
    const int K = g.K, nt = K / BK;
    unsigned voffA[2], voffB[2];
#pragma unroll
    for (int i = 0; i < 2; ++i) { int R, C; stage_rc(tid * 16 + i * 8192, R, C); const int Rb = Epi::PERM ? ((R & ~31) + perm32(R & 31)) : R;
        voffA[i] = (unsigned)(R * g.lda + C) * 2u; voffB[i] = (unsigned)(Rb * K + C) * 2u; }
    const size_t kstep = (size_t)(BK * 2);
    const size_t hstep = (size_t)HALF * K * 2;
    const size_t tstep = 2 * hstep;
    const size_t hstepA = (size_t)HALF * g.lda * 2, tstepA = 2 * hstepA;
    const unsigned ldsw = (unsigned)wid * 1024u;
    const int aoff = lds_byte(wr * 64 + fr, fq * 8), boff = lds_byte(wc * 32 + fr, fq * 8);
#define PG8_SA(b, h) (((b) * 2 + (h)) * HTB)
#define PG8_SB(b, h) ((4 + (b) * 2 + (h)) * HTB)
#define PG8_STAGE(bufoff, gbase, voff) do { _Pragma("unroll") for (int _i = 0; _i < 2; ++_i) \
        __builtin_amdgcn_global_load_lds((const unsigned*)((const char*)(gbase) + (voff)[_i]), (PG8_LAS unsigned*)(lds + (bufoff) + ldsw + _i * 8192), 16, 0, 0); } while (0)
#define PG8_LDA(dst, b, h) do { _Pragma("unroll") for (int m = 0; m < 4; ++m) _Pragma("unroll") for (int k = 0; k < 2; ++k) dst[m][k] = *(const PG8_LAS bf16x8*)(lds + PG8_SA(b, h) + aoff + m * 2048 + k * 1024); } while (0)
#define PG8_LDB(dst, b, h) do { _Pragma("unroll") for (int n = 0; n < 2; ++n) _Pragma("unroll") for (int k = 0; k < 2; ++k) dst[n][k] = *(const PG8_LAS bf16x8*)(lds + PG8_SB(b, h) + boff + n * 2048 + k * 1024); } while (0)
#define PG8_MMA(ai, bj, At, Bt) do { __builtin_amdgcn_s_setprio(1); _Pragma("unroll") for (int m = 0; m < 4; ++m) _Pragma("unroll") for (int n = 0; n < 2; ++n) _Pragma("unroll") for (int k = 0; k < 2; ++k) \
        acc[ai][bj][m][n] = __builtin_amdgcn_mfma_f32_16x16x32_bf16(Bt[n][k], At[m][k], acc[ai][bj][m][n], 0, 0, 0); __builtin_amdgcn_s_setprio(0); } while (0)
#define PG8_WAIT_V(n) asm volatile("s_waitcnt vmcnt(" #n ")" ::: "memory")
#define PG8_WAIT_L(n) asm volatile("s_waitcnt lgkmcnt(" #n ")" ::: "memory")
#define PG8_BAR __builtin_amdgcn_s_barrier()
#define PG8_SCHED __builtin_amdgcn_sched_barrier(0)
    Unit cur, nxt; int ui = 0;
    if (!S.next(0, cur)) return;
    f32x4 acc[2][2][4][2];
#pragma unroll
    for (int a = 0; a < 2; ++a)
#pragma unroll
        for (int b = 0; b < 2; ++b)
#pragma unroll
            for (int m = 0; m < 4; ++m)
#pragma unroll
                for (int n = 0; n < 2; ++n) acc[a][b][m][n] = (f32x4){0.f, 0.f, 0.f, 0.f};
    bf16x8 At[4][2], B0[2][2], B1[2][2];
    const char* cA = (const char*)g.A + (size_t)cur.pm * tstepA; const char* cB = (const char*)g.Bt + (size_t)cur.pn * tstep;
    S.a_ready(cur);
    if constexpr (SP2) {
        PG8_STAGE(PG8_SB(0, 0), cB, voffB); PG8_STAGE(PG8_SB(0, 1), cB + hstep, voffB); PG8_STAGE(PG8_SA(0, 0), cA, voffA); PG8_STAGE(PG8_SA(0, 1), cA + hstepA, voffA);
        if (wr == 1) PG8_BAR;
        PG8_WAIT_V(2); PG8_BAR;
        PG8_STAGE(PG8_SB(1, 0), cB + kstep, voffB); PG8_STAGE(PG8_SA(1, 0), cA + kstep, voffA); PG8_STAGE(PG8_SB(1, 1), cB + hstep + kstep, voffB);
        PG8_WAIT_V(6); PG8_BAR;
    } else {
        PG8_STAGE(PG8_SB(0, 0), cB, voffB); PG8_STAGE(PG8_SA(0, 0), cA, voffA); PG8_STAGE(PG8_SB(0, 1), cB + hstep, voffB); PG8_STAGE(PG8_SA(0, 1), cA + hstepA, voffA);
        if (wr == 1) PG8_BAR;
        PG8_WAIT_V(4); PG8_BAR;
        PG8_STAGE(PG8_SB(1, 0), cB + kstep, voffB); PG8_STAGE(PG8_SA(1, 0), cA + kstep, voffA); PG8_STAGE(PG8_SB(1, 1), cB + hstep + kstep, voffB);
        PG8_WAIT_V(6); PG8_BAR;
    }
    for (;;) {
        const bool has_next = S.next(ui + 1, nxt);
        const char* nA = has_next ? (const char*)g.A + (size_t)nxt.pm * tstepA : cA; const char* nB = has_next ? (const char*)g.Bt + (size_t)nxt.pn * tstep : cB;
        for (int t = 0; t < nt; t += 2) {
            const bool last = (t == nt - 2);
            const char* a1 = cA + (size_t)(t + 1) * kstep;
            const char* a2 = last ? nA : cA + (size_t)(t + 2) * kstep; const char* b2 = last ? nB : cB + (size_t)(t + 2) * kstep;
            const char* a3 = a2 + kstep; const char* b3 = b2 + kstep;
            if (last && has_next) S.a_ready(nxt);
            if constexpr (SP2) {
            PG8_LDB(B0, 0, 0); PG8_LDB(B1, 0, 1); PG8_SCHED; PG8_LDA(At, 0, 0); PG8_STAGE(PG8_SA(1, 1), a1 + hstepA, voffA);
            PG8_WAIT_V(8); PG8_WAIT_L(0); PG8_BAR; PG8_MMA(0, 0, At, B0); PG8_MMA(0, 1, At, B1); PG8_BAR; PG8_SCHED;
            PG8_LDA(At, 0, 1); PG8_STAGE(PG8_SB(0, 0), b2, voffB); PG8_STAGE(PG8_SB(0, 1), b2 + hstep, voffB); PG8_STAGE(PG8_SA(0, 0), a2, voffA);
            PG8_WAIT_V(8); PG8_WAIT_L(0); PG8_BAR; PG8_MMA(1, 0, At, B0); PG8_MMA(1, 1, At, B1); PG8_BAR; PG8_SCHED;
            PG8_LDB(B0, 1, 0); PG8_LDB(B1, 1, 1); PG8_SCHED; PG8_LDA(At, 1, 0); PG8_STAGE(PG8_SA(0, 1), a2 + hstepA, voffA);
            PG8_WAIT_V(8); PG8_WAIT_L(0); PG8_BAR; PG8_MMA(0, 0, At, B0); PG8_MMA(0, 1, At, B1); PG8_BAR; PG8_SCHED;
            PG8_LDA(At, 1, 1); PG8_STAGE(PG8_SB(1, 0), b3, voffB); PG8_STAGE(PG8_SB(1, 1), b3 + hstep, voffB); PG8_STAGE(PG8_SA(1, 0), a3, voffA);
            PG8_WAIT_V(8); PG8_WAIT_L(0); PG8_BAR; PG8_MMA(1, 0, At, B0); PG8_MMA(1, 1, At, B1); PG8_BAR; PG8_SCHED;
            } else {
            PG8_LDB(B0, 0, 0); PG8_SCHED; PG8_LDA(At, 0, 0); PG8_STAGE(PG8_SA(1, 1), a1 + hstepA, voffA);
            PG8_WAIT_L(8); PG8_BAR; PG8_WAIT_L(0); PG8_MMA(0, 0, At, B0); PG8_BAR; PG8_SCHED;
            PG8_LDB(B1, 0, 1); PG8_STAGE(PG8_SB(0, 0), b2, voffB);
            PG8_BAR; PG8_WAIT_L(0); PG8_MMA(0, 1, At, B1); PG8_BAR;
            PG8_LDA(At, 0, 1); PG8_STAGE(PG8_SA(0, 0), a2, voffA);
            PG8_BAR; PG8_WAIT_L(0); PG8_MMA(1, 0, At, B0); PG8_BAR; PG8_SCHED;
            PG8_STAGE(PG8_SB(0, 1), b2 + hstep, voffB);
            PG8_WAIT_V(6); PG8_BAR; PG8_MMA(1, 1, At, B1); PG8_BAR;
            PG8_LDB(B0, 1, 0); PG8_SCHED; PG8_LDA(At, 1, 0); PG8_STAGE(PG8_SA(0, 1), a2 + hstepA, voffA);
            PG8_WAIT_L(8); PG8_BAR; PG8_WAIT_L(0); PG8_MMA(0, 0, At, B0); PG8_BAR; PG8_SCHED;
            PG8_LDB(B1, 1, 1); PG8_STAGE(PG8_SB(1, 0), b3, voffB);
            PG8_BAR; PG8_WAIT_L(0); PG8_MMA(0, 1, At, B1); PG8_BAR;
            PG8_LDA(At, 1, 1); PG8_STAGE(PG8_SA(1, 0), a3, voffA);
            PG8_BAR; PG8_WAIT_L(0); PG8_MMA(1, 0, At, B0); PG8_BAR; PG8_SCHED;
            PG8_STAGE(PG8_SB(1, 1), b3 + hstep, voffB);
            PG8_WAIT_V(6); PG8_BAR; PG8_MMA(1, 1, At, B1); PG8_BAR;
            }
        }
        if constexpr (ALIGN_EPI) { if (wr == 0) PG8_BAR; }
        if constexpr (!Epi::AFTER_DRAIN) { E(acc, cur, wr, wc, fr, fq); S.done(cur); }
        if (!has_next) break;
#pragma unroll
        for (int a = 0; a < 2; ++a)
#pragma unroll
            for (int b = 0; b < 2; ++b)
#pragma unroll
                for (int m = 0; m < 4; ++m)
#pragma unroll
                    for (int n = 0; n < 2; ++n) acc[a][b][m][n] = (f32x4){0.f, 0.f, 0.f, 0.f};
        cur = nxt; cA = nA; cB = nB; ++ui;
        if constexpr (ALIGN_EPI) { if (wr == 1) PG8_BAR; }
    }
    PG8_WAIT_V(0);
    if constexpr (!ALIGN_EPI) { if (wr == 0) PG8_BAR; }
    PG8_BAR;
    if constexpr (Epi::AFTER_DRAIN) { E.fused(acc, cur, wr, wc, fr, fq, lds, wid, lane); S.done(cur); }
#undef PG8_SA
#undef PG8_SB
#undef PG8_STAGE
#undef PG8_LDA
#undef PG8_LDB
#undef PG8_MMA
#undef PG8_WAIT_V
#undef PG8_WAIT_L
#undef PG8_BAR
#undef PG8_SCHED
}
}

#ifndef PG8_SP2
#define PG8_SP2 true
#endif
#ifndef PG8_ALIGN
#define PG8_ALIGN true
#endif

constexpr int NWAVES = 8;
constexpr int N_PHASES = 16;
#ifndef MK_N_LAUNCHES
#define MK_N_LAUNCHES 1
#endif
constexpr int N_LAUNCHES = MK_N_LAUNCHES;

constexpr int D = 2048, M = 65536, NIN = 10496;
constexpr int LP = 16384, LS = 2048;
constexpr int DS5 = 1024, DRW = 1024, DRWIN = 3328;
constexpr float RMS_EPS = 1e-6f, GN_EPS = 64e-5f, L2_EPS = 1e-12f;

constexpr size_t MiB = 1u << 20;
constexpr size_t WS_CTL = 0, CTL_ZERO_BYTES = 1 * MiB;
constexpr size_t WS_WT = 1 * MiB;
constexpr size_t WS_GLUT = 42 * MiB;
constexpr size_t WS_S5OT = 44 * MiB;
constexpr size_t WS_RWOT = 48 * MiB;
constexpr size_t WS_WOT = 52 * MiB;
constexpr size_t WS_HN = 60 * MiB;
constexpr size_t WS_RWIN = 316 * MiB;
constexpr size_t WS_Z = 732 * MiB;
constexpr size_t WS_LUT = 860 * MiB;
constexpr size_t WS_STATE = 862 * MiB;
constexpr size_t WS_S5TAB = 872 * MiB;
constexpr size_t WS_S5XL = 882 * MiB;
constexpr size_t WS_S5W2 = 946 * MiB;
constexpr size_t WS_S5E = 994 * MiB;
constexpr size_t WS_ZG = 882 * MiB;
constexpr size_t WS_END = 1010 * MiB;
constexpr size_t DO_YF = 0, DO_YB = 128 * MiB, DO_A2 = 256 * MiB, DO_INT = 256 * MiB, DO_Q = 256 * MiB;
constexpr int CW_BAR = 4096;

constexpr int LDS_BYTES = 147456;
constexpr int MISC_OFF = LDS_BYTES - 512;
constexpr int WAVE_SCR = 18176;
static_assert(NWAVES * WAVE_SCR <= MISC_OFF && pg8::STAGE_BYTES <= MISC_OFF, "LDS map");

#define GAS __attribute__((address_space(1)))
#define LAS __attribute__((address_space(3)))
typedef unsigned short bf16;
typedef unsigned v4u __attribute__((ext_vector_type(4)));
typedef unsigned v2u __attribute__((ext_vector_type(2)));
typedef float f32x4 __attribute__((ext_vector_type(4)));
#define LDS_WAIT() asm volatile("s_waitcnt lgkmcnt(0)" ::: "memory")
#define VM_WAIT() asm volatile("s_waitcnt vmcnt(0)" ::: "memory")
typedef __bf16 mk_bf2 __attribute__((ext_vector_type(2)));
typedef float mk_f2 __attribute__((ext_vector_type(2)));
__device__ __forceinline__ unsigned pk2(float lo, float hi) { const mk_f2 v = {lo, hi}; return __builtin_bit_cast(unsigned, __builtin_convertvector(v, mk_bf2)); }
__device__ __forceinline__ unsigned f2bf(float f) { return pk2(f, f) & 0xffffu; }
__device__ __forceinline__ float bf2f(bf16 b) { return __uint_as_float(((unsigned)b) << 16); }
__device__ __forceinline__ float blo(unsigned u) { return __uint_as_float(u << 16); }
__device__ __forceinline__ float bhi(unsigned u) { return __uint_as_float(u & 0xffff0000u); }
__device__ __forceinline__ float wave_sum(float v) {
#pragma unroll
    for (int o = 1; o < 64; o <<= 1) v += __shfl_xor(v, o);
    return v;
}
__device__ __forceinline__ float sigm(float v) { return __builtin_amdgcn_rcpf(1.0f + __expf(-v)); }
__device__ __forceinline__ float gelu_tanh(float x) { const float u = 0.7978845608028654f * (x + 0.044715f * x * x * x); return 0.5f * x * (1.0f + tanhf(u)); }

#define XB_TMO      128
#define XB_XCNT(j)  (256  + 64 * (j))
#define XB_XSUB(j)  (1280 + 64 * (j))
#define XB_XGEN(j)  (2304 + 64 * (j))
#define XB_TOP      3328
#define XB_TOPGEN   3392
#define XCD_BAR_WORDS 3456
#define XB_SPIN_CAP (1u << 18)

__device__ __forceinline__ unsigned xb_ld(unsigned* p)              { return __hip_atomic_load(p, __ATOMIC_RELAXED, __HIP_MEMORY_SCOPE_AGENT); }
__device__ __forceinline__ unsigned xb_add(unsigned* p, unsigned v) { return __hip_atomic_fetch_add(p, v, __ATOMIC_RELAXED, __HIP_MEMORY_SCOPE_AGENT); }
__device__ __forceinline__ unsigned xb_xcc_id() { return (unsigned)__builtin_amdgcn_s_getreg((3 << 11) | 20) & 0xFu; }
#define XB_SPIN(cond, bar) do { unsigned _sp = 0; while (cond) { __builtin_amdgcn_s_sleep(1); \
    if ((++_sp & 255u) == 0u) { if (xb_ld(&(bar)[XB_TMO])) break; if (_sp > XB_SPIN_CAP) { atomicAdd(&(bar)[XB_TMO], 1u); break; } } } } while (0)

struct XcdBarrier {
    unsigned* bar; unsigned x;
    volatile LAS unsigned* st;
};

__device__ __forceinline__ XcdBarrier xcd_barrier_post(unsigned* bar, volatile LAS unsigned* st, const int mk_wave) {
    XcdBarrier b; b.bar = bar; b.x = xb_xcc_id(); b.st = st;
    if (mk_wave == 0 && mk_lane() == 0) (void)xb_add(&bar[XB_XCNT(b.x)], 1u);
    return b;
}
__device__ __forceinline__ void xcd_barrier_complete(unsigned* bar, unsigned x, unsigned& nloc, unsigned& nx) {
    const unsigned G = gridDim.x * gridDim.y * gridDim.z;
    unsigned sum, cnt, mine, sp = 0u;
    for (;;) {
        sum = 0u; cnt = 0u; mine = 0u;
#pragma unroll
        for (unsigned j = 0; j < 16; ++j) { const unsigned c = xb_ld(&bar[XB_XCNT(j)]); sum += c; cnt += (c > 0u) ? 1u : 0u; mine = (j == x) ? c : mine; }
        if (sum == G) break;
        __builtin_amdgcn_s_sleep(1);
        if ((++sp & 255u) == 0u) { if (xb_ld(&bar[XB_TMO])) break; if (sp > XB_SPIN_CAP) { atomicAdd(&bar[XB_TMO], 1u); break; } }
    }
    nloc = mine > 0u ? mine : 1u; nx = cnt > 0u ? cnt : 1u;
}

__device__ __forceinline__ void xcd_barrier(const XcdBarrier& b, const int mk_wave) {
    asm volatile("s_waitcnt vmcnt(0)" ::: "memory");
    __syncthreads();
    if (mk_wave == 0 && mk_lane() == 0) {
        unsigned* bar = b.bar;
        __builtin_amdgcn_s_waitcnt(0);
        unsigned nloc = b.st[0], nx = b.st[1];
        if (nloc == 0u) { xcd_barrier_complete(bar, b.x, nloc, nx); b.st[0] = nloc; b.st[1] = nx; }
        const unsigned old = xb_add(&bar[XB_XSUB(b.x)], 1u);
        const unsigned gen = old / nloc;
        if (old + 1u == (gen + 1u) * nloc) {
            __builtin_amdgcn_fence(__ATOMIC_RELEASE, "agent");
            asm volatile("s_waitcnt vmcnt(0)" ::: "memory");
            const unsigned og = xb_add(&bar[XB_TOP], 1u);
            const unsigned tg = og / nx;
            if (og + 1u == (tg + 1u) * nx) xb_add(&bar[XB_TOPGEN], 1u);
            else XB_SPIN(xb_ld(&bar[XB_TOPGEN]) == tg, bar);
            __builtin_amdgcn_fence(__ATOMIC_ACQUIRE, "agent");
            xb_add(&bar[XB_XGEN(b.x)], 1u);
            asm volatile("s_waitcnt vmcnt(0)" ::: "memory");
        } else {
            XB_SPIN(xb_ld(&bar[XB_XGEN(b.x)]) == gen, bar);
            __builtin_amdgcn_fence(__ATOMIC_ACQUIRE, "agent");
            asm volatile("s_waitcnt vmcnt(0)" ::: "memory");
        }
    }
    __syncthreads();
}


struct Args { const float* in[27]; float* out; unsigned char* ws; int ph_lo, ph_hi, li, pad; };

namespace rwk {
typedef short s16x4 __attribute__((ext_vector_type(4)));
typedef short s16x8 __attribute__((ext_vector_type(8)));
constexpr int NSEG = 8;
constexpr int UNITS_PER_SEG = 4096;
constexpr int LDW = 72;
constexpr int MATB = 64 * LDW * 2;
constexpr int O_AB = 0, O_BT = 1 * MATB, O_KT = 2 * MATB, O_RB = 3 * MATB, O_BHT = 4 * MATB, O_KHT = 5 * MATB, O_VT = 6 * MATB;
constexpr int O_MAB = 7 * MATB, O_MAK = 8 * MATB, O_NRB = 9 * MATB, O_NRK = 10 * MATB, O_XT = 11 * MATB  , O_NP = 13 * MATB, O_GT = 14 * MATB;
constexpr int O_TW = O_XT, O_XA = O_XT + MATB;
constexpr int LDC = 68;
constexpr int O_CL = O_MAB, O_AS = O_MAB + 64 * LDC * 4;
constexpr int NPS = 24;
static_assert(O_AS + 64 * LDC * 4 <= O_XT && O_GT + 256 <= 146944, "rwkv LDS map");
constexpr size_t UNIT_ELEMS = 16384;

__device__ __forceinline__ f32x4 mfma32(s16x8 a, s16x8 b, f32x4 c) { return __builtin_amdgcn_mfma_f32_16x16x32_bf16(a, b, c, 0, 0, 0); }
__device__ __forceinline__ f32x4 mfma16(s16x4 a, s16x4 b, f32x4 c) { return __builtin_amdgcn_mfma_f32_16x16x16bf16_1k(a, b, c, 0, 0, 0); }
__device__ __forceinline__ s16x4 pack4(f32x4 v) { v2u p; p.x = pk2(v[0], v[1]); p.y = pk2(v[2], v[3]); return __builtin_bit_cast(s16x4, p); }
__device__ __forceinline__ f32x4 unpack4(v2u p) { return (f32x4){blo(p.x), bhi(p.x), blo(p.y), bhi(p.y)}; }
__device__ __forceinline__ void up8(v4u a, float (&o)[8]) { o[0] = blo(a.x); o[1] = bhi(a.x); o[2] = blo(a.y); o[3] = bhi(a.y); o[4] = blo(a.z); o[5] = bhi(a.z); o[6] = blo(a.w); o[7] = bhi(a.w); }
__device__ __forceinline__ v4u pk8(const float (&v)[8]) { v4u a; a.x = pk2(v[0], v[1]); a.y = pk2(v[2], v[3]); a.z = pk2(v[4], v[5]); a.w = pk2(v[6], v[7]); return a; }

constexpr int O_MU = 131072;
static_assert(O_MU + 3328 * 4 <= 146944, "rwkv LDS map (mu)");
__device__ __forceinline__ int swz_chunk(int row, int tc) { return (row * LDW + ((tc ^ ((row >> 3) & 7)) << 3)) * 2; }
__device__ __forceinline__ float tanh_fast(float x) { return 1.0f - 2.0f * __builtin_amdgcn_rcpf(1.0f + __expf(2.0f * x)); }
struct RawUnit { v4u cur[5], prv[5], nxt[5]; f32x4 kk0, kk1, ka0, ka1; s16x8 lb0, lb1; float bias; };
struct UnitId { int h, d, base, L, gchunk, chain; };
__device__ __forceinline__ UnitId decode_unit(int seg, int u) {
    UnitId o; int c, jc, nch;
    if (u < 2048) { c = u >> 5; jc = u & 31; nch = 32; } else { c = 64 + ((u - 2048) >> 2); jc = (u - 2048) & 3; nch = 4; }
    int s, rem; if (c < 64) { s = c >> 5; rem = c & 31; } else { s = 2 + ((c - 64) >> 5); rem = (c - 64) & 31; }
    o.h = rem >> 1; o.d = rem & 1; o.base = s < 2 ? s * LP : 32768 + (s - 2) * LS; o.L = s < 2 ? LP : LS; o.gchunk = seg * nch + jc; o.chain = c;
    return o;
}
__device__ __forceinline__ int unit_of(int chain, int jc) { return chain < 64 ? chain * 32 + jc : 2048 + (chain - 64) * 4 + jc; }

__device__ __forceinline__ void rw_load_unit(const Args& a, unsigned char* ws, int seg, int u, int wave, int lane, RawUnit& R) {
    const UnitId id = decode_unit(seg, u);
    const int h = id.h, d = id.d, tid = wave * 64 + lane, t = tid >> 3, cg = tid & 7, c8 = h * 64 + 8 * cg;
    const int lp = 64 * id.gchunk + t, pos = d ? id.L - 1 - lp : lp;
    const bf16* prow = (const bf16*)(ws + WS_RWIN) + (size_t)(id.base + pos) * DRWIN;
    const bool hp = pos > 0, hn = pos < id.L - 1;
    const v4u z4 = (v4u){0u, 0u, 0u, 0u};
#pragma unroll
    for (int comp = 0; comp < 5; ++comp) {
        const int col = comp < 3 ? comp * 1024 + c8 : (comp == 3 ? 3072 + d * 64 + 8 * cg : 3200 + d * 64 + 8 * cg);
        R.cur[comp] = *(const v4u*)(prow + col);
        R.prv[comp] = hp ? *(const v4u*)(prow - DRWIN + col) : z4;
        R.nxt[comp] = hn ? *(const v4u*)(prow + DRWIN + col) : z4;
    }
    R.kk0 = *(const f32x4*)(a.in[20] + c8); R.kk1 = *(const f32x4*)(a.in[20] + c8 + 4);
    R.ka0 = *(const f32x4*)(a.in[21] + c8); R.ka1 = *(const f32x4*)(a.in[21] + c8 + 4);
    const int r = lane & 15, g = lane >> 4, ct = wave & 3, role = wave >> 2;
    const bf16* lut = (const bf16*)(ws + WS_LUT) + ((size_t)((role * 2 + d) * 16 + h) * 64 + 16 * ct + r) * 64 + 8 * g;
    R.lb0 = *(const s16x8*)(lut); R.lb1 = *(const s16x8*)(lut + 32);
    R.bias = (role ? a.in[18] : a.in[16])[d * 1024 + h * 64 + 16 * ct + r];
}
__device__ __forceinline__ void rw_precompute_unit(const Args& a, unsigned char* ws, LAS unsigned char* lds, int seg, int u, int wave, int lane, const RawUnit& R) {
    const UnitId id = decode_unit(seg, u);
    const int h = id.h, d = id.d;
    const int tid = wave * 64 + lane;
    const int r = lane & 15, g = lane >> 4;
    const int t = tid >> 3, cg = tid & 7, c8 = h * 64 + 8 * cg;
    float zr[8], zk[8], kk[8], zv[8];
    {
        const LAS float* mu = (const LAS float*)(lds + O_MU);
        float zw[8], za[8];
#pragma unroll
        for (int comp = 0; comp < 5; ++comp) {
            const int col = comp < 3 ? comp * 1024 + c8 : (comp == 3 ? 3072 + d * 64 + 8 * cg : 3200 + d * 64 + 8 * cg);
            float cc[8], pp[8], nn[8];
            up8(R.cur[comp], cc); up8(R.prv[comp], pp); up8(R.nxt[comp], nn);
            const f32x4 m0 = *(const LAS f32x4*)(mu + col), m1 = *(const LAS f32x4*)(mu + col + 4);
            const float mv[8] = {m0[0], m0[1], m0[2], m0[3], m1[0], m1[1], m1[2], m1[3]};
#pragma unroll
            for (int j = 0; j < 8; ++j) {
                const float zz = cc[j] + (0.5f * (pp[j] + nn[j]) - cc[j]) * mv[j];
                if (comp == 0) zr[j] = zz; else if (comp == 1) zk[j] = zz; else if (comp == 2) zv[j] = zz; else if (comp == 3) zw[j] = tanh_fast(zz); else za[j] = zz;
            }
        }
        float ss = 0.f;
        const float kkw[8] = {R.kk0[0], R.kk0[1], R.kk0[2], R.kk0[3], R.kk1[0], R.kk1[1], R.kk1[2], R.kk1[3]};
#pragma unroll
        for (int j = 0; j < 8; ++j) { kk[j] = zk[j] * kkw[j]; ss += kk[j] * kk[j]; }
        ss += __shfl_xor(ss, 1); ss += __shfl_xor(ss, 2); ss += __shfl_xor(ss, 4);
        const float inv = __builtin_amdgcn_rsqf(ss + L2_EPS);
#pragma unroll
        for (int j = 0; j < 8; ++j) kk[j] *= inv;
        *(LAS v4u*)(lds + O_TW + (t * LDW + 8 * cg) * 2) = pk8(zw);
        *(LAS v4u*)(lds + O_XA + (t * LDW + 8 * cg) * 2) = pk8(za);
    }
    __syncthreads();
    {
        const int ct = wave & 3, role = wave >> 2;
        const s16x8 b0 = R.lb0, b1 = R.lb1;
        const int aoff = (role ? O_XA : O_TW) + (r * LDW + 8 * g) * 2;
        f32x4 acc[4];
#pragma unroll
        for (int mt = 0; mt < 4; ++mt) {
            const s16x8 a0 = *(const LAS s16x8*)(lds + aoff + mt * 16 * LDW * 2), a1 = *(const LAS s16x8*)(lds + aoff + mt * 16 * LDW * 2 + 64);
            acc[mt] = mfma32(a0, b0, (f32x4){0.f, 0.f, 0.f, 0.f}); acc[mt] = mfma32(a1, b1, acc[mt]);
        }
        const int cch = 16 * ct + r;
        if (role == 0) {
            const float w0v = R.bias;
            float carry = 0.f;
#pragma unroll
            for (int mt = 0; mt < 4; ++mt) {
                float s[4];
#pragma unroll
                for (int i = 0; i < 4; ++i) { const float lw = -0.6065306597126334f * sigm(acc[mt][i] + w0v); s[i] = (i ? s[i - 1] : 0.f) + lw; }
                const float tot = s[3];
                const float e1 = __shfl(tot, (lane + 48) & 63), e2 = __shfl(tot, (lane + 32) & 63), e3 = __shfl(tot, (lane + 16) & 63);
                const float excl = (g >= 1 ? e1 : 0.f) + (g >= 2 ? e2 : 0.f) + (g >= 3 ? e3 : 0.f);
                const float all = __shfl(tot + excl, 48 + r);
#pragma unroll
                for (int i = 0; i < 4; ++i) *(LAS float*)(lds + O_CL + ((16 * mt + 4 * g + i) * LDC + cch) * 4) = carry + excl + s[i];
                carry += all;
            }
        } else {
            const float a0v = R.bias;
#pragma unroll
            for (int mt = 0; mt < 4; ++mt)
#pragma unroll
                for (int i = 0; i < 4; ++i) *(LAS float*)(lds + O_AS + ((16 * mt + 4 * g + i) * LDC + cch) * 4) = sigm(acc[mt][i] + a0v);
        }
    }
    __syncthreads();
    {
        float cl[8], clp[8], cle[8], as[8];
        { const f32x4 x0 = *(const LAS f32x4*)(lds + O_CL + (t * LDC + 8 * cg) * 4), x1 = *(const LAS f32x4*)(lds + O_CL + (t * LDC + 8 * cg + 4) * 4);
          const f32x4 e0 = *(const LAS f32x4*)(lds + O_CL + (63 * LDC + 8 * cg) * 4), e1 = *(const LAS f32x4*)(lds + O_CL + (63 * LDC + 8 * cg + 4) * 4);
          const f32x4 s0 = *(const LAS f32x4*)(lds + O_AS + (t * LDC + 8 * cg) * 4), s1 = *(const LAS f32x4*)(lds + O_AS + (t * LDC + 8 * cg + 4) * 4);
          f32x4 p0 = (f32x4){0.f, 0.f, 0.f, 0.f}, p1 = p0;
          if (t > 0) { p0 = *(const LAS f32x4*)(lds + O_CL + ((t - 1) * LDC + 8 * cg) * 4); p1 = *(const LAS f32x4*)(lds + O_CL + ((t - 1) * LDC + 8 * cg + 4) * 4); }
#pragma unroll
          for (int j = 0; j < 4; ++j) { cl[j] = x0[j]; cl[4 + j] = x1[j]; cle[j] = e0[j]; cle[4 + j] = e1[j]; as[j] = s0[j]; as[4 + j] = s1[j]; clp[j] = p0[j]; clp[4 + j] = p1[j]; } }
        const float kaw[8] = {R.ka0[0], R.ka0[1], R.ka0[2], R.ka0[3], R.ka1[0], R.ka1[1], R.ka1[2], R.ka1[3]};
        float ab[8], bt[8], kt[8], rb[8], bh[8], kh[8];
#pragma unroll
        for (int j = 0; j < 8; ++j) {
            const float gt = __expf(cl[j]), gi = __expf(-cl[j]), gp = __expf(clp[j]), ge = __expf(cle[j] - cl[j]);
            const float kd = zk[j] * (1.0f + (as[j] - 1.0f) * kaw[j]), kb = kk[j] * as[j];
            ab[j] = -kk[j] * gp; bt[j] = kb * gi; kt[j] = kd * gi; rb[j] = zr[j] * gt; bh[j] = kb * ge; kh[j] = kd * ge;
            if (t == 63) *(LAS float*)(lds + O_GT + (8 * cg + j) * 4) = __expf(cle[j]);
        }
        *(LAS v4u*)(lds + O_AB + (t * LDW + 8 * cg) * 2) = pk8(ab);
        *(LAS v4u*)(lds + O_BT + (t * LDW + 8 * cg) * 2) = pk8(bt);
        *(LAS v4u*)(lds + O_KT + (t * LDW + 8 * cg) * 2) = pk8(kt);
        *(LAS v4u*)(lds + O_RB + (t * LDW + 8 * cg) * 2) = pk8(rb);
#pragma unroll
        for (int j = 0; j < 8; ++j) {
            const int so = swz_chunk(8 * cg + j, t >> 3) + (t & 7) * 2;
            *(LAS bf16*)(lds + O_BHT + so) = (bf16)f2bf(bh[j]);
            *(LAS bf16*)(lds + O_KHT + so) = (bf16)f2bf(kh[j]);
            *(LAS bf16*)(lds + O_VT + so) = (bf16)f2bf(zv[j]);
        }
    }
    __syncthreads();
    {
        const int nt = wave >> 1, pr = wave & 1;
        const int boff = ((16 * nt + r) * LDW + 8 * g) * 2;
        const s16x8 ab0 = *(const LAS s16x8*)(lds + O_AB + boff), ab1 = *(const LAS s16x8*)(lds + O_AB + boff + 64);
        const s16x8 rb0 = *(const LAS s16x8*)(lds + O_RB + boff), rb1 = *(const LAS s16x8*)(lds + O_RB + boff + 64);
        const int asrc = (pr ? O_KT : O_BT) + (r * LDW + 8 * g) * 2;
        const int tt = 16 * nt + r;
#pragma unroll
        for (int mt = 0; mt < 4; ++mt) {
            const s16x8 x0 = *(const LAS s16x8*)(lds + asrc + mt * 16 * LDW * 2), x1 = *(const LAS s16x8*)(lds + asrc + mt * 16 * LDW * 2 + 64);
            f32x4 m = mfma32(x0, ab0, (f32x4){0.f, 0.f, 0.f, 0.f}); m = mfma32(x1, ab1, m);
            f32x4 n = mfma32(x0, rb0, (f32x4){0.f, 0.f, 0.f, 0.f}); n = mfma32(x1, rb1, n);
#pragma unroll
            for (int i = 0; i < 4; ++i) { const int j = 16 * mt + 4 * g + i; m[i] = j < tt ? m[i] : 0.f; n[i] = j <= tt ? n[i] : 0.f; }
            const int so = (tt * LDW + 16 * mt + 4 * g) * 2;
            *(LAS s16x4*)(lds + (pr ? O_MAK : O_MAB) + so) = pack4(m);
            *(LAS s16x4*)(lds + (pr ? O_NRK : O_NRB) + so) = pack4(n);
        }
    }
    __syncthreads();
    f32x4 rhs[4];
    if (wave < 4) {
        const int bi = wave;
        const s16x4 aN = *(const LAS s16x4*)(lds + O_MAB + ((16 * bi + r) * LDW + 16 * bi + 4 * g) * 2);
        s16x4 bN;
#pragma unroll
        for (int i = 0; i < 4; ++i) bN[i] = *(const LAS short*)(lds + O_MAB + ((16 * bi + 4 * g + i) * LDW + 16 * bi + r) * 2);
        f32x4 c2 = mfma16(aN, bN, (f32x4){0.f, 0.f, 0.f, 0.f});
        const int npb = O_NP + bi * 3 * 16 * NPS * 2;
#pragma unroll
        for (int p = 0; p < 3; ++p) {
#pragma unroll
            for (int i = 0; i < 4; ++i) *(LAS bf16*)(lds + npb + p * 16 * NPS * 2 + ((4 * g + i) * NPS + r) * 2) = (bf16)f2bf(c2[i]);
            LDS_WAIT();
            if (p < 2) { const s16x4 aP = *(const LAS s16x4*)(lds + npb + p * 16 * NPS * 2 + (r * NPS + 4 * g) * 2); c2 = mfma16(aP, pack4(c2), (f32x4){0.f, 0.f, 0.f, 0.f}); }
        }
#pragma unroll
        for (int mt = 0; mt < 4; ++mt)
#pragma unroll
            for (int i = 0; i < 4; ++i) rhs[mt][i] = bf2f(*(const LAS bf16*)(lds + O_AB + ((16 * mt + 4 * g + i) * LDW + 16 * wave + r) * 2));
    } else {
        const int vt = wave - 4;
        const s16x8 v0 = *(const LAS s16x8*)(lds + O_VT + swz_chunk(16 * vt + r, g)), v1 = *(const LAS s16x8*)(lds + O_VT + swz_chunk(16 * vt + r, g + 4));
#pragma unroll
        for (int mt = 0; mt < 4; ++mt) {
            const int ao = O_MAK + ((16 * mt + r) * LDW + 8 * g) * 2;
            const s16x8 x0 = *(const LAS s16x8*)(lds + ao), x1 = *(const LAS s16x8*)(lds + ao + 64);
            rhs[mt] = mfma32(x0, v0, (f32x4){0.f, 0.f, 0.f, 0.f}); rhs[mt] = mfma32(x1, v1, rhs[mt]);
        }
    }
    __syncthreads();
    {
        f32x4 xb[4];
#pragma unroll
        for (int bi = 0; bi < 4; ++bi) {
            f32x4 acc = rhs[bi];
#pragma unroll
            for (int bj = 0; bj < 4; ++bj) if (bj < bi) {
                const s16x4 am = *(const LAS s16x4*)(lds + O_MAB + ((16 * bi + r) * LDW + 16 * bj + 4 * g) * 2);
                acc = mfma16(am, pack4(xb[bj]), acc);
            }
#pragma unroll
            for (int p = 0; p < 4; ++p) {
                const s16x4 ap = p == 0 ? *(const LAS s16x4*)(lds + O_MAB + ((16 * bi + r) * LDW + 16 * bi + 4 * g) * 2)
                                        : *(const LAS s16x4*)(lds + O_NP + (bi * 3 + (p - 1)) * 16 * NPS * 2 + (r * NPS + 4 * g) * 2);
                acc = mfma16(ap, pack4(acc), acc);
            }
            xb[bi] = acc;
            *(LAS s16x4*)(lds + O_XT + ((16 * wave + r) * LDW + 16 * bi + 4 * g) * 2) = pack4(acc);
        }
    }
    __syncthreads();
    {
        const int nt = wave & 3;
        bf16* ug = (bf16*)((unsigned char*)a.out + DO_INT) + (size_t)u * UNIT_ELEMS;
        const int boff = ((16 * nt + r) * LDW + 8 * g) * 2;
        if (wave < 4) {
            const s16x8 bh0 = *(const LAS s16x8*)(lds + O_BHT + swz_chunk(16 * nt + r, g)), bh1 = *(const LAS s16x8*)(lds + O_BHT + swz_chunk(16 * nt + r, g + 4));
            const s16x8 nb0 = *(const LAS s16x8*)(lds + O_NRB + boff), nb1 = *(const LAS s16x8*)(lds + O_NRB + boff + 64);
            v2u po[4], ro[4];
#pragma unroll
            for (int mt = 0; mt < 4; ++mt) {
                const int ao = O_XT + ((16 * mt + r) * LDW + 8 * g) * 2;
                const s16x8 x0 = *(const LAS s16x8*)(lds + ao), x1 = *(const LAS s16x8*)(lds + ao + 64);
                f32x4 p = mfma32(x0, bh0, (f32x4){0.f, 0.f, 0.f, 0.f}); p = mfma32(x1, bh1, p);
                if (mt == nt) { const float gt = *(const LAS float*)(lds + O_GT + (16 * mt + r) * 4);
#pragma unroll
                    for (int i = 0; i < 4; ++i) p[i] += (4 * g + i == r) ? gt : 0.f; }
                const f32x4 rbv = unpack4(*(const LAS v2u*)(lds + O_RB + ((16 * nt + r) * LDW + 16 * mt + 4 * g) * 2));
                f32x4 q = mfma32(x0, nb0, rbv); q = mfma32(x1, nb1, q);
                po[mt] = __builtin_bit_cast(v2u, pack4(p)); ro[mt] = __builtin_bit_cast(v2u, pack4(q));
            }
            v4u* pg = (v4u*)(ug + (size_t)(nt * 64 + lane) * 16);
            pg[0] = (v4u){po[0].x, po[0].y, po[1].x, po[1].y}; pg[1] = (v4u){po[2].x, po[2].y, po[3].x, po[3].y};
            v4u* rg = (v4u*)(ug + 4096 + (size_t)(nt * 64 + lane) * 16);
            rg[0] = (v4u){ro[0].x, ro[0].y, ro[1].x, ro[1].y}; rg[1] = (v4u){ro[2].x, ro[2].y, ro[3].x, ro[3].y};
        } else {
            const s16x8 u0 = *(const LAS s16x8*)(lds + O_XT + 64 * LDW * 2 + boff), u1 = *(const LAS s16x8*)(lds + O_XT + 64 * LDW * 2 + boff + 64);
            const s16x8 v0 = *(const LAS s16x8*)(lds + O_VT + swz_chunk(16 * nt + r, g)), v1 = *(const LAS s16x8*)(lds + O_VT + swz_chunk(16 * nt + r, g + 4));
            v2u qo[4], yo[4];
#pragma unroll
            for (int mt = 0; mt < 4; ++mt) {
                const int ro_ = ((16 * mt + r) * LDW + 8 * g) * 2;
                const int sw0 = swz_chunk(16 * mt + r, g), sw1 = swz_chunk(16 * mt + r, g + 4);
                const s16x8 b0 = *(const LAS s16x8*)(lds + O_BHT + sw0), b1 = *(const LAS s16x8*)(lds + O_BHT + sw1);
                const s16x8 k0 = *(const LAS s16x8*)(lds + O_KHT + sw0), k1 = *(const LAS s16x8*)(lds + O_KHT + sw1);
                f32x4 q = mfma32(b0, u0, (f32x4){0.f, 0.f, 0.f, 0.f}); q = mfma32(b1, u1, q); q = mfma32(k0, v0, q); q = mfma32(k1, v1, q);
                const s16x8 n0 = *(const LAS s16x8*)(lds + O_NRB + ro_), n1 = *(const LAS s16x8*)(lds + O_NRB + ro_ + 64);
                const s16x8 m0 = *(const LAS s16x8*)(lds + O_NRK + ro_), m1 = *(const LAS s16x8*)(lds + O_NRK + ro_ + 64);
                f32x4 y = mfma32(n0, u0, (f32x4){0.f, 0.f, 0.f, 0.f}); y = mfma32(n1, u1, y); y = mfma32(m0, v0, y); y = mfma32(m1, v1, y);
                qo[mt] = __builtin_bit_cast(v2u, pack4(q)); yo[mt] = __builtin_bit_cast(v2u, pack4(y));
            }
            v4u* qg = (v4u*)(ug + 8192 + (size_t)(nt * 64 + lane) * 16);
            qg[0] = (v4u){qo[0].x, qo[0].y, qo[1].x, qo[1].y}; qg[1] = (v4u){qo[2].x, qo[2].y, qo[3].x, qo[3].y};
            v4u* yg = (v4u*)(ug + 12288 + (size_t)(nt * 64 + lane) * 16);
            yg[0] = (v4u){yo[0].x, yo[0].y, yo[1].x, yo[1].y}; yg[1] = (v4u){yo[2].x, yo[2].y, yo[3].x, yo[3].y};
        }
    }
    __syncthreads();
}

__device__ __forceinline__ void rw_chain_job(const Args& a, unsigned char* ws, LAS unsigned char* wlds, int seg, int chain, int vt, int lane) {
    int s, rem; if (chain < 64) { s = chain >> 5; rem = chain & 31; } else { s = 2 + ((chain - 64) >> 5); rem = (chain - 64) & 31; }
    const int h = rem >> 1, d = rem & 1, base = s < 2 ? s * LP : 32768 + (s - 2) * LS, L = s < 2 ? LP : LS, nch = chain < 64 ? 32 : 4;
    const int r = lane & 15, g = lane >> 4;
    f32x4* stp = (f32x4*)(ws + WS_STATE) + ((size_t)(chain * 4 + vt) * 4) * 64 + lane;
    f32x4 st[4];
#pragma unroll
    for (int i = 0; i < 4; ++i) st[i] = seg == 0 ? (f32x4){0.f, 0.f, 0.f, 0.f} : stp[i * 64];
    bf16* Y = (bf16*)((unsigned char*)a.out + (d ? DO_YB : DO_YF));
    const bf16* ub = (const bf16*)((unsigned char*)a.out + DO_INT);
#define RW_DMA(ug) do { _Pragma("unroll") for (int _i = 0; _i < 16; ++_i) \
        __builtin_amdgcn_global_load_lds((const unsigned*)((ug) + (size_t)((_i >> 1) * 64 + lane) * 16 + (_i & 1) * 8), (LAS unsigned*)(wlds + _i * 1024), 16, 0, 0); } while (0)
    v4u qf0, qf1, yf0, yf1;
    { const bf16* ug = ub + (size_t)unit_of(chain, 0) * UNIT_ELEMS;
      RW_DMA(ug);
      const v4u* qp = (const v4u*)(ug + 8192 + (size_t)(vt * 64 + lane) * 16); qf0 = qp[0]; qf1 = qp[1];
      const v4u* yp = (const v4u*)(ug + 12288 + (size_t)(vt * 64 + lane) * 16); yf0 = yp[0]; yf1 = yp[1]; }
    for (int jc = 0; jc < nch; ++jc) {
        if (jc == 0) VM_WAIT(); else asm volatile("s_waitcnt vmcnt(16)" ::: "memory");
        v4u pf[4][2], rf[4][2];
#pragma unroll
        for (int i = 0; i < 4; ++i) { pf[i][0] = *(const LAS v4u*)(wlds + (2 * i) * 1024 + lane * 16); pf[i][1] = *(const LAS v4u*)(wlds + (2 * i + 1) * 1024 + lane * 16);
                                      rf[i][0] = *(const LAS v4u*)(wlds + (8 + 2 * i) * 1024 + lane * 16); rf[i][1] = *(const LAS v4u*)(wlds + (9 + 2 * i) * 1024 + lane * 16); }
        LDS_WAIT();
        const v4u cq0 = qf0, cq1 = qf1, cy0 = yf0, cy1 = yf1;
        if (jc + 1 < nch) {
            const bf16* ug = ub + (size_t)unit_of(chain, jc + 1) * UNIT_ELEMS;
            RW_DMA(ug);
            const v4u* qp = (const v4u*)(ug + 8192 + (size_t)(vt * 64 + lane) * 16); qf0 = qp[0]; qf1 = qp[1];
            const v4u* yp = (const v4u*)(ug + 12288 + (size_t)(vt * 64 + lane) * 16); yf0 = yp[0]; yf1 = yp[1];
        }
        s16x4 sb[4];
#pragma unroll
        for (int kt = 0; kt < 4; ++kt) sb[kt] = pack4(st[kt]);
        const int gchunk = seg * nch + jc;
#pragma unroll
        for (int tt = 0; tt < 4; ++tt) {
            const v2u yi = tt == 0 ? (v2u){cy0.x, cy0.y} : tt == 1 ? (v2u){cy0.z, cy0.w} : tt == 2 ? (v2u){cy1.x, cy1.y} : (v2u){cy1.z, cy1.w};
            f32x4 acc = unpack4(yi);
            acc = mfma16(__builtin_bit_cast(s16x4, (v2u){rf[tt][0].x, rf[tt][0].y}), sb[0], acc);
            acc = mfma16(__builtin_bit_cast(s16x4, (v2u){rf[tt][0].z, rf[tt][0].w}), sb[1], acc);
            acc = mfma16(__builtin_bit_cast(s16x4, (v2u){rf[tt][1].x, rf[tt][1].y}), sb[2], acc);
            acc = mfma16(__builtin_bit_cast(s16x4, (v2u){rf[tt][1].z, rf[tt][1].w}), sb[3], acc);
#pragma unroll
            for (int i = 0; i < 4; ++i) { const int lp = 64 * gchunk + 16 * tt + 4 * g + i, pos = d ? L - 1 - lp : lp;
                Y[(size_t)(base + pos) * DRW + h * 64 + 16 * vt + r] = (bf16)f2bf(acc[i]); }
        }
        f32x4 sn[4];
#pragma unroll
        for (int i = 0; i < 4; ++i) {
            const v2u qi = i == 0 ? (v2u){cq0.x, cq0.y} : i == 1 ? (v2u){cq0.z, cq0.w} : i == 2 ? (v2u){cq1.x, cq1.y} : (v2u){cq1.z, cq1.w};
            f32x4 acc = unpack4(qi);
            acc = mfma16(__builtin_bit_cast(s16x4, (v2u){pf[i][0].x, pf[i][0].y}), sb[0], acc);
            acc = mfma16(__builtin_bit_cast(s16x4, (v2u){pf[i][0].z, pf[i][0].w}), sb[1], acc);
            acc = mfma16(__builtin_bit_cast(s16x4, (v2u){pf[i][1].x, pf[i][1].y}), sb[2], acc);
            acc = mfma16(__builtin_bit_cast(s16x4, (v2u){pf[i][1].z, pf[i][1].w}), sb[3], acc);
            sn[i] = acc;
        }
#pragma unroll
        for (int i = 0; i < 4; ++i) st[i] = sn[i];
    }
#undef RW_DMA
#pragma unroll
    for (int i = 0; i < 4; ++i) stp[i * 64] = st[i];
}
}


namespace s5k {
constexpr int ST = 32, NCH = M / ST, K2 = 768, KU = 512;
constexpr size_t POW_ELEMS = (size_t)128 * 33 * 64 * 2, BB_ELEMS = (size_t)128 * 64 * 16 * 2, KTAB_ELEMS = (size_t)64 * 63 * 256;
__device__ __forceinline__ void tables_group(const Args& a, unsigned char* ws, LAS unsigned char* lds, int g, int tid) {
    float* POW = (float*)(ws + WS_S5TAB); float* BB = POW + POW_ELEMS; float* KTAB = BB + BB_ELEMS;
    LAS float* lam = (LAS float*)lds;
    LAS float* bbl = lam + 256;
    LAS float* cl = bbl + 4096;
    LAS float* pwl = cl + 4096;
    if (tid < 128) {
        const int d = tid >> 6, p = tid & 63, gi = d * 64 + g;
        const float lre = a.in[5][gi * 64 + p], lim = a.in[6][gi * 64 + p], dt = expf(a.in[7][gi]);
        const float er = expf(lre * dt); float sn, cs; sincosf(lim * dt, &sn, &cs);
        const float lbr = er * cs, lbi = er * sn;
        const float nr = lbr - 1.0f, ni = lbi, den = lre * lre + lim * lim;
        const float cfr = (nr * lre + ni * lim) / den, cfi = (ni * lre - nr * lim) / den;
        lam[(d * 64 + p) * 2] = lre * dt; lam[(d * 64 + p) * 2 + 1] = lim * dt;
        for (int h = 0; h < 16; ++h) {
            const float br = a.in[8][((size_t)gi * 64 + p) * 16 + h], bi = a.in[9][((size_t)gi * 64 + p) * 16 + h];
            const float xr = cfr * br - cfi * bi, xi = cfr * bi + cfi * br;
            bbl[((d * 64 + p) * 16 + h) * 2] = xr; bbl[((d * 64 + p) * 16 + h) * 2 + 1] = xi;
            BB[(((size_t)gi * 64 + p) * 16 + h) * 2] = xr; BB[(((size_t)gi * 64 + p) * 16 + h) * 2 + 1] = xi;
            cl[((d * 16 + h) * 64 + p) * 2] = a.in[10][((size_t)gi * 16 + h) * 64 + p]; cl[((d * 16 + h) * 64 + p) * 2 + 1] = a.in[11][((size_t)gi * 16 + h) * 64 + p];
        }
    }
    __syncthreads();
    for (int e = tid; e < 2 * 33 * 64; e += NWAVES * 64) {
        const int p = e & 63, tau = (e >> 6) % 33, d = e / (33 * 64), gi = d * 64 + g;
        const float er = expf(lam[(d * 64 + p) * 2] * (float)tau); float sn, cs; sincosf(lam[(d * 64 + p) * 2 + 1] * (float)tau, &sn, &cs);
        pwl[e * 2] = er * cs; pwl[e * 2 + 1] = er * sn;
        POW[(((size_t)gi * 33 + tau) * 64 + p) * 2] = er * cs; POW[(((size_t)gi * 33 + tau) * 64 + p) * 2 + 1] = er * sn;
    }
    __syncthreads();
    for (int o = tid; o < 63 * 256; o += NWAVES * 64) {
        const int hh = o & 255, h = hh >> 4, h2 = hh & 15, lag = (o >> 8) - 31;
        float acc = 0.f;
#pragma unroll
        for (int d = 0; d < 2; ++d) {
            if ((d == 0 && lag >= 0) || (d == 1 && lag <= 0)) {
                const int tau = lag >= 0 ? lag : -lag;
                for (int p = 0; p < 64; ++p) {
                    const float cr = cl[((d * 16 + h) * 64 + p) * 2], ci = cl[((d * 16 + h) * 64 + p) * 2 + 1];
                    const float pr = pwl[((d * 33 + tau) * 64 + p) * 2], pi = pwl[((d * 33 + tau) * 64 + p) * 2 + 1];
                    const float br = bbl[((d * 64 + p) * 16 + h2) * 2], bi = bbl[((d * 64 + p) * 16 + h2) * 2 + 1];
                    const float qr = pr * br - pi * bi, qi = pr * bi + pi * br;
                    acc += cr * qr - ci * qi;
                }
            }
        }
        KTAB[(size_t)g * 63 * 256 + o] = acc;
    }
    __syncthreads();
}
__device__ __forceinline__ void fill_weights(const Args& a, unsigned char* ws, int gw, int NGW, int lane) {
    const float* POW = (const float*)(ws + WS_S5TAB); const float* BB = POW + POW_ELEMS; const float* KTAB = BB + BB_ELEMS;
    bf16* W2 = (bf16*)(ws + WS_S5W2); bf16* E = (bf16*)(ws + WS_S5E);
    const size_t n_w2 = (size_t)64 * 512 * 96, n_e = (size_t)64 * 256 * 64, stride = (size_t)NGW * 64;
    for (size_t it = (size_t)gw * 64 + lane; it < n_w2 + n_e; it += stride) {
        float v[8];
        if (it < n_w2) {
            const int kc = (int)(it % 96), n = (int)((it / 96) % 512), g = (int)(it / (96 * 512)), t = n >> 4, h = n & 15, k0 = kc * 8;
            if (k0 < KU) {
                const int s = k0 >> 4, h0 = k0 & 15, lag = t - s;
                const float* kt = KTAB + ((size_t)(g * 63 + lag + 31) * 16 + h) * 16 + h0;
#pragma unroll
                for (int j = 0; j < 8; ++j) v[j] = kt[j] + ((lag == 0 && h0 + j == h) ? a.in[12][g * 16 + h] : 0.f);
            } else {
                const int kk = k0 - KU, d = kk >> 7, ri = (kk >> 6) & 1, p0 = kk & 63, gi = d * 64 + g, tau = d == 0 ? t + 1 : ST - t;
#pragma unroll
                for (int j = 0; j < 8; ++j) {
                    const int p = p0 + j;
                    const float cr = a.in[10][((size_t)gi * 16 + h) * 64 + p], ci = a.in[11][((size_t)gi * 16 + h) * 64 + p];
                    const float pr = POW[(((size_t)gi * 33 + tau) * 64 + p) * 2], pi = POW[(((size_t)gi * 33 + tau) * 64 + p) * 2 + 1];
                    v[j] = ri == 0 ? (cr * pr - ci * pi) : -(cr * pi + ci * pr);
                }
            }
            *(v4u*)(W2 + ((size_t)(g * 512 + n)) * K2 + k0) = rwk::pk8(v);
        } else {
            const size_t ie = it - n_w2;
            const int kc = (int)(ie % 64), n = (int)((ie / 64) % 256), g = (int)(ie / (64 * 256)), d = n >> 7, ri = (n >> 6) & 1, p = n & 63, gi = d * 64 + g;
            const int k0 = kc * 8, s = k0 >> 4, h0 = k0 & 15, tau = d == 0 ? ST - 1 - s : s;
            const float pr = POW[(((size_t)gi * 33 + tau) * 64 + p) * 2], pi = POW[(((size_t)gi * 33 + tau) * 64 + p) * 2 + 1];
#pragma unroll
            for (int j = 0; j < 8; ++j) {
                const float br = BB[(((size_t)gi * 64 + p) * 16 + h0 + j) * 2], bi = BB[(((size_t)gi * 64 + p) * 16 + h0 + j) * 2 + 1];
                v[j] = ri == 0 ? (pr * br - pi * bi) : (pr * bi + pi * br);
            }
            *(v4u*)(E + ((size_t)(g * 256 + n)) * KU + k0) = rwk::pk8(v);
        }
    }
}
__device__ __forceinline__ void chain_job(unsigned char* ws, bf16* A2, int job, int lane) {
    int s, rem; if (job < 256) { s = job / 128; rem = job % 128; } else { s = 2 + (job - 256) / 128; rem = (job - 256) % 128; }
    const int g = rem >> 1, d = rem & 1, p = lane, gi = d * 64 + g;
    const int c0 = s < 2 ? s * (LP / ST) : 2 * (LP / ST) + (s - 2) * (LS / ST), nc = s < 2 ? LP / ST : LS / ST;
    const float* POW = (const float*)(ws + WS_S5TAB);
    const float lr = POW[(((size_t)gi * 33 + 32) * 64 + p) * 2], li = POW[(((size_t)gi * 33 + 32) * 64 + p) * 2 + 1];
    const bf16* XL = (const bf16*)(ws + WS_S5XL);
    const int step = d ? -1 : 1, cfirst = d ? c0 + nc - 1 : c0;
    const int xcol = d * 128 + p, scol = KU + d * 128 + p;
    float xr = 0.f, xi = 0.f;
    { bf16* row = A2 + ((size_t)g * NCH + cfirst) * K2 + scol; row[0] = 0; row[64] = 0; }
    for (int n = 0; n < nc; n += 8) {
        float lr_[8], li_[8];
#pragma unroll
        for (int j = 0; j < 8; ++j) { const bf16* xrow = XL + ((size_t)g * NCH + cfirst + (n + j) * step) * 256 + xcol; lr_[j] = bf2f(xrow[0]); li_[j] = bf2f(xrow[64]); }
#pragma unroll
        for (int j = 0; j < 8; ++j) {
            const float nr = lr * xr - li * xi + lr_[j], ni = lr * xi + li * xr + li_[j]; xr = nr; xi = ni;
            if (n + j + 1 < nc) { bf16* row = A2 + ((size_t)g * NCH + cfirst + (n + j + 1) * step) * K2 + scol; row[0] = (bf16)f2bf(xr); row[64] = (bf16)f2bf(xi); }
        }
    }
}
}
namespace pg8 {
struct S5Order {
    int G, c, nun, mode;
    __device__ bool next(int i, Unit& u) const {
        const int L = i * G + c; if (L >= nun) return false;
        if (mode == 1) { u.pm = L; u.pn = L >> 3; } else { const int g = L >> 4; u.pm = g * 8 + ((L & 15) >> 1); u.pn = g * 2 + (L & 1); }
        return true;
    }
    __device__ __forceinline__ void a_ready(const Unit&) const {}
    __device__ __forceinline__ void done(const Unit&) const {}
};
struct EpiS5X {
    static constexpr bool PERM = true, AFTER_DRAIN = false;
    bf16_t* O;
    __device__ __forceinline__ void operator()(const f32x4 (&acc)[2][2][4][2], const Unit& u, int wr, int wc, int fr, int fq) const {
        const int row0 = u.pm * BM + wr * 64 + fr, col0 = wc * 32 + 8 * fq;
#pragma unroll
        for (int ai = 0; ai < 2; ++ai)
#pragma unroll
            for (int m = 0; m < 4; ++m) { bf16_t* rowp = O + (size_t)(row0 + ai * HALF + m * 16) * 256 + col0;
#pragma unroll
                for (int bj = 0; bj < 2; ++bj) { const f32x4 v0 = acc[ai][bj][m][0], v1 = acc[ai][bj][m][1];
                    u32x4 w; w.x = cvt_pk_bf16(v0[0], v0[1]); w.y = cvt_pk_bf16(v0[2], v0[3]); w.z = cvt_pk_bf16(v1[0], v1[1]); w.w = cvt_pk_bf16(v1[2], v1[3]);
                    *(u32x4*)(rowp + bj * HALF) = w; } }
    }
};
struct EpiS5Y {
    static constexpr bool PERM = true, AFTER_DRAIN = false;
    bf16_t* Zp;
    __device__ __forceinline__ void operator()(const f32x4 (&acc)[2][2][4][2], const Unit& u, int wr, int wc, int fr, int fq) const {
        const int row0 = u.pm * BM + wr * 64 + fr, col0 = (u.pn & 1) * BM + wc * 32 + 8 * fq;
#pragma unroll
        for (int ai = 0; ai < 2; ++ai)
#pragma unroll
            for (int m = 0; m < 4; ++m) {
                const int row = row0 + ai * HALF + m * 16, g = row >> 11, c = row & 2047;
#pragma unroll
                for (int bj = 0; bj < 2; ++bj) {
                    const int col = col0 + bj * HALF, t = col >> 4, h0 = col & 15;
                    float v[8];
#pragma unroll
                    for (int j = 0; j < 4; ++j) { v[j] = acc[ai][bj][m][0][j]; v[4 + j] = acc[ai][bj][m][1][j]; }
#pragma unroll
                    for (int j = 0; j < 8; ++j) { const float x = v[j]; v[j] = x * sigmoid_f(1.5957691216057308f * (x + 0.044715f * x * x * x)); }
                    u32x4 w; w.x = cvt_pk_bf16(v[0], v[1]); w.y = cvt_pk_bf16(v[2], v[3]); w.z = cvt_pk_bf16(v[4], v[5]); w.w = cvt_pk_bf16(v[6], v[7]);
                    *(u32x4*)(Zp + (size_t)(c * 32 + t) * 1024 + g * 16 + h0) = w;
                }
            }
    }
};
}


__device__ __forceinline__ void transpose_item(const float* W, int ldw, int K, bf16* WT, int drow0, LAS float* scr, int k0, int n0, int lane) {
#pragma unroll 8
    for (int i = 0; i < 32; ++i) { const int kk = 2 * i + (lane >> 5); scr[kk * 33 + (lane & 31)] = W[(size_t)(k0 + kk) * ldw + n0 + (lane & 31)]; }
    LDS_WAIT();
    const int c = lane & 7;
#pragma unroll
    for (int j = 0; j < 4; ++j) { const int n = (lane >> 3) + 8 * j; const LAS float* s = scr + (8 * c) * 33 + n;
        v4u o; o.x = pk2(s[0 * 33], s[1 * 33]); o.y = pk2(s[2 * 33], s[3 * 33]); o.z = pk2(s[4 * 33], s[5 * 33]); o.w = pk2(s[6 * 33], s[7 * 33]);
        *(v4u*)(WT + (size_t)(drow0 + n) * K + k0 + 8 * c) = o; }
    LDS_WAIT();
}
__device__ __forceinline__ int win_dest_row(int n) { return n < 1024 ? n : (n < 2048 ? n + 3328 : (n < 5376 ? n - 1024 : n)); }
__device__ __forceinline__ const float* xrow_ptr(const float* xp, const float* xs, int m) { return m < 32768 ? xp + (size_t)m * D : xs + (size_t)(m - 32768) * D; }

__device__ __forceinline__ void p0_prologue(const Args& a, unsigned char* ws, LAS unsigned char* lds, int gw, int NGW, int wave, int lane) {
    LAS float* scr = (LAS float*)(lds + wave * 16384);
    constexpr int I_IN = (D / 64) * (NIN / 32), I_GLU = (1024 / 64) * (1024 / 32), I_SO = (1024 / 64) * (2048 / 32), I_WO = (2048 / 64) * (2048 / 32);
    constexpr int NITEMS = I_IN + I_GLU + 2 * I_SO + I_WO;
    for (int it = gw; it < NITEMS; it += NGW) {
        int r = it;
        if (r < I_IN) { const int nblk = NIN / 32, kb = r / nblk, nb = r % nblk; transpose_item(a.in[4], NIN, D, (bf16*)(ws + WS_WT), win_dest_row(32 * nb), scr, 64 * kb, 32 * nb, lane); continue; } r -= I_IN;
        if (r < I_GLU) { const int nblk = 1024 / 32, kb = r / nblk, nb = r % nblk; transpose_item(a.in[13], 1024, 1024, (bf16*)(ws + WS_GLUT), 32 * nb, scr, 64 * kb, 32 * nb, lane); continue; } r -= I_GLU;
        if (r < I_SO) { const int nblk = 2048 / 32, kb = r / nblk, nb = r % nblk; transpose_item(a.in[14], 2048, 1024, (bf16*)(ws + WS_S5OT), 32 * nb, scr, 64 * kb, 32 * nb, lane); continue; } r -= I_SO;
        if (r < I_SO) { const int nblk = 2048 / 32, kb = r / nblk, nb = r % nblk; transpose_item(a.in[25], 2048, 1024, (bf16*)(ws + WS_RWOT), 32 * nb, scr, 64 * kb, 32 * nb, lane); continue; } r -= I_SO;
        { const int nblk = 2048 / 32, kb = r / nblk, nb = r % nblk; transpose_item(a.in[26], 2048, 2048, (bf16*)(ws + WS_WOT), 32 * nb, scr, 64 * kb, 32 * nb, lane); }
    }
    { const int bxx = gw / NWAVES; if (bxx < 64) s5k::tables_group(a, ws, lds, bxx, wave * 64 + lane); }
    { bf16* LUT = (bf16*)(ws + WS_LUT);
      for (int e = gw * 64 + lane; e < 4 * 16 * 64 * 64; e += NGW * 64) {
          const int j = e & 63, c = (e >> 6) & 63, h = (e >> 12) & 15, rd = e >> 16, role = rd >> 1, d = rd & 1;
          LUT[e] = (bf16)f2bf((role ? a.in[19] : a.in[17])[(size_t)(d * 64 + j) * 1024 + h * 64 + c]); } }
    const float* g = a.in[2];
    f32x4 gv[8];
#pragma unroll
    for (int j = 0; j < 8; ++j) gv[j] = ((const f32x4*)g)[lane + 64 * j];
    bf16* HN = (bf16*)(ws + WS_HN);
    for (int m = gw; m < M; m += NGW) {
        const f32x4* xr = (const f32x4*)xrow_ptr(a.in[0], a.in[1], m) + lane;
        f32x4 v[8]; float s = 0.f;
#pragma unroll
        for (int j = 0; j < 8; ++j) { v[j] = xr[64 * j]; s += (v[j].x * v[j].x + v[j].y * v[j].y) + (v[j].z * v[j].z + v[j].w * v[j].w); }
        const float rstd = 1.0f / sqrtf(wave_sum(s) * (1.0f / D) + RMS_EPS);
        v2u* o8 = (v2u*)(HN + (size_t)m * D) + lane;
#pragma unroll
        for (int j = 0; j < 8; ++j) { v2u o; o.x = pk2(v[j].x * rstd * gv[j].x, v[j].y * rstd * gv[j].y); o.y = pk2(v[j].z * rstd * gv[j].z, v[j].w * rstd * gv[j].w); o8[64 * j] = o; }
    }
}

__device__ __forceinline__ void unpack8(const bf16* p, float (&o)[8]) {
    const v4u a = *(const v4u*)p;
    o[0] = blo(a.x); o[1] = bhi(a.x); o[2] = blo(a.y); o[3] = bhi(a.y); o[4] = blo(a.z); o[5] = bhi(a.z); o[6] = blo(a.w); o[7] = bhi(a.w);
}
__device__ __forceinline__ void pack8(bf16* p, const float (&v)[8]) {
    v4u a; a.x = pk2(v[0], v[1]); a.y = pk2(v[2], v[3]); a.z = pk2(v[4], v[5]); a.w = pk2(v[6], v[7]); *(v4u*)p = a;
}
__device__ __forceinline__ void p3_finalize(const Args& a, unsigned char* ws, int gw, int NGW, int lane) {
    const bf16* RWIN = (const bf16*)(ws + WS_RWIN);
    unsigned char* ob = (unsigned char*)a.out;
    bf16* YF = (bf16*)(ob + DO_YF); const bf16* YB = (const bf16*)(ob + DO_YB);
    const int half = gw & 1, c0 = half * 512 + lane * 8;
    float lnw[8], lnb[8], rk[8], mur[8], muk[8], muv[8];
#pragma unroll
    for (int j = 0; j < 8; ++j) { lnw[j] = a.in[23][c0 + j]; lnb[j] = a.in[24][c0 + j]; rk[j] = a.in[22][c0 + j]; mur[j] = a.in[15][c0 + j]; muk[j] = a.in[15][1024 + c0 + j]; muv[j] = a.in[15][2048 + c0 + j]; }
    for (int m = gw >> 1; m < M; m += NGW >> 1) {
        const int t = m < 32768 ? (m & (LP - 1)) : ((m - 32768) & (LS - 1)), L = m < 32768 ? LP : LS;
        const bool hp = t > 0, hn = t < L - 1;
        float o[8];
        float y[8];
        {
            float yf[8], yb[8];
            unpack8(YF + (size_t)m * DRW + c0, yf); unpack8(YB + (size_t)m * DRW + c0, yb);
#pragma unroll
            for (int j = 0; j < 8; ++j) y[j] = yf[j] + yb[j];
        }
        float s1 = 0.f;
#pragma unroll
        for (int j = 0; j < 8; ++j) s1 += y[j];
        s1 += __shfl_xor(s1, 1); s1 += __shfl_xor(s1, 2); s1 += __shfl_xor(s1, 4);
        const float mean = s1 * (1.0f / 64.0f);
        float s2 = 0.f;
#pragma unroll
        for (int j = 0; j < 8; ++j) { const float dd = y[j] - mean; s2 += dd * dd; }
        s2 += __shfl_xor(s2, 1); s2 += __shfl_xor(s2, 2); s2 += __shfl_xor(s2, 4);
        const float rstd = 1.0f / sqrtf(s2 * (1.0f / 64.0f) + GN_EPS);
        float zr[8], zk[8], zv[8];
        const bf16* pc = RWIN + (size_t)m * DRWIN + c0;
#pragma unroll
        for (int comp = 0; comp < 3; ++comp) {
            float cc[8], pp[8], nn[8];
            unpack8(pc + comp * 1024, cc);
            if (hp) unpack8(pc - DRWIN + comp * 1024, pp); else {
#pragma unroll
                for (int j = 0; j < 8; ++j) pp[j] = 0.f; }
            if (hn) unpack8(pc + DRWIN + comp * 1024, nn); else {
#pragma unroll
                for (int j = 0; j < 8; ++j) nn[j] = 0.f; }
#pragma unroll
            for (int j = 0; j < 8; ++j) {
                const float muc = comp == 0 ? mur[j] : (comp == 1 ? muk[j] : muv[j]);
                const float zz = cc[j] + (0.5f * (pp[j] + nn[j]) - cc[j]) * muc;
                if (comp == 0) zr[j] = zz; else if (comp == 1) zk[j] = zz; else zv[j] = zz;
            }
        }
        float dot = 0.f;
#pragma unroll
        for (int j = 0; j < 8; ++j) dot += zr[j] * zk[j] * rk[j];
        dot += __shfl_xor(dot, 1); dot += __shfl_xor(dot, 2); dot += __shfl_xor(dot, 4);
#pragma unroll
        for (int j = 0; j < 8; ++j) o[j] = (y[j] - mean) * rstd * lnw[j] + lnb[j] + dot * zv[j];
        pack8(YF + (size_t)m * DRW + c0, o);
    }
}

__device__ __forceinline__ void p12_final(const Args& a, int gw, int NGW, int lane) {
    const float* g = a.in[3];
    f32x4 gv[8];
#pragma unroll
    for (int j = 0; j < 8; ++j) gv[j] = ((const f32x4*)g)[lane + 64 * j];
    for (int m = gw; m < M; m += NGW) {
        const f32x4* xr = (const f32x4*)xrow_ptr(a.in[0], a.in[1], m) + lane;
        f32x4* orow = (f32x4*)(a.out + (size_t)m * D) + lane;
        f32x4 v[8]; float s = 0.f;
#pragma unroll
        for (int j = 0; j < 8; ++j) { v[j] = orow[64 * j]; s += (v[j].x * v[j].x + v[j].y * v[j].y) + (v[j].z * v[j].z + v[j].w * v[j].w); }
        const float rstd = 1.0f / sqrtf(wave_sum(s) * (1.0f / D) + RMS_EPS);
#pragma unroll
        for (int j = 0; j < 8; ++j) { const f32x4 xv = xr[64 * j]; orow[64 * j] = xv + v[j] * rstd * gv[j]; }
    }
}

__global__ void __launch_bounds__(NWAVES * 64, 2) mk_fwd(Args args) {
    extern __shared__ __attribute__((aligned(16))) unsigned char lds_raw[];
    LAS unsigned char* lds = (LAS unsigned char*)lds_raw;
    volatile LAS unsigned* MISC = (volatile LAS unsigned*)(lds + MISC_OFF);
    const int wave = __builtin_amdgcn_readfirstlane((int)threadIdx.x >> 6);
#define lane mk_lane()
    const int tid0 = threadIdx.x;
    const int G = gridDim.x; const int bx = blockIdx.x; const int vcu = (G % 8 == 0) ? (bx % 8) * (G / 8) + bx / 8 : bx;
    unsigned char* ws = args.ws;
    unsigned* ctl = (unsigned*)(ws + WS_CTL);
    for (int u = tid0; u < (LDS_BYTES - MISC_OFF) / 4; u += NWAVES * 64) ((LAS unsigned*)(lds + MISC_OFF))[u] = 0u;
    __syncthreads();
    XcdBarrier bar = xcd_barrier_post(ctl + CW_BAR, MISC + 8, wave);
#define GRID_BAR() xcd_barrier(bar, wave)
#ifndef ONLY_PHASE
#define ONLY_PHASE -1
#endif
#define IN(k) (ONLY_PHASE < 0 || ONLY_PHASE == (k))
    const int gw = vcu * NWAVES + wave, NGW = G * NWAVES;
    bf16* WT = (bf16*)(ws + WS_WT); bf16* HN = (bf16*)(ws + WS_HN); bf16* RWIN = (bf16*)(ws + WS_RWIN); bf16* Z = (bf16*)(ws + WS_Z); bf16* ZG = (bf16*)(ws + WS_ZG);
    bf16* A2 = (bf16*)((unsigned char*)args.out + DO_A2);
    bf16* YN = (bf16*)((unsigned char*)args.out + DO_YF); bf16* Q = (bf16*)((unsigned char*)args.out + DO_Q); bf16* P = RWIN;

    if (IN(0)) { p0_prologue(args, ws, lds, gw, NGW, wave, lane); GRID_BAR(); }
    if (IN(1)) {
        s5k::fill_weights(args, ws, gw, NGW, lane);
        pg8::Gemm g{HN, WT, M, 4352, D, D}; pg8::StaticOrder S; S.init(M, 4352, G, bx);
        pg8::EpiG1 E{A2, RWIN};
        pg8::gemm_phase<pg8::EpiG1, pg8::StaticOrder, PG8_ALIGN, PG8_SP2>(lds, g, S, E, wave);
        GRID_BAR();
    }
    if (IN(2)) {
        pg8::Gemm g{A2, (const bf16*)(ws + WS_S5E), 131072, 256, s5k::KU, s5k::K2}; pg8::S5Order S{G, bx, 512, 1};
        pg8::EpiS5X E{(bf16*)(ws + WS_S5XL)};
        pg8::gemm_phase<pg8::EpiS5X, pg8::S5Order, PG8_ALIGN, PG8_SP2>(lds, g, S, E, wave);
        GRID_BAR();
    }
    if (IN(3)) {
        const int gwt = wave * G + vcu;
        for (int j = gwt; j < 2304; j += NGW) s5k::chain_job(ws, A2, j, lane);
        GRID_BAR();
    }
    if (IN(4)) {
        pg8::Gemm g{A2, (const bf16*)(ws + WS_S5W2), 131072, 512, s5k::K2, s5k::K2}; pg8::S5Order S{G, bx, 1024, 2};
        pg8::EpiS5Y E{Z};
        pg8::gemm_phase<pg8::EpiS5Y, pg8::S5Order, PG8_ALIGN, PG8_SP2>(lds, g, S, E, wave);
        GRID_BAR();
    }
    if (IN(5)) {
        for (int e = tid0; e < 3328; e += NWAVES * 64) ((LAS float*)(lds + rwk::O_MU))[e] = args.in[15][e];
        __syncthreads();
        for (int seg = 0; seg < rwk::NSEG; ++seg) {
            {
                rwk::RawUnit R;
                if (bx < rwk::UNITS_PER_SEG) rwk::rw_load_unit(args, ws, seg, bx, wave, lane, R);
                for (int u = bx; u < rwk::UNITS_PER_SEG; u += G) {
                    rwk::RawUnit Rn;
                    rwk::rw_load_unit(args, ws, seg, u + G < rwk::UNITS_PER_SEG ? u + G : u, wave, lane, Rn);
                    rwk::rw_precompute_unit(args, ws, lds, seg, u, wave, lane, R);
                    R = Rn;
                }
            }
            GRID_BAR();
            {
                int J, Jstride;
                if (bx < 64 && wave < 4) { J = bx * 4 + wave; Jstride = 1 << 20; }
                else { const int fw = bx < 64 ? bx * 4 + (wave - 4) : 256 + (bx - 64) * 8 + wave; J = 256 + fw; Jstride = 1792; }
                for (; J < 2304; J += Jstride) {
                    const int chain = J < 256 ? (J >> 2) : 64 + ((J - 256) >> 2), vt = J & 3;
                    rwk::rw_chain_job(args, ws, lds + wave * 16384, seg, chain, vt, lane);
                }
            }
            GRID_BAR();
        }
    }
    if (IN(6)) { p3_finalize(args, ws, gw, NGW, lane); GRID_BAR(); }
    if (IN(7)) {
        pg8::Gemm g{Z, (const bf16*)(ws + WS_GLUT), M, 1024, 1024, 1024}; pg8::StaticOrder S; S.init(M, 1024, G, bx);
        pg8::EpiMix<1> E{ZG, Z, nullptr, 1024};
        pg8::gemm_phase<pg8::EpiMix<1>, pg8::StaticOrder, PG8_ALIGN, PG8_SP2>(lds, g, S, E, wave);
    }
    if (IN(8)) {
        pg8::Gemm g{HN, WT + (size_t)4352 * D, M, 1024, D, D}; pg8::StaticOrder S; S.init(M, 1024, G, bx);
        pg8::EpiMix<2> E{ZG, ZG, nullptr, 1024};
        pg8::gemm_phase<pg8::EpiMix<2>, pg8::StaticOrder, PG8_ALIGN, PG8_SP2>(lds, g, S, E, wave);
    }
    if (IN(9)) {
        pg8::Gemm g{HN, WT + (size_t)5376 * D, M, 1024, D, D}; pg8::StaticOrder S; S.init(M, 1024, G, bx);
        pg8::EpiMix<2> E{YN, YN, nullptr, 1024};
        pg8::gemm_phase<pg8::EpiMix<2>, pg8::StaticOrder, PG8_ALIGN, PG8_SP2>(lds, g, S, E, wave);
        GRID_BAR();
    }
    if (IN(10)) {
        pg8::Gemm g{ZG, (const bf16*)(ws + WS_S5OT), M, 2048, 1024, 1024}; pg8::StaticOrder S; S.init(M, 2048, G, bx);
        pg8::EpiMix<0> E{P, nullptr, nullptr, 2048};
        pg8::gemm_phase<pg8::EpiMix<0>, pg8::StaticOrder, PG8_ALIGN, PG8_SP2>(lds, g, S, E, wave);
    }
    if (IN(11)) {
        pg8::Gemm g{HN, WT + (size_t)6400 * D, M, 2048, D, D}; pg8::StaticOrder S; S.init(M, 2048, G, bx);
        pg8::EpiMix<1> E{P, P, nullptr, 2048};
        pg8::gemm_phase<pg8::EpiMix<1>, pg8::StaticOrder, PG8_ALIGN, PG8_SP2>(lds, g, S, E, wave);
    }
    if (IN(12)) {
        pg8::Gemm g{YN, (const bf16*)(ws + WS_RWOT), M, 2048, 1024, 1024}; pg8::StaticOrder S; S.init(M, 2048, G, bx);
        pg8::EpiMix<0> E{Q, nullptr, nullptr, 2048};
        pg8::gemm_phase<pg8::EpiMix<0>, pg8::StaticOrder, PG8_ALIGN, PG8_SP2>(lds, g, S, E, wave);
    }
    if (IN(13)) {
        pg8::Gemm g{HN, WT + (size_t)8448 * D, M, 2048, D, D}; pg8::StaticOrder S; S.init(M, 2048, G, bx);
        pg8::EpiMix<3> E{P, Q, P, 2048};
        pg8::gemm_phase<pg8::EpiMix<3>, pg8::StaticOrder, PG8_ALIGN, PG8_SP2>(lds, g, S, E, wave);
        GRID_BAR();
    }
    if (IN(14)) {
        pg8::Gemm g{P, (const bf16*)(ws + WS_WOT), M, 2048, D, D}; pg8::StaticOrder S; S.init(M, 2048, G, bx);
        pg8::EpiF32 E{args.out, 2048};
        pg8::gemm_phase<pg8::EpiF32, pg8::StaticOrder, PG8_ALIGN, PG8_SP2>(lds, g, S, E, wave);
        GRID_BAR();
    }
    if (IN(15)) { p12_final(args, gw, NGW, lane); }
#undef IN
#undef lane
}

extern "C" void kernel_launch(void* const* d_in, const int* in_sizes, int n_in, void* d_out, int out_size, void* d_ws, size_t ws_size, hipStream_t stream) {
    static int grid = 0;
    if (grid == 0) {
        if (n_in != 27 || out_size != 2 * 32768 * D || ws_size < WS_END) { fprintf(stderr, "kernel_launch: unexpected shapes (n_in %d out %d ws %zu)\n", n_in, out_size, ws_size); grid = -1; return; }
        int dev = 0, cus = 0, per_cu = 0;
        if (hipGetDevice(&dev) != hipSuccess || hipDeviceGetAttribute(&cus, hipDeviceAttributeMultiprocessorCount, dev) != hipSuccess) { grid = -1; return; }
        if (hipFuncSetAttribute((const void*)mk_fwd, hipFuncAttributeMaxDynamicSharedMemorySize, LDS_BYTES) != hipSuccess) { fprintf(stderr, "kernel_launch: hipFuncSetAttribute failed\n"); grid = -1; return; }
        if (hipOccupancyMaxActiveBlocksPerMultiprocessor(&per_cu, (const void*)mk_fwd, NWAVES * 64, LDS_BYTES) != hipSuccess || per_cu < 1)
            fprintf(stderr, "kernel_launch: note: occupancy query reports %d workgroups per CU\n", per_cu);
        (void)hipGetLastError();
        grid = cus;
    }
    if (grid < 0) return;
    if (hipMemsetAsync((char*)d_ws + WS_CTL, 0, CTL_ZERO_BYTES, stream) != hipSuccess) return;
    Args a{};
    for (int i = 0; i < 27; ++i) a.in[i] = (const float*)d_in[i];
    a.out = (float*)d_out; a.ws = (unsigned char*)d_ws; a.pad = 0;
    { const int li = 0; a.ph_lo = 0; a.ph_hi = N_PHASES; a.li = 0;
        hipLaunchKernelGGL(mk_fwd, dim3(grid), dim3(NWAVES * 64), LDS_BYTES, stream, a);
        const hipError_t le = hipPeekAtLastError();
        if (le != hipSuccess) { fprintf(stderr, "kernel_launch: launch %d failed: %s\n", li, hipGetErrorName(le)); }
    }
}
```

```cpp
#include <hip/hip_runtime.h>
#include <cstdio>
#include <cstdint>
#define MK_N_LAUNCHES 1
__device__ __forceinline__ int mk_lane() { int l; asm volatile("v_mbcnt_lo_u32_b32 %0, -1, 0\n\tv_mbcnt_hi_u32_b32 %0, -1, %0" : "=v"(l)); return l; }
namespace pg8 {
#define PG8_LAS __attribute__((address_space(3)))
typedef unsigned short bf16_t;
typedef short bf16x8 __attribute__((ext_vector_type(8)));
typedef float f32x4 __attribute__((ext_vector_type(4)));
typedef unsigned u32x4 __attribute__((ext_vector_type(4)));
constexpr int BM = 256, BK = 64, HALF = 128, HTB = HALF * BK * 2  , STAGE_BYTES = 8 * HTB, NXCD = 8, WGM = 8;

__host__ __device__ __forceinline__ int lds_byte(int r, int c) { const int st = (r >> 4) * 2 + (c >> 5), rr = r & 15, cc = c & 31, ob = rr * 64 + cc * 2; return st * 1024 + (ob ^ (((ob >> 9) & 1) << 5)); }
__host__ __device__ __forceinline__ void stage_rc(int b, int& R, int& C) { const int st = b / 1024, sb = b % 1024, swz = sb ^ (((sb >> 9) & 1) << 5); R = (st >> 1) * 16 + swz / 64; C = (st & 1) * 32 + (swz % 64) / 2; }
__host__ __device__ __forceinline__ int perm32(int rho) { const int n = rho >> 4, i = rho & 15; return 8 * (i >> 2) + 4 * n + (i & 3); }

struct Unit { int pm, pn; };
struct Gemm { const bf16_t* A; const bf16_t* Bt; int M, N, K, lda; };

struct StaticOrder {
    int nM, nN, nwg, G, c;
    __host__ __device__ void init(int M, int N, int G_, int c_) { nM = M / BM; nN = N / BM; nwg = nM * nN; G = G_; c = c_; }
    __host__ __device__ bool next(int i, Unit& u) const {
        const long L = (long)i * G + c; if (L >= nwg) return false;
        int wgid = (int)L; { const int q = nwg / NXCD, r = nwg % NXCD, xcd = wgid % NXCD, off = wgid / NXCD; wgid = (xcd < r ? xcd * (q + 1) : r * (q + 1) + (xcd - r) * q) + off; }
        const int nig = WGM * nN, gid = wgid / nig, fm = gid * WGM, gsz = (nM - fm) < WGM ? (nM - fm) : WGM;
        u.pm = fm + ((wgid % nig) % gsz); u.pn = (wgid % nig) / gsz; return true;
    }
    __device__ __forceinline__ void a_ready(const Unit&) const {}
    __device__ __forceinline__ void done(const Unit&) const {}
};

__device__ __forceinline__ unsigned cvt_pk_bf16(float lo, float hi) { unsigned r; asm volatile("v_cvt_pk_bf16_f32 %0, %1, %2" : "=v"(r) : "v"(lo), "v"(hi)); return r; }

__device__ __forceinline__ float bf_lo(unsigned u) { return __uint_as_float(u << 16); }
__device__ __forceinline__ float bf_hi(unsigned u) { return __uint_as_float(u & 0xffff0000u); }
__device__ __forceinline__ float sigmoid_f(float v) { return __builtin_amdgcn_rcpf(1.0f + __expf(-v)); }

struct EpiG1 {
    static constexpr bool PERM = true, AFTER_DRAIN = false;
    bf16_t* a2; bf16_t* rwin;
    __device__ __forceinline__ void operator()(const f32x4 (&acc)[2][2][4][2], const Unit& u, int wr, int wc, int fr, int fq) const {
        const int row0 = u.pm * BM + wr * 64 + fr; const int colt = u.pn * BM; const bool s5 = colt < 1024;
        const int col0 = colt + wc * 32 + 8 * fq;
#pragma unroll
        for (int ai = 0; ai < 2; ++ai)
#pragma unroll
            for (int m = 0; m < 4; ++m) { const int row = row0 + ai * HALF + m * 16;
#pragma unroll
                for (int bj = 0; bj < 2; ++bj) { const f32x4 v0 = acc[ai][bj][m][0], v1 = acc[ai][bj][m][1]; const int col = col0 + bj * HALF;
                    u32x4 w; w.x = cvt_pk_bf16(v0[0], v0[1]); w.y = cvt_pk_bf16(v0[2], v0[3]); w.z = cvt_pk_bf16(v1[0], v1[1]); w.w = cvt_pk_bf16(v1[2], v1[3]);
                    bf16_t* dst = s5 ? a2 + ((size_t)((col >> 4) * 2048 + (row >> 5)) * 768 + (row & 31) * 16 + (col & 15))
                                     : rwin + (size_t)row * 3328 + (col - 1024);
                    *(u32x4*)dst = w; } }
    }
};
template <int MODE> struct EpiMix {
    static constexpr bool PERM = true, AFTER_DRAIN = false;
    bf16_t* O; const bf16_t* S; const bf16_t* Add; int ld;
    __device__ __forceinline__ void operator()(const f32x4 (&acc)[2][2][4][2], const Unit& u, int wr, int wc, int fr, int fq) const {
        const int row0 = u.pm * BM + wr * 64 + fr, col0 = u.pn * BM + wc * 32 + 8 * fq;
#pragma unroll
        for (int ai = 0; ai < 2; ++ai)
#pragma unroll
            for (int m = 0; m < 4; ++m) {
#pragma unroll
                for (int bj = 0; bj < 2; ++bj) {
                    const size_t off = (size_t)(row0 + ai * HALF + m * 16) * ld + col0 + bj * HALF;
                    float v[8];
#pragma unroll
                    for (int j = 0; j < 4; ++j) { v[j] = acc[ai][bj][m][0][j]; v[4 + j] = acc[ai][bj][m][1][j]; }
                    if (MODE >= 1) {
                        const u32x4 s = *(const u32x4*)(S + off);
                        const float sv[8] = {bf_lo(s.x), bf_hi(s.x), bf_lo(s.y), bf_hi(s.y), bf_lo(s.z), bf_hi(s.z), bf_lo(s.w), bf_hi(s.w)};
#pragma unroll
                        for (int j = 0; j < 8; ++j) { const float sg = sigmoid_f(v[j]); v[j] = (MODE == 2) ? sv[j] * v[j] * sg : sv[j] * sg; }
                    }
                    if (MODE == 3) {
                        const u32x4 a = *(const u32x4*)(Add + off);
                        const float av[8] = {bf_lo(a.x), bf_hi(a.x), bf_lo(a.y), bf_hi(a.y), bf_lo(a.z), bf_hi(a.z), bf_lo(a.w), bf_hi(a.w)};
#pragma unroll
                        for (int j = 0; j < 8; ++j) v[j] += av[j];
                    }
                    u32x4 w; w.x = cvt_pk_bf16(v[0], v[1]); w.y = cvt_pk_bf16(v[2], v[3]); w.z = cvt_pk_bf16(v[4], v[5]); w.w = cvt_pk_bf16(v[6], v[7]);
                    *(u32x4*)(O + off) = w;
                }
            }
    }
};
struct EpiF32 {
    static constexpr bool PERM = false, AFTER_DRAIN = false;
    float* C; int ldc;
    __device__ __forceinline__ void operator()(const f32x4 (&acc)[2][2][4][2], const Unit& u, int wr, int wc, int fr, int fq) const {
        const int row0 = u.pm * BM + wr * 64 + fr, col0 = u.pn * BM + wc * 32 + 4 * fq;
#pragma unroll
        for (int ai = 0; ai < 2; ++ai)
#pragma unroll
            for (int m = 0; m < 4; ++m) { float* rowp = C + (size_t)(row0 + ai * HALF + m * 16) * ldc + col0;
#pragma unroll
                for (int bj = 0; bj < 2; ++bj)
#pragma unroll
                    for (int n = 0; n < 2; ++n) *(f32x4*)(rowp + bj * HALF + n * 16) = acc[ai][bj][m][n]; }
    }
};
template <class Epi, class Sched, bool ALIGN_EPI = false, bool SP2 = false>
__device__ __forceinline__ void gemm_phase(PG8_LAS unsigned char* lds, const Gemm g, const Sched& S, const Epi& E, const int mk_wave) {
    const int lane = mk_lane(), wid = mk_wave, tid = wid * 64 + lane, wr = wid >> 2, wc = wid & 3, fr = lane & 15, fq = lane >> 4;
    const int K = g.K, nt = K / BK;
    unsigned voffA[2], voffB[2];
#pragma unroll
    for (int i = 0; i < 2; ++i) { int R, C; stage_rc(tid * 16 + i * 8192, R, C); const int Rb = Epi::PERM ? ((R & ~31) + perm32(R & 31)) : R;
        voffA[i] = (unsigned)(R * g.lda + C) * 2u; voffB[i] = (unsigned)(Rb * K + C) * 2u; }
    const size_t kstep = (size_t)(BK * 2);
    const size_t hstep = (size_t)HALF * K * 2;
    const size_t tstep = 2 * hstep;
    const size_t hstepA = (size_t)HALF * g.lda * 2, tstepA = 2 * hstepA;
    const unsigned ldsw = (unsigned)wid * 1024u;
    const int aoff = lds_byte(wr * 64 + fr, fq * 8), boff = lds_byte(wc * 32 + fr, fq * 8);
#define PG8_SA(b, h) (((b) * 2 + (h)) * HTB)
#define PG8_SB(b, h) ((4 + (b) * 2 + (h)) * HTB)
#define PG8_STAGE(bufoff, gbase, voff) do { _Pragma("unroll") for (int _i = 0; _i < 2; ++_i) \
        __builtin_amdgcn_global_load_lds((const unsigned*)((const char*)(gbase) + (voff)[_i]), (PG8_LAS unsigned*)(lds + (bufoff) + ldsw + _i * 8192), 16, 0, 0); } while (0)
#define PG8_LDA(dst, b, h) do { _Pragma("unroll") for (int m = 0; m < 4; ++m) _Pragma("unroll") for (int k = 0; k < 2; ++k) dst[m][k] = *(const PG8_LAS bf16x8*)(lds + PG8_SA(b, h) + aoff + m * 2048 + k * 1024); } while (0)
#define PG8_LDB(dst, b, h) do { _Pragma("unroll") for (int n = 0; n < 2; ++n) _Pragma("unroll") for (int k = 0; k < 2; ++k) dst[n][k] = *(const PG8_LAS bf16x8*)(lds + PG8_SB(b, h) + boff + n * 2048 + k * 1024); } while (0)
#define PG8_MMA(ai, bj, At, Bt) do { __builtin_amdgcn_s_setprio(1); _Pragma("unroll") for (int m = 0; m < 4; ++m) _Pragma("unroll") for (int n = 0; n < 2; ++n) _Pragma("unroll") for (int k = 0; k < 2; ++k) \
        acc[ai][bj][m][n] = __builtin_amdgcn_mfma_f32_16x16x32_bf16(Bt[n][k], At[m][k], acc[ai][bj][m][n], 0, 0, 0); __builtin_amdgcn_s_setprio(0); } while (0)
#define PG8_WAIT_V(n) asm volatile("s_waitcnt vmcnt(" #n ")" ::: "memory")
#define PG8_WAIT_L(n) asm volatile("s_waitcnt lgkmcnt(" #n ")" ::: "memory")
#define PG8_BAR __builtin_amdgcn_s_barrier()
#define PG8_SCHED __builtin_amdgcn_sched_barrier(0)
    Unit cur, nxt; int ui = 0;
    if (!S.next(0, cur)) return;
    f32x4 acc[2][2][4][2];
#pragma unroll
    for (int a = 0; a < 2; ++a)
#pragma unroll
        for (int b = 0; b < 2; ++b)
#pragma unroll
            for (int m = 0; m < 4; ++m)
#pragma unroll
                for (int n = 0; n < 2; ++n) acc[a][b][m][n] = (f32x4){0.f, 0.f, 0.f, 0.f};
    bf16x8 At[4][2], B0[2][2], B1[2][2];
    const char* cA = (const char*)g.A + (size_t)cur.pm * tstepA; const char* cB = (const char*)g.Bt + (size_t)cur.pn * tstep;
    S.a_ready(cur);
    if constexpr (SP2) {
        PG8_STAGE(PG8_SB(0, 0), cB, voffB); PG8_STAGE(PG8_SB(0, 1), cB + hstep, voffB); PG8_STAGE(PG8_SA(0, 0), cA, voffA); PG8_STAGE(PG8_SA(0, 1), cA + hstepA, voffA);
        if (wr == 1) PG8_BAR;
        PG8_WAIT_V(2); PG8_BAR;
        PG8_STAGE(PG8_SB(1, 0), cB + kstep, voffB); PG8_STAGE(PG8_SA(1, 0), cA + kstep, voffA); PG8_STAGE(PG8_SB(1, 1), cB + hstep + kstep, voffB);
        PG8_WAIT_V(6); PG8_BAR;
    } else {
        PG8_STAGE(PG8_SB(0, 0), cB, voffB); PG8_STAGE(PG8_SA(0, 0), cA, voffA); PG8_STAGE(PG8_SB(0, 1), cB + hstep, voffB); PG8_STAGE(PG8_SA(0, 1), cA + hstepA, voffA);
        if (wr == 1) PG8_BAR;
        PG8_WAIT_V(4); PG8_BAR;
        PG8_STAGE(PG8_SB(1, 0), cB + kstep, voffB); PG8_STAGE(PG8_SA(1, 0), cA + kstep, voffA); PG8_STAGE(PG8_SB(1, 1), cB + hstep + kstep, voffB);
        PG8_WAIT_V(6); PG8_BAR;
    }
    for (;;) {
        const bool has_next = S.next(ui + 1, nxt);
        const char* nA = has_next ? (const char*)g.A + (size_t)nxt.pm * tstepA : cA; const char* nB = has_next ? (const char*)g.Bt + (size_t)nxt.pn * tstep : cB;
        for (int t = 0; t < nt; t += 2) {
            const bool last = (t == nt - 2);
            const char* a1 = cA + (size_t)(t + 1) * kstep;
            const char* a2 = last ? nA : cA + (size_t)(t + 2) * kstep; const char* b2 = last ? nB : cB + (size_t)(t + 2) * kstep;
            const char* a3 = a2 + kstep; const char* b3 = b2 + kstep;
            if (last && has_next) S.a_ready(nxt);
            if constexpr (SP2) {
            PG8_LDB(B0, 0, 0); PG8_LDB(B1, 0, 1); PG8_SCHED; PG8_LDA(At, 0, 0); PG8_STAGE(PG8_SA(1, 1), a1 + hstepA, voffA);
            PG8_WAIT_V(8); PG8_WAIT_L(0); PG8_BAR; PG8_MMA(0, 0, At, B0); PG8_MMA(0, 1, At, B1); PG8_BAR; PG8_SCHED;
            PG8_LDA(At, 0, 1); PG8_STAGE(PG8_SB(0, 0), b2, voffB); PG8_STAGE(PG8_SB(0, 1), b2 + hstep, voffB); PG8_STAGE(PG8_SA(0, 0), a2, voffA);
            PG8_WAIT_V(8); PG8_WAIT_L(0); PG8_BAR; PG8_MMA(1, 0, At, B0); PG8_MMA(1, 1, At, B1); PG8_BAR; PG8_SCHED;
            PG8_LDB(B0, 1, 0); PG8_LDB(B1, 1, 1); PG8_SCHED; PG8_LDA(At, 1, 0); PG8_STAGE(PG8_SA(0, 1), a2 + hstepA, voffA);
            PG8_WAIT_V(8); PG8_WAIT_L(0); PG8_BAR; PG8_MMA(0, 0, At, B0); PG8_MMA(0, 1, At, B1); PG8_BAR; PG8_SCHED;
            PG8_LDA(At, 1, 1); PG8_STAGE(PG8_SB(1, 0), b3, voffB); PG8_STAGE(PG8_SB(1, 1), b3 + hstep, voffB); PG8_STAGE(PG8_SA(1, 0), a3, voffA);
            PG8_WAIT_V(8); PG8_WAIT_L(0); PG8_BAR; PG8_MMA(1, 0, At, B0); PG8_MMA(1, 1, At, B1); PG8_BAR; PG8_SCHED;
            } else {
            PG8_LDB(B0, 0, 0); PG8_SCHED; PG8_LDA(At, 0, 0); PG8_STAGE(PG8_SA(1, 1), a1 + hstepA, voffA);
            PG8_WAIT_L(8); PG8_BAR; PG8_WAIT_L(0); PG8_MMA(0, 0, At, B0); PG8_BAR; PG8_SCHED;
            PG8_LDB(B1, 0, 1); PG8_STAGE(PG8_SB(0, 0), b2, voffB);
            PG8_BAR; PG8_WAIT_L(0); PG8_MMA(0, 1, At, B1); PG8_BAR;
            PG8_LDA(At, 0, 1); PG8_STAGE(PG8_SA(0, 0), a2, voffA);
            PG8_BAR; PG8_WAIT_L(0); PG8_MMA(1, 0, At, B0); PG8_BAR; PG8_SCHED;
            PG8_STAGE(PG8_SB(0, 1), b2 + hstep, voffB);
            PG8_WAIT_V(6); PG8_BAR; PG8_MMA(1, 1, At, B1); PG8_BAR;
            PG8_LDB(B0, 1, 0); PG8_SCHED; PG8_LDA(At, 1, 0); PG8_STAGE(PG8_SA(0, 1), a2 + hstepA, voffA);
            PG8_WAIT_L(8); PG8_BAR; PG8_WAIT_L(0); PG8_MMA(0, 0, At, B0); PG8_BAR; PG8_SCHED;
            PG8_LDB(B1, 1, 1); PG8_STAGE(PG8_SB(1, 0), b3, voffB);
            PG8_BAR; PG8_WAIT_L(0); PG8_MMA(0, 1, At, B1); PG8_BAR;
            PG8_LDA(At, 1, 1); PG8_STAGE(PG8_SA(1, 0), a3, voffA);
            PG8_BAR; PG8_WAIT_L(0); PG8_MMA(1, 0, At, B0); PG8_BAR; PG8_SCHED;
            PG8_STAGE(PG8_SB(1, 1), b3 + hstep, voffB);
            PG8_WAIT_V(6); PG8_BAR; PG8_MMA(1, 1, At, B1); PG8_BAR;
            }
        }
        if constexpr (ALIGN_EPI) { if (wr == 0) PG8_BAR; }
        if constexpr (!Epi::AFTER_DRAIN) { E(acc, cur, wr, wc, fr, fq); S.done(cur); }
        if (!has_next) break;
#pragma unroll
        for (int a = 0; a < 2; ++a)
#pragma unroll
            for (int b = 0; b < 2; ++b)
#pragma unroll
                for (int m = 0; m < 4; ++m)
#pragma unroll
                    for (int n = 0; n < 2; ++n) acc[a][b][m][n] = (f32x4){0.f, 0.f, 0.f, 0.f};
        cur = nxt; cA = nA; cB = nB; ++ui;
        if constexpr (ALIGN_EPI) { if (wr == 1) PG8_BAR; }
    }
    PG8_WAIT_V(0);
    if constexpr (!ALIGN_EPI) { if (wr == 0) PG8_BAR; }
    PG8_BAR;
    if constexpr (Epi::AFTER_DRAIN) { E.fused(acc, cur, wr, wc, fr, fq, lds, wid, lane); S.done(cur); }
#undef PG8_SA
#undef PG8_SB
#undef PG8_STAGE
#undef PG8_LDA
#undef PG8_LDB
#undef PG8_MMA
#undef PG8_WAIT_V
#undef PG8_WAIT_L
#undef PG8_BAR
#undef PG8_SCHED
}
}

#ifndef PG8_SP2
#define PG8_SP2 true
#endif
#ifndef PG8_ALIGN
#define PG8_ALIGN true
#endif

constexpr int NWAVES = 8;
constexpr int N_PHASES = 16;
#ifndef MK_N_LAUNCHES
#define MK_N_LAUNCHES 1
#endif
constexpr int N_LAUNCHES = MK_N_LAUNCHES;

constexpr int D = 2048, M = 65536, NIN = 10496;
constexpr int LP = 16384, LS = 2048;
constexpr int DS5 = 1024, DRW = 1024, DRWIN = 3328;
constexpr float RMS_EPS = 1e-6f, GN_EPS = 64e-5f, L2_EPS = 1e-12f;

constexpr size_t MiB = 1u << 20;
constexpr size_t WS_CTL = 0, CTL_ZERO_BYTES = 1 * MiB;
constexpr size_t WS_WT = 1 * MiB;
constexpr size_t WS_GLUT = 42 * MiB;
constexpr size_t WS_S5OT = 44 * MiB;
constexpr size_t WS_RWOT = 48 * MiB;
constexpr size_t WS_WOT = 52 * MiB;
constexpr size_t WS_HN = 60 * MiB;
constexpr size_t WS_RWIN = 316 * MiB;
constexpr size_t WS_Z = 732 * MiB;
constexpr size_t WS_LUT = 860 * MiB;
constexpr size_t WS_STATE = 862 * MiB;
constexpr size_t WS_S5TAB = 872 * MiB;
constexpr size_t WS_S5XL = 882 * MiB;
constexpr size_t WS_S5W2 = 946 * MiB;
constexpr size_t WS_S5E = 994 * MiB;
constexpr size_t WS_ZG = 882 * MiB;
constexpr size_t WS_END = 1010 * MiB;
constexpr size_t DO_YF = 0, DO_YB = 128 * MiB, DO_A2 = 256 * MiB, DO_INT = 256 * MiB, DO_Q = 256 * MiB;
constexpr int CW_BAR = 4096;

constexpr int LDS_BYTES = 147456;
constexpr int MISC_OFF = LDS_BYTES - 512;
constexpr int WAVE_SCR = 18176;
static_assert(NWAVES * WAVE_SCR <= MISC_OFF && pg8::STAGE_BYTES <= MISC_OFF, "LDS map");

#define GAS __attribute__((address_space(1)))
#define LAS __attribute__((address_space(3)))
typedef unsigned short bf16;
typedef unsigned v4u __attribute__((ext_vector_type(4)));
typedef unsigned v2u __attribute__((ext_vector_type(2)));
typedef float f32x4 __attribute__((ext_vector_type(4)));
#define LDS_WAIT() asm volatile("s_waitcnt lgkmcnt(0)" ::: "memory")
#define VM_WAIT() asm volatile("s_waitcnt vmcnt(0)" ::: "memory")
typedef __bf16 mk_bf2 __attribute__((ext_vector_type(2)));
typedef float mk_f2 __attribute__((ext_vector_type(2)));
__device__ __forceinline__ unsigned pk2(float lo, float hi) { const mk_f2 v = {lo, hi}; return __builtin_bit_cast(unsigned, __builtin_convertvector(v, mk_bf2)); }
__device__ __forceinline__ unsigned f2bf(float f) { return pk2(f, f) & 0xffffu; }
__device__ __forceinline__ float bf2f(bf16 b) { return __uint_as_float(((unsigned)b) << 16); }
__device__ __forceinline__ float blo(unsigned u) { return __uint_as_float(u << 16); }
__device__ __forceinline__ float bhi(unsigned u) { return __uint_as_float(u & 0xffff0000u); }
__device__ __forceinline__ float wave_sum(float v) {
#pragma unroll
    for (int o = 1; o < 64; o <<= 1) v += __shfl_xor(v, o);
    return v;
}
__device__ __forceinline__ float sigm(float v) { return __builtin_amdgcn_rcpf(1.0f + __expf(-v)); }
__device__ __forceinline__ float gelu_tanh(float x) { const float u = 0.7978845608028654f * (x + 0.044715f * x * x * x); return 0.5f * x * (1.0f + tanhf(u)); }

#define XB_TMO      128
#define XB_XCNT(j)  (256  + 64 * (j))
#define XB_XSUB(j)  (1280 + 64 * (j))
#define XB_XGEN(j)  (2304 + 64 * (j))
#define XB_TOP      3328
#define XB_TOPGEN   3392
#define XCD_BAR_WORDS 3456
#define XB_SPIN_CAP (1u << 18)

__device__ __forceinline__ unsigned xb_ld(unsigned* p)              { return __hip_atomic_load(p, __ATOMIC_RELAXED, __HIP_MEMORY_SCOPE_AGENT); }
__device__ __forceinline__ unsigned xb_add(unsigned* p, unsigned v) { return __hip_atomic_fetch_add(p, v, __ATOMIC_RELAXED, __HIP_MEMORY_SCOPE_AGENT); }
__device__ __forceinline__ unsigned xb_xcc_id() { return (unsigned)__builtin_amdgcn_s_getreg((3 << 11) | 20) & 0xFu; }
#define XB_SPIN(cond, bar) do { unsigned _sp = 0; while (cond) { __builtin_amdgcn_s_sleep(1); \
    if ((++_sp & 255u) == 0u) { if (xb_ld(&(bar)[XB_TMO])) break; if (_sp > XB_SPIN_CAP) { atomicAdd(&(bar)[XB_TMO], 1u); break; } } } } while (0)

struct XcdBarrier {
    unsigned* bar; unsigned x;
    volatile LAS unsigned* st;
};

__device__ __forceinline__ XcdBarrier xcd_barrier_post(unsigned* bar, volatile LAS unsigned* st, const int mk_wave) {
    XcdBarrier b; b.bar = bar; b.x = xb_xcc_id(); b.st = st;
    if (mk_wave == 0 && mk_lane() == 0) (void)xb_add(&bar[XB_XCNT(b.x)], 1u);
    return b;
}
__device__ __forceinline__ void xcd_barrier_complete(unsigned* bar, unsigned x, unsigned& nloc, unsigned& nx) {
    const unsigned G = gridDim.x * gridDim.y * gridDim.z;
    unsigned sum, cnt, mine, sp = 0u;
    for (;;) {
        sum = 0u; cnt = 0u; mine = 0u;
#pragma unroll
        for (unsigned j = 0; j < 16; ++j) { const unsigned c = xb_ld(&bar[XB_XCNT(j)]); sum += c; cnt += (c > 0u) ? 1u : 0u; mine = (j == x) ? c : mine; }
        if (sum == G) break;
        __builtin_amdgcn_s_sleep(1);
        if ((++sp & 255u) == 0u) { if (xb_ld(&bar[XB_TMO])) break; if (sp > XB_SPIN_CAP) { atomicAdd(&bar[XB_TMO], 1u); break; } }
    }
    nloc = mine > 0u ? mine : 1u; nx = cnt > 0u ? cnt : 1u;
}

__device__ __forceinline__ void xcd_barrier(const XcdBarrier& b, const int mk_wave) {
    asm volatile("s_waitcnt vmcnt(0)" ::: "memory");
    __syncthreads();
    if (mk_wave == 0 && mk_lane() == 0) {
        unsigned* bar = b.bar;
        __builtin_amdgcn_s_waitcnt(0);
        unsigned nloc = b.st[0], nx = b.st[1];
        if (nloc == 0u) { xcd_barrier_complete(bar, b.x, nloc, nx); b.st[0] = nloc; b.st[1] = nx; }
        const unsigned old = xb_add(&bar[XB_XSUB(b.x)], 1u);
        const unsigned gen = old / nloc;
        if (old + 1u == (gen + 1u) * nloc) {
            __builtin_amdgcn_fence(__ATOMIC_RELEASE, "agent");
            asm volatile("s_waitcnt vmcnt(0)" ::: "memory");
            const unsigned og = xb_add(&bar[XB_TOP], 1u);
            const unsigned tg = og / nx;
            if (og + 1u == (tg + 1u) * nx) xb_add(&bar[XB_TOPGEN], 1u);
            else XB_SPIN(xb_ld(&bar[XB_TOPGEN]) == tg, bar);
            __builtin_amdgcn_fence(__ATOMIC_ACQUIRE, "agent");
            xb_add(&bar[XB_XGEN(b.x)], 1u);
            asm volatile("s_waitcnt vmcnt(0)" ::: "memory");
        } else {
            XB_SPIN(xb_ld(&bar[XB_XGEN(b.x)]) == gen, bar);
            __builtin_amdgcn_fence(__ATOMIC_ACQUIRE, "agent");
            asm volatile("s_waitcnt vmcnt(0)" ::: "memory");
        }
    }
    __syncthreads();
}


struct Args { const float* in[27]; float* out; unsigned char* ws; int ph_lo, ph_hi, li, pad; };

namespace rwk {
typedef short s16x4 __attribute__((ext_vector_type(4)));
typedef short s16x8 __attribute__((ext_vector_type(8)));
constexpr int NSEG = 8;
constexpr int UNITS_PER_SEG = 4096;
constexpr int LDW = 72;
constexpr int MATB = 64 * LDW * 2;
constexpr int O_AB = 0, O_BT = 1 * MATB, O_KT = 2 * MATB, O_RB = 3 * MATB, O_BHT = 4 * MATB, O_KHT = 5 * MATB, O_VT = 6 * MATB;
constexpr int O_MAB = 7 * MATB, O_MAK = 8 * MATB, O_NRB = 9 * MATB, O_NRK = 10 * MATB, O_XT = 11 * MATB  , O_NP = 13 * MATB, O_GT = 14 * MATB;
constexpr int O_TW = O_XT, O_XA = O_XT + MATB;
constexpr int LDC = 68;
constexpr int O_CL = O_MAB, O_AS = O_MAB + 64 * LDC * 4;
constexpr int NPS = 24;
static_assert(O_AS + 64 * LDC * 4 <= O_XT && O_GT + 256 <= 146944, "rwkv LDS map");
constexpr size_t UNIT_ELEMS = 16384;

__device__ __forceinline__ f32x4 mfma32(s16x8 a, s16x8 b, f32x4 c) { return __builtin_amdgcn_mfma_f32_16x16x32_bf16(a, b, c, 0, 0, 0); }
__device__ __forceinline__ f32x4 mfma16(s16x4 a, s16x4 b, f32x4 c) { return __builtin_amdgcn_mfma_f32_16x16x16bf16_1k(a, b, c, 0, 0, 0); }
__device__ __forceinline__ s16x4 pack4(f32x4 v) { v2u p; p.x = pk2(v[0], v[1]); p.y = pk2(v[2], v[3]); return __builtin_bit_cast(s16x4, p); }
__device__ __forceinline__ f32x4 unpack4(v2u p) { return (f32x4){blo(p.x), bhi(p.x), blo(p.y), bhi(p.y)}; }
__device__ __forceinline__ void up8(v4u a, float (&o)[8]) { o[0] = blo(a.x); o[1] = bhi(a.x); o[2] = blo(a.y); o[3] = bhi(a.y); o[4] = blo(a.z); o[5] = bhi(a.z); o[6] = blo(a.w); o[7] = bhi(a.w); }
__device__ __forceinline__ v4u pk8(const float (&v)[8]) { v4u a; a.x = pk2(v[0], v[1]); a.y = pk2(v[2], v[3]); a.z = pk2(v[4], v[5]); a.w = pk2(v[6], v[7]); return a; }

constexpr int O_MU = 131072;
static_assert(O_MU + 3328 * 4 <= 146944, "rwkv LDS map (mu)");
__device__ __forceinline__ int swz_chunk(int row, int tc) { return (row * LDW + ((tc ^ ((row >> 3) & 7)) << 3)) * 2; }
__device__ __forceinline__ float tanh_fast(float x) { return 1.0f - 2.0f * __builtin_amdgcn_rcpf(1.0f + __expf(2.0f * x)); }
struct RawUnit { v4u cur[5], prv[5], nxt[5]; f32x4 kk0, kk1, ka0, ka1; s16x8 lb0, lb1; float bias; };
struct UnitId { int h, d, base, L, gchunk, chain; };
__device__ __forceinline__ UnitId decode_unit(int seg, int u) {
    UnitId o; int c, jc, nch;
    if (u < 2048) { c = u >> 5; jc = u & 31; nch = 32; } else { c = 64 + ((u - 2048) >> 2); jc = (u - 2048) & 3; nch = 4; }
    int s, rem; if (c < 64) { s = c >> 5; rem = c & 31; } else { s = 2 + ((c - 64) >> 5); rem = (c - 64) & 31; }
    o.h = rem >> 1; o.d = rem & 1; o.base = s < 2 ? s * LP : 32768 + (s - 2) * LS; o.L = s < 2 ? LP : LS; o.gchunk = seg * nch + jc; o.chain = c;
    return o;
}
__device__ __forceinline__ int unit_of(int chain, int jc) { return chain < 64 ? chain * 32 + jc : 2048 + (chain - 64) * 4 + jc; }

__device__ __forceinline__ void rw_load_unit(const Args& a, unsigned char* ws, int seg, int u, int wave, int lane, RawUnit& R) {
    const UnitId id = decode_unit(seg, u);
    const int h = id.h, d = id.d, tid = wave * 64 + lane, t = tid >> 3, cg = tid & 7, c8 = h * 64 + 8 * cg;
    const int lp = 64 * id.gchunk + t, pos = d ? id.L - 1 - lp : lp;
    const bf16* prow = (const bf16*)(ws + WS_RWIN) + (size_t)(id.base + pos) * DRWIN;
    const bool hp = pos > 0, hn = pos < id.L - 1;
    const v4u z4 = (v4u){0u, 0u, 0u, 0u};
#pragma unroll
    for (int comp = 0; comp < 5; ++comp) {
        const int col = comp < 3 ? comp * 1024 + c8 : (comp == 3 ? 3072 + d * 64 + 8 * cg : 3200 + d * 64 + 8 * cg);
        R.cur[comp] = *(const v4u*)(prow + col);
        R.prv[comp] = hp ? *(const v4u*)(prow - DRWIN + col) : z4;
        R.nxt[comp] = hn ? *(const v4u*)(prow + DRWIN + col) : z4;
    }
    R.kk0 = *(const f32x4*)(a.in[20] + c8); R.kk1 = *(const f32x4*)(a.in[20] + c8 + 4);
    R.ka0 = *(const f32x4*)(a.in[21] + c8); R.ka1 = *(const f32x4*)(a.in[21] + c8 + 4);
    const int r = lane & 15, g = lane >> 4, ct = wave & 3, role = wave >> 2;
    const bf16* lut = (const bf16*)(ws + WS_LUT) + ((size_t)((role * 2 + d) * 16 + h) * 64 + 16 * ct + r) * 64 + 8 * g;
    R.lb0 = *(const s16x8*)(lut); R.lb1 = *(const s16x8*)(lut + 32);
    R.bias = (role ? a.in[18] : a.in[16])[d * 1024 + h * 64 + 16 * ct + r];
}
__device__ __forceinline__ void rw_precompute_unit(const Args& a, unsigned char* ws, LAS unsigned char* lds, int seg, int u, int wave, int lane, const RawUnit& R) {
    const UnitId id = decode_unit(seg, u);
    const int h = id.h, d = id.d;
    const int tid = wave * 64 + lane;
    const int r = lane & 15, g = lane >> 4;
    const int t = tid >> 3, cg = tid & 7, c8 = h * 64 + 8 * cg;
    float zr[8], zk[8], kk[8], zv[8];
    {
        const LAS float* mu = (const LAS float*)(lds + O_MU);
        float zw[8], za[8];
#pragma unroll
        for (int comp = 0; comp < 5; ++comp) {
            const int col = comp < 3 ? comp * 1024 + c8 : (comp == 3 ? 3072 + d * 64 + 8 * cg : 3200 + d * 64 + 8 * cg);
            float cc[8], pp[8], nn[8];
            up8(R.cur[comp], cc); up8(R.prv[comp], pp); up8(R.nxt[comp], nn);
            const f32x4 m0 = *(const LAS f32x4*)(mu + col), m1 = *(const LAS f32x4*)(mu + col + 4);
            const float mv[8] = {m0[0], m0[1], m0[2], m0[3], m1[0], m1[1], m1[2], m1[3]};
#pragma unroll
            for (int j = 0; j < 8; ++j) {
                const float zz = cc[j] + (0.5f * (pp[j] + nn[j]) - cc[j]) * mv[j];
                if (comp == 0) zr[j] = zz; else if (comp == 1) zk[j] = zz; else if (comp == 2) zv[j] = zz; else if (comp == 3) zw[j] = tanh_fast(zz); else za[j] = zz;
            }
        }
        float ss = 0.f;
        const float kkw[8] = {R.kk0[0], R.kk0[1], R.kk0[2], R.kk0[3], R.kk1[0], R.kk1[1], R.kk1[2], R.kk1[3]};
#pragma unroll
        for (int j = 0; j < 8; ++j) { kk[j] = zk[j] * kkw[j]; ss += kk[j] * kk[j]; }
        ss += __shfl_xor(ss, 1); ss += __shfl_xor(ss, 2); ss += __shfl_xor(ss, 4);
        const float inv = __builtin_amdgcn_rsqf(ss + L2_EPS);
#pragma unroll
        for (int j = 0; j < 8; ++j) kk[j] *= inv;
        *(LAS v4u*)(lds + O_TW + (t * LDW + 8 * cg) * 2) = pk8(zw);
        *(LAS v4u*)(lds + O_XA + (t * LDW + 8 * cg) * 2) = pk8(za);
    }
    __syncthreads();
    {
        const int ct = wave & 3, role = wave >> 2;
        const s16x8 b0 = R.lb0, b1 = R.lb1;
        const int aoff = (role ? O_XA : O_TW) + (r * LDW + 8 * g) * 2;
        f32x4 acc[4];
#pragma unroll
        for (int mt = 0; mt < 4; ++mt) {
            const s16x8 a0 = *(const LAS s16x8*)(lds + aoff + mt * 16 * LDW * 2), a1 = *(const LAS s16x8*)(lds + aoff + mt * 16 * LDW * 2 + 64);
            acc[mt] = mfma32(a0, b0, (f32x4){0.f, 0.f, 0.f, 0.f}); acc[mt] = mfma32(a1, b1, acc[mt]);
        }
        const int cch = 16 * ct + r;
        if (role == 0) {
            const float w0v = R.bias;
            float carry = 0.f;
#pragma unroll
            for (int mt = 0; mt < 4; ++mt) {
                float s[4];
#pragma unroll
                for (int i = 0; i < 4; ++i) { const float lw = -0.6065306597126334f * sigm(acc[mt][i] + w0v); s[i] = (i ? s[i - 1] : 0.f) + lw; }
                const float tot = s[3];
                const float e1 = __shfl(tot, (lane + 48) & 63), e2 = __shfl(tot, (lane + 32) & 63), e3 = __shfl(tot, (lane + 16) & 63);
                const float excl = (g >= 1 ? e1 : 0.f) + (g >= 2 ? e2 : 0.f) + (g >= 3 ? e3 : 0.f);
                const float all = __shfl(tot + excl, 48 + r);
#pragma unroll
                for (int i = 0; i < 4; ++i) *(LAS float*)(lds + O_CL + ((16 * mt + 4 * g + i) * LDC + cch) * 4) = carry + excl + s[i];
                carry += all;
            }
        } else {
            const float a0v = R.bias;
#pragma unroll
            for (int mt = 0; mt < 4; ++mt)
#pragma unroll
                for (int i = 0; i < 4; ++i) *(LAS float*)(lds + O_AS + ((16 * mt + 4 * g + i) * LDC + cch) * 4) = sigm(acc[mt][i] + a0v);
        }
    }
    __syncthreads();
    {
        float cl[8], clp[8], cle[8], as[8];
        { const f32x4 x0 = *(const LAS f32x4*)(lds + O_CL + (t * LDC + 8 * cg) * 4), x1 = *(const LAS f32x4*)(lds + O_CL + (t * LDC + 8 * cg + 4) * 4);
          const f32x4 e0 = *(const LAS f32x4*)(lds + O_CL + (63 * LDC + 8 * cg) * 4), e1 = *(const LAS f32x4*)(lds + O_CL + (63 * LDC + 8 * cg + 4) * 4);
          const f32x4 s0 = *(const LAS f32x4*)(lds + O_AS + (t * LDC + 8 * cg) * 4), s1 = *(const LAS f32x4*)(lds + O_AS + (t * LDC + 8 * cg + 4) * 4);
          f32x4 p0 = (f32x4){0.f, 0.f, 0.f, 0.f}, p1 = p0;
          if (t > 0) { p0 = *(const LAS f32x4*)(lds + O_CL + ((t - 1) * LDC + 8 * cg) * 4); p1 = *(const LAS f32x4*)(lds + O_CL + ((t - 1) * LDC + 8 * cg + 4) * 4); }
#pragma unroll
          for (int j = 0; j < 4; ++j) { cl[j] = x0[j]; cl[4 + j] = x1[j]; cle[j] = e0[j]; cle[4 + j] = e1[j]; as[j] = s0[j]; as[4 + j] = s1[j]; clp[j] = p0[j]; clp[4 + j] = p1[j]; } }
        const float kaw[8] = {R.ka0[0], R.ka0[1], R.ka0[2], R.ka0[3], R.ka1[0], R.ka1[1], R.ka1[2], R.ka1[3]};
        float ab[8], bt[8], kt[8], rb[8], bh[8], kh[8];
#pragma unroll
        for (int j = 0; j < 8; ++j) {
            const float gt = __expf(cl[j]), gi = __expf(-cl[j]), gp = __expf(clp[j]), ge = __expf(cle[j] - cl[j]);
            const float kd = zk[j] * (1.0f + (as[j] - 1.0f) * kaw[j]), kb = kk[j] * as[j];
            ab[j] = -kk[j] * gp; bt[j] = kb * gi; kt[j] = kd * gi; rb[j] = zr[j] * gt; bh[j] = kb * ge; kh[j] = kd * ge;
            if (t == 63) *(LAS float*)(lds + O_GT + (8 * cg + j) * 4) = __expf(cle[j]);
        }
        *(LAS v4u*)(lds + O_AB + (t * LDW + 8 * cg) * 2) = pk8(ab);
        *(LAS v4u*)(lds + O_BT + (t * LDW + 8 * cg) * 2) = pk8(bt);
        *(LAS v4u*)(lds + O_KT + (t * LDW + 8 * cg) * 2) = pk8(kt);
        *(LAS v4u*)(lds + O_RB + (t * LDW + 8 * cg) * 2) = pk8(rb);
#pragma unroll
        for (int j = 0; j < 8; ++j) {
            const int so = swz_chunk(8 * cg + j, t >> 3) + (t & 7) * 2;
            *(LAS bf16*)(lds + O_BHT + so) = (bf16)f2bf(bh[j]);
            *(LAS bf16*)(lds + O_KHT + so) = (bf16)f2bf(kh[j]);
            *(LAS bf16*)(lds + O_VT + so) = (bf16)f2bf(zv[j]);
        }
    }
    __syncthreads();
    {
        const int nt = wave >> 1, pr = wave & 1;
        const int boff = ((16 * nt + r) * LDW + 8 * g) * 2;
        const s16x8 ab0 = *(const LAS s16x8*)(lds + O_AB + boff), ab1 = *(const LAS s16x8*)(lds + O_AB + boff + 64);
        const s16x8 rb0 = *(const LAS s16x8*)(lds + O_RB + boff), rb1 = *(const LAS s16x8*)(lds + O_RB + boff + 64);
        const int asrc = (pr ? O_KT : O_BT) + (r * LDW + 8 * g) * 2;
        const int tt = 16 * nt + r;
#pragma unroll
        for (int mt = 0; mt < 4; ++mt) {
            const s16x8 x0 = *(const LAS s16x8*)(lds + asrc + mt * 16 * LDW * 2), x1 = *(const LAS s16x8*)(lds + asrc + mt * 16 * LDW * 2 + 64);
            f32x4 m = mfma32(x0, ab0, (f32x4){0.f, 0.f, 0.f, 0.f}); m = mfma32(x1, ab1, m);
            f32x4 n = mfma32(x0, rb0, (f32x4){0.f, 0.f, 0.f, 0.f}); n = mfma32(x1, rb1, n);
#pragma unroll
            for (int i = 0; i < 4; ++i) { const int j = 16 * mt + 4 * g + i; m[i] = j < tt ? m[i] : 0.f; n[i] = j <= tt ? n[i] : 0.f; }
            const int so = (tt * LDW + 16 * mt + 4 * g) * 2;
            *(LAS s16x4*)(lds + (pr ? O_MAK : O_MAB) + so) = pack4(m);
            *(LAS s16x4*)(lds + (pr ? O_NRK : O_NRB) + so) = pack4(n);
        }
    }
    __syncthreads();
    f32x4 rhs[4];
    if (wave < 4) {
        const int bi = wave;
        const s16x4 aN = *(const LAS s16x4*)(lds + O_MAB + ((16 * bi + r) * LDW + 16 * bi + 4 * g) * 2);
        s16x4 bN;
#pragma unroll
        for (int i = 0; i < 4; ++i) bN[i] = *(const LAS short*)(lds + O_MAB + ((16 * bi + 4 * g + i) * LDW + 16 * bi + r) * 2);
        f32x4 c2 = mfma16(aN, bN, (f32x4){0.f, 0.f, 0.f, 0.f});
        const int npb = O_NP + bi * 3 * 16 * NPS * 2;
#pragma unroll
        for (int p = 0; p < 3; ++p) {
#pragma unroll
            for (int i = 0; i < 4; ++i) *(LAS bf16*)(lds + npb + p * 16 * NPS * 2 + ((4 * g + i) * NPS + r) * 2) = (bf16)f2bf(c2[i]);
            LDS_WAIT();
            if (p < 2) { const s16x4 aP = *(const LAS s16x4*)(lds + npb + p * 16 * NPS * 2 + (r * NPS + 4 * g) * 2); c2 = mfma16(aP, pack4(c2), (f32x4){0.f, 0.f, 0.f, 0.f}); }
        }
#pragma unroll
        for (int mt = 0; mt < 4; ++mt)
#pragma unroll
            for (int i = 0; i < 4; ++i) rhs[mt][i] = bf2f(*(const LAS bf16*)(lds + O_AB + ((16 * mt + 4 * g + i) * LDW + 16 * wave + r) * 2));
    } else {
        const int vt = wave - 4;
        const s16x8 v0 = *(const LAS s16x8*)(lds + O_VT + swz_chunk(16 * vt + r, g)), v1 = *(const LAS s16x8*)(lds + O_VT + swz_chunk(16 * vt + r, g + 4));
#pragma unroll
        for (int mt = 0; mt < 4; ++mt) {
            const int ao = O_MAK + ((16 * mt + r) * LDW + 8 * g) * 2;
            const s16x8 x0 = *(const LAS s16x8*)(lds + ao), x1 = *(const LAS s16x8*)(lds + ao + 64);
            rhs[mt] = mfma32(x0, v0, (f32x4){0.f, 0.f, 0.f, 0.f}); rhs[mt] = mfma32(x1, v1, rhs[mt]);
        }
    }
    __syncthreads();
    {
        f32x4 xb[4];
#pragma unroll
        for (int bi = 0; bi < 4; ++bi) {
            f32x4 acc = rhs[bi];
#pragma unroll
            for (int bj = 0; bj < 4; ++bj) if (bj < bi) {
                const s16x4 am = *(const LAS s16x4*)(lds + O_MAB + ((16 * bi + r) * LDW + 16 * bj + 4 * g) * 2);
                acc = mfma16(am, pack4(xb[bj]), acc);
            }
#pragma unroll
            for (int p = 0; p < 4; ++p) {
                const s16x4 ap = p == 0 ? *(const LAS s16x4*)(lds + O_MAB + ((16 * bi + r) * LDW + 16 * bi + 4 * g) * 2)
                                        : *(const LAS s16x4*)(lds + O_NP + (bi * 3 + (p - 1)) * 16 * NPS * 2 + (r * NPS + 4 * g) * 2);
                acc = mfma16(ap, pack4(acc), acc);
            }
            xb[bi] = acc;
            *(LAS s16x4*)(lds + O_XT + ((16 * wave + r) * LDW + 16 * bi + 4 * g) * 2) = pack4(acc);
        }
    }
    __syncthreads();
    {
        const int nt = wave & 3;
        bf16* ug = (bf16*)((unsigned char*)a.out + DO_INT + (size_t)(seg & 1) * (128u << 20)) + (size_t)u * UNIT_ELEMS;
        const int boff = ((16 * nt + r) * LDW + 8 * g) * 2;
        if (wave < 4) {
            const s16x8 bh0 = *(const LAS s16x8*)(lds + O_BHT + swz_chunk(16 * nt + r, g)), bh1 = *(const LAS s16x8*)(lds + O_BHT + swz_chunk(16 * nt + r, g + 4));
            const s16x8 nb0 = *(const LAS s16x8*)(lds + O_NRB + boff), nb1 = *(const LAS s16x8*)(lds + O_NRB + boff + 64);
            v2u po[4], ro[4];
#pragma unroll
            for (int mt = 0; mt < 4; ++mt) {
                const int ao = O_XT + ((16 * mt + r) * LDW + 8 * g) * 2;
                const s16x8 x0 = *(const LAS s16x8*)(lds + ao), x1 = *(const LAS s16x8*)(lds + ao + 64);
                f32x4 p = mfma32(x0, bh0, (f32x4){0.f, 0.f, 0.f, 0.f}); p = mfma32(x1, bh1, p);
                if (mt == nt) { const float gt = *(const LAS float*)(lds + O_GT + (16 * mt + r) * 4);
#pragma unroll
                    for (int i = 0; i < 4; ++i) p[i] += (4 * g + i == r) ? gt : 0.f; }
                const f32x4 rbv = unpack4(*(const LAS v2u*)(lds + O_RB + ((16 * nt + r) * LDW + 16 * mt + 4 * g) * 2));
                f32x4 q = mfma32(x0, nb0, rbv); q = mfma32(x1, nb1, q);
                po[mt] = __builtin_bit_cast(v2u, pack4(p)); ro[mt] = __builtin_bit_cast(v2u, pack4(q));
            }
            v4u* pg = (v4u*)(ug + (size_t)(nt * 64 + lane) * 16);
            pg[0] = (v4u){po[0].x, po[0].y, po[1].x, po[1].y}; pg[1] = (v4u){po[2].x, po[2].y, po[3].x, po[3].y};
            v4u* rg = (v4u*)(ug + 4096 + (size_t)(nt * 64 + lane) * 16);
            rg[0] = (v4u){ro[0].x, ro[0].y, ro[1].x, ro[1].y}; rg[1] = (v4u){ro[2].x, ro[2].y, ro[3].x, ro[3].y};
        } else {
            const s16x8 u0 = *(const LAS s16x8*)(lds + O_XT + 64 * LDW * 2 + boff), u1 = *(const LAS s16x8*)(lds + O_XT + 64 * LDW * 2 + boff + 64);
            const s16x8 v0 = *(const LAS s16x8*)(lds + O_VT + swz_chunk(16 * nt + r, g)), v1 = *(const LAS s16x8*)(lds + O_VT + swz_chunk(16 * nt + r, g + 4));
            v2u qo[4], yo[4];
#pragma unroll
            for (int mt = 0; mt < 4; ++mt) {
                const int ro_ = ((16 * mt + r) * LDW + 8 * g) * 2;
                const int sw0 = swz_chunk(16 * mt + r, g), sw1 = swz_chunk(16 * mt + r, g + 4);
                const s16x8 b0 = *(const LAS s16x8*)(lds + O_BHT + sw0), b1 = *(const LAS s16x8*)(lds + O_BHT + sw1);
                const s16x8 k0 = *(const LAS s16x8*)(lds + O_KHT + sw0), k1 = *(const LAS s16x8*)(lds + O_KHT + sw1);
                f32x4 q = mfma32(b0, u0, (f32x4){0.f, 0.f, 0.f, 0.f}); q = mfma32(b1, u1, q); q = mfma32(k0, v0, q); q = mfma32(k1, v1, q);
                const s16x8 n0 = *(const LAS s16x8*)(lds + O_NRB + ro_), n1 = *(const LAS s16x8*)(lds + O_NRB + ro_ + 64);
                const s16x8 m0 = *(const LAS s16x8*)(lds + O_NRK + ro_), m1 = *(const LAS s16x8*)(lds + O_NRK + ro_ + 64);
                f32x4 y = mfma32(n0, u0, (f32x4){0.f, 0.f, 0.f, 0.f}); y = mfma32(n1, u1, y); y = mfma32(m0, v0, y); y = mfma32(m1, v1, y);
                qo[mt] = __builtin_bit_cast(v2u, pack4(q)); yo[mt] = __builtin_bit_cast(v2u, pack4(y));
            }
            v4u* qg = (v4u*)(ug + 8192 + (size_t)(nt * 64 + lane) * 16);
            qg[0] = (v4u){qo[0].x, qo[0].y, qo[1].x, qo[1].y}; qg[1] = (v4u){qo[2].x, qo[2].y, qo[3].x, qo[3].y};
            v4u* yg = (v4u*)(ug + 12288 + (size_t)(nt * 64 + lane) * 16);
            yg[0] = (v4u){yo[0].x, yo[0].y, yo[1].x, yo[1].y}; yg[1] = (v4u){yo[2].x, yo[2].y, yo[3].x, yo[3].y};
        }
    }
    __syncthreads();
}

__device__ __forceinline__ void rw_chain_job(const Args& a, unsigned char* ws, LAS unsigned char* wlds, int seg, int chain, int vt, int lane) {
    int s, rem; if (chain < 64) { s = chain >> 5; rem = chain & 31; } else { s = 2 + ((chain - 64) >> 5); rem = (chain - 64) & 31; }
    const int h = rem >> 1, d = rem & 1, base = s < 2 ? s * LP : 32768 + (s - 2) * LS, L = s < 2 ? LP : LS, nch = chain < 64 ? 32 : 4;
    const int r = lane & 15, g = lane >> 4;
    f32x4* stp = (f32x4*)(ws + WS_STATE) + ((size_t)(chain * 4 + vt) * 4) * 64 + lane;
    f32x4 st[4];
#pragma unroll
    for (int i = 0; i < 4; ++i) st[i] = seg == 0 ? (f32x4){0.f, 0.f, 0.f, 0.f} : stp[i * 64];
    bf16* Y = (bf16*)((unsigned char*)a.out + (d ? DO_YB : DO_YF));
    const bf16* ub = (const bf16*)((unsigned char*)a.out + DO_INT + (size_t)(seg & 1) * (128u << 20));
#define RW_DMA(ug) do { _Pragma("unroll") for (int _i = 0; _i < 16; ++_i) \
        __builtin_amdgcn_global_load_lds((const unsigned*)((ug) + (size_t)((_i >> 1) * 64 + lane) * 16 + (_i & 1) * 8), (LAS unsigned*)(wlds + _i * 1024), 16, 0, 0); } while (0)
    v4u qf0, qf1, yf0, yf1;
    { const bf16* ug = ub + (size_t)unit_of(chain, 0) * UNIT_ELEMS;
      RW_DMA(ug);
      const v4u* qp = (const v4u*)(ug + 8192 + (size_t)(vt * 64 + lane) * 16); qf0 = qp[0]; qf1 = qp[1];
      const v4u* yp = (const v4u*)(ug + 12288 + (size_t)(vt * 64 + lane) * 16); yf0 = yp[0]; yf1 = yp[1]; }
    for (int jc = 0; jc < nch; ++jc) {
        if (jc == 0) VM_WAIT(); else asm volatile("s_waitcnt vmcnt(16)" ::: "memory");
        v4u pf[4][2], rf[4][2];
#pragma unroll
        for (int i = 0; i < 4; ++i) { pf[i][0] = *(const LAS v4u*)(wlds + (2 * i) * 1024 + lane * 16); pf[i][1] = *(const LAS v4u*)(wlds + (2 * i + 1) * 1024 + lane * 16);
                                      rf[i][0] = *(const LAS v4u*)(wlds + (8 + 2 * i) * 1024 + lane * 16); rf[i][1] = *(const LAS v4u*)(wlds + (9 + 2 * i) * 1024 + lane * 16); }
        LDS_WAIT();
        const v4u cq0 = qf0, cq1 = qf1, cy0 = yf0, cy1 = yf1;
        if (jc + 1 < nch) {
            const bf16* ug = ub + (size_t)unit_of(chain, jc + 1) * UNIT_ELEMS;
            RW_DMA(ug);
            const v4u* qp = (const v4u*)(ug + 8192 + (size_t)(vt * 64 + lane) * 16); qf0 = qp[0]; qf1 = qp[1];
            const v4u* yp = (const v4u*)(ug + 12288 + (size_t)(vt * 64 + lane) * 16); yf0 = yp[0]; yf1 = yp[1];
        }
        s16x4 sb[4];
#pragma unroll
        for (int kt = 0; kt < 4; ++kt) sb[kt] = pack4(st[kt]);
        const int gchunk = seg * nch + jc;
#pragma unroll
        for (int tt = 0; tt < 4; ++tt) {
            const v2u yi = tt == 0 ? (v2u){cy0.x, cy0.y} : tt == 1 ? (v2u){cy0.z, cy0.w} : tt == 2 ? (v2u){cy1.x, cy1.y} : (v2u){cy1.z, cy1.w};
            f32x4 acc = unpack4(yi);
            acc = mfma16(__builtin_bit_cast(s16x4, (v2u){rf[tt][0].x, rf[tt][0].y}), sb[0], acc);
            acc = mfma16(__builtin_bit_cast(s16x4, (v2u){rf[tt][0].z, rf[tt][0].w}), sb[1], acc);
            acc = mfma16(__builtin_bit_cast(s16x4, (v2u){rf[tt][1].x, rf[tt][1].y}), sb[2], acc);
            acc = mfma16(__builtin_bit_cast(s16x4, (v2u){rf[tt][1].z, rf[tt][1].w}), sb[3], acc);
#pragma unroll
            for (int i = 0; i < 4; ++i) { const int lp = 64 * gchunk + 16 * tt + 4 * g + i, pos = d ? L - 1 - lp : lp;
                Y[(size_t)(base + pos) * DRW + h * 64 + 16 * vt + r] = (bf16)f2bf(acc[i]); }
        }
        f32x4 sn[4];
#pragma unroll
        for (int i = 0; i < 4; ++i) {
            const v2u qi = i == 0 ? (v2u){cq0.x, cq0.y} : i == 1 ? (v2u){cq0.z, cq0.w} : i == 2 ? (v2u){cq1.x, cq1.y} : (v2u){cq1.z, cq1.w};
            f32x4 acc = unpack4(qi);
            acc = mfma16(__builtin_bit_cast(s16x4, (v2u){pf[i][0].x, pf[i][0].y}), sb[0], acc);
            acc = mfma16(__builtin_bit_cast(s16x4, (v2u){pf[i][0].z, pf[i][0].w}), sb[1], acc);
            acc = mfma16(__builtin_bit_cast(s16x4, (v2u){pf[i][1].x, pf[i][1].y}), sb[2], acc);
            acc = mfma16(__builtin_bit_cast(s16x4, (v2u){pf[i][1].z, pf[i][1].w}), sb[3], acc);
            sn[i] = acc;
        }
#pragma unroll
        for (int i = 0; i < 4; ++i) st[i] = sn[i];
    }
#undef RW_DMA
#pragma unroll
    for (int i = 0; i < 4; ++i) stp[i * 64] = st[i];
}
}


namespace s5k {
constexpr int ST = 32, NCH = M / ST, K2 = 768, KU = 512;
constexpr size_t POW_ELEMS = (size_t)128 * 33 * 64 * 2, BB_ELEMS = (size_t)128 * 64 * 16 * 2, KTAB_ELEMS = (size_t)64 * 63 * 256;
__device__ __forceinline__ void tables_group(const Args& a, unsigned char* ws, LAS unsigned char* lds, int g, int tid) {
    float* POW = (float*)(ws + WS_S5TAB); float* BB = POW + POW_ELEMS; float* KTAB = BB + BB_ELEMS;
    LAS float* lam = (LAS float*)lds;
    LAS float* bbl = lam + 256;
    LAS float* cl = bbl + 4096;
    LAS float* pwl = cl + 4096;
    if (tid < 128) {
        const int d = tid >> 6, p = tid & 63, gi = d * 64 + g;
        const float lre = a.in[5][gi * 64 + p], lim = a.in[6][gi * 64 + p], dt = expf(a.in[7][gi]);
        const float er = expf(lre * dt); float sn, cs; sincosf(lim * dt, &sn, &cs);
        const float lbr = er * cs, lbi = er * sn;
        const float nr = lbr - 1.0f, ni = lbi, den = lre * lre + lim * lim;
        const float cfr = (nr * lre + ni * lim) / den, cfi = (ni * lre - nr * lim) / den;
        lam[(d * 64 + p) * 2] = lre * dt; lam[(d * 64 + p) * 2 + 1] = lim * dt;
        for (int h = 0; h < 16; ++h) {
            const float br = a.in[8][((size_t)gi * 64 + p) * 16 + h], bi = a.in[9][((size_t)gi * 64 + p) * 16 + h];
            const float xr = cfr * br - cfi * bi, xi = cfr * bi + cfi * br;
            bbl[((d * 64 + p) * 16 + h) * 2] = xr; bbl[((d * 64 + p) * 16 + h) * 2 + 1] = xi;
            BB[(((size_t)gi * 64 + p) * 16 + h) * 2] = xr; BB[(((size_t)gi * 64 + p) * 16 + h) * 2 + 1] = xi;
            cl[((d * 16 + h) * 64 + p) * 2] = a.in[10][((size_t)gi * 16 + h) * 64 + p]; cl[((d * 16 + h) * 64 + p) * 2 + 1] = a.in[11][((size_t)gi * 16 + h) * 64 + p];
        }
    }
    __syncthreads();
    for (int e = tid; e < 2 * 33 * 64; e += NWAVES * 64) {
        const int p = e & 63, tau = (e >> 6) % 33, d = e / (33 * 64), gi = d * 64 + g;
        const float er = expf(lam[(d * 64 + p) * 2] * (float)tau); float sn, cs; sincosf(lam[(d * 64 + p) * 2 + 1] * (float)tau, &sn, &cs);
        pwl[e * 2] = er * cs; pwl[e * 2 + 1] = er * sn;
        POW[(((size_t)gi * 33 + tau) * 64 + p) * 2] = er * cs; POW[(((size_t)gi * 33 + tau) * 64 + p) * 2 + 1] = er * sn;
    }
    __syncthreads();
    for (int o = tid; o < 63 * 256; o += NWAVES * 64) {
        const int hh = o & 255, h = hh >> 4, h2 = hh & 15, lag = (o >> 8) - 31;
        float acc = 0.f;
#pragma unroll
        for (int d = 0; d < 2; ++d) {
            if ((d == 0 && lag >= 0) || (d == 1 && lag <= 0)) {
                const int tau = lag >= 0 ? lag : -lag;
                for (int p = 0; p < 64; ++p) {
                    const float cr = cl[((d * 16 + h) * 64 + p) * 2], ci = cl[((d * 16 + h) * 64 + p) * 2 + 1];
                    const float pr = pwl[((d * 33 + tau) * 64 + p) * 2], pi = pwl[((d * 33 + tau) * 64 + p) * 2 + 1];
                    const float br = bbl[((d * 64 + p) * 16 + h2) * 2], bi = bbl[((d * 64 + p) * 16 + h2) * 2 + 1];
                    const float qr = pr * br - pi * bi, qi = pr * bi + pi * br;
                    acc += cr * qr - ci * qi;
                }
            }
        }
        KTAB[(size_t)g * 63 * 256 + o] = acc;
    }
    __syncthreads();
}
__device__ __forceinline__ void fill_weights(const Args& a, unsigned char* ws, int gw, int NGW, int lane) {
    const float* POW = (const float*)(ws + WS_S5TAB); const float* BB = POW + POW_ELEMS; const float* KTAB = BB + BB_ELEMS;
    bf16* W2 = (bf16*)(ws + WS_S5W2); bf16* E = (bf16*)(ws + WS_S5E);
    const size_t n_w2 = (size_t)64 * 512 * 96, n_e = (size_t)64 * 256 * 64, stride = (size_t)NGW * 64;
    for (size_t it = (size_t)gw * 64 + lane; it < n_w2 + n_e; it += stride) {
        float v[8];
        if (it < n_w2) {
            const int kc = (int)(it % 96), n = (int)((it / 96) % 512), g = (int)(it / (96 * 512)), t = n >> 4, h = n & 15, k0 = kc * 8;
            if (k0 < KU) {
                const int s = k0 >> 4, h0 = k0 & 15, lag = t - s;
                const float* kt = KTAB + ((size_t)(g * 63 + lag + 31) * 16 + h) * 16 + h0;
#pragma unroll
                for (int j = 0; j < 8; ++j) v[j] = kt[j] + ((lag == 0 && h0 + j == h) ? a.in[12][g * 16 + h] : 0.f);
            } else {
                const int kk = k0 - KU, d = kk >> 7, ri = (kk >> 6) & 1, p0 = kk & 63, gi = d * 64 + g, tau = d == 0 ? t + 1 : ST - t;
#pragma unroll
                for (int j = 0; j < 8; ++j) {
                    const int p = p0 + j;
                    const float cr = a.in[10][((size_t)gi * 16 + h) * 64 + p], ci = a.in[11][((size_t)gi * 16 + h) * 64 + p];
                    const float pr = POW[(((size_t)gi * 33 + tau) * 64 + p) * 2], pi = POW[(((size_t)gi * 33 + tau) * 64 + p) * 2 + 1];
                    v[j] = ri == 0 ? (cr * pr - ci * pi) : -(cr * pi + ci * pr);
                }
            }
            *(v4u*)(W2 + ((size_t)(g * 512 + n)) * K2 + k0) = rwk::pk8(v);
        } else {
            const size_t ie = it - n_w2;
            const int kc = (int)(ie % 64), n = (int)((ie / 64) % 256), g = (int)(ie / (64 * 256)), d = n >> 7, ri = (n >> 6) & 1, p = n & 63, gi = d * 64 + g;
            const int k0 = kc * 8, s = k0 >> 4, h0 = k0 & 15, tau = d == 0 ? ST - 1 - s : s;
            const float pr = POW[(((size_t)gi * 33 + tau) * 64 + p) * 2], pi = POW[(((size_t)gi * 33 + tau) * 64 + p) * 2 + 1];
#pragma unroll
            for (int j = 0; j < 8; ++j) {
                const float br = BB[(((size_t)gi * 64 + p) * 16 + h0 + j) * 2], bi = BB[(((size_t)gi * 64 + p) * 16 + h0 + j) * 2 + 1];
                v[j] = ri == 0 ? (pr * br - pi * bi) : (pr * bi + pi * br);
            }
            *(v4u*)(E + ((size_t)(g * 256 + n)) * KU + k0) = rwk::pk8(v);
        }
    }
}
__device__ __forceinline__ void chain_job(unsigned char* ws, bf16* A2, int job, int lane) {
    int s, rem; if (job < 256) { s = job / 128; rem = job % 128; } else { s = 2 + (job - 256) / 128; rem = (job - 256) % 128; }
    const int g = rem >> 1, d = rem & 1, p = lane, gi = d * 64 + g;
    const int c0 = s < 2 ? s * (LP / ST) : 2 * (LP / ST) + (s - 2) * (LS / ST), nc = s < 2 ? LP / ST : LS / ST;
    const float* POW = (const float*)(ws + WS_S5TAB);
    const float lr = POW[(((size_t)gi * 33 + 32) * 64 + p) * 2], li = POW[(((size_t)gi * 33 + 32) * 64 + p) * 2 + 1];
    const bf16* XL = (const bf16*)(ws + WS_S5XL);
    const int step = d ? -1 : 1, cfirst = d ? c0 + nc - 1 : c0;
    const int xcol = d * 128 + p, scol = KU + d * 128 + p;
    float xr = 0.f, xi = 0.f;
    { bf16* row = A2 + ((size_t)g * NCH + cfirst) * K2 + scol; row[0] = 0; row[64] = 0; }
    for (int n = 0; n < nc; n += 8) {
        float lr_[8], li_[8];
#pragma unroll
        for (int j = 0; j < 8; ++j) { const bf16* xrow = XL + ((size_t)g * NCH + cfirst + (n + j) * step) * 256 + xcol; lr_[j] = bf2f(xrow[0]); li_[j] = bf2f(xrow[64]); }
#pragma unroll
        for (int j = 0; j < 8; ++j) {
            const float nr = lr * xr - li * xi + lr_[j], ni = lr * xi + li * xr + li_[j]; xr = nr; xi = ni;
            if (n + j + 1 < nc) { bf16* row = A2 + ((size_t)g * NCH + cfirst + (n + j + 1) * step) * K2 + scol; row[0] = (bf16)f2bf(xr); row[64] = (bf16)f2bf(xi); }
        }
    }
}
}
namespace pg8 {
struct S5Order {
    int G, c, nun, mode;
    __device__ bool next(int i, Unit& u) const {
        const int L = i * G + c; if (L >= nun) return false;
        if (mode == 1) { u.pm = L; u.pn = L >> 3; } else { const int g = L >> 4; u.pm = g * 8 + ((L & 15) >> 1); u.pn = g * 2 + (L & 1); }
        return true;
    }
    __device__ __forceinline__ void a_ready(const Unit&) const {}
    __device__ __forceinline__ void done(const Unit&) const {}
};
struct EpiS5X {
    static constexpr bool PERM = true, AFTER_DRAIN = false;
    bf16_t* O;
    __device__ __forceinline__ void operator()(const f32x4 (&acc)[2][2][4][2], const Unit& u, int wr, int wc, int fr, int fq) const {
        const int row0 = u.pm * BM + wr * 64 + fr, col0 = wc * 32 + 8 * fq;
#pragma unroll
        for (int ai = 0; ai < 2; ++ai)
#pragma unroll
            for (int m = 0; m < 4; ++m) { bf16_t* rowp = O + (size_t)(row0 + ai * HALF + m * 16) * 256 + col0;
#pragma unroll
                for (int bj = 0; bj < 2; ++bj) { const f32x4 v0 = acc[ai][bj][m][0], v1 = acc[ai][bj][m][1];
                    u32x4 w; w.x = cvt_pk_bf16(v0[0], v0[1]); w.y = cvt_pk_bf16(v0[2], v0[3]); w.z = cvt_pk_bf16(v1[0], v1[1]); w.w = cvt_pk_bf16(v1[2], v1[3]);
                    *(u32x4*)(rowp + bj * HALF) = w; } }
    }
};
struct EpiS5Y {
    static constexpr bool PERM = true, AFTER_DRAIN = false;
    bf16_t* Zp;
    __device__ __forceinline__ void operator()(const f32x4 (&acc)[2][2][4][2], const Unit& u, int wr, int wc, int fr, int fq) const {
        const int row0 = u.pm * BM + wr * 64 + fr, col0 = (u.pn & 1) * BM + wc * 32 + 8 * fq;
#pragma unroll
        for (int ai = 0; ai < 2; ++ai)
#pragma unroll
            for (int m = 0; m < 4; ++m) {
                const int row = row0 + ai * HALF + m * 16, g = row >> 11, c = row & 2047;
#pragma unroll
                for (int bj = 0; bj < 2; ++bj) {
                    const int col = col0 + bj * HALF, t = col >> 4, h0 = col & 15;
                    float v[8];
#pragma unroll
                    for (int j = 0; j < 4; ++j) { v[j] = acc[ai][bj][m][0][j]; v[4 + j] = acc[ai][bj][m][1][j]; }
#pragma unroll
                    for (int j = 0; j < 8; ++j) { const float x = v[j]; v[j] = x * sigmoid_f(1.5957691216057308f * (x + 0.044715f * x * x * x)); }
                    u32x4 w; w.x = cvt_pk_bf16(v[0], v[1]); w.y = cvt_pk_bf16(v[2], v[3]); w.z = cvt_pk_bf16(v[4], v[5]); w.w = cvt_pk_bf16(v[6], v[7]);
                    *(u32x4*)(Zp + (size_t)(c * 32 + t) * 1024 + g * 16 + h0) = w;
                }
            }
    }
};
}


__device__ __forceinline__ void transpose_item(const float* W, int ldw, int K, bf16* WT, int drow0, LAS float* scr, int k0, int n0, int lane) {
#pragma unroll 8
    for (int i = 0; i < 32; ++i) { const int kk = 2 * i + (lane >> 5); scr[kk * 33 + (lane & 31)] = W[(size_t)(k0 + kk) * ldw + n0 + (lane & 31)]; }
    LDS_WAIT();
    const int c = lane & 7;
#pragma unroll
    for (int j = 0; j < 4; ++j) { const int n = (lane >> 3) + 8 * j; const LAS float* s = scr + (8 * c) * 33 + n;
        v4u o; o.x = pk2(s[0 * 33], s[1 * 33]); o.y = pk2(s[2 * 33], s[3 * 33]); o.z = pk2(s[4 * 33], s[5 * 33]); o.w = pk2(s[6 * 33], s[7 * 33]);
        *(v4u*)(WT + (size_t)(drow0 + n) * K + k0 + 8 * c) = o; }
    LDS_WAIT();
}
__device__ __forceinline__ int win_dest_row(int n) { return n < 1024 ? n : (n < 2048 ? n + 3328 : (n < 5376 ? n - 1024 : n)); }
__device__ __forceinline__ const float* xrow_ptr(const float* xp, const float* xs, int m) { return m < 32768 ? xp + (size_t)m * D : xs + (size_t)(m - 32768) * D; }

__device__ __forceinline__ void p0_prologue(const Args& a, unsigned char* ws, LAS unsigned char* lds, int gw, int NGW, int wave, int lane) {
    LAS float* scr = (LAS float*)(lds + wave * 16384);
    constexpr int I_IN = (D / 64) * (NIN / 32), I_GLU = (1024 / 64) * (1024 / 32), I_SO = (1024 / 64) * (2048 / 32), I_WO = (2048 / 64) * (2048 / 32);
    constexpr int NITEMS = I_IN + I_GLU + 2 * I_SO + I_WO;
    for (int it = gw; it < NITEMS; it += NGW) {
        int r = it;
        if (r < I_IN) { const int nblk = NIN / 32, kb = r / nblk, nb = r % nblk; transpose_item(a.in[4], NIN, D, (bf16*)(ws + WS_WT), win_dest_row(32 * nb), scr, 64 * kb, 32 * nb, lane); continue; } r -= I_IN;
        if (r < I_GLU) { const int nblk = 1024 / 32, kb = r / nblk, nb = r % nblk; transpose_item(a.in[13], 1024, 1024, (bf16*)(ws + WS_GLUT), 32 * nb, scr, 64 * kb, 32 * nb, lane); continue; } r -= I_GLU;
        if (r < I_SO) { const int nblk = 2048 / 32, kb = r / nblk, nb = r % nblk; transpose_item(a.in[14], 2048, 1024, (bf16*)(ws + WS_S5OT), 32 * nb, scr, 64 * kb, 32 * nb, lane); continue; } r -= I_SO;
        if (r < I_SO) { const int nblk = 2048 / 32, kb = r / nblk, nb = r % nblk; transpose_item(a.in[25], 2048, 1024, (bf16*)(ws + WS_RWOT), 32 * nb, scr, 64 * kb, 32 * nb, lane); continue; } r -= I_SO;
        { const int nblk = 2048 / 32, kb = r / nblk, nb = r % nblk; transpose_item(a.in[26], 2048, 2048, (bf16*)(ws + WS_WOT), 32 * nb, scr, 64 * kb, 32 * nb, lane); }
    }
    { const int bxx = gw / NWAVES; if (bxx < 64) s5k::tables_group(a, ws, lds, bxx, wave * 64 + lane); }
    { bf16* LUT = (bf16*)(ws + WS_LUT);
      for (int e = gw * 64 + lane; e < 4 * 16 * 64 * 64; e += NGW * 64) {
          const int j = e & 63, c = (e >> 6) & 63, h = (e >> 12) & 15, rd = e >> 16, role = rd >> 1, d = rd & 1;
          LUT[e] = (bf16)f2bf((role ? a.in[19] : a.in[17])[(size_t)(d * 64 + j) * 1024 + h * 64 + c]); } }
    const float* g = a.in[2];
    f32x4 gv[8];
#pragma unroll
    for (int j = 0; j < 8; ++j) gv[j] = ((const f32x4*)g)[lane + 64 * j];
    bf16* HN = (bf16*)(ws + WS_HN);
    for (int m = gw; m < M; m += NGW) {
        const f32x4* xr = (const f32x4*)xrow_ptr(a.in[0], a.in[1], m) + lane;
        f32x4 v[8]; float s = 0.f;
#pragma unroll
        for (int j = 0; j < 8; ++j) { v[j] = xr[64 * j]; s += (v[j].x * v[j].x + v[j].y * v[j].y) + (v[j].z * v[j].z + v[j].w * v[j].w); }
        const float rstd = 1.0f / sqrtf(wave_sum(s) * (1.0f / D) + RMS_EPS);
        v2u* o8 = (v2u*)(HN + (size_t)m * D) + lane;
#pragma unroll
        for (int j = 0; j < 8; ++j) { v2u o; o.x = pk2(v[j].x * rstd * gv[j].x, v[j].y * rstd * gv[j].y); o.y = pk2(v[j].z * rstd * gv[j].z, v[j].w * rstd * gv[j].w); o8[64 * j] = o; }
    }
}

__device__ __forceinline__ void unpack8(const bf16* p, float (&o)[8]) {
    const v4u a = *(const v4u*)p;
    o[0] = blo(a.x); o[1] = bhi(a.x); o[2] = blo(a.y); o[3] = bhi(a.y); o[4] = blo(a.z); o[5] = bhi(a.z); o[6] = blo(a.w); o[7] = bhi(a.w);
}
__device__ __forceinline__ void pack8(bf16* p, const float (&v)[8]) {
    v4u a; a.x = pk2(v[0], v[1]); a.y = pk2(v[2], v[3]); a.z = pk2(v[4], v[5]); a.w = pk2(v[6], v[7]); *(v4u*)p = a;
}
__device__ __forceinline__ void p3_finalize(const Args& a, unsigned char* ws, int gw, int NGW, int lane) {
    const bf16* RWIN = (const bf16*)(ws + WS_RWIN);
    unsigned char* ob = (unsigned char*)a.out;
    bf16* YF = (bf16*)(ob + DO_YF); const bf16* YB = (const bf16*)(ob + DO_YB);
    const int half = gw & 1, c0 = half * 512 + lane * 8;
    float lnw[8], lnb[8], rk[8], mur[8], muk[8], muv[8];
#pragma unroll
    for (int j = 0; j < 8; ++j) { lnw[j] = a.in[23][c0 + j]; lnb[j] = a.in[24][c0 + j]; rk[j] = a.in[22][c0 + j]; mur[j] = a.in[15][c0 + j]; muk[j] = a.in[15][1024 + c0 + j]; muv[j] = a.in[15][2048 + c0 + j]; }
    for (int m = gw >> 1; m < M; m += NGW >> 1) {
        const int t = m < 32768 ? (m & (LP - 1)) : ((m - 32768) & (LS - 1)), L = m < 32768 ? LP : LS;
        const bool hp = t > 0, hn = t < L - 1;
        float o[8];
        float y[8];
        {
            float yf[8], yb[8];
            unpack8(YF + (size_t)m * DRW + c0, yf); unpack8(YB + (size_t)m * DRW + c0, yb);
#pragma unroll
            for (int j = 0; j < 8; ++j) y[j] = yf[j] + yb[j];
        }
        float s1 = 0.f;
#pragma unroll
        for (int j = 0; j < 8; ++j) s1 += y[j];
        s1 += __shfl_xor(s1, 1); s1 += __shfl_xor(s1, 2); s1 += __shfl_xor(s1, 4);
        const float mean = s1 * (1.0f / 64.0f);
        float s2 = 0.f;
#pragma unroll
        for (int j = 0; j < 8; ++j) { const float dd = y[j] - mean; s2 += dd * dd; }
        s2 += __shfl_xor(s2, 1); s2 += __shfl_xor(s2, 2); s2 += __shfl_xor(s2, 4);
        const float rstd = 1.0f / sqrtf(s2 * (1.0f / 64.0f) + GN_EPS);
        float zr[8], zk[8], zv[8];
        const bf16* pc = RWIN + (size_t)m * DRWIN + c0;
#pragma unroll
        for (int comp = 0; comp < 3; ++comp) {
            float cc[8], pp[8], nn[8];
            unpack8(pc + comp * 1024, cc);
            if (hp) unpack8(pc - DRWIN + comp * 1024, pp); else {
#pragma unroll
                for (int j = 0; j < 8; ++j) pp[j] = 0.f; }
            if (hn) unpack8(pc + DRWIN + comp * 1024, nn); else {
#pragma unroll
                for (int j = 0; j < 8; ++j) nn[j] = 0.f; }
#pragma unroll
            for (int j = 0; j < 8; ++j) {
                const float muc = comp == 0 ? mur[j] : (comp == 1 ? muk[j] : muv[j]);
                const float zz = cc[j] + (0.5f * (pp[j] + nn[j]) - cc[j]) * muc;
                if (comp == 0) zr[j] = zz; else if (comp == 1) zk[j] = zz; else zv[j] = zz;
            }
        }
        float dot = 0.f;
#pragma unroll
        for (int j = 0; j < 8; ++j) dot += zr[j] * zk[j] * rk[j];
        dot += __shfl_xor(dot, 1); dot += __shfl_xor(dot, 2); dot += __shfl_xor(dot, 4);
#pragma unroll
        for (int j = 0; j < 8; ++j) o[j] = (y[j] - mean) * rstd * lnw[j] + lnb[j] + dot * zv[j];
        pack8(YF + (size_t)m * DRW + c0, o);
    }
}

__device__ __forceinline__ void p12_final(const Args& a, int gw, int NGW, int lane) {
    const float* g = a.in[3];
    f32x4 gv[8];
#pragma unroll
    for (int j = 0; j < 8; ++j) gv[j] = ((const f32x4*)g)[lane + 64 * j];
    for (int m = gw; m < M; m += NGW) {
        const f32x4* xr = (const f32x4*)xrow_ptr(a.in[0], a.in[1], m) + lane;
        f32x4* orow = (f32x4*)(a.out + (size_t)m * D) + lane;
        f32x4 v[8]; float s = 0.f;
#pragma unroll
        for (int j = 0; j < 8; ++j) { v[j] = orow[64 * j]; s += (v[j].x * v[j].x + v[j].y * v[j].y) + (v[j].z * v[j].z + v[j].w * v[j].w); }
        const float rstd = 1.0f / sqrtf(wave_sum(s) * (1.0f / D) + RMS_EPS);
#pragma unroll
        for (int j = 0; j < 8; ++j) { const f32x4 xv = xr[64 * j]; orow[64 * j] = xv + v[j] * rstd * gv[j]; }
    }
}

__global__ void __launch_bounds__(NWAVES * 64, 2) mk_fwd(Args args) {
    extern __shared__ __attribute__((aligned(16))) unsigned char lds_raw[];
    LAS unsigned char* lds = (LAS unsigned char*)lds_raw;
    volatile LAS unsigned* MISC = (volatile LAS unsigned*)(lds + MISC_OFF);
    const int wave = __builtin_amdgcn_readfirstlane((int)threadIdx.x >> 6);
#define lane mk_lane()
    const int tid0 = threadIdx.x;
    const int G = gridDim.x; const int bx = blockIdx.x; const int vcu = (G % 8 == 0) ? (bx % 8) * (G / 8) + bx / 8 : bx;
    unsigned char* ws = args.ws;
    unsigned* ctl = (unsigned*)(ws + WS_CTL);
    for (int u = tid0; u < (LDS_BYTES - MISC_OFF) / 4; u += NWAVES * 64) ((LAS unsigned*)(lds + MISC_OFF))[u] = 0u;
    __syncthreads();
    XcdBarrier bar = xcd_barrier_post(ctl + CW_BAR, MISC + 8, wave);
#define GRID_BAR() xcd_barrier(bar, wave)
#ifndef ONLY_PHASE
#define ONLY_PHASE -1
#endif
#define IN(k) (ONLY_PHASE < 0 || ONLY_PHASE == (k))
    const int gw = vcu * NWAVES + wave, NGW = G * NWAVES;
    bf16* WT = (bf16*)(ws + WS_WT); bf16* HN = (bf16*)(ws + WS_HN); bf16* RWIN = (bf16*)(ws + WS_RWIN); bf16* Z = (bf16*)(ws + WS_Z); bf16* ZG = (bf16*)(ws + WS_ZG);
    bf16* A2 = (bf16*)((unsigned char*)args.out + DO_A2);
    bf16* YN = (bf16*)((unsigned char*)args.out + DO_YF); bf16* Q = (bf16*)((unsigned char*)args.out + DO_Q); bf16* P = RWIN;

    if (IN(0)) { p0_prologue(args, ws, lds, gw, NGW, wave, lane); GRID_BAR(); }
    if (IN(1)) {
        s5k::fill_weights(args, ws, gw, NGW, lane);
        pg8::Gemm g{HN, WT, M, 4352, D, D}; pg8::StaticOrder S; S.init(M, 4352, G, bx);
        pg8::EpiG1 E{A2, RWIN};
        pg8::gemm_phase<pg8::EpiG1, pg8::StaticOrder, PG8_ALIGN, PG8_SP2>(lds, g, S, E, wave);
        GRID_BAR();
    }
    if (IN(2)) {
        pg8::Gemm g{A2, (const bf16*)(ws + WS_S5E), 131072, 256, s5k::KU, s5k::K2}; pg8::S5Order S{G, bx, 512, 1};
        pg8::EpiS5X E{(bf16*)(ws + WS_S5XL)};
        pg8::gemm_phase<pg8::EpiS5X, pg8::S5Order, PG8_ALIGN, PG8_SP2>(lds, g, S, E, wave);
        GRID_BAR();
    }
    if (IN(3)) {
        const int gwt = wave * G + vcu;
        for (int j = gwt; j < 2304; j += NGW) s5k::chain_job(ws, A2, j, lane);
        GRID_BAR();
    }
    if (IN(4)) {
        pg8::Gemm g{A2, (const bf16*)(ws + WS_S5W2), 131072, 512, s5k::K2, s5k::K2}; pg8::S5Order S{G, bx, 1024, 2};
        pg8::EpiS5Y E{Z};
        pg8::gemm_phase<pg8::EpiS5Y, pg8::S5Order, PG8_ALIGN, PG8_SP2>(lds, g, S, E, wave);
        GRID_BAR();
    }
    if (IN(5)) {
        for (int e = tid0; e < 3328; e += NWAVES * 64) ((LAS float*)(lds + rwk::O_MU))[e] = args.in[15][e];
        __syncthreads();
        for (int k = 0; k <= rwk::NSEG; ++k) {
            if (k >= 1) {
                const int seg = k - 1;
                int J, Jstride;
                if (bx < 64 && wave < 4) { J = bx * 4 + wave; Jstride = 1 << 20; }
                else { const int fw = bx < 64 ? bx * 4 + (wave - 4) : 256 + (bx - 64) * 8 + wave; J = 256 + fw; Jstride = 1792; }
                for (; J < 2304; J += Jstride) {
                    const int chain = J < 256 ? (J >> 2) : 64 + ((J - 256) >> 2), vt = J & 3;
                    rwk::rw_chain_job(args, ws, lds + wave * 16384, seg, chain, vt, lane);
                }
                VM_WAIT(); __syncthreads();
            }
            if (k < rwk::NSEG) {
                const int seg = k;
                const int u0 = bx < 64 ? bx * 10 : 640 + (bx - 64) * 18, u1 = u0 + (bx < 64 ? 10 : 18);
                rwk::RawUnit R;
                rwk::rw_load_unit(args, ws, seg, u0, wave, lane, R);
                for (int u = u0; u < u1; ++u) {
                    rwk::RawUnit Rn;
                    rwk::rw_load_unit(args, ws, seg, u + 1 < u1 ? u + 1 : u, wave, lane, Rn);
                    rwk::rw_precompute_unit(args, ws, lds, seg, u, wave, lane, R);
                    R = Rn;
                }
            }
            GRID_BAR();
        }
    }
    if (IN(6)) { p3_finalize(args, ws, gw, NGW, lane); GRID_BAR(); }
    if (IN(7)) {
        pg8::Gemm g{Z, (const bf16*)(ws + WS_GLUT), M, 1024, 1024, 1024}; pg8::StaticOrder S; S.init(M, 1024, G, bx);
        pg8::EpiMix<1> E{ZG, Z, nullptr, 1024};
        pg8::gemm_phase<pg8::EpiMix<1>, pg8::StaticOrder, PG8_ALIGN, PG8_SP2>(lds, g, S, E, wave);
    }
    if (IN(8)) {
        pg8::Gemm g{HN, WT + (size_t)4352 * D, M, 1024, D, D}; pg8::StaticOrder S; S.init(M, 1024, G, bx);
        pg8::EpiMix<2> E{ZG, ZG, nullptr, 1024};
        pg8::gemm_phase<pg8::EpiMix<2>, pg8::StaticOrder, PG8_ALIGN, PG8_SP2>(lds, g, S, E, wave);
    }
    if (IN(9)) {
        pg8::Gemm g{HN, WT + (size_t)5376 * D, M, 1024, D, D}; pg8::StaticOrder S; S.init(M, 1024, G, bx);
        pg8::EpiMix<2> E{YN, YN, nullptr, 1024};
        pg8::gemm_phase<pg8::EpiMix<2>, pg8::StaticOrder, PG8_ALIGN, PG8_SP2>(lds, g, S, E, wave);
        GRID_BAR();
    }
    if (IN(10)) {
        pg8::Gemm g{ZG, (const bf16*)(ws + WS_S5OT), M, 2048, 1024, 1024}; pg8::StaticOrder S; S.init(M, 2048, G, bx);
        pg8::EpiMix<0> E{P, nullptr, nullptr, 2048};
        pg8::gemm_phase<pg8::EpiMix<0>, pg8::StaticOrder, PG8_ALIGN, PG8_SP2>(lds, g, S, E, wave);
    }
    if (IN(11)) {
        pg8::Gemm g{HN, WT + (size_t)6400 * D, M, 2048, D, D}; pg8::StaticOrder S; S.init(M, 2048, G, bx);
        pg8::EpiMix<1> E{P, P, nullptr, 2048};
        pg8::gemm_phase<pg8::EpiMix<1>, pg8::StaticOrder, PG8_ALIGN, PG8_SP2>(lds, g, S, E, wave);
    }
    if (IN(12)) {
        pg8::Gemm g{YN, (const bf16*)(ws + WS_RWOT), M, 2048, 1024, 1024}; pg8::StaticOrder S; S.init(M, 2048, G, bx);
        pg8::EpiMix<0> E{Q, nullptr, nullptr, 2048};
        pg8::gemm_phase<pg8::EpiMix<0>, pg8::StaticOrder, PG8_ALIGN, PG8_SP2>(lds, g, S, E, wave);
    }
    if (IN(13)) {
        pg8::Gemm g{HN, WT + (size_t)8448 * D, M, 2048, D, D}; pg8::StaticOrder S; S.init(M, 2048, G, bx);
        pg8::EpiMix<3> E{P, Q, P, 2048};
        pg8::gemm_phase<pg8::EpiMix<3>, pg8::StaticOrder, PG8_ALIGN, PG8_SP2>(lds, g, S, E, wave);
        GRID_BAR();
    }
    if (IN(14)) {
        pg8::Gemm g{P, (const bf16*)(ws + WS_WOT), M, 2048, D, D}; pg8::StaticOrder S; S.init(M, 2048, G, bx);
        pg8::EpiF32 E{args.out, 2048};
        pg8::gemm_phase<pg8::EpiF32, pg8::StaticOrder, PG8_ALIGN, PG8_SP2>(lds, g, S, E, wave);
        GRID_BAR();
    }
    if (IN(15)) { p12_final(args, gw, NGW, lane); }
#undef IN
#undef lane
}

extern "C" void kernel_launch(void* const* d_in, const int* in_sizes, int n_in, void* d_out, int out_size, void* d_ws, size_t ws_size, hipStream_t stream) {
    static int grid = 0;
    if (grid == 0) {
        if (n_in != 27 || out_size != 2 * 32768 * D || ws_size < WS_END) { fprintf(stderr, "kernel_launch: unexpected shapes (n_in %d out %d ws %zu)\n", n_in, out_size, ws_size); grid = -1; return; }
        int dev = 0, cus = 0, per_cu = 0;
        if (hipGetDevice(&dev) != hipSuccess || hipDeviceGetAttribute(&cus, hipDeviceAttributeMultiprocessorCount, dev) != hipSuccess) { grid = -1; return; }
        if (hipFuncSetAttribute((const void*)mk_fwd, hipFuncAttributeMaxDynamicSharedMemorySize, LDS_BYTES) != hipSuccess) { fprintf(stderr, "kernel_launch: hipFuncSetAttribute failed\n"); grid = -1; return; }
        if (hipOccupancyMaxActiveBlocksPerMultiprocessor(&per_cu, (const void*)mk_fwd, NWAVES * 64, LDS_BYTES) != hipSuccess || per_cu < 1)
            fprintf(stderr, "kernel_launch: note: occupancy query reports %d workgroups per CU\n", per_cu);
        (void)hipGetLastError();
        grid = cus;
    }
    if (grid < 0) return;
    if (hipMemsetAsync((char*)d_ws + WS_CTL, 0, CTL_ZERO_BYTES, stream) != hipSuccess) return;
    Args a{};
    for (int i = 0; i < 27; ++i) a.in[i] = (const float*)d_in[i];
    a.out = (float*)d_out; a.ws = (unsigned char*)d_ws; a.pad = 0;
    { const int li = 0; a.ph_lo = 0; a.ph_hi = N_PHASES; a.li = 0;
        hipLaunchKernelGGL(mk_fwd, dim3(grid), dim3(NWAVES * 64), LDS_BYTES, stream, a);
        const hipError_t le = hipPeekAtLastError();
        if (le != hipSuccess) { fprintf(stderr, "kernel_launch: launch %d failed: %s\n", li, hipGetErrorName(le)); }
    }
}
```

```cpp
#include <hip/hip_runtime.h>
#include <cstdio>
#include <cstdint>
#define MK_N_LAUNCHES 1

__device__ __forceinline__ int mk_lane() { int l; asm volatile("v_mbcnt_lo_u32_b32 %0, -1, 0\n\tv_mbcnt_hi_u32_b32 %0, -1, %0" : "=v"(l)); return l; }
namespace pg8 {
#define PG8_LAS __attribute__((address_space(3)))
typedef unsigned short bf16_t;
typedef short bf16x8 __attribute__((ext_vector_type(8)));
typedef float f32x4 __attribute__((ext_vector_type(4)));
typedef unsigned u32x4 __attribute__((ext_vector_type(4)));
constexpr int BM = 256, BK = 64, HALF = 128, HTB = HALF * BK * 2  , STAGE_BYTES = 8 * HTB, NXCD = 8, WGM = 8;

__host__ __device__ __forceinline__ int lds_byte(int r, int c) { const int st = (r >> 4) * 2 + (c >> 5), rr = r & 15, cc = c & 31, ob = rr * 64 + cc * 2; return st * 1024 + (ob ^ (((ob >> 9) & 1) << 5)); }
__host__ __device__ __forceinline__ void stage_rc(int b, int& R, int& C) { const int st = b / 1024, sb = b % 1024, swz = sb ^ (((sb >> 9) & 1) << 5); R = (st >> 1) * 16 + swz / 64; C = (st & 1) * 32 + (swz % 64) / 2; }
__host__ __device__ __forceinline__ int perm32(int rho) { const int n = rho >> 4, i = rho & 15; return 8 * (i >> 2) + 4 * n + (i & 3); }

struct Unit { int pm, pn; };
struct Gemm { const bf16_t* A; const bf16_t* Bt; int M, N, K, lda; };

struct StaticOrder {
    int nM, nN, nwg, G, c;
    __host__ __device__ void init(int M, int N, int G_, int c_) { nM = M / BM; nN = N / BM; nwg = nM * nN; G = G_; c = c_; }
    __host__ __device__ bool next(int i, Unit& u) const {
        const long L = (long)i * G + c; if (L >= nwg) return false;
        int wgid = (int)L; { const int q = nwg / NXCD, r = nwg % NXCD, xcd = wgid % NXCD, off = wgid / NXCD; wgid = (xcd < r ? xcd * (q + 1) : r * (q + 1) + (xcd - r) * q) + off; }
        const int nig = WGM * nN, gid = wgid / nig, fm = gid * WGM, gsz = (nM - fm) < WGM ? (nM - fm) : WGM;
        u.pm = fm + ((wgid % nig) % gsz); u.pn = (wgid % nig) / gsz; return true;
    }
    __device__ __forceinline__ void a_ready(const Unit&) const {}
    __device__ __forceinline__ void done(const Unit&) const {}
};

__device__ __forceinline__ unsigned cvt_pk_bf16(float lo, float hi) { unsigned r; asm volatile("v_cvt_pk_bf16_f32 %0, %1, %2" : "=v"(r) : "v"(lo), "v"(hi)); return r; }

__device__ __forceinline__ float bf_lo(unsigned u) { return __uint_as_float(u << 16); }
__device__ __forceinline__ float bf_hi(unsigned u) { return __uint_as_float(u & 0xffff0000u); }
__device__ __forceinline__ float sigmoid_f(float v) { return __builtin_amdgcn_rcpf(1.0f + __expf(-v)); }

struct EpiG1 {
    static constexpr bool PERM = true, AFTER_DRAIN = false;
    bf16_t* a2; bf16_t* rwin;
    __device__ __forceinline__ void operator()(const f32x4 (&acc)[2][2][4][2], const Unit& u, int wr, int wc, int fr, int fq) const {
        const int row0 = u.pm * BM + wr * 64 + fr; const int colt = u.pn * BM; const bool s5 = colt < 1024;
        const int col0 = colt + wc * 32 + 8 * fq;
#ifndef EPI_REP
#define EPI_REP 1
#endif
        _Pragma("unroll 1") for (int er_ = 0; er_ < EPI_REP; ++er_)
#pragma unroll
        for (int ai = 0; ai < 2; ++ai)
#pragma unroll
            for (int m = 0; m < 4; ++m) { const int row = row0 + ai * HALF + m * 16;
#pragma unroll
                for (int bj = 0; bj < 2; ++bj) { const f32x4 v0 = acc[ai][bj][m][0], v1 = acc[ai][bj][m][1]; const int col = col0 + bj * HALF;
                    u32x4 w; w.x = cvt_pk_bf16(v0[0], v0[1]); w.y = cvt_pk_bf16(v0[2], v0[3]); w.z = cvt_pk_bf16(v1[0], v1[1]); w.w = cvt_pk_bf16(v1[2], v1[3]);
                    bf16_t* dst = s5 ? a2 + ((size_t)((col >> 4) * 2048 + (row >> 5)) * 768 + (row & 31) * 16 + (col & 15))
                                     : rwin + (size_t)row * 3328 + (col - 1024);
                    *(u32x4*)dst = w; } }
    }
};
template <int MODE> struct EpiMix {
    static constexpr bool PERM = true, AFTER_DRAIN = false;
    bf16_t* O; const bf16_t* S; const bf16_t* Add; int ld;
    __device__ __forceinline__ void operator()(const f32x4 (&acc)[2][2][4][2], const Unit& u, int wr, int wc, int fr, int fq) const {
        const int row0 = u.pm * BM + wr * 64 + fr, col0 = u.pn * BM + wc * 32 + 8 * fq;
#pragma unroll
        for (int ai = 0; ai < 2; ++ai) {
            u32x4 sv4[4][2], av4[4][2];
            if (MODE >= 1) {
#pragma unroll
                for (int m = 0; m < 4; ++m)
#pragma unroll
                    for (int bj = 0; bj < 2; ++bj) { const size_t off = (size_t)(row0 + ai * HALF + m * 16) * ld + col0 + bj * HALF;
                        sv4[m][bj] = *(const u32x4*)(S + off); if (MODE == 3) av4[m][bj] = *(const u32x4*)(Add + off); }
            }
#pragma unroll
            for (int m = 0; m < 4; ++m) {
#pragma unroll
                for (int bj = 0; bj < 2; ++bj) {
                    const size_t off = (size_t)(row0 + ai * HALF + m * 16) * ld + col0 + bj * HALF;
                    float v[8];
#pragma unroll
                    for (int j = 0; j < 4; ++j) { v[j] = acc[ai][bj][m][0][j]; v[4 + j] = acc[ai][bj][m][1][j]; }
                    if (MODE >= 1) {
                        const u32x4 s = sv4[m][bj];
                        const float sv[8] = {bf_lo(s.x), bf_hi(s.x), bf_lo(s.y), bf_hi(s.y), bf_lo(s.z), bf_hi(s.z), bf_lo(s.w), bf_hi(s.w)};
#pragma unroll
                        for (int j = 0; j < 8; ++j) { const float sg = sigmoid_f(v[j]); v[j] = (MODE == 2) ? sv[j] * v[j] * sg : sv[j] * sg; }
                    }
                    if (MODE == 3) {
                        const u32x4 a = av4[m][bj];
                        const float av[8] = {bf_lo(a.x), bf_hi(a.x), bf_lo(a.y), bf_hi(a.y), bf_lo(a.z), bf_hi(a.z), bf_lo(a.w), bf_hi(a.w)};
#pragma unroll
                        for (int j = 0; j < 8; ++j) v[j] += av[j];
                    }
                    u32x4 w; w.x = cvt_pk_bf16(v[0], v[1]); w.y = cvt_pk_bf16(v[2], v[3]); w.z = cvt_pk_bf16(v[4], v[5]); w.w = cvt_pk_bf16(v[6], v[7]);
                    *(u32x4*)(O + off) = w;
                }
            }
        }
    }
};
template <int MLO, int MHI> struct EpiSplit {
    static constexpr bool PERM = true, AFTER_DRAIN = false;
    EpiMix<MLO> lo; EpiMix<MHI> hi; int split;
    __device__ __forceinline__ void operator()(const f32x4 (&acc)[2][2][4][2], const Unit& u, int wr, int wc, int fr, int fq) const {
        if (u.pn < split) lo(acc, u, wr, wc, fr, fq);
        else { const Unit v{u.pm, u.pn - split}; hi(acc, v, wr, wc, fr, fq); }
    }
};
struct EpiF32 {
    static constexpr bool PERM = false, AFTER_DRAIN = false;
    float* C; int ldc;
    __device__ __forceinline__ void operator()(const f32x4 (&acc)[2][2][4][2], const Unit& u, int wr, int wc, int fr, int fq) const {
        const int row0 = u.pm * BM + wr * 64 + fr, col0 = u.pn * BM + wc * 32 + 4 * fq;
#pragma unroll
        for (int ai = 0; ai < 2; ++ai)
#pragma unroll
            for (int m = 0; m < 4; ++m) { float* rowp = C + (size_t)(row0 + ai * HALF + m * 16) * ldc + col0;
#pragma unroll
                for (int bj = 0; bj < 2; ++bj)
#pragma unroll
                    for (int n = 0; n < 2; ++n) *(f32x4*)(rowp + bj * HALF + n * 16) = acc[ai][bj][m][n]; }
    }
};
template <class Epi, class Sched, bool ALIGN_EPI = false, bool SP2 = false>
__device__ __forceinline__ void gemm_phase(PG8_LAS unsigned char* lds, const Gemm g, const Sched& S, const Epi& E, const int mk_wave) {
    const int lane = mk_lane(), wid = mk_wave, tid = wid * 64 + lane, wr = wid >> 2, wc = wid & 3, fr = lane & 15, fq = lane >> 4;
    const int K = g.K, nt = K / BK;
    unsigned voffA[2], voffB[2];
#pragma unroll
    for (int i = 0; i < 2; ++i) { int R, C; stage_rc(tid * 16 + i * 8192, R, C); const int Rb = Epi::PERM ? ((R & ~31) + perm32(R & 31)) : R;
        voffA[i] = (unsigned)(R * g.lda + C) * 2u; voffB[i] = (unsigned)(Rb * K + C) * 2u; }
    const size_t kstep = (size_t)(BK * 2);
    const size_t hstep = (size_t)HALF * K * 2;
    const size_t tstep = 2 * hstep;
    const size_t hstepA = (size_t)HALF * g.lda * 2, tstepA = 2 * hstepA;
    const unsigned ldsw = (unsigned)wid * 1024u;
    const int aoff = lds_byte(wr * 64 + fr, fq * 8), boff = lds_byte(wc * 32 + fr, fq * 8);
#define PG8_SA(b, h) (((b) * 2 + (h)) * HTB)
#define PG8_SB(b, h) ((4 + (b) * 2 + (h)) * HTB)
#define PG8_STAGE(bufoff, gbase, voff) do { _Pragma("unroll") for (int _i = 0; _i < 2; ++_i) \
        __builtin_amdgcn_global_load_lds((const unsigned*)((const char*)(gbase) + (voff)[_i]), (PG8_LAS unsigned*)(lds + (bufoff) + ldsw + _i * 8192), 16, 0, 0); } while (0)
#define PG8_LDA(dst, b, h) do { _Pragma("unroll") for (int m = 0; m < 4; ++m) _Pragma("unroll") for (int k = 0; k < 2; ++k) dst[m][k] = *(const PG8_LAS bf16x8*)(lds + PG8_SA(b, h) + aoff + m * 2048 + k * 1024); } while (0)
#define PG8_LDB(dst, b, h) do { _Pragma("unroll") for (int n = 0; n < 2; ++n) _Pragma("unroll") for (int k = 0; k < 2; ++k) dst[n][k] = *(const PG8_LAS bf16x8*)(lds + PG8_SB(b, h) + boff + n * 2048 + k * 1024); } while (0)
#define PG8_MMA(ai, bj, At, Bt) do { __builtin_amdgcn_s_setprio(1); _Pragma("unroll") for (int m = 0; m < 4; ++m) _Pragma("unroll") for (int n = 0; n < 2; ++n) _Pragma("unroll") for (int k = 0; k < 2; ++k) \
        acc[ai][bj][m][n] = __builtin_amdgcn_mfma_f32_16x16x32_bf16(Bt[n][k], At[m][k], acc[ai][bj][m][n], 0, 0, 0); __builtin_amdgcn_s_setprio(0); } while (0)
#define PG8_WAIT_V(n) asm volatile("s_waitcnt vmcnt(" #n ")" ::: "memory")
#define PG8_WAIT_L(n) asm volatile("s_waitcnt lgkmcnt(" #n ")" ::: "memory")
#define PG8_BAR __builtin_amdgcn_s_barrier()
#define PG8_SCHED __builtin_amdgcn_sched_barrier(0)
    Unit cur, nxt; int ui = 0;
    if (!S.next(0, cur)) return;
    f32x4 acc[2][2][4][2];
#pragma unroll
    for (int a = 0; a < 2; ++a)
#pragma unroll
        for (int b = 0; b < 2; ++b)
#pragma unroll
            for (int m = 0; m < 4; ++m)
#pragma unroll
                for (int n = 0; n < 2; ++n) acc[a][b][m][n] = (f32x4){0.f, 0.f, 0.f, 0.f};
    bf16x8 At[4][2], B0[2][2], B1[2][2];
    const char* cA = (const char*)g.A + (size_t)cur.pm * tstepA; const char* cB = (const char*)g.Bt + (size_t)cur.pn * tstep;
    S.a_ready(cur);
    if constexpr (SP2) {
        PG8_STAGE(PG8_SB(0, 0), cB, voffB); PG8_STAGE(PG8_SB(0, 1), cB + hstep, voffB); PG8_STAGE(PG8_SA(0, 0), cA, voffA); PG8_STAGE(PG8_SA(0, 1), cA + hstepA, voffA);
        if (wr == 1) PG8_BAR;
        PG8_WAIT_V(2); PG8_BAR;
        PG8_STAGE(PG8_SB(1, 0), cB + kstep, voffB); PG8_STAGE(PG8_SA(1, 0), cA + kstep, voffA); PG8_STAGE(PG8_SB(1, 1), cB + hstep + kstep, voffB);
        PG8_WAIT_V(6); PG8_BAR;
    } else {
        PG8_STAGE(PG8_SB(0, 0), cB, voffB); PG8_STAGE(PG8_SA(0, 0), cA, voffA); PG8_STAGE(PG8_SB(0, 1), cB + hstep, voffB); PG8_STAGE(PG8_SA(0, 1), cA + hstepA, voffA);
        if (wr == 1) PG8_BAR;
        PG8_WAIT_V(4); PG8_BAR;
        PG8_STAGE(PG8_SB(1, 0), cB + kstep, voffB); PG8_STAGE(PG8_SA(1, 0), cA + kstep, voffA); PG8_STAGE(PG8_SB(1, 1), cB + hstep + kstep, voffB);
        PG8_WAIT_V(6); PG8_BAR;
    }
    for (;;) {
        const bool has_next = S.next(ui + 1, nxt);
        const char* nA = has_next ? (const char*)g.A + (size_t)nxt.pm * tstepA : cA; const char* nB = has_next ? (const char*)g.Bt + (size_t)nxt.pn * tstep : cB;
        for (int t = 0; t < nt; t += 2) {
            const bool last = (t == nt - 2);
            const char* a1 = cA + (size_t)(t + 1) * kstep;
            const char* a2 = last ? nA : cA + (size_t)(t + 2) * kstep; const char* b2 = last ? nB : cB + (size_t)(t + 2) * kstep;
            const char* a3 = a2 + kstep; const char* b3 = b2 + kstep;
            if (last && has_next) S.a_ready(nxt);
            if constexpr (SP2) {
            PG8_LDB(B0, 0, 0); PG8_LDB(B1, 0, 1); PG8_SCHED; PG8_LDA(At, 0, 0); PG8_STAGE(PG8_SA(1, 1), a1 + hstepA, voffA);
            PG8_WAIT_V(8); PG8_WAIT_L(0); PG8_BAR; PG8_MMA(0, 0, At, B0); PG8_MMA(0, 1, At, B1); PG8_BAR; PG8_SCHED;
            PG8_LDA(At, 0, 1); PG8_STAGE(PG8_SB(0, 0), b2, voffB); PG8_STAGE(PG8_SB(0, 1), b2 + hstep, voffB); PG8_STAGE(PG8_SA(0, 0), a2, voffA);
            PG8_WAIT_V(8); PG8_WAIT_L(0); PG8_BAR; PG8_MMA(1, 0, At, B0); PG8_MMA(1, 1, At, B1); PG8_BAR; PG8_SCHED;
            PG8_LDB(B0, 1, 0); PG8_LDB(B1, 1, 1); PG8_SCHED; PG8_LDA(At, 1, 0); PG8_STAGE(PG8_SA(0, 1), a2 + hstepA, voffA);
            PG8_WAIT_V(8); PG8_WAIT_L(0); PG8_BAR; PG8_MMA(0, 0, At, B0); PG8_MMA(0, 1, At, B1); PG8_BAR; PG8_SCHED;
            PG8_LDA(At, 1, 1); PG8_STAGE(PG8_SB(1, 0), b3, voffB); PG8_STAGE(PG8_SB(1, 1), b3 + hstep, voffB); PG8_STAGE(PG8_SA(1, 0), a3, voffA);
            PG8_WAIT_V(8); PG8_WAIT_L(0); PG8_BAR; PG8_MMA(1, 0, At, B0); PG8_MMA(1, 1, At, B1); PG8_BAR; PG8_SCHED;
            } else {
            PG8_LDB(B0, 0, 0); PG8_SCHED; PG8_LDA(At, 0, 0); PG8_STAGE(PG8_SA(1, 1), a1 + hstepA, voffA);
            PG8_WAIT_L(8); PG8_BAR; PG8_WAIT_L(0); PG8_MMA(0, 0, At, B0); PG8_BAR; PG8_SCHED;
            PG8_LDB(B1, 0, 1); PG8_STAGE(PG8_SB(0, 0), b2, voffB);
            PG8_BAR; PG8_WAIT_L(0); PG8_MMA(0, 1, At, B1); PG8_BAR;
            PG8_LDA(At, 0, 1); PG8_STAGE(PG8_SA(0, 0), a2, voffA);
            PG8_BAR; PG8_WAIT_L(0); PG8_MMA(1, 0, At, B0); PG8_BAR; PG8_SCHED;
            PG8_STAGE(PG8_SB(0, 1), b2 + hstep, voffB);
            PG8_WAIT_V(6); PG8_BAR; PG8_MMA(1, 1, At, B1); PG8_BAR;
            PG8_LDB(B0, 1, 0); PG8_SCHED; PG8_LDA(At, 1, 0); PG8_STAGE(PG8_SA(0, 1), a2 + hstepA, voffA);
            PG8_WAIT_L(8); PG8_BAR; PG8_WAIT_L(0); PG8_MMA(0, 0, At, B0); PG8_BAR; PG8_SCHED;
            PG8_LDB(B1, 1, 1); PG8_STAGE(PG8_SB(1, 0), b3, voffB);
            PG8_BAR; PG8_WAIT_L(0); PG8_MMA(0, 1, At, B1); PG8_BAR;
            PG8_LDA(At, 1, 1); PG8_STAGE(PG8_SA(1, 0), a3, voffA);
            PG8_BAR; PG8_WAIT_L(0); PG8_MMA(1, 0, At, B0); PG8_BAR; PG8_SCHED;
            PG8_STAGE(PG8_SB(1, 1), b3 + hstep, voffB);
            PG8_WAIT_V(6); PG8_BAR; PG8_MMA(1, 1, At, B1); PG8_BAR;
            }
        }
        if constexpr (ALIGN_EPI) { if (wr == 0) PG8_BAR; }
        if constexpr (!Epi::AFTER_DRAIN) { E(acc, cur, wr, wc, fr, fq); S.done(cur); }
        if (!has_next) break;
#pragma unroll
        for (int a = 0; a < 2; ++a)
#pragma unroll
            for (int b = 0; b < 2; ++b)
#pragma unroll
                for (int m = 0; m < 4; ++m)
#pragma unroll
                    for (int n = 0; n < 2; ++n) acc[a][b][m][n] = (f32x4){0.f, 0.f, 0.f, 0.f};
        cur = nxt; cA = nA; cB = nB; ++ui;
        if constexpr (ALIGN_EPI) { if (wr == 1) PG8_BAR; }
    }
    PG8_WAIT_V(0);
    if constexpr (!ALIGN_EPI) { if (wr == 0) PG8_BAR; }
    PG8_BAR;
    if constexpr (Epi::AFTER_DRAIN) { E.fused(acc, cur, wr, wc, fr, fq, lds, wid, lane); S.done(cur); }
#undef PG8_SA
#undef PG8_SB
#undef PG8_STAGE
#undef PG8_LDA
#undef PG8_LDB
#undef PG8_MMA
#undef PG8_WAIT_V
#undef PG8_WAIT_L
#undef PG8_BAR
#undef PG8_SCHED
}
}

#ifndef PG8_SP2
#define PG8_SP2 true
#endif
#ifndef PG8_ALIGN
#define PG8_ALIGN true
#endif

constexpr int NWAVES = 8;
constexpr int N_PHASES = 16;
#ifndef MK_N_LAUNCHES
#define MK_N_LAUNCHES 1
#endif
constexpr int N_LAUNCHES = MK_N_LAUNCHES;

constexpr int D = 2048, M = 65536, NIN = 10496;
constexpr int LP = 16384, LS = 2048;
constexpr int DS5 = 1024, DRW = 1024, DRWIN = 3328;
constexpr float RMS_EPS = 1e-6f, GN_EPS = 64e-5f, L2_EPS = 1e-12f;

constexpr size_t MiB = 1u << 20;
constexpr size_t WS_CTL = 0, CTL_ZERO_BYTES = 128 * 1024;
constexpr size_t WS_ZROW = 96 * 1024;
constexpr size_t WS_WT = 1 * MiB;
constexpr size_t WS_GLUT = 42 * MiB;
constexpr size_t WS_S5OT = 44 * MiB;
constexpr size_t WS_RWOT = 48 * MiB;
constexpr size_t WS_WOT = 52 * MiB;
constexpr size_t WS_HN = 60 * MiB;
constexpr size_t WS_RWIN = 316 * MiB;
constexpr size_t WS_Z = 732 * MiB;
constexpr size_t WS_LUT = 860 * MiB;
constexpr size_t WS_STATE = 862 * MiB;
constexpr size_t WS_S5TAB = 872 * MiB;
constexpr size_t WS_S5XL = 882 * MiB;
constexpr size_t WS_S5W2 = 946 * MiB;
constexpr size_t WS_S5E = 994 * MiB;
constexpr size_t WS_ZG = 882 * MiB;
constexpr size_t WS_END = 1010 * MiB;
constexpr size_t DO_YF = 0, DO_YB = 128 * MiB, DO_A2 = 256 * MiB, DO_INT = 256 * MiB, DO_Q = 256 * MiB;
constexpr int CW_BAR = 4096;
constexpr int CW_QUEUE = 16384;

constexpr int LDS_BYTES = 147456;
constexpr int MISC_OFF = LDS_BYTES - 512;
constexpr int WAVE_SCR = 18176;
static_assert(NWAVES * WAVE_SCR <= MISC_OFF && pg8::STAGE_BYTES <= MISC_OFF, "LDS map");

#define GAS __attribute__((address_space(1)))
#define LAS __attribute__((address_space(3)))
typedef unsigned short bf16;
typedef unsigned v4u __attribute__((ext_vector_type(4)));
typedef unsigned v2u __attribute__((ext_vector_type(2)));
typedef float f32x4 __attribute__((ext_vector_type(4)));
#define LDS_WAIT() asm volatile("s_waitcnt lgkmcnt(0)" ::: "memory")
#define VM_WAIT() asm volatile("s_waitcnt vmcnt(0)" ::: "memory")
typedef __bf16 mk_bf2 __attribute__((ext_vector_type(2)));
typedef float mk_f2 __attribute__((ext_vector_type(2)));
__device__ __forceinline__ unsigned pk2(float lo, float hi) { const mk_f2 v = {lo, hi}; return __builtin_bit_cast(unsigned, __builtin_convertvector(v, mk_bf2)); }
__device__ __forceinline__ unsigned f2bf(float f) { return pk2(f, f) & 0xffffu; }
__device__ __forceinline__ float bf2f(bf16 b) { return __uint_as_float(((unsigned)b) << 16); }
__device__ __forceinline__ float blo(unsigned u) { return __uint_as_float(u << 16); }
__device__ __forceinline__ float bhi(unsigned u) { return __uint_as_float(u & 0xffff0000u); }
__device__ __forceinline__ float wave_sum(float v) {
#pragma unroll
    for (int o = 1; o < 64; o <<= 1) v += __shfl_xor(v, o);
    return v;
}
__device__ __forceinline__ float sigm(float v) { return __builtin_amdgcn_rcpf(1.0f + __expf(-v)); }
__device__ __forceinline__ float gelu_tanh(float x) { const float u = 0.7978845608028654f * (x + 0.044715f * x * x * x); return 0.5f * x * (1.0f + tanhf(u)); }

#define XB_TMO      128
#define XB_XCNT(j)  (256  + 64 * (j))
#define XB_XSUB(j)  (1280 + 64 * (j))
#define XB_XGEN(j)  (2304 + 64 * (j))
#define XB_TOP      3328
#define XB_TOPGEN   3392
#define XCD_BAR_WORDS 3456
#define XB_SPIN_CAP (1u << 18)

__device__ __forceinline__ unsigned xb_ld(unsigned* p)              { return __hip_atomic_load(p, __ATOMIC_RELAXED, __HIP_MEMORY_SCOPE_AGENT); }
__device__ __forceinline__ unsigned xb_add(unsigned* p, unsigned v) { return __hip_atomic_fetch_add(p, v, __ATOMIC_RELAXED, __HIP_MEMORY_SCOPE_AGENT); }
__device__ __forceinline__ unsigned xb_xcc_id() { return (unsigned)__builtin_amdgcn_s_getreg((3 << 11) | 20) & 0xFu; }
#define XB_SPIN(cond, bar) do { unsigned _sp = 0; while (cond) { __builtin_amdgcn_s_sleep(1); \
    if ((++_sp & 255u) == 0u) { if (xb_ld(&(bar)[XB_TMO])) break; if (_sp > XB_SPIN_CAP) { atomicAdd(&(bar)[XB_TMO], 1u); break; } } } } while (0)

struct XcdBarrier {
    unsigned* bar; unsigned x;
    volatile LAS unsigned* st;
};

__device__ __forceinline__ XcdBarrier xcd_barrier_post(unsigned* bar, volatile LAS unsigned* st, const int mk_wave) {
    XcdBarrier b; b.bar = bar; b.x = xb_xcc_id(); b.st = st;
    if (mk_wave == 0 && mk_lane() == 0) (void)xb_add(&bar[XB_XCNT(b.x)], 1u);
    return b;
}
__device__ __forceinline__ void xcd_barrier_complete(unsigned* bar, unsigned x, unsigned& nloc, unsigned& nx) {
    const unsigned G = gridDim.x * gridDim.y * gridDim.z;
    unsigned sum, cnt, mine, sp = 0u;
    for (;;) {
        sum = 0u; cnt = 0u; mine = 0u;
#pragma unroll
        for (unsigned j = 0; j < 16; ++j) { const unsigned c = xb_ld(&bar[XB_XCNT(j)]); sum += c; cnt += (c > 0u) ? 1u : 0u; mine = (j == x) ? c : mine; }
        if (sum == G) break;
        __builtin_amdgcn_s_sleep(1);
        if ((++sp & 255u) == 0u) { if (xb_ld(&bar[XB_TMO])) break; if (sp > XB_SPIN_CAP) { atomicAdd(&bar[XB_TMO], 1u); break; } }
    }
    nloc = mine > 0u ? mine : 1u; nx = cnt > 0u ? cnt : 1u;
}

__device__ __forceinline__ void xcd_barrier(const XcdBarrier& b, const int mk_wave) {
    asm volatile("s_waitcnt vmcnt(0)" ::: "memory");
    __syncthreads();
    if (mk_wave == 0 && mk_lane() == 0) {
        unsigned* bar = b.bar;
        __builtin_amdgcn_s_waitcnt(0);
        unsigned nloc = b.st[0], nx = b.st[1];
        if (nloc == 0u) { xcd_barrier_complete(bar, b.x, nloc, nx); b.st[0] = nloc; b.st[1] = nx; }
        const unsigned old = xb_add(&bar[XB_XSUB(b.x)], 1u);
        const unsigned gen = old / nloc;
        if (old + 1u == (gen + 1u) * nloc) {
            __builtin_amdgcn_fence(__ATOMIC_RELEASE, "agent");
            asm volatile("s_waitcnt vmcnt(0)" ::: "memory");
            const unsigned og = xb_add(&bar[XB_TOP], 1u);
            const unsigned tg = og / nx;
            if (og + 1u == (tg + 1u) * nx) xb_add(&bar[XB_TOPGEN], 1u);
            else XB_SPIN(xb_ld(&bar[XB_TOPGEN]) == tg, bar);
            __builtin_amdgcn_fence(__ATOMIC_ACQUIRE, "agent");
            xb_add(&bar[XB_XGEN(b.x)], 1u);
            asm volatile("s_waitcnt vmcnt(0)" ::: "memory");
        } else {
            XB_SPIN(xb_ld(&bar[XB_XGEN(b.x)]) == gen, bar);
            __builtin_amdgcn_fence(__ATOMIC_ACQUIRE, "agent");
            asm volatile("s_waitcnt vmcnt(0)" ::: "memory");
        }
    }
    __syncthreads();
}


struct Args { const float* in[27]; float* out; unsigned char* ws; int ph_lo, ph_hi, li, pad; };

namespace rwk {
typedef short s16x4 __attribute__((ext_vector_type(4)));
typedef short s16x8 __attribute__((ext_vector_type(8)));
constexpr int NSEG = 8;
constexpr int UNITS_PER_SEG = 4096;
constexpr int LDW = 72;
constexpr int MATB = 64 * LDW * 2;
constexpr int O_AB = 0, O_BT = 1 * MATB, O_KT = 2 * MATB, O_RB = 3 * MATB, O_BHT = 4 * MATB, O_KHT = 5 * MATB, O_VT = 6 * MATB;
constexpr int O_MAB = 7 * MATB, O_MAK = 8 * MATB, O_NRB = 9 * MATB, O_NRK = 10 * MATB, O_XT = 11 * MATB  , O_NP = 13 * MATB, O_GT = 14 * MATB;
constexpr int O_TW = O_MAB, O_XA = O_MAK;
constexpr int LDC = 68;
constexpr int O_CL = O_NRB, O_AS = O_NRB + 64 * LDC * 4;
constexpr int NPS = 24;
static_assert(O_AS + 64 * LDC * 4 <= O_NP && O_GT + 256 <= 146944, "rwkv LDS map");
constexpr size_t UNIT_ELEMS = 16384;

__device__ __forceinline__ f32x4 mfma32(s16x8 a, s16x8 b, f32x4 c) { return __builtin_amdgcn_mfma_f32_16x16x32_bf16(a, b, c, 0, 0, 0); }
__device__ __forceinline__ f32x4 mfma16(s16x4 a, s16x4 b, f32x4 c) { return __builtin_amdgcn_mfma_f32_16x16x16bf16_1k(a, b, c, 0, 0, 0); }
__device__ __forceinline__ s16x4 pack4(f32x4 v) { v2u p; p.x = pk2(v[0], v[1]); p.y = pk2(v[2], v[3]); return __builtin_bit_cast(s16x4, p); }
__device__ __forceinline__ f32x4 unpack4(v2u p) { return (f32x4){blo(p.x), bhi(p.x), blo(p.y), bhi(p.y)}; }
__device__ __forceinline__ void up8(v4u a, float (&o)[8]) { o[0] = blo(a.x); o[1] = bhi(a.x); o[2] = blo(a.y); o[3] = bhi(a.y); o[4] = blo(a.z); o[5] = bhi(a.z); o[6] = blo(a.w); o[7] = bhi(a.w); }
__device__ __forceinline__ v4u pk8(const float (&v)[8]) { v4u a; a.x = pk2(v[0], v[1]); a.y = pk2(v[2], v[3]); a.z = pk2(v[4], v[5]); a.w = pk2(v[6], v[7]); return a; }

constexpr int O_MU = 131072;
static_assert(O_MU + 3328 * 4 <= 146944, "rwkv LDS map (mu)");
__device__ __forceinline__ int swz_chunk(int row, int tc) { return (row * LDW + ((tc ^ ((row >> 3) & 7)) << 3)) * 2; }
__device__ __forceinline__ float tanh_fast(float x) { return 1.0f - 2.0f * __builtin_amdgcn_rcpf(1.0f + __expf(2.0f * x)); }
__device__ __forceinline__ mk_f2 upf2(unsigned w) { return (mk_f2){blo(w), bhi(w)}; }
__device__ __forceinline__ v4u pk8v(const mk_f2 (&v)[4]) { v4u a; a.x = pk2(v[0].x, v[0].y); a.y = pk2(v[1].x, v[1].y); a.z = pk2(v[2].x, v[2].y); a.w = pk2(v[3].x, v[3].y); return a; }
struct RawUnit { v4u cur[5], prv[5], nxt[5]; f32x4 kk0, kk1, ka0, ka1, rk0, rk1; s16x8 lb0, lb1; float bias; };
struct UnitId { int h, d, base, L, gchunk, chain; };
__device__ __forceinline__ UnitId decode_unit(int seg, int u) {
    UnitId o; int c, jc, nch;
    if (u < 2048) { c = u >> 5; jc = u & 31; nch = 32; } else { c = 64 + ((u - 2048) >> 2); jc = (u - 2048) & 3; nch = 4; }
    int s, rem; if (c < 64) { s = c >> 5; rem = c & 31; } else { s = 2 + ((c - 64) >> 5); rem = (c - 64) & 31; }
    o.h = rem >> 1; o.d = rem & 1; o.base = s < 2 ? s * LP : 32768 + (s - 2) * LS; o.L = s < 2 ? LP : LS; o.gchunk = seg * nch + jc; o.chain = c;
    return o;
}
__device__ __forceinline__ int unit_of(int chain, int jc) { return chain < 64 ? chain * 32 + jc : 2048 + (chain - 64) * 4 + jc; }
constexpr int QUNITS = 128;
__device__ __forceinline__ int unit_from_queue(int q, int i) { return i < 64 ? unit_of((i >> 5) * 32 + q, i & 31) : unit_of(64 + ((i - 64) >> 2) * 32 + q, (i - 64) & 3); }

template <bool WITH_WEIGHTS> __device__ __forceinline__ void rw_load_unit(const Args& a, unsigned char* ws, int seg, int u, int wave, int lane, RawUnit& R) {
    const UnitId id = decode_unit(seg, u);
    const int h = id.h, d = id.d, tid = wave * 64 + lane, t = tid >> 3, cg = tid & 7;
    const int pos = d ? id.L - 1 - 64 * id.gchunk - t : 64 * id.gchunk + t;
    const unsigned rowA = (unsigned)WS_RWIN + (unsigned)(id.base + pos) * (unsigned)(DRWIN * 2) + (unsigned)(h * 128 + 2048) + 16u * (unsigned)cg;
    const unsigned dB = (unsigned)(4096 + 128 * d - 128 * h);
    const unsigned zA = (unsigned)WS_ZROW + 2048u + 16u * (unsigned)cg;
    const unsigned prvA = pos > 0 ? rowA - (unsigned)(DRWIN * 2) : zA, nxtA = pos < id.L - 1 ? rowA + (unsigned)(DRWIN * 2) : zA;
    const unsigned rowB = rowA + dB, prvB = prvA + dB, nxtB = nxtA + dB;
#define RW_LD(off, imm) (*(const v4u*)(ws + (size_t)(off) + (imm)))
#if defined(PROBE_X) && (PROBE_X & 2)
    R.cur[0] = RW_LD(rowA, -2048); R.cur[1] = RW_LD(rowA, 0); R.cur[2] = RW_LD(rowA, 2048); R.cur[3] = RW_LD(rowB, 0); R.cur[4] = RW_LD(rowB, 256);
#else
    R.cur[0] = RW_LD(rowA, -2048); R.prv[0] = RW_LD(prvA, -2048); R.nxt[0] = RW_LD(nxtA, -2048);
    R.cur[1] = RW_LD(rowA, 0);     R.prv[1] = RW_LD(prvA, 0);     R.nxt[1] = RW_LD(nxtA, 0);
    R.cur[2] = RW_LD(rowA, 2048);  R.prv[2] = RW_LD(prvA, 2048);  R.nxt[2] = RW_LD(nxtA, 2048);
    R.cur[3] = RW_LD(rowB, 0);     R.prv[3] = RW_LD(prvB, 0);     R.nxt[3] = RW_LD(nxtB, 0);
    R.cur[4] = RW_LD(rowB, 256);   R.prv[4] = RW_LD(prvB, 256);   R.nxt[4] = RW_LD(nxtB, 256);
#endif
#undef RW_LD
#if defined(PROBE_X) && (PROBE_X & 1)
    return;
#endif
    if (!WITH_WEIGHTS) return;
    const unsigned wo = (unsigned)(h * 256) + 32u * (unsigned)cg;
    R.kk0 = *(const f32x4*)((const unsigned char*)a.in[20] + (size_t)wo); R.kk1 = *(const f32x4*)((const unsigned char*)a.in[20] + (size_t)wo + 16);
    R.ka0 = *(const f32x4*)((const unsigned char*)a.in[21] + (size_t)wo); R.ka1 = *(const f32x4*)((const unsigned char*)a.in[21] + (size_t)wo + 16);
    R.rk0 = *(const f32x4*)((const unsigned char*)a.in[22] + (size_t)wo); R.rk1 = *(const f32x4*)((const unsigned char*)a.in[22] + (size_t)wo + 16);
    const int r = lane & 15, g = lane >> 4, ct = wave & 3, role = wave >> 2;
    const unsigned lo = (unsigned)WS_LUT + (unsigned)((((role * 2 + d) * 16 + h) * 64 + 16 * ct) * 128) + 128u * (unsigned)r + 16u * (unsigned)g;
    R.lb0 = *(const s16x8*)(ws + (size_t)lo); R.lb1 = *(const s16x8*)(ws + (size_t)lo + 64);
    R.bias = *(const float*)((const unsigned char*)(role ? a.in[18] : a.in[16]) + (size_t)((unsigned)((d * 1024 + h * 64 + 16 * ct) * 4) + 4u * (unsigned)r));
}
template <int NT, int PR> __device__ __forceinline__ void rw_s1_wave(LAS unsigned char* lds, int r, int g, int lane) {
    constexpr int OM = PR ? O_MAK : O_MAB, ON = PR ? O_NRK : O_NRB, OX = PR ? O_KT : O_BT;
    const f32x4 z4 = (f32x4){0.f, 0.f, 0.f, 0.f};
    const int boff = ((16 * NT + r) * LDW + 8 * g) * 2;
    const s16x8 ab0 = *(const LAS s16x8*)(lds + O_AB + boff), ab1 = *(const LAS s16x8*)(lds + O_AB + boff + 64);
    const s16x8 rb0 = *(const LAS s16x8*)(lds + O_RB + boff), rb1 = *(const LAS s16x8*)(lds + O_RB + boff + 64);
    const int xoff = OX + (r * LDW + 8 * g) * 2;
    const int srow = ((16 * NT + r) * LDW + 4 * g) * 2;
    const s16x8 d0 = *(const LAS s16x8*)(lds + xoff + NT * 16 * LDW * 2), d1 = *(const LAS s16x8*)(lds + xoff + NT * 16 * LDW * 2 + 64);
    {
        f32x4 m = mfma32(d0, ab0, z4); m = mfma32(d1, ab1, m);
        f32x4 n = mfma32(d0, rb0, z4); n = mfma32(d1, rb1, n);
#pragma unroll
        for (int i = 0; i < 4; ++i) { const int j = 4 * g + i; m[i] = j < r ? m[i] : 0.f; n[i] = j <= r ? n[i] : 0.f; }
        *(LAS s16x4*)(lds + OM + srow + 32 * NT) = pack4(m);
        *(LAS s16x4*)(lds + ON + srow + 32 * NT) = pack4(n);
        if (PR == 0) {
            f32x4 bn = mfma32(ab0, d0, z4); bn = mfma32(ab1, d1, bn);
#pragma unroll
            for (int i = 0; i < 4; ++i) bn[i] = r < 4 * g + i ? bn[i] : 0.f;
            const s16x4 aN = pack4(m), bN = pack4(bn);
            f32x4 G = m;
#pragma unroll
            for (int i = 0; i < 4; ++i) G[i] += (4 * g + i == r) ? 1.0f : 0.0f;
            f32x4 pb = mfma16(aN, bN, z4), pa = mfma16(bN, aN, z4);
            G = mfma16(pack4(pb), pack4(G), G);
            { const f32x4 pb4 = mfma16(pack4(pa), pack4(pb), z4), pa4 = mfma16(pack4(pb), pack4(pa), z4); pb = pb4; pa = pa4; }
            G = mfma16(pack4(pb), pack4(G), G);
            pb = mfma16(pack4(pa), pack4(pb), z4);
            G = mfma16(pack4(pb), pack4(G), G);
            *(LAS s16x4*)(lds + O_NP + (NT * 64 + lane) * 8) = pack4(G);
        }
    }
#pragma unroll
    for (int mt = NT - 1; mt >= (NT == 3 ? 1 : 0); --mt) {
        const s16x8 x0 = *(const LAS s16x8*)(lds + xoff + mt * 16 * LDW * 2), x1 = *(const LAS s16x8*)(lds + xoff + mt * 16 * LDW * 2 + 64);
        f32x4 m = mfma32(x0, ab0, z4); m = mfma32(x1, ab1, m);
        f32x4 n = mfma32(x0, rb0, z4); n = mfma32(x1, rb1, n);
        *(LAS s16x4*)(lds + OM + srow + 32 * mt) = pack4(m);
        *(LAS s16x4*)(lds + ON + srow + 32 * mt) = pack4(n);
    }
#pragma unroll
    for (int mt = NT + 1; mt < 4; ++mt) {
        *(LAS s16x4*)(lds + OM + srow + 32 * mt) = (s16x4){0, 0, 0, 0};
        *(LAS s16x4*)(lds + ON + srow + 32 * mt) = (s16x4){0, 0, 0, 0};
    }
    if (NT == 0) {
        const int b3 = ((48 + r) * LDW + 8 * g) * 2, s3 = ((48 + r) * LDW + 4 * g) * 2;
        const s16x8 a0 = *(const LAS s16x8*)(lds + O_AB + b3), a1 = *(const LAS s16x8*)(lds + O_AB + b3 + 64);
        const s16x8 q0 = *(const LAS s16x8*)(lds + O_RB + b3), q1 = *(const LAS s16x8*)(lds + O_RB + b3 + 64);
        f32x4 m = mfma32(d0, a0, z4); m = mfma32(d1, a1, m);
        f32x4 n = mfma32(d0, q0, z4); n = mfma32(d1, q1, n);
        *(LAS s16x4*)(lds + OM + s3) = pack4(m);
        *(LAS s16x4*)(lds + ON + s3) = pack4(n);
    }
}
__device__ __forceinline__ void rw_pin_unit(RawUnit& R) {
#pragma unroll
    for (int c = 0; c < 5; ++c) asm volatile("" : "+v"(R.cur[c]), "+v"(R.prv[c]), "+v"(R.nxt[c]));
    asm volatile("" : "+v"(R.kk0), "+v"(R.kk1), "+v"(R.ka0), "+v"(R.ka1), "+v"(R.rk0), "+v"(R.rk1), "+v"(R.lb0), "+v"(R.lb1), "+v"(R.bias));
}
__device__ __forceinline__ void rw_precompute_unit(const Args& a, unsigned char* ws, LAS unsigned char* lds, int seg, int q, int qi, int qnext, int wave, int lane, RawUnit& R, volatile LAS unsigned* qslot, unsigned qval, int& unext) {
    const int u = unit_from_queue(q, qi);
    const UnitId id = decode_unit(seg, u);
    const int h = id.h, d = id.d;
    const int tid = wave * 64 + lane;
    const int r = lane & 15, g = lane >> 4;
#ifndef RP_S0
#define RP_S0 1
#endif
#ifndef RQ_A
#define RQ_A 1
#endif
#ifndef RQ_B
#define RQ_B 1
#endif
#ifndef RQ_C
#define RQ_C 1
#endif
#ifndef RQ_1
#define RQ_1 1
#endif
#ifndef RQ_23
#define RQ_23 1
#endif
#ifndef RQ_4
#define RQ_4 1
#endif
#ifndef RP_S1
#define RP_S1 1
#endif
    const int t = tid >> 3, cg = tid & 7, c8 = h * 64 + 8 * cg;
    _Pragma("unroll 1") for (int rp0_ = 0; rp0_ < RP_S0; ++rp0_) {
    mk_f2 zr[4], zk[4], kk[4], zv[4];
    _Pragma("unroll 1") for (int rq_RQ_A = 0; rq_RQ_A < RQ_A; ++rq_RQ_A) {
    {
        const LAS float* mu = (const LAS float*)(lds + O_MU);
        mk_f2 zw[4], za[4];
#pragma unroll
        for (int comp = 0; comp < 5; ++comp) {
            const int col = comp < 3 ? comp * 1024 + c8 : (comp == 3 ? 3072 + d * 64 + 8 * cg : 3200 + d * 64 + 8 * cg);
            const f32x4 m0 = *(const LAS f32x4*)(mu + col), m1 = *(const LAS f32x4*)(mu + col + 4);
            const mk_f2 mv[4] = {(mk_f2){m0[0], m0[1]}, (mk_f2){m0[2], m0[3]}, (mk_f2){m1[0], m1[1]}, (mk_f2){m1[2], m1[3]}};
            const v4u C = R.cur[comp], P = R.prv[comp], N = R.nxt[comp];
#pragma unroll
            for (int q = 0; q < 4; ++q) {
                const mk_f2 cc = upf2(C[q]), zz = cc + ((upf2(P[q]) + upf2(N[q])) * 0.5f - cc) * mv[q];
                if (comp == 0) zr[q] = zz; else if (comp == 1) zk[q] = zz; else if (comp == 2) zv[q] = zz; else if (comp == 4) za[q] = zz;
                else { const mk_f2 e2 = zz * 2.885390081777927f; mk_f2 dn; dn.x = __builtin_amdgcn_exp2f(e2.x); dn.y = __builtin_amdgcn_exp2f(e2.y); dn = dn + 1.0f;
                       mk_f2 rc; rc.x = __builtin_amdgcn_rcpf(dn.x); rc.y = __builtin_amdgcn_rcpf(dn.y); zw[q] = 1.0f - rc * 2.0f; }
            }
        }
        if (d == 0) {
            const mk_f2 rkw[4] = {(mk_f2){R.rk0[0], R.rk0[1]}, (mk_f2){R.rk0[2], R.rk0[3]}, (mk_f2){R.rk1[0], R.rk1[1]}, (mk_f2){R.rk1[2], R.rk1[3]}};
            mk_f2 d2 = zr[0] * zk[0] * rkw[0];
#pragma unroll
            for (int q = 1; q < 4; ++q) d2 = d2 + zr[q] * zk[q] * rkw[q];
            float dot = d2.x + d2.y;
            dot += __shfl_xor(dot, 1); dot += __shfl_xor(dot, 2); dot += __shfl_xor(dot, 4);
            mk_f2 bo[4];
#pragma unroll
            for (int q = 0; q < 4; ++q) bo[q] = zv[q] * dot;
            *(v4u*)((bf16*)(ws + WS_ZG) + (size_t)(id.base + 64 * id.gchunk + t) * DRW + c8) = pk8v(bo);
        }
        const mk_f2 kkw[4] = {(mk_f2){R.kk0[0], R.kk0[1]}, (mk_f2){R.kk0[2], R.kk0[3]}, (mk_f2){R.kk1[0], R.kk1[1]}, (mk_f2){R.kk1[2], R.kk1[3]}};
        mk_f2 s2 = (mk_f2){0.f, 0.f};
#pragma unroll
        for (int q = 0; q < 4; ++q) { kk[q] = zk[q] * kkw[q]; s2 = s2 + kk[q] * kk[q]; }
        float ss = s2.x + s2.y;
        ss += __shfl_xor(ss, 1); ss += __shfl_xor(ss, 2); ss += __shfl_xor(ss, 4);
        const float inv = __builtin_amdgcn_rsqf(ss + L2_EPS);
#pragma unroll
        for (int q = 0; q < 4; ++q) kk[q] = kk[q] * inv;
        *(LAS v4u*)(lds + O_TW + (t * LDW + 8 * cg) * 2) = pk8v(zw);
        *(LAS v4u*)(lds + O_XA + (t * LDW + 8 * cg) * 2) = pk8v(za);
    }
#if RP_S0 == 1 && RQ_A == 1
    rw_load_unit<false>(a, ws, seg, unit_from_queue(q, qnext < QUNITS ? qnext : qi), wave, lane, R);
#endif
    __syncthreads();
    }
    _Pragma("unroll 1") for (int rq_RQ_B = 0; rq_RQ_B < RQ_B; ++rq_RQ_B) {
    {
        const int ct = wave & 3, role = wave >> 2;
        const s16x8 b0 = R.lb0, b1 = R.lb1;
        const int aoff = (role ? O_XA : O_TW) + (r * LDW + 8 * g) * 2;
        f32x4 acc[4];
#pragma unroll
        for (int mt = 0; mt < 4; ++mt) {
            const s16x8 a0 = *(const LAS s16x8*)(lds + aoff + mt * 16 * LDW * 2), a1 = *(const LAS s16x8*)(lds + aoff + mt * 16 * LDW * 2 + 64);
            acc[mt] = mfma32(a0, b0, (f32x4){0.f, 0.f, 0.f, 0.f}); acc[mt] = mfma32(a1, b1, acc[mt]);
        }
        const int cch = 16 * ct + r;
        if (role == 0) {
            const float w0v = R.bias;
            float carry = 0.f;
#pragma unroll
            for (int mt = 0; mt < 4; ++mt) {
                float s[4];
#pragma unroll
                for (int i = 0; i < 4; ++i) { const float lw = -0.8750343827198594f * sigm(acc[mt][i] + w0v); s[i] = (i ? s[i - 1] : 0.f) + lw; }
                const float tot = s[3];
                const float e1 = __shfl(tot, (lane + 48) & 63), e2 = __shfl(tot, (lane + 32) & 63), e3 = __shfl(tot, (lane + 16) & 63);
                const float excl = (g >= 1 ? e1 : 0.f) + (g >= 2 ? e2 : 0.f) + (g >= 3 ? e3 : 0.f);
                const float all = __shfl(tot + excl, 48 + r);
#pragma unroll
                for (int i = 0; i < 4; ++i) *(LAS float*)(lds + O_CL + ((16 * mt + 4 * g + i) * LDC + cch) * 4) = carry + excl + s[i];
                carry += all;
            }
            if (g == 0) *(LAS float*)(lds + O_GT + cch * 4) = __builtin_amdgcn_exp2f(carry);
        } else {
            const float a0v = R.bias;
#pragma unroll
            for (int mt = 0; mt < 4; ++mt)
#pragma unroll
                for (int i = 0; i < 4; ++i) *(LAS float*)(lds + O_AS + ((16 * mt + 4 * g + i) * LDC + cch) * 4) = sigm(acc[mt][i] + a0v);
        }
        if (wave == 0 && lane == 0) *qslot = qval;
    }
    __syncthreads();
    }
    _Pragma("unroll 1") for (int rq_RQ_C = 0; rq_RQ_C < RQ_C; ++rq_RQ_C) {
    {
        const f32x4 x0 = *(const LAS f32x4*)(lds + O_CL + (t * LDC + 8 * cg) * 4), x1 = *(const LAS f32x4*)(lds + O_CL + (t * LDC + 8 * cg + 4) * 4);
        const f32x4 e0 = *(const LAS f32x4*)(lds + O_GT + (8 * cg) * 4), e1 = *(const LAS f32x4*)(lds + O_GT + (8 * cg + 4) * 4);
        const f32x4 s0 = *(const LAS f32x4*)(lds + O_AS + (t * LDC + 8 * cg) * 4), s1 = *(const LAS f32x4*)(lds + O_AS + (t * LDC + 8 * cg + 4) * 4);
        f32x4 p0 = (f32x4){0.f, 0.f, 0.f, 0.f}, p1 = p0;
        if (t > 0) { p0 = *(const LAS f32x4*)(lds + O_CL + ((t - 1) * LDC + 8 * cg) * 4); p1 = *(const LAS f32x4*)(lds + O_CL + ((t - 1) * LDC + 8 * cg + 4) * 4); }
        const mk_f2 cl[4] = {(mk_f2){x0[0], x0[1]}, (mk_f2){x0[2], x0[3]}, (mk_f2){x1[0], x1[1]}, (mk_f2){x1[2], x1[3]}};
        const mk_f2 clp[4] = {(mk_f2){p0[0], p0[1]}, (mk_f2){p0[2], p0[3]}, (mk_f2){p1[0], p1[1]}, (mk_f2){p1[2], p1[3]}};
        const mk_f2 gte[4] = {(mk_f2){e0[0], e0[1]}, (mk_f2){e0[2], e0[3]}, (mk_f2){e1[0], e1[1]}, (mk_f2){e1[2], e1[3]}};
        const mk_f2 as[4] = {(mk_f2){s0[0], s0[1]}, (mk_f2){s0[2], s0[3]}, (mk_f2){s1[0], s1[1]}, (mk_f2){s1[2], s1[3]}};
        const mk_f2 kaw[4] = {(mk_f2){R.ka0[0], R.ka0[1]}, (mk_f2){R.ka0[2], R.ka0[3]}, (mk_f2){R.ka1[0], R.ka1[1]}, (mk_f2){R.ka1[2], R.ka1[3]}};
        mk_f2 ab[4], bt[4], kt[4], rb[4], bh[4], kh[4];
#pragma unroll
        for (int q = 0; q < 4; ++q) {
            mk_f2 gt, gi, gp;
            gt.x = __builtin_amdgcn_exp2f(cl[q].x); gt.y = __builtin_amdgcn_exp2f(cl[q].y);
            gi.x = __builtin_amdgcn_exp2f(-cl[q].x); gi.y = __builtin_amdgcn_exp2f(-cl[q].y);
            gp.x = __builtin_amdgcn_exp2f(clp[q].x); gp.y = __builtin_amdgcn_exp2f(clp[q].y);
            const mk_f2 ge = gte[q] * gi;
            const mk_f2 kd = zk[q] * ((as[q] - 1.0f) * kaw[q] + 1.0f), kb = kk[q] * as[q];
            ab[q] = -(kk[q] * gp); bt[q] = kb * gi; kt[q] = kd * gi; rb[q] = zr[q] * gt; bh[q] = kb * ge; kh[q] = kd * ge;
        }
        *(LAS v4u*)(lds + O_AB + (t * LDW + 8 * cg) * 2) = pk8v(ab);
        *(LAS v4u*)(lds + O_BT + (t * LDW + 8 * cg) * 2) = pk8v(bt);
        *(LAS v4u*)(lds + O_KT + (t * LDW + 8 * cg) * 2) = pk8v(kt);
        *(LAS v4u*)(lds + O_RB + (t * LDW + 8 * cg) * 2) = pk8v(rb);
#pragma unroll
        for (int q = 0; q < 4; ++q) {
            const unsigned wb = pk2(bh[q].x, bh[q].y), wk = pk2(kh[q].x, kh[q].y), wv = pk2(zv[q].x, zv[q].y);
            const int so0 = swz_chunk(8 * cg + 2 * q, t >> 3) + (t & 7) * 2, so1 = swz_chunk(8 * cg + 2 * q + 1, t >> 3) + (t & 7) * 2;
            *(LAS bf16*)(lds + O_BHT + so0) = (bf16)(wb & 0xffffu); *(LAS bf16*)(lds + O_BHT + so1) = (bf16)(wb >> 16);
            *(LAS bf16*)(lds + O_KHT + so0) = (bf16)(wk & 0xffffu); *(LAS bf16*)(lds + O_KHT + so1) = (bf16)(wk >> 16);
            *(LAS bf16*)(lds + O_VT + so0) = (bf16)(wv & 0xffffu); *(LAS bf16*)(lds + O_VT + so1) = (bf16)(wv >> 16);
        }
    }
    __syncthreads();
    }
    }
    unext = __builtin_amdgcn_readfirstlane((int)*qslot);
#ifndef PROBE_NOLD
#if !(RP_S0 == 1 && RQ_A == 1)
    rw_load_unit<false>(a, ws, seg, unit_from_queue(q, qnext < QUNITS ? qnext : qi), wave, lane, R);
#endif
#endif
    _Pragma("unroll 1") for (int rp1_ = 0; rp1_ < RP_S1; ++rp1_) {
    _Pragma("unroll 1") for (int rq_RQ_1 = 0; rq_RQ_1 < RQ_1; ++rq_RQ_1) {
    switch (wave) {
        case 0: rw_s1_wave<0, 0>(lds, r, g, lane); break;
        case 1: rw_s1_wave<0, 1>(lds, r, g, lane); break;
        case 2: rw_s1_wave<1, 0>(lds, r, g, lane); break;
        case 3: rw_s1_wave<1, 1>(lds, r, g, lane); break;
        case 4: rw_s1_wave<2, 0>(lds, r, g, lane); break;
        case 5: rw_s1_wave<2, 1>(lds, r, g, lane); break;
        case 6: rw_s1_wave<3, 0>(lds, r, g, lane); break;
        default: rw_s1_wave<3, 1>(lds, r, g, lane); break;
    }
    __syncthreads();
    }
    _Pragma("unroll 1") for (int rq_RQ_23 = 0; rq_RQ_23 < RQ_23; ++rq_RQ_23) {
    f32x4 rhs[4];
    if (wave < 4) {
#pragma unroll
        for (int mt = 0; mt < 4; ++mt)
#pragma unroll
            for (int i = 0; i < 4; ++i) rhs[mt][i] = bf2f(*(const LAS bf16*)(lds + O_AB + ((16 * mt + 4 * g + i) * LDW + 16 * wave + r) * 2));
    } else {
        const int vt = wave - 4;
        const s16x8 v0 = *(const LAS s16x8*)(lds + O_VT + swz_chunk(16 * vt + r, g)), v1 = *(const LAS s16x8*)(lds + O_VT + swz_chunk(16 * vt + r, g + 4));
#pragma unroll
        for (int mt = 0; mt < 4; ++mt) {
            const int ao = O_MAK + ((16 * mt + r) * LDW + 8 * g) * 2;
            const s16x8 x0 = *(const LAS s16x8*)(lds + ao), x1 = *(const LAS s16x8*)(lds + ao + 64);
            rhs[mt] = mfma32(x0, v0, (f32x4){0.f, 0.f, 0.f, 0.f}); rhs[mt] = mfma32(x1, v1, rhs[mt]);
        }
    }
    {
        f32x4 xb[4];
#pragma unroll
        for (int bi = 0; bi < 4; ++bi) {
            f32x4 acc = rhs[bi];
#pragma unroll
            for (int bj = 0; bj < 4; ++bj) if (bj < bi) {
                const s16x4 am = *(const LAS s16x4*)(lds + O_MAB + ((16 * bi + r) * LDW + 16 * bj + 4 * g) * 2);
                acc = mfma16(am, pack4(xb[bj]), acc);
            }
            acc = mfma16(*(const LAS s16x4*)(lds + O_NP + (bi * 64 + lane) * 8), pack4(acc), (f32x4){0.f, 0.f, 0.f, 0.f});
            xb[bi] = acc;
            *(LAS s16x4*)(lds + O_XT + ((16 * wave + r) * LDW + 16 * bi + 4 * g) * 2) = pack4(acc);
        }
    }
    __syncthreads();
    }
    _Pragma("unroll 1") for (int rq_RQ_4 = 0; rq_RQ_4 < RQ_4; ++rq_RQ_4) {
    {
        rw_pin_unit(R);
        const int nt = wave & 3;
        bf16* ug = (bf16*)((unsigned char*)a.out + DO_INT + (size_t)(seg & 1) * (128u << 20)) + (size_t)u * UNIT_ELEMS;
        const int boff = ((16 * nt + r) * LDW + 8 * g) * 2;
        const s16x8 u0 = *(const LAS s16x8*)(lds + O_XT + 64 * LDW * 2 + boff), u1 = *(const LAS s16x8*)(lds + O_XT + 64 * LDW * 2 + boff + 64);
        const s16x8 v0 = *(const LAS s16x8*)(lds + O_VT + swz_chunk(16 * nt + r, g)), v1 = *(const LAS s16x8*)(lds + O_VT + swz_chunk(16 * nt + r, g + 4));
        v2u yo[2];
#pragma unroll
        for (int my = 0; my < 2; ++my) {
            const int mt = 2 * (wave >> 2) + my, ro_ = ((16 * mt + r) * LDW + 8 * g) * 2;
            const s16x8 n0 = *(const LAS s16x8*)(lds + O_NRB + ro_), n1 = *(const LAS s16x8*)(lds + O_NRB + ro_ + 64);
            const s16x8 m0 = *(const LAS s16x8*)(lds + O_NRK + ro_), m1 = *(const LAS s16x8*)(lds + O_NRK + ro_ + 64);
            f32x4 y = mfma32(n0, u0, (f32x4){0.f, 0.f, 0.f, 0.f}); y = mfma32(n1, u1, y); y = mfma32(m0, v0, y); y = mfma32(m1, v1, y);
            yo[my] = __builtin_bit_cast(v2u, pack4(y));
        }
#ifdef PROBE_NOST
#define RW_ST(p, v) asm volatile("" :: "v"(v))
#else
#define RW_ST(p, v) (p) = (v)
#endif
        RW_ST(*((v4u*)(ug + 12288 + (size_t)(nt * 64 + lane) * 16) + (wave >> 2)), ((v4u){yo[0].x, yo[0].y, yo[1].x, yo[1].y}));
        if (wave < 4) {
            const s16x8 bh0 = *(const LAS s16x8*)(lds + O_BHT + swz_chunk(16 * nt + r, g)), bh1 = *(const LAS s16x8*)(lds + O_BHT + swz_chunk(16 * nt + r, g + 4));
            const s16x8 nb0 = *(const LAS s16x8*)(lds + O_NRB + boff), nb1 = *(const LAS s16x8*)(lds + O_NRB + boff + 64);
            v2u po[4], ro[4];
#pragma unroll
            for (int mt = 0; mt < 4; ++mt) {
                const int ao = O_XT + ((16 * mt + r) * LDW + 8 * g) * 2;
                const s16x8 x0 = *(const LAS s16x8*)(lds + ao), x1 = *(const LAS s16x8*)(lds + ao + 64);
                f32x4 p = mfma32(x0, bh0, (f32x4){0.f, 0.f, 0.f, 0.f}); p = mfma32(x1, bh1, p);
                if (mt == nt) { const float gt = *(const LAS float*)(lds + O_GT + (16 * mt + r) * 4);
#pragma unroll
                    for (int i = 0; i < 4; ++i) p[i] += (4 * g + i == r) ? gt : 0.f; }
                const f32x4 rbv = unpack4(*(const LAS v2u*)(lds + O_RB + ((16 * nt + r) * LDW + 16 * mt + 4 * g) * 2));
                f32x4 q = mfma32(x0, nb0, rbv); q = mfma32(x1, nb1, q);
                po[mt] = __builtin_bit_cast(v2u, pack4(p)); ro[mt] = __builtin_bit_cast(v2u, pack4(q));
            }
            v4u* pg = (v4u*)(ug + (size_t)(nt * 64 + lane) * 16);
            RW_ST(pg[0], ((v4u){po[0].x, po[0].y, po[1].x, po[1].y})); RW_ST(pg[1], ((v4u){po[2].x, po[2].y, po[3].x, po[3].y}));
            v4u* rg = (v4u*)(ug + 4096 + (size_t)(nt * 64 + lane) * 16);
            RW_ST(rg[0], ((v4u){ro[0].x, ro[0].y, ro[1].x, ro[1].y})); RW_ST(rg[1], ((v4u){ro[2].x, ro[2].y, ro[3].x, ro[3].y}));
        } else {
            v2u qo[4];
#pragma unroll
            for (int mt = 0; mt < 4; ++mt) {
                const int sw0 = swz_chunk(16 * mt + r, g), sw1 = swz_chunk(16 * mt + r, g + 4);
                const s16x8 b0 = *(const LAS s16x8*)(lds + O_BHT + sw0), b1 = *(const LAS s16x8*)(lds + O_BHT + sw1);
                const s16x8 k0 = *(const LAS s16x8*)(lds + O_KHT + sw0), k1 = *(const LAS s16x8*)(lds + O_KHT + sw1);
                f32x4 q = mfma32(b0, u0, (f32x4){0.f, 0.f, 0.f, 0.f}); q = mfma32(b1, u1, q); q = mfma32(k0, v0, q); q = mfma32(k1, v1, q);
                qo[mt] = __builtin_bit_cast(v2u, pack4(q));
            }
            v4u* qg = (v4u*)(ug + 8192 + (size_t)(nt * 64 + lane) * 16);
            RW_ST(qg[0], ((v4u){qo[0].x, qo[0].y, qo[1].x, qo[1].y})); RW_ST(qg[1], ((v4u){qo[2].x, qo[2].y, qo[3].x, qo[3].y}));
        }
    }
    }
    }
}

__device__ __forceinline__ void rw_chain_job(const Args& a, unsigned char* ws, LAS unsigned char* lds, int seg, int chain, int wave, int lane) {
    const int vt = wave & 3;
    LAS unsigned char* cl = lds + (wave >> 2) * 65536;
    int s, rem; if (chain < 64) { s = chain >> 5; rem = chain & 31; } else { s = 2 + ((chain - 64) >> 5); rem = (chain - 64) & 31; }
    const int h = rem >> 1, d = rem & 1, base = s < 2 ? s * LP : 32768 + (s - 2) * LS, L = s < 2 ? LP : LS, nch = chain < 64 ? 32 : 4;
    const int r = lane & 15, g = lane >> 4;
    f32x4* stp = (f32x4*)(ws + WS_STATE) + ((size_t)(chain * 4 + vt) * 4) * 64 + lane;
    f32x4 st[4];
#pragma unroll
    for (int i = 0; i < 4; ++i) st[i] = seg == 0 ? (f32x4){0.f, 0.f, 0.f, 0.f} : stp[i * 64];
#pragma unroll
    for (int i = 0; i < 4; ++i) asm volatile("" : "+v"(st[i]));
    const bf16* ub = (const bf16*)((unsigned char*)a.out + DO_INT + (size_t)(seg & 1) * (128u << 20));
#define RW_DMA(ug, buf) do { LAS unsigned char* b_ = cl + (buf) * 32768; \
        _Pragma("unroll") for (int _i = 0; _i < 4; ++_i) { const int pc_ = 4 * vt + _i; \
            __builtin_amdgcn_global_load_lds((const unsigned*)((ug) + (size_t)((pc_ >> 1) * 64 + lane) * 16 + (pc_ & 1) * 8), (LAS unsigned*)(b_ + pc_ * 1024), 16, 0, 0); } \
        _Pragma("unroll") for (int _i = 0; _i < 4; ++_i) \
            __builtin_amdgcn_global_load_lds((const unsigned*)((ug) + 8192 + (_i >> 1) * 4096 + (size_t)(vt * 64 + lane) * 16 + (_i & 1) * 8), (LAS unsigned*)(b_ + 16384 + vt * 4096 + _i * 1024), 16, 0, 0); } while (0)
    RW_DMA(ub + (size_t)unit_of(chain, 0) * UNIT_ELEMS, 0);
    for (int jc = 0; jc < nch; ++jc) {
#if defined(PROBE_X) && (PROBE_X & 8)
        if (jc == 0) VM_WAIT();
#else
        if (jc == 0) VM_WAIT(); else asm volatile("s_waitcnt vmcnt(16)" ::: "memory");
#endif
        __builtin_amdgcn_s_barrier();
        asm volatile("" ::: "memory");
        if (jc + 1 < nch) RW_DMA(ub + (size_t)unit_of(chain, jc + 1) * UNIT_ELEMS, (jc + 1) & 1);
        const LAS unsigned char* b = cl + (jc & 1) * 32768 + lane * 16;
        v4u pf[4][2], rf[4][2];
#pragma unroll
        for (int i = 0; i < 4; ++i) { pf[i][0] = *(const LAS v4u*)(b + (2 * i) * 1024); pf[i][1] = *(const LAS v4u*)(b + (2 * i + 1) * 1024);
                                      rf[i][0] = *(const LAS v4u*)(b + (8 + 2 * i) * 1024); rf[i][1] = *(const LAS v4u*)(b + (9 + 2 * i) * 1024); }
        const LAS unsigned char* bq = b + 16384 + vt * 4096;
        const v4u cq0 = *(const LAS v4u*)(bq), cq1 = *(const LAS v4u*)(bq + 1024), cy0 = *(const LAS v4u*)(bq + 2048), cy1 = *(const LAS v4u*)(bq + 3072);
        s16x4 sb[4];
#pragma unroll
        for (int kt = 0; kt < 4; ++kt) sb[kt] = pack4(st[kt]);
        const int gchunk = seg * nch + jc;
        const unsigned ystep = d ? 0u - (unsigned)(DRW * 2) : (unsigned)(DRW * 2);
        const unsigned yoff0 = (unsigned)(d ? DO_YB : DO_YF) + (unsigned)(((base + (d ? L - 1 - 64 * gchunk : 64 * gchunk)) * DRW + h * 64 + 16 * vt) * 2) + (unsigned)(4 * g) * ystep + 2u * (unsigned)r;
#pragma unroll
        for (int tt = 0; tt < 4; ++tt) {
            const v2u yi = tt == 0 ? (v2u){cy0.x, cy0.y} : tt == 1 ? (v2u){cy0.z, cy0.w} : tt == 2 ? (v2u){cy1.x, cy1.y} : (v2u){cy1.z, cy1.w};
            f32x4 acc = unpack4(yi);
            acc = mfma16(__builtin_bit_cast(s16x4, (v2u){rf[tt][0].x, rf[tt][0].y}), sb[0], acc);
            acc = mfma16(__builtin_bit_cast(s16x4, (v2u){rf[tt][0].z, rf[tt][0].w}), sb[1], acc);
            acc = mfma16(__builtin_bit_cast(s16x4, (v2u){rf[tt][1].x, rf[tt][1].y}), sb[2], acc);
            acc = mfma16(__builtin_bit_cast(s16x4, (v2u){rf[tt][1].z, rf[tt][1].w}), sb[3], acc);
#pragma unroll
            for (int i = 0; i < 4; ++i) *(bf16*)((unsigned char*)a.out + (size_t)(yoff0 + (unsigned)(16 * tt + i) * ystep)) = (bf16)f2bf(acc[i]);
        }
        f32x4 sn[4];
#pragma unroll
        for (int i = 0; i < 4; ++i) {
            const v2u qi = i == 0 ? (v2u){cq0.x, cq0.y} : i == 1 ? (v2u){cq0.z, cq0.w} : i == 2 ? (v2u){cq1.x, cq1.y} : (v2u){cq1.z, cq1.w};
            f32x4 acc = unpack4(qi);
            acc = mfma16(__builtin_bit_cast(s16x4, (v2u){pf[i][0].x, pf[i][0].y}), sb[0], acc);
            acc = mfma16(__builtin_bit_cast(s16x4, (v2u){pf[i][0].z, pf[i][0].w}), sb[1], acc);
            acc = mfma16(__builtin_bit_cast(s16x4, (v2u){pf[i][1].x, pf[i][1].y}), sb[2], acc);
            acc = mfma16(__builtin_bit_cast(s16x4, (v2u){pf[i][1].z, pf[i][1].w}), sb[3], acc);
            sn[i] = acc;
        }
#pragma unroll
        for (int i = 0; i < 4; ++i) st[i] = sn[i];
    }
#undef RW_DMA
#pragma unroll
    for (int i = 0; i < 4; ++i) stp[i * 64] = st[i];
}
}


namespace s5k {
constexpr int ST = 32, NCH = M / ST, K2 = 768, KU = 512;
constexpr size_t POW_ELEMS = (size_t)128 * 33 * 64 * 2, BB_ELEMS = (size_t)128 * 64 * 16 * 2, KTAB_ELEMS = (size_t)64 * 63 * 256;
__device__ __forceinline__ void tables_group(const Args& a, unsigned char* ws, LAS unsigned char* lds, int g, int quarter, int tid) {
    float* POW = (float*)(ws + WS_S5TAB); float* BB = POW + POW_ELEMS; float* KTAB = BB + BB_ELEMS;
    LAS float* lam = (LAS float*)lds;
    LAS float* bbl = lam + 256;
    LAS float* cl = bbl + 4096;
    LAS float* pwl = cl + 4096;
    __syncthreads();
    if (tid < 128) {
        const int d = tid >> 6, p = tid & 63, gi = d * 64 + g;
        const float lre = a.in[5][gi * 64 + p], lim = a.in[6][gi * 64 + p], dt = expf(a.in[7][gi]);
        const float er = expf(lre * dt); float sn, cs; sincosf(lim * dt, &sn, &cs);
        const float lbr = er * cs, lbi = er * sn;
        const float nr = lbr - 1.0f, ni = lbi, den = lre * lre + lim * lim;
        const float cfr = (nr * lre + ni * lim) / den, cfi = (ni * lre - nr * lim) / den;
        lam[(d * 64 + p) * 2] = lre * dt; lam[(d * 64 + p) * 2 + 1] = lim * dt;
        for (int h = 0; h < 16; ++h) {
            const float br = a.in[8][((size_t)gi * 64 + p) * 16 + h], bi = a.in[9][((size_t)gi * 64 + p) * 16 + h];
            const float xr = cfr * br - cfi * bi, xi = cfr * bi + cfi * br;
            bbl[((d * 64 + p) * 16 + h) * 2] = xr; bbl[((d * 64 + p) * 16 + h) * 2 + 1] = xi;
            if (quarter == 0) { BB[(((size_t)gi * 64 + p) * 16 + h) * 2] = xr; BB[(((size_t)gi * 64 + p) * 16 + h) * 2 + 1] = xi; }
            cl[((d * 16 + h) * 64 + p) * 2] = a.in[10][((size_t)gi * 16 + h) * 64 + p]; cl[((d * 16 + h) * 64 + p) * 2 + 1] = a.in[11][((size_t)gi * 16 + h) * 64 + p];
        }
    }
    __syncthreads();
    for (int e = tid; e < 2 * 33 * 64; e += NWAVES * 64) {
        const int p = e & 63, tau = (e >> 6) % 33, d = e / (33 * 64), gi = d * 64 + g;
        const float er = expf(lam[(d * 64 + p) * 2] * (float)tau); float sn, cs; sincosf(lam[(d * 64 + p) * 2 + 1] * (float)tau, &sn, &cs);
        pwl[e * 2] = er * cs; pwl[e * 2 + 1] = er * sn;
        if (quarter == 0) { POW[(((size_t)gi * 33 + tau) * 64 + p) * 2] = er * cs; POW[(((size_t)gi * 33 + tau) * 64 + p) * 2 + 1] = er * sn; }
    }
    __syncthreads();
    for (int o = quarter * (NWAVES * 64) + tid; o < 63 * 256; o += 4 * NWAVES * 64) {
        const int hh = o & 255, h = hh >> 4, h2 = hh & 15, lag = (o >> 8) - 31;
        float acc = 0.f;
#pragma unroll
        for (int d = 0; d < 2; ++d) {
            if ((d == 0 && lag >= 0) || (d == 1 && lag <= 0)) {
                const int tau = lag >= 0 ? lag : -lag;
                for (int p = 0; p < 64; ++p) {
                    const float cr = cl[((d * 16 + h) * 64 + p) * 2], ci = cl[((d * 16 + h) * 64 + p) * 2 + 1];
                    const float pr = pwl[((d * 33 + tau) * 64 + p) * 2], pi = pwl[((d * 33 + tau) * 64 + p) * 2 + 1];
                    const float br = bbl[((d * 64 + p) * 16 + h2) * 2], bi = bbl[((d * 64 + p) * 16 + h2) * 2 + 1];
                    const float qr = pr * br - pi * bi, qi = pr * bi + pi * br;
                    acc += cr * qr - ci * qi;
                }
            }
        }
        KTAB[(size_t)g * 63 * 256 + o] = acc;
    }
    __syncthreads();
}
__device__ __forceinline__ void fill_weights(const Args& a, unsigned char* ws, int gw, int NGW, int lane, int part) {
    const float* POW = (const float*)(ws + WS_S5TAB); const float* BB = POW + POW_ELEMS; const float* KTAB = BB + BB_ELEMS;
    bf16* W2 = (bf16*)(ws + WS_S5W2); bf16* E = (bf16*)(ws + WS_S5E);
    const size_t n_w2 = (size_t)64 * 512 * 96, n_e = (size_t)64 * 256 * 64, stride = (size_t)NGW * 64;
    const size_t it0 = part ? 0 : n_w2, it1 = part ? n_w2 : n_w2 + n_e;
    for (size_t it = it0 + (size_t)gw * 64 + lane; it < it1; it += stride) {
        float v[8];
        if (it < n_w2) {
            const int kc = (int)(it % 96), n = (int)((it / 96) % 512), g = (int)(it / (96 * 512)), t = n >> 4, h = n & 15, k0 = kc * 8;
            if (k0 < KU) {
                const int s = k0 >> 4, h0 = k0 & 15, lag = t - s;
                const float* kt = KTAB + ((size_t)(g * 63 + lag + 31) * 16 + h) * 16 + h0;
#pragma unroll
                for (int j = 0; j < 8; ++j) v[j] = kt[j] + ((lag == 0 && h0 + j == h) ? a.in[12][g * 16 + h] : 0.f);
            } else {
                const int kk = k0 - KU, d = kk >> 7, ri = (kk >> 6) & 1, p0 = kk & 63, gi = d * 64 + g, tau = d == 0 ? t + 1 : ST - t;
#pragma unroll
                for (int j = 0; j < 8; ++j) {
                    const int p = p0 + j;
                    const float cr = a.in[10][((size_t)gi * 16 + h) * 64 + p], ci = a.in[11][((size_t)gi * 16 + h) * 64 + p];
                    const float pr = POW[(((size_t)gi * 33 + tau) * 64 + p) * 2], pi = POW[(((size_t)gi * 33 + tau) * 64 + p) * 2 + 1];
                    v[j] = ri == 0 ? (cr * pr - ci * pi) : -(cr * pi + ci * pr);
                }
            }
            *(v4u*)(W2 + ((size_t)(g * 512 + n)) * K2 + k0) = rwk::pk8(v);
        } else {
            const size_t ie = it - n_w2;
            const int kc = (int)(ie % 64), n = (int)((ie / 64) % 256), g = (int)(ie / (64 * 256)), d = n >> 7, ri = (n >> 6) & 1, p = n & 63, gi = d * 64 + g;
            const int k0 = kc * 8, s = k0 >> 4, h0 = k0 & 15, tau = d == 0 ? ST - 1 - s : s;
            const float pr = POW[(((size_t)gi * 33 + tau) * 64 + p) * 2], pi = POW[(((size_t)gi * 33 + tau) * 64 + p) * 2 + 1];
#pragma unroll
            for (int j = 0; j < 8; ++j) {
                const float br = BB[(((size_t)gi * 64 + p) * 16 + h0 + j) * 2], bi = BB[(((size_t)gi * 64 + p) * 16 + h0 + j) * 2 + 1];
                v[j] = ri == 0 ? (pr * br - pi * bi) : (pr * bi + pi * br);
            }
            *(v4u*)(E + ((size_t)(g * 256 + n)) * KU + k0) = rwk::pk8(v);
        }
    }
}
__device__ __forceinline__ void chain_job(unsigned char* ws, bf16* A2, int job, int lane) {
    int s, rem; if (job < 256) { s = job / 128; rem = job % 128; } else { s = 2 + (job - 256) / 128; rem = (job - 256) % 128; }
    const int g = rem >> 1, d = rem & 1, p = lane, gi = d * 64 + g;
    const int c0 = s < 2 ? s * (LP / ST) : 2 * (LP / ST) + (s - 2) * (LS / ST), nc = s < 2 ? LP / ST : LS / ST;
    const float* POW = (const float*)(ws + WS_S5TAB);
    const float lr = POW[(((size_t)gi * 33 + 32) * 64 + p) * 2], li = POW[(((size_t)gi * 33 + 32) * 64 + p) * 2 + 1];
    const bf16* XL = (const bf16*)(ws + WS_S5XL);
    const int step = d ? -1 : 1, cfirst = d ? c0 + nc - 1 : c0;
    const int xcol = d * 128 + p, scol = KU + d * 128 + p;
    float xr = 0.f, xi = 0.f;
    { bf16* row = A2 + ((size_t)g * NCH + cfirst) * K2 + scol; row[0] = 0; row[64] = 0; }
    for (int n = 0; n < nc; n += 32) {
        float lr_[32], li_[32];
#pragma unroll
        for (int j = 0; j < 32; ++j) { const bf16* xrow = XL + ((size_t)g * NCH + cfirst + (n + j) * step) * 256 + xcol; lr_[j] = bf2f(xrow[0]); li_[j] = bf2f(xrow[64]); }
#pragma unroll
        for (int j = 0; j < 32; ++j) {
            const float nr = lr * xr - li * xi + lr_[j], ni = lr * xi + li * xr + li_[j]; xr = nr; xi = ni;
            if (n + j + 1 < nc) { bf16* row = A2 + ((size_t)g * NCH + cfirst + (n + j + 1) * step) * K2 + scol; row[0] = (bf16)f2bf(xr); row[64] = (bf16)f2bf(xi); }
        }
    }
}
}
namespace pg8 {
struct S5Order {
    int G, c, nun, mode;
    __device__ bool next(int i, Unit& u) const {
        const int L = i * G + c; if (L >= nun) return false;
        if (mode == 1) { u.pm = L; u.pn = L >> 3; } else { const int g = L >> 4; u.pm = g * 8 + ((L & 15) >> 1); u.pn = g * 2 + (L & 1); }
        return true;
    }
    __device__ __forceinline__ void a_ready(const Unit&) const {}
    __device__ __forceinline__ void done(const Unit&) const {}
};
struct WrapOrder : StaticOrder { int wrap; __device__ bool next(int i, Unit& u) const { const bool ok = StaticOrder::next(i, u); u.pm &= wrap; return ok; } };
struct EpiNull { static constexpr bool PERM = true, AFTER_DRAIN = false;
    __device__ __forceinline__ void operator()(const f32x4 (&acc)[2][2][4][2], const Unit& u, int wr, int wc, int fr, int fq) const {
#pragma unroll
        for (int a = 0; a < 2; ++a)
#pragma unroll
            for (int b = 0; b < 2; ++b)
#pragma unroll
                for (int m = 0; m < 4; ++m)
#pragma unroll
                    for (int n = 0; n < 2; ++n) asm volatile("" :: "v"(acc[a][b][m][n]));
    } };
struct EpiS5X {
    static constexpr bool PERM = true, AFTER_DRAIN = false;
    bf16_t* O;
    __device__ __forceinline__ void operator()(const f32x4 (&acc)[2][2][4][2], const Unit& u, int wr, int wc, int fr, int fq) const {
        const int row0 = u.pm * BM + wr * 64 + fr, col0 = wc * 32 + 8 * fq;
#pragma unroll
        for (int ai = 0; ai < 2; ++ai)
#pragma unroll
            for (int m = 0; m < 4; ++m) { bf16_t* rowp = O + (size_t)(row0 + ai * HALF + m * 16) * 256 + col0;
#pragma unroll
                for (int bj = 0; bj < 2; ++bj) { const f32x4 v0 = acc[ai][bj][m][0], v1 = acc[ai][bj][m][1];
                    u32x4 w; w.x = cvt_pk_bf16(v0[0], v0[1]); w.y = cvt_pk_bf16(v0[2], v0[3]); w.z = cvt_pk_bf16(v1[0], v1[1]); w.w = cvt_pk_bf16(v1[2], v1[3]);
                    *(u32x4*)(rowp + bj * HALF) = w; } }
    }
};
struct EpiS5Y {
    static constexpr bool PERM = true, AFTER_DRAIN = false;
    bf16_t* Zp;
    __device__ __forceinline__ void operator()(const f32x4 (&acc)[2][2][4][2], const Unit& u, int wr, int wc, int fr, int fq) const {
        const int row0 = u.pm * BM + wr * 64 + fr, col0 = (u.pn & 1) * BM + wc * 32 + 8 * fq;
#pragma unroll
        for (int ai = 0; ai < 2; ++ai)
#pragma unroll
            for (int m = 0; m < 4; ++m) {
                const int row = row0 + ai * HALF + m * 16, g = row >> 11, c = row & 2047;
#pragma unroll
                for (int bj = 0; bj < 2; ++bj) {
                    const int col = col0 + bj * HALF, t = col >> 4, h0 = col & 15;
                    float v[8];
#pragma unroll
                    for (int j = 0; j < 4; ++j) { v[j] = acc[ai][bj][m][0][j]; v[4 + j] = acc[ai][bj][m][1][j]; }
#pragma unroll
                    for (int j = 0; j < 8; ++j) { const float x = v[j]; v[j] = x * sigmoid_f(1.5957691216057308f * (x + 0.044715f * x * x * x)); }
                    u32x4 w; w.x = cvt_pk_bf16(v[0], v[1]); w.y = cvt_pk_bf16(v[2], v[3]); w.z = cvt_pk_bf16(v[4], v[5]); w.w = cvt_pk_bf16(v[6], v[7]);
                    *(u32x4*)(Zp + (size_t)(c * 32 + t) * 1024 + g * 16 + h0) = w;
                }
            }
    }
};
}


__device__ __forceinline__ void transpose_item(const float* W, int ldw, int K, bf16* WT, int drow0, LAS float* scr, int k0, int n0, int lane) {
#pragma unroll 8
    for (int i = 0; i < 32; ++i) { const int kk = 2 * i + (lane >> 5); scr[kk * 33 + (lane & 31)] = W[(size_t)(k0 + kk) * ldw + n0 + (lane & 31)]; }
    LDS_WAIT();
    const int c = lane & 7;
#pragma unroll
    for (int j = 0; j < 4; ++j) { const int n = (lane >> 3) + 8 * j; const LAS float* s = scr + (8 * c) * 33 + n;
        v4u o; o.x = pk2(s[0 * 33], s[1 * 33]); o.y = pk2(s[2 * 33], s[3 * 33]); o.z = pk2(s[4 * 33], s[5 * 33]); o.w = pk2(s[6 * 33], s[7 * 33]);
        *(v4u*)(WT + (size_t)(drow0 + n) * K + k0 + 8 * c) = o; }
    LDS_WAIT();
}
__device__ __forceinline__ int win_dest_row(int n) { return n < 1024 ? n : (n < 2048 ? n + 3328 : (n < 5376 ? n - 1024 : n)); }
__device__ __forceinline__ const float* xrow_ptr(const float* xp, const float* xs, int m) { return m < 32768 ? xp + (size_t)m * D : xs + (size_t)(m - 32768) * D; }

__device__ __forceinline__ void p0_prologue(const Args& a, unsigned char* ws, LAS unsigned char* lds, int gw, int NGW, int wave, int lane) {
    LAS float* scr = (LAS float*)(lds + wave * 16384);
    constexpr int I_IN = (D / 64) * (NIN / 32), I_GLU = (1024 / 64) * (1024 / 32), I_SO = (1024 / 64) * (2048 / 32), I_WO = (2048 / 64) * (2048 / 32);
    constexpr int NITEMS = I_IN + I_GLU + 2 * I_SO + I_WO;
    for (int it = gw; it < NITEMS; it += NGW) {
        int r = it;
        if (r < I_IN) { const int nblk = NIN / 32, kb = r / nblk, nb = r % nblk; transpose_item(a.in[4], NIN, D, (bf16*)(ws + WS_WT), win_dest_row(32 * nb), scr, 64 * kb, 32 * nb, lane); continue; } r -= I_IN;
        if (r < I_GLU) { const int nblk = 1024 / 32, kb = r / nblk, nb = r % nblk; transpose_item(a.in[13], 1024, 1024, (bf16*)(ws + WS_GLUT), 32 * nb, scr, 64 * kb, 32 * nb, lane); continue; } r -= I_GLU;
        if (r < I_SO) { const int nblk = 2048 / 32, kb = r / nblk, nb = r % nblk; transpose_item(a.in[14], 2048, 1024, (bf16*)(ws + WS_S5OT), 32 * nb, scr, 64 * kb, 32 * nb, lane); continue; } r -= I_SO;
        if (r < I_SO) { const int nblk = 2048 / 32, kb = r / nblk, nb = r % nblk; transpose_item(a.in[25], 2048, 1024, (bf16*)(ws + WS_RWOT), 32 * nb, scr, 64 * kb, 32 * nb, lane); continue; } r -= I_SO;
        { const int nblk = 2048 / 32, kb = r / nblk, nb = r % nblk; transpose_item(a.in[26], 2048, 2048, (bf16*)(ws + WS_WOT), 32 * nb, scr, 64 * kb, 32 * nb, lane); }
    }
    { const int bxx = gw / NWAVES; s5k::tables_group(a, ws, lds, (bxx >> 2) & 63, bxx & 3, wave * 64 + lane); }
    { bf16* LUT = (bf16*)(ws + WS_LUT);
      for (int e = gw * 64 + lane; e < 4 * 16 * 64 * 64; e += NGW * 64) {
          const int j = e & 63, c = (e >> 6) & 63, h = (e >> 12) & 15, rd = e >> 16, role = rd >> 1, d = rd & 1;
          LUT[e] = (bf16)f2bf((role ? a.in[19] : a.in[17])[(size_t)(d * 64 + j) * 1024 + h * 64 + c]); } }
    const float* g = a.in[2];
    f32x4 gv[8];
#pragma unroll
    for (int j = 0; j < 8; ++j) gv[j] = ((const f32x4*)g)[lane + 64 * j];
    bf16* HN = (bf16*)(ws + WS_HN);
    for (int m = gw; m < M; m += NGW) {
        const f32x4* xr = (const f32x4*)xrow_ptr(a.in[0], a.in[1], m) + lane;
        f32x4 v[8]; float s = 0.f;
#pragma unroll
        for (int j = 0; j < 8; ++j) { v[j] = __builtin_nontemporal_load(xr + 64 * j); s += (v[j].x * v[j].x + v[j].y * v[j].y) + (v[j].z * v[j].z + v[j].w * v[j].w); }
        const float rstd = 1.0f / sqrtf(wave_sum(s) * (1.0f / D) + RMS_EPS);
        v2u* o8 = (v2u*)(HN + (size_t)m * D) + lane;
#pragma unroll
        for (int j = 0; j < 8; ++j) { v2u o; o.x = pk2(v[j].x * rstd * gv[j].x, v[j].y * rstd * gv[j].y); o.y = pk2(v[j].z * rstd * gv[j].z, v[j].w * rstd * gv[j].w); o8[64 * j] = o; }
    }
}

__device__ __forceinline__ void unpack8(const bf16* p, float (&o)[8]) {
    const v4u a = *(const v4u*)p;
    o[0] = blo(a.x); o[1] = bhi(a.x); o[2] = blo(a.y); o[3] = bhi(a.y); o[4] = blo(a.z); o[5] = bhi(a.z); o[6] = blo(a.w); o[7] = bhi(a.w);
}
__device__ __forceinline__ void pack8(bf16* p, const float (&v)[8]) {
    v4u a; a.x = pk2(v[0], v[1]); a.y = pk2(v[2], v[3]); a.z = pk2(v[4], v[5]); a.w = pk2(v[6], v[7]); *(v4u*)p = a;
}
__device__ __forceinline__ void p3_finalize(const Args& a, unsigned char* ws, int gw, int NGW, int lane) {
    const bf16* BON = (const bf16*)(ws + WS_ZG);
    unsigned char* ob = (unsigned char*)a.out;
    bf16* YF = (bf16*)(ob + DO_YF); const bf16* YB = (const bf16*)(ob + DO_YB);
    const int half = gw & 1, c0 = half * 512 + lane * 8;
    float lnw[8], lnb[8];
#pragma unroll
    for (int j = 0; j < 8; ++j) { lnw[j] = a.in[23][c0 + j]; lnb[j] = a.in[24][c0 + j]; }
    for (int m = gw >> 1; m < M; m += NGW >> 1) {
        const int t = m < 32768 ? (m & (LP - 1)) : ((m - 32768) & (LS - 1)), L = m < 32768 ? LP : LS;
        const bool hp = t > 0, hn = t < L - 1;
        float o[8];
        float y[8];
        {
            float yf[8], yb[8];
            unpack8(YF + (size_t)m * DRW + c0, yf); unpack8(YB + (size_t)m * DRW + c0, yb);
#pragma unroll
            for (int j = 0; j < 8; ++j) y[j] = yf[j] + yb[j];
        }
        float s1 = 0.f;
#pragma unroll
        for (int j = 0; j < 8; ++j) s1 += y[j];
        s1 += __shfl_xor(s1, 1); s1 += __shfl_xor(s1, 2); s1 += __shfl_xor(s1, 4);
        const float mean = s1 * (1.0f / 64.0f);
        float s2 = 0.f;
#pragma unroll
        for (int j = 0; j < 8; ++j) { const float dd = y[j] - mean; s2 += dd * dd; }
        s2 += __shfl_xor(s2, 1); s2 += __shfl_xor(s2, 2); s2 += __shfl_xor(s2, 4);
        const float rstd = 1.0f / sqrtf(s2 * (1.0f / 64.0f) + GN_EPS);
        float bon[8];
        unpack8(BON + (size_t)m * DRW + c0, bon);
#pragma unroll
        for (int j = 0; j < 8; ++j) o[j] = (y[j] - mean) * rstd * lnw[j] + lnb[j] + bon[j];
        pack8(YF + (size_t)m * DRW + c0, o);
    }
}

__device__ __forceinline__ void p12_final(const Args& a, const bf16* OUTB, int gw, int NGW, int lane) {
    const float* g = a.in[3];
    f32x4 gv[8];
#pragma unroll
    for (int j = 0; j < 8; ++j) gv[j] = ((const f32x4*)g)[lane + 64 * j];
    for (int m = gw; m < M; m += NGW) {
        const f32x4* xr = (const f32x4*)xrow_ptr(a.in[0], a.in[1], m) + lane;
        f32x4* orow = (f32x4*)(a.out + (size_t)m * D) + lane;
        const v2u* brow = (const v2u*)(OUTB + (size_t)m * D) + lane;
        f32x4 v[8]; float s = 0.f;
#pragma unroll
        for (int j = 0; j < 8; ++j) { const v2u b = __builtin_nontemporal_load(brow + 64 * j); v[j] = (f32x4){blo(b.x), bhi(b.x), blo(b.y), bhi(b.y)}; s += (v[j].x * v[j].x + v[j].y * v[j].y) + (v[j].z * v[j].z + v[j].w * v[j].w); }
        const float rstd = 1.0f / sqrtf(wave_sum(s) * (1.0f / D) + RMS_EPS);
#pragma unroll
#ifdef PROBE_DMG
        for (int j = 0; j < 8; ++j) { const f32x4 xv = __builtin_nontemporal_load(xr + 64 * j); __builtin_nontemporal_store(xv, orow + 64 * j); }
#else
        for (int j = 0; j < 8; ++j) { const f32x4 xv = __builtin_nontemporal_load(xr + 64 * j); __builtin_nontemporal_store(xv + v[j] * rstd * gv[j], orow + 64 * j); }
#endif
    }
}

#ifndef RW_UA
#define RW_UA 10
#define RW_UB 18
#endif
static_assert(64 * RW_UA + 192 * RW_UB == 4096, "RWKV unit split");
__global__ void __launch_bounds__(NWAVES * 64, 2) mk_fwd(Args args) {
    extern __shared__ __attribute__((aligned(16))) unsigned char lds_raw[];
    LAS unsigned char* lds = (LAS unsigned char*)lds_raw;
    volatile LAS unsigned* MISC = (volatile LAS unsigned*)(lds + MISC_OFF);
    const int wave = __builtin_amdgcn_readfirstlane((int)threadIdx.x >> 6);
#define lane mk_lane()
    const int tid0 = threadIdx.x;
    const int G = gridDim.x; const int bx = blockIdx.x; const int vcu = (G % 8 == 0) ? (bx % 8) * (G / 8) + bx / 8 : bx;
    unsigned char* ws = args.ws;
    unsigned* ctl = (unsigned*)(ws + WS_CTL);
    for (int u = tid0; u < (LDS_BYTES - MISC_OFF) / 4; u += NWAVES * 64) ((LAS unsigned*)(lds + MISC_OFF))[u] = 0u;
    __syncthreads();
    XcdBarrier bar = xcd_barrier_post(ctl + CW_BAR, MISC + 8, wave);
#ifdef PROBE_A
    int nstamp = 0;
#define STAMP() do { if (bx == 0 && tid0 == 0) MISC[32 + nstamp] = (unsigned)__builtin_amdgcn_s_memrealtime(); ++nstamp; } while (0)
#else
#define STAMP() do { } while (0)
#endif
    STAMP();
#define GRID_BAR() do { xcd_barrier(bar, wave); STAMP(); } while (0)
#ifndef ONLY_PHASE
#define ONLY_PHASE -1
#endif
#ifndef REP_PHASE
#define REP_PHASE -1
#endif
#define IN(k) (ONLY_PHASE < 0 || ONLY_PHASE == (k))
#define REPS(k) _Pragma("unroll 1") for (int rep_ = 0; rep_ < ((REP_PHASE == (k)) ? 2 : 1); ++rep_)
    const int gw = vcu * NWAVES + wave, NGW = G * NWAVES;
#ifdef GEMM_WAVE_PERM
    const int gwave = ((wave & 1) << 2) | (wave >> 1);
#else
    const int gwave = wave;
#endif
    bf16* WT = (bf16*)(ws + WS_WT); bf16* HN = (bf16*)(ws + WS_HN); bf16* RWIN = (bf16*)(ws + WS_RWIN); bf16* Z = (bf16*)(ws + WS_Z); bf16* ZG = (bf16*)(ws + WS_ZG);
    bf16* A2 = (bf16*)((unsigned char*)args.out + DO_A2);
    bf16* YN = (bf16*)((unsigned char*)args.out + DO_YF); bf16* Q = (bf16*)((unsigned char*)args.out + DO_Q); bf16* P = RWIN;

#if defined(PROBE_SPIN) && !defined(PROBE_SPIN_END)
    if (bx == 0 && tid0 == 0) { const unsigned long long t0_ = __builtin_amdgcn_s_memrealtime(); while (__builtin_amdgcn_s_memrealtime() - t0_ < (unsigned long long)PROBE_SPIN) __builtin_amdgcn_s_sleep(8); }
    __syncthreads();
#endif
    if (IN(0)) REPS(0) { p0_prologue(args, ws, lds, gw, NGW, wave, lane); GRID_BAR(); }
    if (IN(1)) REPS(1) {
        s5k::fill_weights(args, ws, gw, NGW, lane, 0);
        pg8::Gemm g{HN, WT, M, 4352, D, D}; pg8::StaticOrder S; S.init(M, 4352, G, bx);
        pg8::EpiG1 E{A2, RWIN};
        pg8::gemm_phase<pg8::EpiG1, pg8::StaticOrder, PG8_ALIGN, PG8_SP2>(lds, g, S, E, gwave);
        GRID_BAR();
    }
#ifdef PROBE_GEMM
    {
        pg8::Gemm g{HN, WT, M, 4352, D, D}; pg8::WrapOrder S; S.init(M, 4352, G, bx); S.wrap = (PROBE_GEMM == 2) ? 15 : 0xffff;
        pg8::EpiNull E{};
        pg8::gemm_phase<pg8::EpiNull, pg8::WrapOrder, PG8_ALIGN, PG8_SP2>(lds, g, S, E, gwave);
        GRID_BAR();
    }
#endif
    if (IN(2)) REPS(2) {
        pg8::Gemm g{A2, (const bf16*)(ws + WS_S5E), 131072, 256, s5k::KU, s5k::K2}; pg8::S5Order S{G, bx, 512, 1};
        pg8::EpiS5X E{(bf16*)(ws + WS_S5XL)};
        pg8::gemm_phase<pg8::EpiS5X, pg8::S5Order, PG8_ALIGN, PG8_SP2>(lds, g, S, E, gwave);
        GRID_BAR();
    }
    if (IN(3)) REPS(3) {
        const int gwt = wave * G + vcu;
        for (int j = gwt; j < 2304; j += NGW) s5k::chain_job(ws, A2, j, lane);
        if (wave > 0) s5k::fill_weights(args, ws, vcu * (NWAVES - 1) + (wave - 1), G * (NWAVES - 1), lane, 1);
        GRID_BAR();
    }
    if (IN(4)) REPS(4) {
        pg8::Gemm g{A2, (const bf16*)(ws + WS_S5W2), 131072, 512, s5k::K2, s5k::K2}; pg8::S5Order S{G, bx, 1024, 2};
        pg8::EpiS5Y E{Z};
        pg8::gemm_phase<pg8::EpiS5Y, pg8::S5Order, PG8_ALIGN, PG8_SP2>(lds, g, S, E, gwave);
        GRID_BAR();
    }
    if (IN(5)) REPS(5) {
#if REP_PHASE == 5
        if (rep_ > 0) { if (bx == 0 && tid0 < rwk::NSEG) __hip_atomic_store(ctl + CW_QUEUE + tid0 * 64, 0u, __ATOMIC_RELAXED, __HIP_MEMORY_SCOPE_AGENT); GRID_BAR(); }
#endif
        for (int e = tid0; e < 3328; e += NWAVES * 64) ((LAS float*)(lds + rwk::O_MU))[e] = args.in[15][e];
        __syncthreads();
        for (int k = 0; k <= rwk::NSEG; ++k) {
            if (k >= 1) {
                const int seg = k - 1;
                int J, Jstride;
                if (bx < 32) { J = bx * 8 + wave; Jstride = 1 << 20; }
                else { J = 256 + (bx - 32) * 8 + wave; Jstride = 1792; }
                for (; J < 2304; J += Jstride) {
                    const int chain = J < 256 ? (J >> 2) : 64 + ((J - 256) >> 2);
                    rwk::rw_chain_job(args, ws, lds, seg, chain, wave, lane);
                }
                VM_WAIT(); __syncthreads();
            }
            if (k < rwk::NSEG) {
                const int seg = k;
                const int q = bx & 31;
                unsigned* qc = ctl + CW_QUEUE + (k * 32 + q) * 16;
                volatile LAS unsigned* qs = MISC + 16;
                if (wave == 0 && lane == 0) { qs[0] = __hip_atomic_fetch_add(qc, 1u, __ATOMIC_RELAXED, __HIP_MEMORY_SCOPE_AGENT); qs[1] = __hip_atomic_fetch_add(qc, 1u, __ATOMIC_RELAXED, __HIP_MEMORY_SCOPE_AGENT); }
                __syncthreads();
                int ucur = __builtin_amdgcn_readfirstlane((int)qs[0]), unxt = __builtin_amdgcn_readfirstlane((int)qs[1]);
                rwk::RawUnit R;
                rwk::rw_load_unit<true>(args, ws, seg, rwk::unit_from_queue(q, ucur < rwk::QUNITS ? ucur : 0), wave, lane, R);
                rwk::rw_pin_unit(R);
                while (ucur < rwk::QUNITS) {
                    unsigned pulled = 0u;
                    if (wave == 0 && lane == 0) { GAS unsigned* qcv = (GAS unsigned*)qc; asm volatile("" : "+v"(qcv)); pulled = __hip_atomic_fetch_add(qcv, 1u, __ATOMIC_RELAXED, __HIP_MEMORY_SCOPE_AGENT); }
                    int unn;
                    rwk::rw_precompute_unit(args, ws, lds, seg, q, ucur, unxt, wave, lane, R, qs + 2, pulled, unn);
                    ucur = unxt; unxt = unn;
                }
            }
            GRID_BAR();
        }
    }
    if (IN(6)) REPS(6) { p3_finalize(args, ws, gw, NGW, lane); GRID_BAR(); }
    if (IN(7)) REPS(7) {
        pg8::Gemm g{Z, (const bf16*)(ws + WS_GLUT), M, 1024, 1024, 1024}; pg8::StaticOrder S; S.init(M, 1024, G, bx);
        pg8::EpiMix<1> E{ZG, Z, nullptr, 1024};
        pg8::gemm_phase<pg8::EpiMix<1>, pg8::StaticOrder, PG8_ALIGN, PG8_SP2>(lds, g, S, E, gwave);
    }
    if (IN(8)) REPS(8) {
        pg8::Gemm g{HN, WT + (size_t)4352 * D, M, 2048, D, D}; pg8::StaticOrder S; S.init(M, 2048, G, bx);
        pg8::EpiSplit<2, 2> E{{ZG, ZG, nullptr, 1024}, {YN, YN, nullptr, 1024}, 4};
        pg8::gemm_phase<pg8::EpiSplit<2, 2>, pg8::StaticOrder, PG8_ALIGN, PG8_SP2>(lds, g, S, E, gwave);
        GRID_BAR();
    }
    if (IN(10)) REPS(10) {
        pg8::Gemm g{ZG, (const bf16*)(ws + WS_S5OT), M, 2048, 1024, 1024}; pg8::StaticOrder S; S.init(M, 2048, G, bx);
        pg8::EpiMix<0> E{P, nullptr, nullptr, 2048};
        pg8::gemm_phase<pg8::EpiMix<0>, pg8::StaticOrder, PG8_ALIGN, PG8_SP2>(lds, g, S, E, gwave);
    }
    if (IN(12)) REPS(12) {
        pg8::Gemm g{YN, (const bf16*)(ws + WS_RWOT), M, 2048, 1024, 1024}; pg8::StaticOrder S; S.init(M, 2048, G, bx);
        pg8::EpiMix<0> E{Q, nullptr, nullptr, 2048};
        pg8::gemm_phase<pg8::EpiMix<0>, pg8::StaticOrder, PG8_ALIGN, PG8_SP2>(lds, g, S, E, gwave);
    }
    if (IN(13)) REPS(13) {
        pg8::Gemm g{HN, WT + (size_t)6400 * D, M, 4096, D, D}; pg8::StaticOrder S; S.init(M, 4096, G, bx);
        pg8::EpiSplit<1, 3> E{{P, P, nullptr, 2048}, {P, Q, P, 2048}, 8};
        pg8::gemm_phase<pg8::EpiSplit<1, 3>, pg8::StaticOrder, PG8_ALIGN, PG8_SP2>(lds, g, S, E, gwave);
        GRID_BAR();
    }
    if (IN(14)) REPS(14) {
        pg8::Gemm g{P, (const bf16*)(ws + WS_WOT), M, 2048, D, D}; pg8::StaticOrder S; S.init(M, 2048, G, bx);
        pg8::EpiMix<0> E{HN, nullptr, nullptr, 2048};
        pg8::gemm_phase<pg8::EpiMix<0>, pg8::StaticOrder, PG8_ALIGN, PG8_SP2>(lds, g, S, E, gwave);
        GRID_BAR();
    }
#ifdef PROBE_BARS
    _Pragma("unroll 1") for (int pb_ = 0; pb_ < PROBE_BARS; ++pb_) GRID_BAR();
#endif
    if (IN(15)) REPS(15) { p12_final(args, HN, gw, NGW, lane); }
#ifdef PROBE_SPIN_END
    if (bx == 0 && tid0 == 0) { const unsigned long long t0_ = __builtin_amdgcn_s_memrealtime(); while (__builtin_amdgcn_s_memrealtime() - t0_ < (unsigned long long)PROBE_SPIN) __builtin_amdgcn_s_sleep(8); }
#endif
#ifdef PROBE_A
#ifdef PROBE_ENDBAR
    GRID_BAR();
#else
    STAMP();
#endif
    if (bx == 0 && tid0 == 0) {
        VM_WAIT();
        const float dt = (float)(MISC[32 + PROBE_B] - MISC[32 + PROBE_A]) * 0.01f;
#ifdef PROBE_DMG
        args.out[0] += 20.0f + rintf((dt - (float)PROBE_C) / (float)PROBE_D);
#else
        args.out[0] += 10.0f + rintf((dt - (float)PROBE_C) / (float)PROBE_D);
#endif
    }
#endif
#undef IN
#undef lane
}

extern "C" void kernel_launch(void* const* d_in, const int* in_sizes, int n_in, void* d_out, int out_size, void* d_ws, size_t ws_size, hipStream_t stream) {
    static int grid = 0;
    if (grid == 0) {
        if (n_in != 27 || out_size != 2 * 32768 * D || ws_size < WS_END) { fprintf(stderr, "kernel_launch: unexpected shapes (n_in %d out %d ws %zu)\n", n_in, out_size, ws_size); grid = -1; return; }
        int dev = 0, cus = 0, per_cu = 0;
        if (hipGetDevice(&dev) != hipSuccess || hipDeviceGetAttribute(&cus, hipDeviceAttributeMultiprocessorCount, dev) != hipSuccess) { grid = -1; return; }
        if (hipFuncSetAttribute((const void*)mk_fwd, hipFuncAttributeMaxDynamicSharedMemorySize, LDS_BYTES) != hipSuccess) { fprintf(stderr, "kernel_launch: hipFuncSetAttribute failed\n"); grid = -1; return; }
        if (hipOccupancyMaxActiveBlocksPerMultiprocessor(&per_cu, (const void*)mk_fwd, NWAVES * 64, LDS_BYTES) != hipSuccess || per_cu < 1)
            fprintf(stderr, "kernel_launch: note: occupancy query reports %d workgroups per CU\n", per_cu);
        (void)hipGetLastError();
        if (cus < 256) fprintf(stderr, "kernel_launch: note: %d CUs; the phase program is written for 256 resident workgroups\n", cus);
        grid = 256;
    }
    if (grid < 0) return;
    if (hipMemsetAsync((char*)d_ws + WS_CTL, 0, CTL_ZERO_BYTES, stream) != hipSuccess) return;
    Args a{};
    for (int i = 0; i < 27; ++i) a.in[i] = (const float*)d_in[i];
    a.out = (float*)d_out; a.ws = (unsigned char*)d_ws; a.pad = 0;
    { const int li = 0; a.ph_lo = 0; a.ph_hi = N_PHASES; a.li = 0;
        hipLaunchKernelGGL(mk_fwd, dim3(grid), dim3(NWAVES * 64), LDS_BYTES, stream, a);
        const hipError_t le = hipPeekAtLastError();
        if (le != hipSuccess) { fprintf(stderr, "kernel_launch: launch %d failed: %s\n", li, hipGetErrorName(le)); }
    }
}
```

```cpp
#include <hip/hip_runtime.h>
#include <cstdio>
#include <cstdint>
#define MK_N_LAUNCHES 1

__device__ __forceinline__ int mk_lane() { int l; asm volatile("v_mbcnt_lo_u32_b32 %0, -1, 0\n\tv_mbcnt_hi_u32_b32 %0, -1, %0" : "=v"(l)); return l; }
namespace pg8 {
#define PG8_LAS __attribute__((address_space(3)))
typedef unsigned short bf16_t;
typedef short bf16x8 __attribute__((ext_vector_type(8)));
typedef float f32x4 __attribute__((ext_vector_type(4)));
typedef unsigned u32x4 __attribute__((ext_vector_type(4)));
constexpr int BM = 256, BK = 64, HALF = 128, HTB = HALF * BK * 2  , STAGE_BYTES = 8 * HTB, NXCD = 8, WGM = 8;

__host__ __device__ __forceinline__ int lds_byte(int r, int c) { const int st = (r >> 4) * 2 + (c >> 5), rr = r & 15, cc = c & 31, ob = rr * 64 + cc * 2; return st * 1024 + (ob ^ (((ob >> 9) & 1) << 5)); }
__host__ __device__ __forceinline__ void stage_rc(int b, int& R, int& C) { const int st = b / 1024, sb = b % 1024, swz = sb ^ (((sb >> 9) & 1) << 5); R = (st >> 1) * 16 + swz / 64; C = (st & 1) * 32 + (swz % 64) / 2; }
__host__ __device__ __forceinline__ int perm32(int rho) { const int n = rho >> 4, i = rho & 15; return 8 * (i >> 2) + 4 * n + (i & 3); }

struct Unit { int pm, pn; };
struct Gemm { const bf16_t* A; const bf16_t* Bt; int M, N, K, lda; };

struct StaticOrder {
    int nM, nN, nwg, G, c;
    __host__ __device__ void init(int M, int N, int G_, int c_) { nM = M / BM; nN = N / BM; nwg = nM * nN; G = G_; c = c_; }
    __host__ __device__ bool next(int i, Unit& u) const {
        const long L = (long)i * G + c; if (L >= nwg) return false;
        int wgid = (int)L; { const int q = nwg / NXCD, r = nwg % NXCD, xcd = wgid % NXCD, off = wgid / NXCD; wgid = (xcd < r ? xcd * (q + 1) : r * (q + 1) + (xcd - r) * q) + off; }
        const int nig = WGM * nN, gid = wgid / nig, fm = gid * WGM, gsz = (nM - fm) < WGM ? (nM - fm) : WGM;
        u.pm = fm + ((wgid % nig) % gsz); u.pn = (wgid % nig) / gsz; return true;
    }
    __device__ __forceinline__ void a_ready(const Unit&) const {}
    __device__ __forceinline__ void done(const Unit&) const {}
};

__device__ __forceinline__ unsigned cvt_pk_bf16(float lo, float hi) { unsigned r; asm volatile("v_cvt_pk_bf16_f32 %0, %1, %2" : "=v"(r) : "v"(lo), "v"(hi)); return r; }

__device__ __forceinline__ float bf_lo(unsigned u) { return __uint_as_float(u << 16); }
__device__ __forceinline__ float bf_hi(unsigned u) { return __uint_as_float(u & 0xffff0000u); }
__device__ __forceinline__ float sigmoid_f(float v) { return __builtin_amdgcn_rcpf(1.0f + __expf(-v)); }

struct EpiG1 {
    static constexpr bool PERM = true, AFTER_DRAIN = false;
    bf16_t* a2; bf16_t* rwin;
    __device__ __forceinline__ void operator()(const f32x4 (&acc)[2][2][4][2], const Unit& u, int wr, int wc, int fr, int fq) const {
        const int row0 = u.pm * BM + wr * 64 + fr; const int colt = u.pn * BM; const bool s5 = colt < 1024;
        const int col0 = colt + wc * 32 + 8 * fq;
#ifndef EPI_REP
#define EPI_REP 1
#endif
        _Pragma("unroll 1") for (int er_ = 0; er_ < EPI_REP; ++er_)
#pragma unroll
        for (int ai = 0; ai < 2; ++ai)
#pragma unroll
            for (int m = 0; m < 4; ++m) { const int row = row0 + ai * HALF + m * 16;
#pragma unroll
                for (int bj = 0; bj < 2; ++bj) { const f32x4 v0 = acc[ai][bj][m][0], v1 = acc[ai][bj][m][1]; const int col = col0 + bj * HALF;
                    u32x4 w; w.x = cvt_pk_bf16(v0[0], v0[1]); w.y = cvt_pk_bf16(v0[2], v0[3]); w.z = cvt_pk_bf16(v1[0], v1[1]); w.w = cvt_pk_bf16(v1[2], v1[3]);
                    bf16_t* dst = s5 ? a2 + ((size_t)((col >> 4) * 2048 + (row >> 5)) * 768 + (row & 31) * 16 + (col & 15))
                                     : rwin + (size_t)row * 3328 + (col - 1024);
                    *(u32x4*)dst = w; } }
    }
};
template <int MODE> struct EpiMix {
    static constexpr bool PERM = true, AFTER_DRAIN = false;
    bf16_t* O; const bf16_t* S; const bf16_t* Add; int ld;
    __device__ __forceinline__ void operator()(const f32x4 (&acc)[2][2][4][2], const Unit& u, int wr, int wc, int fr, int fq) const {
        const int row0 = u.pm * BM + wr * 64 + fr, col0 = u.pn * BM + wc * 32 + 8 * fq;
#pragma unroll
        for (int ai = 0; ai < 2; ++ai) {
            u32x4 sv4[4][2], av4[4][2];
            if (MODE >= 1) {
#pragma unroll
                for (int m = 0; m < 4; ++m)
#pragma unroll
                    for (int bj = 0; bj < 2; ++bj) { const size_t off = (size_t)(row0 + ai * HALF + m * 16) * ld + col0 + bj * HALF;
                        sv4[m][bj] = *(const u32x4*)(S + off); if (MODE == 3) av4[m][bj] = *(const u32x4*)(Add + off); }
            }
#pragma unroll
            for (int m = 0; m < 4; ++m) {
#pragma unroll
                for (int bj = 0; bj < 2; ++bj) {
                    const size_t off = (size_t)(row0 + ai * HALF + m * 16) * ld + col0 + bj * HALF;
                    float v[8];
#pragma unroll
                    for (int j = 0; j < 4; ++j) { v[j] = acc[ai][bj][m][0][j]; v[4 + j] = acc[ai][bj][m][1][j]; }
                    if (MODE >= 1) {
                        const u32x4 s = sv4[m][bj];
                        const float sv[8] = {bf_lo(s.x), bf_hi(s.x), bf_lo(s.y), bf_hi(s.y), bf_lo(s.z), bf_hi(s.z), bf_lo(s.w), bf_hi(s.w)};
#pragma unroll
                        for (int j = 0; j < 8; ++j) { const float sg = sigmoid_f(v[j]); v[j] = (MODE == 2) ? sv[j] * v[j] * sg : sv[j] * sg; }
                    }
                    if (MODE == 3) {
                        const u32x4 a = av4[m][bj];
                        const float av[8] = {bf_lo(a.x), bf_hi(a.x), bf_lo(a.y), bf_hi(a.y), bf_lo(a.z), bf_hi(a.z), bf_lo(a.w), bf_hi(a.w)};
#pragma unroll
                        for (int j = 0; j < 8; ++j) v[j] += av[j];
                    }
                    u32x4 w; w.x = cvt_pk_bf16(v[0], v[1]); w.y = cvt_pk_bf16(v[2], v[3]); w.z = cvt_pk_bf16(v[4], v[5]); w.w = cvt_pk_bf16(v[6], v[7]);
                    *(u32x4*)(O + off) = w;
                }
            }
        }
    }
};
template <int MLO, int MHI> struct EpiSplit {
    static constexpr bool PERM = true, AFTER_DRAIN = false;
    EpiMix<MLO> lo; EpiMix<MHI> hi; int split;
    __device__ __forceinline__ void operator()(const f32x4 (&acc)[2][2][4][2], const Unit& u, int wr, int wc, int fr, int fq) const {
        if (u.pn < split) lo(acc, u, wr, wc, fr, fq);
        else { const Unit v{u.pm, u.pn - split}; hi(acc, v, wr, wc, fr, fq); }
    }
};
struct EpiF32 {
    static constexpr bool PERM = false, AFTER_DRAIN = false;
    float* C; int ldc;
    __device__ __forceinline__ void operator()(const f32x4 (&acc)[2][2][4][2], const Unit& u, int wr, int wc, int fr, int fq) const {
        const int row0 = u.pm * BM + wr * 64 + fr, col0 = u.pn * BM + wc * 32 + 4 * fq;
#pragma unroll
        for (int ai = 0; ai < 2; ++ai)
#pragma unroll
            for (int m = 0; m < 4; ++m) { float* rowp = C + (size_t)(row0 + ai * HALF + m * 16) * ldc + col0;
#pragma unroll
                for (int bj = 0; bj < 2; ++bj)
#pragma unroll
                    for (int n = 0; n < 2; ++n) *(f32x4*)(rowp + bj * HALF + n * 16) = acc[ai][bj][m][n]; }
    }
};
template <class Epi, class Sched, bool ALIGN_EPI = false, bool SP2 = false>
__device__ __forceinline__ void gemm_phase(PG8_LAS unsigned char* lds, const Gemm g, const Sched& S, const Epi& E, const int mk_wave) {
    const int lane = mk_lane(), wid = mk_wave, tid = wid * 64 + lane, wr = wid >> 2, wc = wid & 3, fr = lane & 15, fq = lane >> 4;
    const int K = g.K, nt = K / BK;
    unsigned voffA[2], voffB[2];
#pragma unroll
    for (int i = 0; i < 2; ++i) { int R, C; stage_rc(tid * 16 + i * 8192, R, C); const int Rb = Epi::PERM ? ((R & ~31) + perm32(R & 31)) : R;
        voffA[i] = (unsigned)(R * g.lda + C) * 2u; voffB[i] = (unsigned)(Rb * K + C) * 2u; }
    const size_t kstep = (size_t)(BK * 2);
    const size_t hstep = (size_t)HALF * K * 2;
    const size_t tstep = 2 * hstep;
    const size_t hstepA = (size_t)HALF * g.lda * 2, tstepA = 2 * hstepA;
    const unsigned ldsw = (unsigned)wid * 1024u;
    const int aoff = lds_byte(wr * 64 + fr, fq * 8), boff = lds_byte(wc * 32 + fr, fq * 8);
#define PG8_SA(b, h) (((b) * 2 + (h)) * HTB)
#define PG8_SB(b, h) ((4 + (b) * 2 + (h)) * HTB)
#define PG8_STAGE(bufoff, gbase, voff) do { _Pragma("unroll") for (int _i = 0; _i < 2; ++_i) \
        __builtin_amdgcn_global_load_lds((const unsigned*)((const char*)(gbase) + (voff)[_i]), (PG8_LAS unsigned*)(lds + (bufoff) + ldsw + _i * 8192), 16, 0, 0); } while (0)
#define PG8_LDA(dst, b, h) do { _Pragma("unroll") for (int m = 0; m < 4; ++m) _Pragma("unroll") for (int k = 0; k < 2; ++k) dst[m][k] = *(const PG8_LAS bf16x8*)(lds + PG8_SA(b, h) + aoff + m * 2048 + k * 1024); } while (0)
#define PG8_LDB(dst, b, h) do { _Pragma("unroll") for (int n = 0; n < 2; ++n) _Pragma("unroll") for (int k = 0; k < 2; ++k) dst[n][k] = *(const PG8_LAS bf16x8*)(lds + PG8_SB(b, h) + boff + n * 2048 + k * 1024); } while (0)
#define PG8_MMA(ai, bj, At, Bt) do { __builtin_amdgcn_s_setprio(1); _Pragma("unroll") for (int m = 0; m < 4; ++m) _Pragma("unroll") for (int n = 0; n < 2; ++n) _Pragma("unroll") for (int k = 0; k < 2; ++k) \
        acc[ai][bj][m][n] = __builtin_amdgcn_mfma_f32_16x16x32_bf16(Bt[n][k], At[m][k], acc[ai][bj][m][n], 0, 0, 0); __builtin_amdgcn_s_setprio(0); } while (0)
#define PG8_WAIT_V(n) asm volatile("s_waitcnt vmcnt(" #n ")" ::: "memory")
#define PG8_WAIT_L(n) asm volatile("s_waitcnt lgkmcnt(" #n ")" ::: "memory")
#define PG8_BAR __builtin_amdgcn_s_barrier()
#define PG8_SCHED __builtin_amdgcn_sched_barrier(0)
    Unit cur, nxt; int ui = 0;
    if (!S.next(0, cur)) return;
    f32x4 acc[2][2][4][2];
#pragma unroll
    for (int a = 0; a < 2; ++a)
#pragma unroll
        for (int b = 0; b < 2; ++b)
#pragma unroll
            for (int m = 0; m < 4; ++m)
#pragma unroll
                for (int n = 0; n < 2; ++n) acc[a][b][m][n] = (f32x4){0.f, 0.f, 0.f, 0.f};
    bf16x8 At[4][2], B0[2][2], B1[2][2];
    const char* cA = (const char*)g.A + (size_t)cur.pm * tstepA; const char* cB = (const char*)g.Bt + (size_t)cur.pn * tstep;
    S.a_ready(cur);
    if constexpr (SP2) {
        PG8_STAGE(PG8_SB(0, 0), cB, voffB); PG8_STAGE(PG8_SB(0, 1), cB + hstep, voffB); PG8_STAGE(PG8_SA(0, 0), cA, voffA); PG8_STAGE(PG8_SA(0, 1), cA + hstepA, voffA);
        if (wr == 1) PG8_BAR;
        PG8_WAIT_V(2); PG8_BAR;
        PG8_STAGE(PG8_SB(1, 0), cB + kstep, voffB); PG8_STAGE(PG8_SA(1, 0), cA + kstep, voffA); PG8_STAGE(PG8_SB(1, 1), cB + hstep + kstep, voffB);
        PG8_WAIT_V(6); PG8_BAR;
    } else {
        PG8_STAGE(PG8_SB(0, 0), cB, voffB); PG8_STAGE(PG8_SA(0, 0), cA, voffA); PG8_STAGE(PG8_SB(0, 1), cB + hstep, voffB); PG8_STAGE(PG8_SA(0, 1), cA + hstepA, voffA);
        if (wr == 1) PG8_BAR;
        PG8_WAIT_V(4); PG8_BAR;
        PG8_STAGE(PG8_SB(1, 0), cB + kstep, voffB); PG8_STAGE(PG8_SA(1, 0), cA + kstep, voffA); PG8_STAGE(PG8_SB(1, 1), cB + hstep + kstep, voffB);
        PG8_WAIT_V(6); PG8_BAR;
    }
    for (;;) {
        const bool has_next = S.next(ui + 1, nxt);
        const char* nA = has_next ? (const char*)g.A + (size_t)nxt.pm * tstepA : cA; const char* nB = has_next ? (const char*)g.Bt + (size_t)nxt.pn * tstep : cB;
        for (int t = 0; t < nt; t += 2) {
            const bool last = (t == nt - 2);
            const char* a1 = cA + (size_t)(t + 1) * kstep;
            const char* a2 = last ? nA : cA + (size_t)(t + 2) * kstep; const char* b2 = last ? nB : cB + (size_t)(t + 2) * kstep;
            const char* a3 = a2 + kstep; const char* b3 = b2 + kstep;
            if (last && has_next) S.a_ready(nxt);
            if constexpr (SP2) {
            PG8_LDB(B0, 0, 0); PG8_LDB(B1, 0, 1); PG8_SCHED; PG8_LDA(At, 0, 0); PG8_STAGE(PG8_SA(1, 1), a1 + hstepA, voffA);
            PG8_WAIT_V(8); PG8_WAIT_L(0); PG8_BAR; PG8_MMA(0, 0, At, B0); PG8_MMA(0, 1, At, B1); PG8_BAR; PG8_SCHED;
            PG8_LDA(At, 0, 1); PG8_STAGE(PG8_SB(0, 0), b2, voffB); PG8_STAGE(PG8_SB(0, 1), b2 + hstep, voffB); PG8_STAGE(PG8_SA(0, 0), a2, voffA);
            PG8_WAIT_V(8); PG8_WAIT_L(0); PG8_BAR; PG8_MMA(1, 0, At, B0); PG8_MMA(1, 1, At, B1); PG8_BAR; PG8_SCHED;
            PG8_LDB(B0, 1, 0); PG8_LDB(B1, 1, 1); PG8_SCHED; PG8_LDA(At, 1, 0); PG8_STAGE(PG8_SA(0, 1), a2 + hstepA, voffA);
            PG8_WAIT_V(8); PG8_WAIT_L(0); PG8_BAR; PG8_MMA(0, 0, At, B0); PG8_MMA(0, 1, At, B1); PG8_BAR; PG8_SCHED;
            PG8_LDA(At, 1, 1); PG8_STAGE(PG8_SB(1, 0), b3, voffB); PG8_STAGE(PG8_SB(1, 1), b3 + hstep, voffB); PG8_STAGE(PG8_SA(1, 0), a3, voffA);
            PG8_WAIT_V(8); PG8_WAIT_L(0); PG8_BAR; PG8_MMA(1, 0, At, B0); PG8_MMA(1, 1, At, B1); PG8_BAR; PG8_SCHED;
            } else {
            PG8_LDB(B0, 0, 0); PG8_SCHED; PG8_LDA(At, 0, 0); PG8_STAGE(PG8_SA(1, 1), a1 + hstepA, voffA);
            PG8_WAIT_L(8); PG8_BAR; PG8_WAIT_L(0); PG8_MMA(0, 0, At, B0); PG8_BAR; PG8_SCHED;
            PG8_LDB(B1, 0, 1); PG8_STAGE(PG8_SB(0, 0), b2, voffB);
            PG8_BAR; PG8_WAIT_L(0); PG8_MMA(0, 1, At, B1); PG8_BAR;
            PG8_LDA(At, 0, 1); PG8_STAGE(PG8_SA(0, 0), a2, voffA);
            PG8_BAR; PG8_WAIT_L(0); PG8_MMA(1, 0, At, B0); PG8_BAR; PG8_SCHED;
            PG8_STAGE(PG8_SB(0, 1), b2 + hstep, voffB);
            PG8_WAIT_V(6); PG8_BAR; PG8_MMA(1, 1, At, B1); PG8_BAR;
            PG8_LDB(B0, 1, 0); PG8_SCHED; PG8_LDA(At, 1, 0); PG8_STAGE(PG8_SA(0, 1), a2 + hstepA, voffA);
            PG8_WAIT_L(8); PG8_BAR; PG8_WAIT_L(0); PG8_MMA(0, 0, At, B0); PG8_BAR; PG8_SCHED;
            PG8_LDB(B1, 1, 1); PG8_STAGE(PG8_SB(1, 0), b3, voffB);
            PG8_BAR; PG8_WAIT_L(0); PG8_MMA(0, 1, At, B1); PG8_BAR;
            PG8_LDA(At, 1, 1); PG8_STAGE(PG8_SA(1, 0), a3, voffA);
            PG8_BAR; PG8_WAIT_L(0); PG8_MMA(1, 0, At, B0); PG8_BAR; PG8_SCHED;
            PG8_STAGE(PG8_SB(1, 1), b3 + hstep, voffB);
            PG8_WAIT_V(6); PG8_BAR; PG8_MMA(1, 1, At, B1); PG8_BAR;
            }
        }
        if constexpr (ALIGN_EPI) { if (wr == 0) PG8_BAR; }
        if constexpr (!Epi::AFTER_DRAIN) { E(acc, cur, wr, wc, fr, fq); S.done(cur); }
        if (!has_next) break;
#pragma unroll
        for (int a = 0; a < 2; ++a)
#pragma unroll
            for (int b = 0; b < 2; ++b)
#pragma unroll
                for (int m = 0; m < 4; ++m)
#pragma unroll
                    for (int n = 0; n < 2; ++n) acc[a][b][m][n] = (f32x4){0.f, 0.f, 0.f, 0.f};
        cur = nxt; cA = nA; cB = nB; ++ui;
        if constexpr (ALIGN_EPI) { if (wr == 1) PG8_BAR; }
    }
    PG8_WAIT_V(0);
    if constexpr (!ALIGN_EPI) { if (wr == 0) PG8_BAR; }
    PG8_BAR;
    if constexpr (Epi::AFTER_DRAIN) { E.fused(acc, cur, wr, wc, fr, fq, lds, wid, lane); S.done(cur); }
#undef PG8_SA
#undef PG8_SB
#undef PG8_STAGE
#undef PG8_LDA
#undef PG8_LDB
#undef PG8_MMA
#undef PG8_WAIT_V
#undef PG8_WAIT_L
#undef PG8_BAR
#undef PG8_SCHED
}
}

#ifndef PG8_SP2
#define PG8_SP2 true
#endif
#ifndef PG8_ALIGN
#define PG8_ALIGN true
#endif

constexpr int NWAVES = 8;
constexpr int N_PHASES = 16;
#ifndef MK_N_LAUNCHES
#define MK_N_LAUNCHES 1
#endif
constexpr int N_LAUNCHES = MK_N_LAUNCHES;

constexpr int D = 2048, M = 65536, NIN = 10496;
constexpr int LP = 16384, LS = 2048;
constexpr int DS5 = 1024, DRW = 1024, DRWIN = 3328;
constexpr float RMS_EPS = 1e-6f, GN_EPS = 64e-5f, L2_EPS = 1e-12f;

constexpr size_t MiB = 1u << 20;
constexpr size_t WS_CTL = 0, CTL_ZERO_BYTES = 128 * 1024;
constexpr size_t WS_ZROW = 96 * 1024;
constexpr size_t WS_WT = 1 * MiB;
constexpr size_t WS_TWB = 1 * MiB;
constexpr size_t WS_GLUT = 42 * MiB;
constexpr size_t WS_S5OT = 44 * MiB;
constexpr size_t WS_RWOT = 48 * MiB;
constexpr size_t WS_WOT = 52 * MiB;
constexpr size_t WS_HN = 60 * MiB;
constexpr size_t WS_RWIN = 316 * MiB;
constexpr size_t WS_Z = 732 * MiB;
constexpr size_t WS_LUT = 860 * MiB;
constexpr size_t WS_STATE = 862 * MiB;
constexpr size_t WS_S5TAB = 872 * MiB;
constexpr size_t WS_S5XL = 882 * MiB;
constexpr size_t WS_S5W2 = 946 * MiB;
constexpr size_t WS_S5E = 994 * MiB;
constexpr size_t WS_ZG = 882 * MiB;
constexpr size_t WS_END = 1010 * MiB;
constexpr size_t DO_YF = 0, DO_YB = 128 * MiB, DO_A2 = 256 * MiB, DO_INT = 256 * MiB, DO_Q = 256 * MiB;
constexpr int CW_BAR = 4096;
constexpr int CW_QUEUE = 16384;

constexpr int LDS_BYTES = 147456;
constexpr int MISC_OFF = LDS_BYTES - 512;
constexpr int WAVE_SCR = 18176;
static_assert(NWAVES * WAVE_SCR <= MISC_OFF && pg8::STAGE_BYTES <= MISC_OFF, "LDS map");

#define GAS __attribute__((address_space(1)))
#define LAS __attribute__((address_space(3)))
typedef unsigned short bf16;
typedef unsigned v4u __attribute__((ext_vector_type(4)));
typedef unsigned v2u __attribute__((ext_vector_type(2)));
typedef float f32x4 __attribute__((ext_vector_type(4)));
#define LDS_WAIT() asm volatile("s_waitcnt lgkmcnt(0)" ::: "memory")
#define VM_WAIT() asm volatile("s_waitcnt vmcnt(0)" ::: "memory")
typedef __bf16 mk_bf2 __attribute__((ext_vector_type(2)));
typedef float mk_f2 __attribute__((ext_vector_type(2)));
__device__ __forceinline__ unsigned pk2(float lo, float hi) { const mk_f2 v = {lo, hi}; return __builtin_bit_cast(unsigned, __builtin_convertvector(v, mk_bf2)); }
__device__ __forceinline__ unsigned f2bf(float f) { return pk2(f, f) & 0xffffu; }
__device__ __forceinline__ float bf2f(bf16 b) { return __uint_as_float(((unsigned)b) << 16); }
__device__ __forceinline__ float blo(unsigned u) { return __uint_as_float(u << 16); }
__device__ __forceinline__ float bhi(unsigned u) { return __uint_as_float(u & 0xffff0000u); }
__device__ __forceinline__ float wave_sum(float v) {
#pragma unroll
    for (int o = 1; o < 64; o <<= 1) v += __shfl_xor(v, o);
    return v;
}
__device__ __forceinline__ float sigm(float v) { return __builtin_amdgcn_rcpf(1.0f + __expf(-v)); }
__device__ __forceinline__ float gelu_tanh(float x) { const float u = 0.7978845608028654f * (x + 0.044715f * x * x * x); return 0.5f * x * (1.0f + tanhf(u)); }

#define XB_TMO      128
#define XB_XCNT(j)  (256  + 64 * (j))
#define XB_XSUB(j)  (1280 + 64 * (j))
#define XB_XGEN(j)  (2304 + 64 * (j))
#define XB_TOP      3328
#define XB_TOPGEN   3392
#define XCD_BAR_WORDS 3456
#define XB_SPIN_CAP (1u << 18)

__device__ __forceinline__ unsigned xb_ld(unsigned* p)              { return __hip_atomic_load(p, __ATOMIC_RELAXED, __HIP_MEMORY_SCOPE_AGENT); }
__device__ __forceinline__ unsigned xb_add(unsigned* p, unsigned v) { return __hip_atomic_fetch_add(p, v, __ATOMIC_RELAXED, __HIP_MEMORY_SCOPE_AGENT); }
__device__ __forceinline__ unsigned xb_xcc_id() { return (unsigned)__builtin_amdgcn_s_getreg((3 << 11) | 20) & 0xFu; }
#define XB_SPIN(cond, bar) do { unsigned _sp = 0; while (cond) { __builtin_amdgcn_s_sleep(1); \
    if ((++_sp & 255u) == 0u) { if (xb_ld(&(bar)[XB_TMO])) break; if (_sp > XB_SPIN_CAP) { atomicAdd(&(bar)[XB_TMO], 1u); break; } } } } while (0)

struct XcdBarrier {
    unsigned* bar; unsigned x;
    volatile LAS unsigned* st;
};

__device__ __forceinline__ XcdBarrier xcd_barrier_post(unsigned* bar, volatile LAS unsigned* st, const int mk_wave) {
    XcdBarrier b; b.bar = bar; b.x = xb_xcc_id(); b.st = st;
    if (mk_wave == 0 && mk_lane() == 0) (void)xb_add(&bar[XB_XCNT(b.x)], 1u);
    return b;
}
__device__ __forceinline__ void xcd_barrier_complete(unsigned* bar, unsigned x, unsigned& nloc, unsigned& nx) {
    const unsigned G = gridDim.x * gridDim.y * gridDim.z;
    unsigned sum, cnt, mine, sp = 0u;
    for (;;) {
        sum = 0u; cnt = 0u; mine = 0u;
#pragma unroll
        for (unsigned j = 0; j < 16; ++j) { const unsigned c = xb_ld(&bar[XB_XCNT(j)]); sum += c; cnt += (c > 0u) ? 1u : 0u; mine = (j == x) ? c : mine; }
        if (sum == G) break;
        __builtin_amdgcn_s_sleep(1);
        if ((++sp & 255u) == 0u) { if (xb_ld(&bar[XB_TMO])) break; if (sp > XB_SPIN_CAP) { atomicAdd(&bar[XB_TMO], 1u); break; } }
    }
    nloc = mine > 0u ? mine : 1u; nx = cnt > 0u ? cnt : 1u;
}

__device__ __forceinline__ void xcd_barrier(const XcdBarrier& b, const int mk_wave) {
    asm volatile("s_waitcnt vmcnt(0)" ::: "memory");
    __syncthreads();
    if (mk_wave == 0 && mk_lane() == 0) {
        unsigned* bar = b.bar;
        __builtin_amdgcn_s_waitcnt(0);
        unsigned nloc = b.st[0], nx = b.st[1];
        if (nloc == 0u) { xcd_barrier_complete(bar, b.x, nloc, nx); b.st[0] = nloc; b.st[1] = nx; }
        const unsigned old = xb_add(&bar[XB_XSUB(b.x)], 1u);
        const unsigned gen = old / nloc;
        if (old + 1u == (gen + 1u) * nloc) {
            __builtin_amdgcn_fence(__ATOMIC_RELEASE, "agent");
            asm volatile("s_waitcnt vmcnt(0)" ::: "memory");
            const unsigned og = xb_add(&bar[XB_TOP], 1u);
            const unsigned tg = og / nx;
            if (og + 1u == (tg + 1u) * nx) xb_add(&bar[XB_TOPGEN], 1u);
            else XB_SPIN(xb_ld(&bar[XB_TOPGEN]) == tg, bar);
            __builtin_amdgcn_fence(__ATOMIC_ACQUIRE, "agent");
            xb_add(&bar[XB_XGEN(b.x)], 1u);
            asm volatile("s_waitcnt vmcnt(0)" ::: "memory");
        } else {
            XB_SPIN(xb_ld(&bar[XB_XGEN(b.x)]) == gen, bar);
            __builtin_amdgcn_fence(__ATOMIC_ACQUIRE, "agent");
            asm volatile("s_waitcnt vmcnt(0)" ::: "memory");
        }
    }
    __syncthreads();
}


struct Args { const float* in[27]; float* out; unsigned char* ws; int ph_lo, ph_hi, li, pad; };

namespace rwk {
typedef short s16x4 __attribute__((ext_vector_type(4)));
typedef short s16x8 __attribute__((ext_vector_type(8)));
constexpr int NSEG = 8;
constexpr int UNITS_PER_SEG = 4096;
constexpr int LDW = 72;
constexpr int MATB = 64 * LDW * 2;
constexpr int O_AB = 0, O_BT = 1 * MATB, O_KT = 2 * MATB, O_RB = 3 * MATB, O_BHT = 4 * MATB, O_KHT = 5 * MATB, O_VT = 6 * MATB;
constexpr int O_MAB = 7 * MATB, O_MAK = 8 * MATB, O_NRB = 9 * MATB, O_NRK = 10 * MATB, O_XT = 11 * MATB  , O_NP = 13 * MATB, O_GT = 14 * MATB;
constexpr int O_TW = O_MAB, O_XA = O_MAK;
constexpr int LDC = 68;
constexpr int O_CL = O_NRB, O_AS = O_NRB + 64 * LDC * 4;
constexpr int NPS = 24;
static_assert(O_AS + 64 * LDC * 4 <= O_NP && O_GT + 256 <= 146944, "rwkv LDS map");
constexpr size_t UNIT_ELEMS = 16384;

__device__ __forceinline__ f32x4 mfma32(s16x8 a, s16x8 b, f32x4 c) { return __builtin_amdgcn_mfma_f32_16x16x32_bf16(a, b, c, 0, 0, 0); }
__device__ __forceinline__ f32x4 mfma16(s16x4 a, s16x4 b, f32x4 c) { return __builtin_amdgcn_mfma_f32_16x16x16bf16_1k(a, b, c, 0, 0, 0); }
__device__ __forceinline__ s16x4 pack4(f32x4 v) { v2u p; p.x = pk2(v[0], v[1]); p.y = pk2(v[2], v[3]); return __builtin_bit_cast(s16x4, p); }
__device__ __forceinline__ f32x4 unpack4(v2u p) { return (f32x4){blo(p.x), bhi(p.x), blo(p.y), bhi(p.y)}; }
__device__ __forceinline__ void up8(v4u a, float (&o)[8]) { o[0] = blo(a.x); o[1] = bhi(a.x); o[2] = blo(a.y); o[3] = bhi(a.y); o[4] = blo(a.z); o[5] = bhi(a.z); o[6] = blo(a.w); o[7] = bhi(a.w); }
__device__ __forceinline__ v4u pk8(const float (&v)[8]) { v4u a; a.x = pk2(v[0], v[1]); a.y = pk2(v[2], v[3]); a.z = pk2(v[4], v[5]); a.w = pk2(v[6], v[7]); return a; }

constexpr int O_MU = 131072;
static_assert(O_MU + 3328 * 4 <= 146944, "rwkv LDS map (mu)");
__device__ __forceinline__ int swz_chunk(int row, int tc) { return (row * LDW + ((tc ^ ((row >> 3) & 7)) << 3)) * 2; }
__device__ __forceinline__ float tanh_fast(float x) { return 1.0f - 2.0f * __builtin_amdgcn_rcpf(1.0f + __expf(2.0f * x)); }
__device__ __forceinline__ mk_f2 upf2(unsigned w) { return (mk_f2){blo(w), bhi(w)}; }
__device__ __forceinline__ v4u pk8v(const mk_f2 (&v)[4]) { v4u a; a.x = pk2(v[0].x, v[0].y); a.y = pk2(v[1].x, v[1].y); a.z = pk2(v[2].x, v[2].y); a.w = pk2(v[3].x, v[3].y); return a; }
struct RawUnit { v4u cur[5], prv[5], nxt[5]; f32x4 kk0, kk1, ka0, ka1, rk0, rk1; s16x8 lb0, lb1; float bias; };
struct UnitId { int h, d, base, L, gchunk, chain; };
__device__ __forceinline__ UnitId decode_unit(int seg, int u) {
    UnitId o; int c, jc, nch;
    if (u < 2048) { c = u >> 5; jc = u & 31; nch = 32; } else { c = 64 + ((u - 2048) >> 2); jc = (u - 2048) & 3; nch = 4; }
    int s, rem; if (c < 64) { s = c >> 5; rem = c & 31; } else { s = 2 + ((c - 64) >> 5); rem = (c - 64) & 31; }
    o.h = rem >> 1; o.d = rem & 1; o.base = s < 2 ? s * LP : 32768 + (s - 2) * LS; o.L = s < 2 ? LP : LS; o.gchunk = seg * nch + jc; o.chain = c;
    return o;
}
__device__ __forceinline__ int unit_of(int chain, int jc) { return chain < 64 ? chain * 32 + jc : 2048 + (chain - 64) * 4 + jc; }
constexpr int QUNITS = 128;
__device__ __forceinline__ int unit_from_queue(int q, int i) { return i < 64 ? unit_of((i >> 5) * 32 + q, i & 31) : unit_of(64 + ((i - 64) >> 2) * 32 + q, (i - 64) & 3); }

template <bool WITH_WEIGHTS> __device__ __forceinline__ void rw_load_unit(const Args& a, unsigned char* ws, int seg, int u, int wave, int lane, RawUnit& R) {
    const UnitId id = decode_unit(seg, u);
    const int h = id.h, d = id.d, tid = wave * 64 + lane, t = tid >> 3, cg = tid & 7;
    const int pos = d ? id.L - 1 - 64 * id.gchunk - t : 64 * id.gchunk + t;
    const unsigned rowA = (unsigned)WS_RWIN + (unsigned)(id.base + pos) * (unsigned)(DRWIN * 2) + (unsigned)(h * 128 + 2048) + 16u * (unsigned)cg;
    const unsigned dB = (unsigned)(4096 + 128 * d - 128 * h);
    const unsigned zA = (unsigned)WS_ZROW + 2048u + 16u * (unsigned)cg;
    const unsigned prvA = pos > 0 ? rowA - (unsigned)(DRWIN * 2) : zA, nxtA = pos < id.L - 1 ? rowA + (unsigned)(DRWIN * 2) : zA;
    const unsigned rowB = rowA + dB, prvB = prvA + dB, nxtB = nxtA + dB;
    const unsigned twoff = (unsigned)WS_TWB + (unsigned)(id.base + pos) * 256u + (unsigned)(d * 128) + 16u * (unsigned)cg;
#define RW_LD(off, imm) (*(const v4u*)(ws + (size_t)(off) + (imm)))
#if defined(PROBE_X) && (PROBE_X & 2)
    R.cur[0] = RW_LD(rowA, -2048); R.cur[1] = RW_LD(rowA, 0); R.cur[2] = RW_LD(rowA, 2048); R.cur[3] = RW_LD(rowB, 0); R.cur[4] = RW_LD(rowB, 256);
#else
    R.cur[0] = RW_LD(rowA, -2048); R.prv[0] = RW_LD(prvA, -2048); R.nxt[0] = RW_LD(nxtA, -2048);
    R.cur[1] = RW_LD(rowA, 0);     R.prv[1] = RW_LD(prvA, 0);     R.nxt[1] = RW_LD(nxtA, 0);
    R.cur[2] = RW_LD(rowA, 2048);  R.prv[2] = RW_LD(prvA, 2048);  R.nxt[2] = RW_LD(nxtA, 2048);
    R.cur[3] = RW_LD(twoff, 0);
    R.cur[4] = RW_LD(rowB, 256);   R.prv[4] = RW_LD(prvB, 256);   R.nxt[4] = RW_LD(nxtB, 256);
#endif
#undef RW_LD
#if defined(PROBE_X) && (PROBE_X & 1)
    return;
#endif
    if (!WITH_WEIGHTS) return;
    const unsigned wo = (unsigned)(h * 256) + 32u * (unsigned)cg;
    R.kk0 = *(const f32x4*)((const unsigned char*)a.in[20] + (size_t)wo); R.kk1 = *(const f32x4*)((const unsigned char*)a.in[20] + (size_t)wo + 16);
    R.ka0 = *(const f32x4*)((const unsigned char*)a.in[21] + (size_t)wo); R.ka1 = *(const f32x4*)((const unsigned char*)a.in[21] + (size_t)wo + 16);
    R.rk0 = *(const f32x4*)((const unsigned char*)a.in[22] + (size_t)wo); R.rk1 = *(const f32x4*)((const unsigned char*)a.in[22] + (size_t)wo + 16);
    const int r = lane & 15, g = lane >> 4, ct = wave & 3, role = wave >> 2;
    const unsigned lo = (unsigned)WS_LUT + (unsigned)((((role * 2 + d) * 16 + h) * 64 + 16 * ct) * 128) + 128u * (unsigned)r + 16u * (unsigned)g;
    R.lb0 = *(const s16x8*)(ws + (size_t)lo); R.lb1 = *(const s16x8*)(ws + (size_t)lo + 64);
    R.bias = *(const float*)((const unsigned char*)(role ? a.in[18] : a.in[16]) + (size_t)((unsigned)((d * 1024 + h * 64 + 16 * ct) * 4) + 4u * (unsigned)r));
}
template <int NT, int PR> __device__ __forceinline__ void rw_s1_wave(LAS unsigned char* lds, int r, int g, int lane) {
    constexpr int OM = PR ? O_MAK : O_MAB, ON = PR ? O_NRK : O_NRB, OX = PR ? O_KT : O_BT;
    const f32x4 z4 = (f32x4){0.f, 0.f, 0.f, 0.f};
    const int boff = ((16 * NT + r) * LDW + 8 * g) * 2;
    const s16x8 ab0 = *(const LAS s16x8*)(lds + O_AB + boff), ab1 = *(const LAS s16x8*)(lds + O_AB + boff + 64);
    const s16x8 rb0 = *(const LAS s16x8*)(lds + O_RB + boff), rb1 = *(const LAS s16x8*)(lds + O_RB + boff + 64);
    const int xoff = OX + (r * LDW + 8 * g) * 2;
    const int srow = ((16 * NT + r) * LDW + 4 * g) * 2;
    const s16x8 d0 = *(const LAS s16x8*)(lds + xoff + NT * 16 * LDW * 2), d1 = *(const LAS s16x8*)(lds + xoff + NT * 16 * LDW * 2 + 64);
    {
        f32x4 m = mfma32(d0, ab0, z4); m = mfma32(d1, ab1, m);
        f32x4 n = mfma32(d0, rb0, z4); n = mfma32(d1, rb1, n);
#pragma unroll
        for (int i = 0; i < 4; ++i) { const int j = 4 * g + i; m[i] = j < r ? m[i] : 0.f; n[i] = j <= r ? n[i] : 0.f; }
        *(LAS s16x4*)(lds + OM + srow + 32 * NT) = pack4(m);
        *(LAS s16x4*)(lds + ON + srow + 32 * NT) = pack4(n);
        if (PR == 0) {
            f32x4 bn = mfma32(ab0, d0, z4); bn = mfma32(ab1, d1, bn);
#pragma unroll
            for (int i = 0; i < 4; ++i) bn[i] = r < 4 * g + i ? bn[i] : 0.f;
            const s16x4 aN = pack4(m), bN = pack4(bn);
            f32x4 G = m;
#pragma unroll
            for (int i = 0; i < 4; ++i) G[i] += (4 * g + i == r) ? 1.0f : 0.0f;
            f32x4 pb = mfma16(aN, bN, z4), pa = mfma16(bN, aN, z4);
            G = mfma16(pack4(pb), pack4(G), G);
            { const f32x4 pb4 = mfma16(pack4(pa), pack4(pb), z4), pa4 = mfma16(pack4(pb), pack4(pa), z4); pb = pb4; pa = pa4; }
            G = mfma16(pack4(pb), pack4(G), G);
            pb = mfma16(pack4(pa), pack4(pb), z4);
            G = mfma16(pack4(pb), pack4(G), G);
            *(LAS s16x4*)(lds + O_NP + (NT * 64 + lane) * 8) = pack4(G);
        }
    }
#pragma unroll
    for (int mt = NT - 1; mt >= (NT == 3 ? 1 : 0); --mt) {
        const s16x8 x0 = *(const LAS s16x8*)(lds + xoff + mt * 16 * LDW * 2), x1 = *(const LAS s16x8*)(lds + xoff + mt * 16 * LDW * 2 + 64);
        f32x4 m = mfma32(x0, ab0, z4); m = mfma32(x1, ab1, m);
        f32x4 n = mfma32(x0, rb0, z4); n = mfma32(x1, rb1, n);
        *(LAS s16x4*)(lds + OM + srow + 32 * mt) = pack4(m);
        *(LAS s16x4*)(lds + ON + srow + 32 * mt) = pack4(n);
    }
#pragma unroll
    for (int mt = NT + 1; mt < 4; ++mt) {
        *(LAS s16x4*)(lds + OM + srow + 32 * mt) = (s16x4){0, 0, 0, 0};
        *(LAS s16x4*)(lds + ON + srow + 32 * mt) = (s16x4){0, 0, 0, 0};
    }
    if (NT == 0) {
        const int b3 = ((48 + r) * LDW + 8 * g) * 2, s3 = ((48 + r) * LDW + 4 * g) * 2;
        const s16x8 a0 = *(const LAS s16x8*)(lds + O_AB + b3), a1 = *(const LAS s16x8*)(lds + O_AB + b3 + 64);
        const s16x8 q0 = *(const LAS s16x8*)(lds + O_RB + b3), q1 = *(const LAS s16x8*)(lds + O_RB + b3 + 64);
        f32x4 m = mfma32(d0, a0, z4); m = mfma32(d1, a1, m);
        f32x4 n = mfma32(d0, q0, z4); n = mfma32(d1, q1, n);
        *(LAS s16x4*)(lds + OM + s3) = pack4(m);
        *(LAS s16x4*)(lds + ON + s3) = pack4(n);
    }
}
__device__ __forceinline__ void rw_tw_prepass(const Args& a, unsigned char* ws, int wv, int nwv, int lane) {
    const int sub = lane >> 4, c16 = lane & 15;
    const float* mu = a.in[15] + 3072 + 8 * c16;
    const f32x4 m0 = *(const f32x4*)mu, m1 = *(const f32x4*)(mu + 4);
    const mk_f2 mv[4] = {(mk_f2){m0[0], m0[1]}, (mk_f2){m0[2], m0[3]}, (mk_f2){m1[0], m1[1]}, (mk_f2){m1[2], m1[3]}};
    const v4u z4 = (v4u){0u, 0u, 0u, 0u};
    for (int m4 = wv; m4 < M / 4; m4 += nwv) {
        const int m = 4 * m4 + sub;
        const int pos = m < 32768 ? (m & (LP - 1)) : ((m - 32768) & (LS - 1)), L = m < 32768 ? LP : LS;
        const bf16* row = (const bf16*)(ws + WS_RWIN) + (size_t)m * DRWIN + 3072 + 8 * c16;
        const v4u C = *(const v4u*)row;
        const v4u P = pos > 0 ? *(const v4u*)(row - DRWIN) : z4, N = pos < L - 1 ? *(const v4u*)(row + DRWIN) : z4;
        mk_f2 zw[4];
#pragma unroll
        for (int q = 0; q < 4; ++q) {
            const mk_f2 cc = upf2(C[q]), zz = cc + ((upf2(P[q]) + upf2(N[q])) * 0.5f - cc) * mv[q];
            const mk_f2 e2 = zz * 2.885390081777927f; mk_f2 dn; dn.x = __builtin_amdgcn_exp2f(e2.x); dn.y = __builtin_amdgcn_exp2f(e2.y); dn = dn + 1.0f;
            mk_f2 rc; rc.x = __builtin_amdgcn_rcpf(dn.x); rc.y = __builtin_amdgcn_rcpf(dn.y); zw[q] = 1.0f - rc * 2.0f;
        }
        *(v4u*)((bf16*)(ws + WS_TWB) + (size_t)m * 128 + 8 * c16) = pk8v(zw);
    }
}
__device__ __forceinline__ void rw_pin_unit(RawUnit& R) {
#pragma unroll
    for (int c = 0; c < 5; ++c) { if (c == 3) asm volatile("" : "+v"(R.cur[c])); else asm volatile("" : "+v"(R.cur[c]), "+v"(R.prv[c]), "+v"(R.nxt[c])); }
    asm volatile("" : "+v"(R.kk0), "+v"(R.kk1), "+v"(R.ka0), "+v"(R.ka1), "+v"(R.rk0), "+v"(R.rk1), "+v"(R.lb0), "+v"(R.lb1), "+v"(R.bias));
}
__device__ __forceinline__ void rw_precompute_unit(const Args& a, unsigned char* ws, LAS unsigned char* lds, int seg, int q, int qi, int qnext, int wave, int lane, RawUnit& R, volatile LAS unsigned* qslot, unsigned qval, int& unext) {
    const int u = unit_from_queue(q, qi);
    const UnitId id = decode_unit(seg, u);
    const int h = id.h, d = id.d;
    const int tid = wave * 64 + lane;
    const int r = lane & 15, g = lane >> 4;
#ifndef RP_S0
#define RP_S0 1
#endif
#ifndef RQ_A
#define RQ_A 1
#endif
#ifndef RQ_B
#define RQ_B 1
#endif
#ifndef RQ_C
#define RQ_C 1
#endif
#ifndef RQ_1
#define RQ_1 1
#endif
#ifndef RQ_23
#define RQ_23 1
#endif
#ifndef RQ_4
#define RQ_4 1
#endif
#ifndef RP_S1
#define RP_S1 1
#endif
    const int t = tid >> 3, cg = tid & 7, c8 = h * 64 + 8 * cg;
    _Pragma("unroll 1") for (int rp0_ = 0; rp0_ < RP_S0; ++rp0_) {
#ifdef PROBE_USPIN
    if (wave == 0 && lane == 0) { const unsigned long long t0_ = __builtin_amdgcn_s_memrealtime(); while (__builtin_amdgcn_s_memrealtime() - t0_ < (unsigned long long)PROBE_USPIN) __builtin_amdgcn_s_sleep(2); }
#endif
    mk_f2 zr[4], zk[4], kk[4], zv[4];
    _Pragma("unroll 1") for (int rq_RQ_A = 0; rq_RQ_A < RQ_A; ++rq_RQ_A) {
    {
        const LAS float* mu = (const LAS float*)(lds + O_MU);
        mk_f2 za[4];
#pragma unroll
        for (int comp = 0; comp < 5; ++comp) {
            if (comp == 3) continue;
            const int col = comp < 3 ? comp * 1024 + c8 : (comp == 3 ? 3072 + d * 64 + 8 * cg : 3200 + d * 64 + 8 * cg);
            const f32x4 m0 = *(const LAS f32x4*)(mu + col), m1 = *(const LAS f32x4*)(mu + col + 4);
            const mk_f2 mv[4] = {(mk_f2){m0[0], m0[1]}, (mk_f2){m0[2], m0[3]}, (mk_f2){m1[0], m1[1]}, (mk_f2){m1[2], m1[3]}};
            const v4u C = R.cur[comp], P = R.prv[comp], N = R.nxt[comp];
#pragma unroll
            for (int q = 0; q < 4; ++q) {
                const mk_f2 cc = upf2(C[q]), zz = cc + ((upf2(P[q]) + upf2(N[q])) * 0.5f - cc) * mv[q];
                if (comp == 0) zr[q] = zz; else if (comp == 1) zk[q] = zz; else if (comp == 2) zv[q] = zz; else za[q] = zz;
            }
        }
        if (d == 0) {
            const mk_f2 rkw[4] = {(mk_f2){R.rk0[0], R.rk0[1]}, (mk_f2){R.rk0[2], R.rk0[3]}, (mk_f2){R.rk1[0], R.rk1[1]}, (mk_f2){R.rk1[2], R.rk1[3]}};
            mk_f2 d2 = zr[0] * zk[0] * rkw[0];
#pragma unroll
            for (int q = 1; q < 4; ++q) d2 = d2 + zr[q] * zk[q] * rkw[q];
            float dot = d2.x + d2.y;
            dot += __shfl_xor(dot, 1); dot += __shfl_xor(dot, 2); dot += __shfl_xor(dot, 4);
            mk_f2 bo[4];
#pragma unroll
            for (int q = 0; q < 4; ++q) bo[q] = zv[q] * dot;
            *(v4u*)((bf16*)(ws + WS_ZG) + (size_t)(id.base + 64 * id.gchunk + t) * DRW + c8) = pk8v(bo);
        }
        const mk_f2 kkw[4] = {(mk_f2){R.kk0[0], R.kk0[1]}, (mk_f2){R.kk0[2], R.kk0[3]}, (mk_f2){R.kk1[0], R.kk1[1]}, (mk_f2){R.kk1[2], R.kk1[3]}};
        mk_f2 s2 = (mk_f2){0.f, 0.f};
#pragma unroll
        for (int q = 0; q < 4; ++q) { kk[q] = zk[q] * kkw[q]; s2 = s2 + kk[q] * kk[q]; }
        float ss = s2.x + s2.y;
        ss += __shfl_xor(ss, 1); ss += __shfl_xor(ss, 2); ss += __shfl_xor(ss, 4);
        const float inv = __builtin_amdgcn_rsqf(ss + L2_EPS);
#pragma unroll
        for (int q = 0; q < 4; ++q) kk[q] = kk[q] * inv;
        *(LAS v4u*)(lds + O_TW + (t * LDW + 8 * cg) * 2) = R.cur[3];
        *(LAS v4u*)(lds + O_XA + (t * LDW + 8 * cg) * 2) = pk8v(za);
    }
#if RP_S0 == 1 && RQ_A == 1
    rw_load_unit<false>(a, ws, seg, unit_from_queue(q, qnext < QUNITS ? qnext : qi), wave, lane, R);
#endif
    __syncthreads();
    }
    _Pragma("unroll 1") for (int rq_RQ_B = 0; rq_RQ_B < RQ_B; ++rq_RQ_B) {
    {
        const int ct = wave & 3, role = wave >> 2;
        const s16x8 b0 = R.lb0, b1 = R.lb1;
        const int aoff = (role ? O_XA : O_TW) + (r * LDW + 8 * g) * 2;
        f32x4 acc[4];
#pragma unroll
        for (int mt = 0; mt < 4; ++mt) {
            const s16x8 a0 = *(const LAS s16x8*)(lds + aoff + mt * 16 * LDW * 2), a1 = *(const LAS s16x8*)(lds + aoff + mt * 16 * LDW * 2 + 64);
            acc[mt] = mfma32(a0, b0, (f32x4){0.f, 0.f, 0.f, 0.f}); acc[mt] = mfma32(a1, b1, acc[mt]);
        }
        const int cch = 16 * ct + r;
        if (role == 0) {
            const float w0v = R.bias;
            float carry = 0.f;
#pragma unroll
            for (int mt = 0; mt < 4; ++mt) {
                float s[4];
#pragma unroll
                for (int i = 0; i < 4; ++i) { const float lw = -0.8750343827198594f * sigm(acc[mt][i] + w0v); s[i] = (i ? s[i - 1] : 0.f) + lw; }
                const float tot = s[3];
                const float e1 = __shfl(tot, (lane + 48) & 63), e2 = __shfl(tot, (lane + 32) & 63), e3 = __shfl(tot, (lane + 16) & 63);
                const float excl = (g >= 1 ? e1 : 0.f) + (g >= 2 ? e2 : 0.f) + (g >= 3 ? e3 : 0.f);
                const float all = __shfl(tot + excl, 48 + r);
#pragma unroll
                for (int i = 0; i < 4; ++i) *(LAS float*)(lds + O_CL + ((16 * mt + 4 * g + i) * LDC + cch) * 4) = carry + excl + s[i];
                carry += all;
            }
            if (g == 0) *(LAS float*)(lds + O_GT + cch * 4) = __builtin_amdgcn_exp2f(carry);
        } else {
            const float a0v = R.bias;
#pragma unroll
            for (int mt = 0; mt < 4; ++mt)
#pragma unroll
                for (int i = 0; i < 4; ++i) *(LAS float*)(lds + O_AS + ((16 * mt + 4 * g + i) * LDC + cch) * 4) = sigm(acc[mt][i] + a0v);
        }
        if (wave == 0 && lane == 0) *qslot = qval;
    }
    __syncthreads();
    }
    _Pragma("unroll 1") for (int rq_RQ_C = 0; rq_RQ_C < RQ_C; ++rq_RQ_C) {
    {
        const f32x4 x0 = *(const LAS f32x4*)(lds + O_CL + (t * LDC + 8 * cg) * 4), x1 = *(const LAS f32x4*)(lds + O_CL + (t * LDC + 8 * cg + 4) * 4);
        const f32x4 e0 = *(const LAS f32x4*)(lds + O_GT + (8 * cg) * 4), e1 = *(const LAS f32x4*)(lds + O_GT + (8 * cg + 4) * 4);
        const f32x4 s0 = *(const LAS f32x4*)(lds + O_AS + (t * LDC + 8 * cg) * 4), s1 = *(const LAS f32x4*)(lds + O_AS + (t * LDC + 8 * cg + 4) * 4);
        f32x4 p0 = (f32x4){0.f, 0.f, 0.f, 0.f}, p1 = p0;
        if (t > 0) { p0 = *(const LAS f32x4*)(lds + O_CL + ((t - 1) * LDC + 8 * cg) * 4); p1 = *(const LAS f32x4*)(lds + O_CL + ((t - 1) * LDC + 8 * cg + 4) * 4); }
        const mk_f2 cl[4] = {(mk_f2){x0[0], x0[1]}, (mk_f2){x0[2], x0[3]}, (mk_f2){x1[0], x1[1]}, (mk_f2){x1[2], x1[3]}};
        const mk_f2 clp[4] = {(mk_f2){p0[0], p0[1]}, (mk_f2){p0[2], p0[3]}, (mk_f2){p1[0], p1[1]}, (mk_f2){p1[2], p1[3]}};
        const mk_f2 gte[4] = {(mk_f2){e0[0], e0[1]}, (mk_f2){e0[2], e0[3]}, (mk_f2){e1[0], e1[1]}, (mk_f2){e1[2], e1[3]}};
        const mk_f2 as[4] = {(mk_f2){s0[0], s0[1]}, (mk_f2){s0[2], s0[3]}, (mk_f2){s1[0], s1[1]}, (mk_f2){s1[2], s1[3]}};
        const mk_f2 kaw[4] = {(mk_f2){R.ka0[0], R.ka0[1]}, (mk_f2){R.ka0[2], R.ka0[3]}, (mk_f2){R.ka1[0], R.ka1[1]}, (mk_f2){R.ka1[2], R.ka1[3]}};
        mk_f2 ab[4], bt[4], kt[4], rb[4], bh[4], kh[4];
#pragma unroll
        for (int q = 0; q < 4; ++q) {
            mk_f2 gt, gi, gp;
            gt.x = __builtin_amdgcn_exp2f(cl[q].x); gt.y = __builtin_amdgcn_exp2f(cl[q].y);
            gi.x = __builtin_amdgcn_exp2f(-cl[q].x); gi.y = __builtin_amdgcn_exp2f(-cl[q].y);
            gp.x = __builtin_amdgcn_exp2f(clp[q].x); gp.y = __builtin_amdgcn_exp2f(clp[q].y);
            const mk_f2 ge = gte[q] * gi;
            const mk_f2 kd = zk[q] * ((as[q] - 1.0f) * kaw[q] + 1.0f), kb = kk[q] * as[q];
            ab[q] = -(kk[q] * gp); bt[q] = kb * gi; kt[q] = kd * gi; rb[q] = zr[q] * gt; bh[q] = kb * ge; kh[q] = kd * ge;
        }
        *(LAS v4u*)(lds + O_AB + (t * LDW + 8 * cg) * 2) = pk8v(ab);
        *(LAS v4u*)(lds + O_BT + (t * LDW + 8 * cg) * 2) = pk8v(bt);
        *(LAS v4u*)(lds + O_KT + (t * LDW + 8 * cg) * 2) = pk8v(kt);
        *(LAS v4u*)(lds + O_RB + (t * LDW + 8 * cg) * 2) = pk8v(rb);
#pragma unroll
        for (int q = 0; q < 4; ++q) {
            const unsigned wb = pk2(bh[q].x, bh[q].y), wk = pk2(kh[q].x, kh[q].y), wv = pk2(zv[q].x, zv[q].y);
            const int so0 = swz_chunk(8 * cg + 2 * q, t >> 3) + (t & 7) * 2, so1 = swz_chunk(8 * cg + 2 * q + 1, t >> 3) + (t & 7) * 2;
            *(LAS bf16*)(lds + O_BHT + so0) = (bf16)(wb & 0xffffu); *(LAS bf16*)(lds + O_BHT + so1) = (bf16)(wb >> 16);
            *(LAS bf16*)(lds + O_KHT + so0) = (bf16)(wk & 0xffffu); *(LAS bf16*)(lds + O_KHT + so1) = (bf16)(wk >> 16);
            *(LAS bf16*)(lds + O_VT + so0) = (bf16)(wv & 0xffffu); *(LAS bf16*)(lds + O_VT + so1) = (bf16)(wv >> 16);
        }
    }
    __syncthreads();
    }
    }
    unext = __builtin_amdgcn_readfirstlane((int)*qslot);
#ifndef PROBE_NOLD
#if !(RP_S0 == 1 && RQ_A == 1)
    rw_load_unit<false>(a, ws, seg, unit_from_queue(q, qnext < QUNITS ? qnext : qi), wave, lane, R);
#endif
#endif
    _Pragma("unroll 1") for (int rp1_ = 0; rp1_ < RP_S1; ++rp1_) {
    _Pragma("unroll 1") for (int rq_RQ_1 = 0; rq_RQ_1 < RQ_1; ++rq_RQ_1) {
    switch (wave) {
        case 0: rw_s1_wave<0, 0>(lds, r, g, lane); break;
        case 1: rw_s1_wave<0, 1>(lds, r, g, lane); break;
        case 2: rw_s1_wave<1, 0>(lds, r, g, lane); break;
        case 3: rw_s1_wave<1, 1>(lds, r, g, lane); break;
        case 4: rw_s1_wave<2, 0>(lds, r, g, lane); break;
        case 5: rw_s1_wave<2, 1>(lds, r, g, lane); break;
        case 6: rw_s1_wave<3, 0>(lds, r, g, lane); break;
        default: rw_s1_wave<3, 1>(lds, r, g, lane); break;
    }
    __syncthreads();
    }
    _Pragma("unroll 1") for (int rq_RQ_23 = 0; rq_RQ_23 < RQ_23; ++rq_RQ_23) {
    f32x4 rhs[4];
    if (wave < 4) {
#pragma unroll
        for (int mt = 0; mt < 4; ++mt)
#pragma unroll
            for (int i = 0; i < 4; ++i) rhs[mt][i] = bf2f(*(const LAS bf16*)(lds + O_AB + ((16 * mt + 4 * g + i) * LDW + 16 * wave + r) * 2));
    } else {
        const int vt = wave - 4;
        const s16x8 v0 = *(const LAS s16x8*)(lds + O_VT + swz_chunk(16 * vt + r, g)), v1 = *(const LAS s16x8*)(lds + O_VT + swz_chunk(16 * vt + r, g + 4));
#pragma unroll
        for (int mt = 0; mt < 4; ++mt) {
            const int ao = O_MAK + ((16 * mt + r) * LDW + 8 * g) * 2;
            const s16x8 x0 = *(const LAS s16x8*)(lds + ao), x1 = *(const LAS s16x8*)(lds + ao + 64);
            rhs[mt] = mfma32(x0, v0, (f32x4){0.f, 0.f, 0.f, 0.f}); rhs[mt] = mfma32(x1, v1, rhs[mt]);
        }
    }
    {
        f32x4 xb[4];
#pragma unroll
        for (int bi = 0; bi < 4; ++bi) {
            f32x4 acc = rhs[bi];
#pragma unroll
            for (int bj = 0; bj < 4; ++bj) if (bj < bi) {
                const s16x4 am = *(const LAS s16x4*)(lds + O_MAB + ((16 * bi + r) * LDW + 16 * bj + 4 * g) * 2);
                acc = mfma16(am, pack4(xb[bj]), acc);
            }
            acc = mfma16(*(const LAS s16x4*)(lds + O_NP + (bi * 64 + lane) * 8), pack4(acc), (f32x4){0.f, 0.f, 0.f, 0.f});
            xb[bi] = acc;
            *(LAS s16x4*)(lds + O_XT + ((16 * wave + r) * LDW + 16 * bi + 4 * g) * 2) = pack4(acc);
        }
    }
    __syncthreads();
    }
    _Pragma("unroll 1") for (int rq_RQ_4 = 0; rq_RQ_4 < RQ_4; ++rq_RQ_4) {
    {
        rw_pin_unit(R);
        const int nt = wave & 3;
        bf16* ug = (bf16*)((unsigned char*)a.out + DO_INT + (size_t)(seg & 1) * (128u << 20)) + (size_t)u * UNIT_ELEMS;
        const int boff = ((16 * nt + r) * LDW + 8 * g) * 2;
        const s16x8 u0 = *(const LAS s16x8*)(lds + O_XT + 64 * LDW * 2 + boff), u1 = *(const LAS s16x8*)(lds + O_XT + 64 * LDW * 2 + boff + 64);
        const s16x8 v0 = *(const LAS s16x8*)(lds + O_VT + swz_chunk(16 * nt + r, g)), v1 = *(const LAS s16x8*)(lds + O_VT + swz_chunk(16 * nt + r, g + 4));
        v2u yo[2];
#pragma unroll
        for (int my = 0; my < 2; ++my) {
            const int mt = 2 * (wave >> 2) + my, ro_ = ((16 * mt + r) * LDW + 8 * g) * 2;
            const s16x8 n0 = *(const LAS s16x8*)(lds + O_NRB + ro_), n1 = *(const LAS s16x8*)(lds + O_NRB + ro_ + 64);
            const s16x8 m0 = *(const LAS s16x8*)(lds + O_NRK + ro_), m1 = *(const LAS s16x8*)(lds + O_NRK + ro_ + 64);
            f32x4 y = mfma32(n0, u0, (f32x4){0.f, 0.f, 0.f, 0.f}); y = mfma32(n1, u1, y); y = mfma32(m0, v0, y); y = mfma32(m1, v1, y);
            yo[my] = __builtin_bit_cast(v2u, pack4(y));
        }
#ifdef PROBE_NOST
#define RW_ST(p, v) asm volatile("" :: "v"(v))
#else
#define RW_ST(p, v) (p) = (v)
#endif
        RW_ST(*((v4u*)(ug + 12288 + (size_t)(nt * 64 + lane) * 16) + (wave >> 2)), ((v4u){yo[0].x, yo[0].y, yo[1].x, yo[1].y}));
        if (wave < 4) {
            const s16x8 bh0 = *(const LAS s16x8*)(lds + O_BHT + swz_chunk(16 * nt + r, g)), bh1 = *(const LAS s16x8*)(lds + O_BHT + swz_chunk(16 * nt + r, g + 4));
            const s16x8 nb0 = *(const LAS s16x8*)(lds + O_NRB + boff), nb1 = *(const LAS s16x8*)(lds + O_NRB + boff + 64);
            v2u po[4], ro[4];
#pragma unroll
            for (int mt = 0; mt < 4; ++mt) {
                const int ao = O_XT + ((16 * mt + r) * LDW + 8 * g) * 2;
                const s16x8 x0 = *(const LAS s16x8*)(lds + ao), x1 = *(const LAS s16x8*)(lds + ao + 64);
                f32x4 p = mfma32(x0, bh0, (f32x4){0.f, 0.f, 0.f, 0.f}); p = mfma32(x1, bh1, p);
                if (mt == nt) { const float gt = *(const LAS float*)(lds + O_GT + (16 * mt + r) * 4);
#pragma unroll
                    for (int i = 0; i < 4; ++i) p[i] += (4 * g + i == r) ? gt : 0.f; }
                const f32x4 rbv = unpack4(*(const LAS v2u*)(lds + O_RB + ((16 * nt + r) * LDW + 16 * mt + 4 * g) * 2));
                f32x4 q = mfma32(x0, nb0, rbv); q = mfma32(x1, nb1, q);
                po[mt] = __builtin_bit_cast(v2u, pack4(p)); ro[mt] = __builtin_bit_cast(v2u, pack4(q));
            }
            v4u* pg = (v4u*)(ug + (size_t)(nt * 64 + lane) * 16);
            RW_ST(pg[0], ((v4u){po[0].x, po[0].y, po[1].x, po[1].y})); RW_ST(pg[1], ((v4u){po[2].x, po[2].y, po[3].x, po[3].y}));
            v4u* rg = (v4u*)(ug + 4096 + (size_t)(nt * 64 + lane) * 16);
            RW_ST(rg[0], ((v4u){ro[0].x, ro[0].y, ro[1].x, ro[1].y})); RW_ST(rg[1], ((v4u){ro[2].x, ro[2].y, ro[3].x, ro[3].y}));
        } else {
            v2u qo[4];
#pragma unroll
            for (int mt = 0; mt < 4; ++mt) {
                const int sw0 = swz_chunk(16 * mt + r, g), sw1 = swz_chunk(16 * mt + r, g + 4);
                const s16x8 b0 = *(const LAS s16x8*)(lds + O_BHT + sw0), b1 = *(const LAS s16x8*)(lds + O_BHT + sw1);
                const s16x8 k0 = *(const LAS s16x8*)(lds + O_KHT + sw0), k1 = *(const LAS s16x8*)(lds + O_KHT + sw1);
                f32x4 q = mfma32(b0, u0, (f32x4){0.f, 0.f, 0.f, 0.f}); q = mfma32(b1, u1, q); q = mfma32(k0, v0, q); q = mfma32(k1, v1, q);
                qo[mt] = __builtin_bit_cast(v2u, pack4(q));
            }
            v4u* qg = (v4u*)(ug + 8192 + (size_t)(nt * 64 + lane) * 16);
            RW_ST(qg[0], ((v4u){qo[0].x, qo[0].y, qo[1].x, qo[1].y})); RW_ST(qg[1], ((v4u){qo[2].x, qo[2].y, qo[3].x, qo[3].y}));
        }
    }
    }
    }
}

__device__ __forceinline__ void rw_chain_job(const Args& a, unsigned char* ws, LAS unsigned char* lds, int seg, int chain, int wave, int lane) {
    const int vt = wave & 3;
    LAS unsigned char* cl = lds + (wave >> 2) * 65536;
    int s, rem; if (chain < 64) { s = chain >> 5; rem = chain & 31; } else { s = 2 + ((chain - 64) >> 5); rem = (chain - 64) & 31; }
    const int h = rem >> 1, d = rem & 1, base = s < 2 ? s * LP : 32768 + (s - 2) * LS, L = s < 2 ? LP : LS, nch = chain < 64 ? 32 : 4;
    const int r = lane & 15, g = lane >> 4;
    f32x4* stp = (f32x4*)(ws + WS_STATE) + ((size_t)(chain * 4 + vt) * 4) * 64 + lane;
    f32x4 st[4];
#pragma unroll
    for (int i = 0; i < 4; ++i) st[i] = seg == 0 ? (f32x4){0.f, 0.f, 0.f, 0.f} : stp[i * 64];
#pragma unroll
    for (int i = 0; i < 4; ++i) asm volatile("" : "+v"(st[i]));
    const bf16* ub = (const bf16*)((unsigned char*)a.out + DO_INT + (size_t)(seg & 1) * (128u << 20));
#define RW_DMA(ug, buf) do { LAS unsigned char* b_ = cl + (buf) * 32768; \
        _Pragma("unroll") for (int _i = 0; _i < 4; ++_i) { const int pc_ = 4 * vt + _i; \
            __builtin_amdgcn_global_load_lds((const unsigned*)((ug) + (size_t)((pc_ >> 1) * 64 + lane) * 16 + (pc_ & 1) * 8), (LAS unsigned*)(b_ + pc_ * 1024), 16, 0, 0); } \
        _Pragma("unroll") for (int _i = 0; _i < 4; ++_i) \
            __builtin_amdgcn_global_load_lds((const unsigned*)((ug) + 8192 + (_i >> 1) * 4096 + (size_t)(vt * 64 + lane) * 16 + (_i & 1) * 8), (LAS unsigned*)(b_ + 16384 + vt * 4096 + _i * 1024), 16, 0, 0); } while (0)
    RW_DMA(ub + (size_t)unit_of(chain, 0) * UNIT_ELEMS, 0);
    for (int jc = 0; jc < nch; ++jc) {
#if defined(PROBE_X) && (PROBE_X & 8)
        if (jc == 0) VM_WAIT();
#else
        if (jc == 0) VM_WAIT(); else asm volatile("s_waitcnt vmcnt(16)" ::: "memory");
#endif
        __builtin_amdgcn_s_barrier();
        asm volatile("" ::: "memory");
        if (jc + 1 < nch) RW_DMA(ub + (size_t)unit_of(chain, jc + 1) * UNIT_ELEMS, (jc + 1) & 1);
        const LAS unsigned char* b = cl + (jc & 1) * 32768 + lane * 16;
        v4u pf[4][2], rf[4][2];
#pragma unroll
        for (int i = 0; i < 4; ++i) { pf[i][0] = *(const LAS v4u*)(b + (2 * i) * 1024); pf[i][1] = *(const LAS v4u*)(b + (2 * i + 1) * 1024);
                                      rf[i][0] = *(const LAS v4u*)(b + (8 + 2 * i) * 1024); rf[i][1] = *(const LAS v4u*)(b + (9 + 2 * i) * 1024); }
        const LAS unsigned char* bq = b + 16384 + vt * 4096;
        const v4u cq0 = *(const LAS v4u*)(bq), cq1 = *(const LAS v4u*)(bq + 1024), cy0 = *(const LAS v4u*)(bq + 2048), cy1 = *(const LAS v4u*)(bq + 3072);
        s16x4 sb[4];
#pragma unroll
        for (int kt = 0; kt < 4; ++kt) sb[kt] = pack4(st[kt]);
        const int gchunk = seg * nch + jc;
        const unsigned ystep = d ? 0u - (unsigned)(DRW * 2) : (unsigned)(DRW * 2);
        const unsigned yoff0 = (unsigned)(d ? DO_YB : DO_YF) + (unsigned)(((base + (d ? L - 1 - 64 * gchunk : 64 * gchunk)) * DRW + h * 64 + 16 * vt) * 2) + (unsigned)(4 * g) * ystep + 2u * (unsigned)r;
#pragma unroll
        for (int tt = 0; tt < 4; ++tt) {
            const v2u yi = tt == 0 ? (v2u){cy0.x, cy0.y} : tt == 1 ? (v2u){cy0.z, cy0.w} : tt == 2 ? (v2u){cy1.x, cy1.y} : (v2u){cy1.z, cy1.w};
            f32x4 acc = unpack4(yi);
            acc = mfma16(__builtin_bit_cast(s16x4, (v2u){rf[tt][0].x, rf[tt][0].y}), sb[0], acc);
            acc = mfma16(__builtin_bit_cast(s16x4, (v2u){rf[tt][0].z, rf[tt][0].w}), sb[1], acc);
            acc = mfma16(__builtin_bit_cast(s16x4, (v2u){rf[tt][1].x, rf[tt][1].y}), sb[2], acc);
            acc = mfma16(__builtin_bit_cast(s16x4, (v2u){rf[tt][1].z, rf[tt][1].w}), sb[3], acc);
#pragma unroll
            for (int i = 0; i < 4; ++i) *(bf16*)((unsigned char*)a.out + (size_t)(yoff0 + (unsigned)(16 * tt + i) * ystep)) = (bf16)f2bf(acc[i]);
        }
        f32x4 sn[4];
#pragma unroll
        for (int i = 0; i < 4; ++i) {
            const v2u qi = i == 0 ? (v2u){cq0.x, cq0.y} : i == 1 ? (v2u){cq0.z, cq0.w} : i == 2 ? (v2u){cq1.x, cq1.y} : (v2u){cq1.z, cq1.w};
            f32x4 acc = unpack4(qi);
            acc = mfma16(__builtin_bit_cast(s16x4, (v2u){pf[i][0].x, pf[i][0].y}), sb[0], acc);
            acc = mfma16(__builtin_bit_cast(s16x4, (v2u){pf[i][0].z, pf[i][0].w}), sb[1], acc);
            acc = mfma16(__builtin_bit_cast(s16x4, (v2u){pf[i][1].x, pf[i][1].y}), sb[2], acc);
            acc = mfma16(__builtin_bit_cast(s16x4, (v2u){pf[i][1].z, pf[i][1].w}), sb[3], acc);
            sn[i] = acc;
        }
#pragma unroll
        for (int i = 0; i < 4; ++i) st[i] = sn[i];
    }
#undef RW_DMA
#pragma unroll
    for (int i = 0; i < 4; ++i) stp[i * 64] = st[i];
}
}


namespace s5k {
constexpr int ST = 32, NCH = M / ST, K2 = 768, KU = 512;
constexpr size_t POW_ELEMS = (size_t)128 * 33 * 64 * 2, BB_ELEMS = (size_t)128 * 64 * 16 * 2, KTAB_ELEMS = (size_t)64 * 63 * 256;
__device__ __forceinline__ void tables_group(const Args& a, unsigned char* ws, LAS unsigned char* lds, int g, int quarter, int tid) {
    float* POW = (float*)(ws + WS_S5TAB); float* BB = POW + POW_ELEMS; float* KTAB = BB + BB_ELEMS;
    LAS float* lam = (LAS float*)lds;
    LAS float* bbl = lam + 256;
    LAS float* cl = bbl + 4096;
    LAS float* pwl = cl + 4096;
    __syncthreads();
    if (tid < 128) {
        const int d = tid >> 6, p = tid & 63, gi = d * 64 + g;
        const float lre = a.in[5][gi * 64 + p], lim = a.in[6][gi * 64 + p], dt = expf(a.in[7][gi]);
        const float er = expf(lre * dt); float sn, cs; sincosf(lim * dt, &sn, &cs);
        const float lbr = er * cs, lbi = er * sn;
        const float nr = lbr - 1.0f, ni = lbi, den = lre * lre + lim * lim;
        const float cfr = (nr * lre + ni * lim) / den, cfi = (ni * lre - nr * lim) / den;
        lam[(d * 64 + p) * 2] = lre * dt; lam[(d * 64 + p) * 2 + 1] = lim * dt;
        for (int h = 0; h < 16; ++h) {
            const float br = a.in[8][((size_t)gi * 64 + p) * 16 + h], bi = a.in[9][((size_t)gi * 64 + p) * 16 + h];
            const float xr = cfr * br - cfi * bi, xi = cfr * bi + cfi * br;
            bbl[((d * 64 + p) * 16 + h) * 2] = xr; bbl[((d * 64 + p) * 16 + h) * 2 + 1] = xi;
            if (quarter == 0) { BB[(((size_t)gi * 64 + p) * 16 + h) * 2] = xr; BB[(((size_t)gi * 64 + p) * 16 + h) * 2 + 1] = xi; }
            cl[((d * 16 + h) * 64 + p) * 2] = a.in[10][((size_t)gi * 16 + h) * 64 + p]; cl[((d * 16 + h) * 64 + p) * 2 + 1] = a.in[11][((size_t)gi * 16 + h) * 64 + p];
        }
    }
    __syncthreads();
    for (int e = tid; e < 2 * 33 * 64; e += NWAVES * 64) {
        const int p = e & 63, tau = (e >> 6) % 33, d = e / (33 * 64), gi = d * 64 + g;
        const float er = expf(lam[(d * 64 + p) * 2] * (float)tau); float sn, cs; sincosf(lam[(d * 64 + p) * 2 + 1] * (float)tau, &sn, &cs);
        pwl[e * 2] = er * cs; pwl[e * 2 + 1] = er * sn;
        if (quarter == 0) { POW[(((size_t)gi * 33 + tau) * 64 + p) * 2] = er * cs; POW[(((size_t)gi * 33 + tau) * 64 + p) * 2 + 1] = er * sn; }
    }
    __syncthreads();
    for (int o = quarter * (NWAVES * 64) + tid; o < 63 * 256; o += 4 * NWAVES * 64) {
        const int hh = o & 255, h = hh >> 4, h2 = hh & 15, lag = (o >> 8) - 31;
        float acc = 0.f;
#pragma unroll
        for (int d = 0; d < 2; ++d) {
            if ((d == 0 && lag >= 0) || (d == 1 && lag <= 0)) {
                const int tau = lag >= 0 ? lag : -lag;
                for (int p = 0; p < 64; ++p) {
                    const float cr = cl[((d * 16 + h) * 64 + p) * 2], ci = cl[((d * 16 + h) * 64 + p) * 2 + 1];
                    const float pr = pwl[((d * 33 + tau) * 64 + p) * 2], pi = pwl[((d * 33 + tau) * 64 + p) * 2 + 1];
                    const float br = bbl[((d * 64 + p) * 16 + h2) * 2], bi = bbl[((d * 64 + p) * 16 + h2) * 2 + 1];
                    const float qr = pr * br - pi * bi, qi = pr * bi + pi * br;
                    acc += cr * qr - ci * qi;
                }
            }
        }
        KTAB[(size_t)g * 63 * 256 + o] = acc;
    }
    __syncthreads();
}
__device__ __forceinline__ void fill_weights(const Args& a, unsigned char* ws, int gw, int NGW, int lane, int part) {
    const float* POW = (const float*)(ws + WS_S5TAB); const float* BB = POW + POW_ELEMS; const float* KTAB = BB + BB_ELEMS;
    bf16* W2 = (bf16*)(ws + WS_S5W2); bf16* E = (bf16*)(ws + WS_S5E);
    const size_t n_w2 = (size_t)64 * 512 * 96, n_e = (size_t)64 * 256 * 64, stride = (size_t)NGW * 64;
    const size_t it0 = part ? 0 : n_w2, it1 = part ? n_w2 : n_w2 + n_e;
    for (size_t it = it0 + (size_t)gw * 64 + lane; it < it1; it += stride) {
        float v[8];
        if (it < n_w2) {
            const int kc = (int)(it % 96), n = (int)((it / 96) % 512), g = (int)(it / (96 * 512)), t = n >> 4, h = n & 15, k0 = kc * 8;
            if (k0 < KU) {
                const int s = k0 >> 4, h0 = k0 & 15, lag = t - s;
                const float* kt = KTAB + ((size_t)(g * 63 + lag + 31) * 16 + h) * 16 + h0;
#pragma unroll
                for (int j = 0; j < 8; ++j) v[j] = kt[j] + ((lag == 0 && h0 + j == h) ? a.in[12][g * 16 + h] : 0.f);
            } else {
                const int kk = k0 - KU, d = kk >> 7, ri = (kk >> 6) & 1, p0 = kk & 63, gi = d * 64 + g, tau = d == 0 ? t + 1 : ST - t;
#pragma unroll
                for (int j = 0; j < 8; ++j) {
                    const int p = p0 + j;
                    const float cr = a.in[10][((size_t)gi * 16 + h) * 64 + p], ci = a.in[11][((size_t)gi * 16 + h) * 64 + p];
                    const float pr = POW[(((size_t)gi * 33 + tau) * 64 + p) * 2], pi = POW[(((size_t)gi * 33 + tau) * 64 + p) * 2 + 1];
                    v[j] = ri == 0 ? (cr * pr - ci * pi) : -(cr * pi + ci * pr);
                }
            }
            *(v4u*)(W2 + ((size_t)(g * 512 + n)) * K2 + k0) = rwk::pk8(v);
        } else {
            const size_t ie = it - n_w2;
            const int kc = (int)(ie % 64), n = (int)((ie / 64) % 256), g = (int)(ie / (64 * 256)), d = n >> 7, ri = (n >> 6) & 1, p = n & 63, gi = d * 64 + g;
            const int k0 = kc * 8, s = k0 >> 4, h0 = k0 & 15, tau = d == 0 ? ST - 1 - s : s;
            const float pr = POW[(((size_t)gi * 33 + tau) * 64 + p) * 2], pi = POW[(((size_t)gi * 33 + tau) * 64 + p) * 2 + 1];
#pragma unroll
            for (int j = 0; j < 8; ++j) {
                const float br = BB[(((size_t)gi * 64 + p) * 16 + h0 + j) * 2], bi = BB[(((size_t)gi * 64 + p) * 16 + h0 + j) * 2 + 1];
                v[j] = ri == 0 ? (pr * br - pi * bi) : (pr * bi + pi * br);
            }
            *(v4u*)(E + ((size_t)(g * 256 + n)) * KU + k0) = rwk::pk8(v);
        }
    }
}
__device__ __forceinline__ void chain_job(unsigned char* ws, bf16* A2, int job, int lane) {
    int s, rem; if (job < 256) { s = job / 128; rem = job % 128; } else { s = 2 + (job - 256) / 128; rem = (job - 256) % 128; }
    const int g = rem >> 1, d = rem & 1, p = lane, gi = d * 64 + g;
    const int c0 = s < 2 ? s * (LP / ST) : 2 * (LP / ST) + (s - 2) * (LS / ST), nc = s < 2 ? LP / ST : LS / ST;
    const float* POW = (const float*)(ws + WS_S5TAB);
    const float lr = POW[(((size_t)gi * 33 + 32) * 64 + p) * 2], li = POW[(((size_t)gi * 33 + 32) * 64 + p) * 2 + 1];
    const bf16* XL = (const bf16*)(ws + WS_S5XL);
    const int step = d ? -1 : 1, cfirst = d ? c0 + nc - 1 : c0;
    const int xcol = d * 128 + p, scol = KU + d * 128 + p;
    float xr = 0.f, xi = 0.f;
    { bf16* row = A2 + ((size_t)g * NCH + cfirst) * K2 + scol; row[0] = 0; row[64] = 0; }
    for (int n = 0; n < nc; n += 32) {
        float lr_[32], li_[32];
#pragma unroll
        for (int j = 0; j < 32; ++j) { const bf16* xrow = XL + ((size_t)g * NCH + cfirst + (n + j) * step) * 256 + xcol; lr_[j] = bf2f(xrow[0]); li_[j] = bf2f(xrow[64]); }
#pragma unroll
        for (int j = 0; j < 32; ++j) {
            const float nr = lr * xr - li * xi + lr_[j], ni = lr * xi + li * xr + li_[j]; xr = nr; xi = ni;
            if (n + j + 1 < nc) { bf16* row = A2 + ((size_t)g * NCH + cfirst + (n + j + 1) * step) * K2 + scol; row[0] = (bf16)f2bf(xr); row[64] = (bf16)f2bf(xi); }
        }
    }
}
}
namespace pg8 {
struct S5Order {
    int G, c, nun, mode;
    __device__ bool next(int i, Unit& u) const {
        const int L = i * G + c; if (L >= nun) return false;
        if (mode == 1) { u.pm = L; u.pn = L >> 3; } else { const int g = L >> 4; u.pm = g * 8 + ((L & 15) >> 1); u.pn = g * 2 + (L & 1); }
        return true;
    }
    __device__ __forceinline__ void a_ready(const Unit&) const {}
    __device__ __forceinline__ void done(const Unit&) const {}
};
struct WrapOrder : StaticOrder { int wrap; __device__ bool next(int i, Unit& u) const { const bool ok = StaticOrder::next(i, u); u.pm &= wrap; return ok; } };
struct EpiNull { static constexpr bool PERM = true, AFTER_DRAIN = false;
    __device__ __forceinline__ void operator()(const f32x4 (&acc)[2][2][4][2], const Unit& u, int wr, int wc, int fr, int fq) const {
#pragma unroll
        for (int a = 0; a < 2; ++a)
#pragma unroll
            for (int b = 0; b < 2; ++b)
#pragma unroll
                for (int m = 0; m < 4; ++m)
#pragma unroll
                    for (int n = 0; n < 2; ++n) asm volatile("" :: "v"(acc[a][b][m][n]));
    } };
struct EpiS5X {
    static constexpr bool PERM = true, AFTER_DRAIN = false;
    bf16_t* O;
    __device__ __forceinline__ void operator()(const f32x4 (&acc)[2][2][4][2], const Unit& u, int wr, int wc, int fr, int fq) const {
        const int row0 = u.pm * BM + wr * 64 + fr, col0 = wc * 32 + 8 * fq;
#pragma unroll
        for (int ai = 0; ai < 2; ++ai)
#pragma unroll
            for (int m = 0; m < 4; ++m) { bf16_t* rowp = O + (size_t)(row0 + ai * HALF + m * 16) * 256 + col0;
#pragma unroll
                for (int bj = 0; bj < 2; ++bj) { const f32x4 v0 = acc[ai][bj][m][0], v1 = acc[ai][bj][m][1];
                    u32x4 w; w.x = cvt_pk_bf16(v0[0], v0[1]); w.y = cvt_pk_bf16(v0[2], v0[3]); w.z = cvt_pk_bf16(v1[0], v1[1]); w.w = cvt_pk_bf16(v1[2], v1[3]);
                    *(u32x4*)(rowp + bj * HALF) = w; } }
    }
};
struct EpiS5Y {
    static constexpr bool PERM = true, AFTER_DRAIN = false;
    bf16_t* Zp;
    __device__ __forceinline__ void operator()(const f32x4 (&acc)[2][2][4][2], const Unit& u, int wr, int wc, int fr, int fq) const {
        const int row0 = u.pm * BM + wr * 64 + fr, col0 = (u.pn & 1) * BM + wc * 32 + 8 * fq;
#pragma unroll
        for (int ai = 0; ai < 2; ++ai)
#pragma unroll
            for (int m = 0; m < 4; ++m) {
                const int row = row0 + ai * HALF + m * 16, g = row >> 11, c = row & 2047;
#pragma unroll
                for (int bj = 0; bj < 2; ++bj) {
                    const int col = col0 + bj * HALF, t = col >> 4, h0 = col & 15;
                    float v[8];
#pragma unroll
                    for (int j = 0; j < 4; ++j) { v[j] = acc[ai][bj][m][0][j]; v[4 + j] = acc[ai][bj][m][1][j]; }
#pragma unroll
                    for (int j = 0; j < 8; ++j) { const float x = v[j]; v[j] = x * sigmoid_f(1.5957691216057308f * (x + 0.044715f * x * x * x)); }
                    u32x4 w; w.x = cvt_pk_bf16(v[0], v[1]); w.y = cvt_pk_bf16(v[2], v[3]); w.z = cvt_pk_bf16(v[4], v[5]); w.w = cvt_pk_bf16(v[6], v[7]);
                    *(u32x4*)(Zp + (size_t)(c * 32 + t) * 1024 + g * 16 + h0) = w;
                }
            }
    }
};
}


__device__ __forceinline__ void transpose_item(const float* W, int ldw, int K, bf16* WT, int drow0, LAS float* scr, int k0, int n0, int lane) {
#pragma unroll 8
    for (int i = 0; i < 32; ++i) { const int kk = 2 * i + (lane >> 5); scr[kk * 33 + (lane & 31)] = W[(size_t)(k0 + kk) * ldw + n0 + (lane & 31)]; }
    LDS_WAIT();
    const int c = lane & 7;
#pragma unroll
    for (int j = 0; j < 4; ++j) { const int n = (lane >> 3) + 8 * j; const LAS float* s = scr + (8 * c) * 33 + n;
        v4u o; o.x = pk2(s[0 * 33], s[1 * 33]); o.y = pk2(s[2 * 33], s[3 * 33]); o.z = pk2(s[4 * 33], s[5 * 33]); o.w = pk2(s[6 * 33], s[7 * 33]);
        *(v4u*)(WT + (size_t)(drow0 + n) * K + k0 + 8 * c) = o; }
    LDS_WAIT();
}
__device__ __forceinline__ int win_dest_row(int n) { return n < 1024 ? n : (n < 2048 ? n + 3328 : (n < 5376 ? n - 1024 : n)); }
__device__ __forceinline__ const float* xrow_ptr(const float* xp, const float* xs, int m) { return m < 32768 ? xp + (size_t)m * D : xs + (size_t)(m - 32768) * D; }

__device__ __forceinline__ void p0_prologue(const Args& a, unsigned char* ws, LAS unsigned char* lds, int gw, int NGW, int wave, int lane) {
    LAS float* scr = (LAS float*)(lds + wave * 16384);
    constexpr int I_IN = (D / 64) * (NIN / 32), I_GLU = (1024 / 64) * (1024 / 32), I_SO = (1024 / 64) * (2048 / 32), I_WO = (2048 / 64) * (2048 / 32);
    constexpr int NITEMS = I_IN + I_GLU + 2 * I_SO + I_WO;
    for (int it = gw; it < NITEMS; it += NGW) {
        int r = it;
        if (r < I_IN) { const int nblk = NIN / 32, kb = r / nblk, nb = r % nblk; transpose_item(a.in[4], NIN, D, (bf16*)(ws + WS_WT), win_dest_row(32 * nb), scr, 64 * kb, 32 * nb, lane); continue; } r -= I_IN;
        if (r < I_GLU) { const int nblk = 1024 / 32, kb = r / nblk, nb = r % nblk; transpose_item(a.in[13], 1024, 1024, (bf16*)(ws + WS_GLUT), 32 * nb, scr, 64 * kb, 32 * nb, lane); continue; } r -= I_GLU;
        if (r < I_SO) { const int nblk = 2048 / 32, kb = r / nblk, nb = r % nblk; transpose_item(a.in[14], 2048, 1024, (bf16*)(ws + WS_S5OT), 32 * nb, scr, 64 * kb, 32 * nb, lane); continue; } r -= I_SO;
        if (r < I_SO) { const int nblk = 2048 / 32, kb = r / nblk, nb = r % nblk; transpose_item(a.in[25], 2048, 1024, (bf16*)(ws + WS_RWOT), 32 * nb, scr, 64 * kb, 32 * nb, lane); continue; } r -= I_SO;
        { const int nblk = 2048 / 32, kb = r / nblk, nb = r % nblk; transpose_item(a.in[26], 2048, 2048, (bf16*)(ws + WS_WOT), 32 * nb, scr, 64 * kb, 32 * nb, lane); }
    }
    { const int bxx = gw / NWAVES; s5k::tables_group(a, ws, lds, (bxx >> 2) & 63, bxx & 3, wave * 64 + lane); }
    { bf16* LUT = (bf16*)(ws + WS_LUT);
      for (int e = gw * 64 + lane; e < 4 * 16 * 64 * 64; e += NGW * 64) {
          const int j = e & 63, c = (e >> 6) & 63, h = (e >> 12) & 15, rd = e >> 16, role = rd >> 1, d = rd & 1;
          LUT[e] = (bf16)f2bf((role ? a.in[19] : a.in[17])[(size_t)(d * 64 + j) * 1024 + h * 64 + c]); } }
    const float* g = a.in[2];
    f32x4 gv[8];
#pragma unroll
    for (int j = 0; j < 8; ++j) gv[j] = ((const f32x4*)g)[lane + 64 * j];
    bf16* HN = (bf16*)(ws + WS_HN);
    for (int m = gw; m < M; m += NGW) {
        const f32x4* xr = (const f32x4*)xrow_ptr(a.in[0], a.in[1], m) + lane;
        f32x4 v[8]; float s = 0.f;
#pragma unroll
        for (int j = 0; j < 8; ++j) { v[j] = __builtin_nontemporal_load(xr + 64 * j); s += (v[j].x * v[j].x + v[j].y * v[j].y) + (v[j].z * v[j].z + v[j].w * v[j].w); }
        const float rstd = 1.0f / sqrtf(wave_sum(s) * (1.0f / D) + RMS_EPS);
        v2u* o8 = (v2u*)(HN + (size_t)m * D) + lane;
#pragma unroll
        for (int j = 0; j < 8; ++j) { v2u o; o.x = pk2(v[j].x * rstd * gv[j].x, v[j].y * rstd * gv[j].y); o.y = pk2(v[j].z * rstd * gv[j].z, v[j].w * rstd * gv[j].w); o8[64 * j] = o; }
    }
}

__device__ __forceinline__ void unpack8(const bf16* p, float (&o)[8]) {
    const v4u a = *(const v4u*)p;
    o[0] = blo(a.x); o[1] = bhi(a.x); o[2] = blo(a.y); o[3] = bhi(a.y); o[4] = blo(a.z); o[5] = bhi(a.z); o[6] = blo(a.w); o[7] = bhi(a.w);
}
__device__ __forceinline__ void pack8(bf16* p, const float (&v)[8]) {
    v4u a; a.x = pk2(v[0], v[1]); a.y = pk2(v[2], v[3]); a.z = pk2(v[4], v[5]); a.w = pk2(v[6], v[7]); *(v4u*)p = a;
}
__device__ __forceinline__ void p3_finalize(const Args& a, unsigned char* ws, int gw, int NGW, int lane) {
    const bf16* BON = (const bf16*)(ws + WS_ZG);
    unsigned char* ob = (unsigned char*)a.out;
    bf16* YF = (bf16*)(ob + DO_YF); const bf16* YB = (const bf16*)(ob + DO_YB);
    const int half = gw & 1, c0 = half * 512 + lane * 8;
    float lnw[8], lnb[8];
#pragma unroll
    for (int j = 0; j < 8; ++j) { lnw[j] = a.in[23][c0 + j]; lnb[j] = a.in[24][c0 + j]; }
    for (int m = gw >> 1; m < M; m += NGW >> 1) {
        const int t = m < 32768 ? (m & (LP - 1)) : ((m - 32768) & (LS - 1)), L = m < 32768 ? LP : LS;
        const bool hp = t > 0, hn = t < L - 1;
        float o[8];
        float y[8];
        {
            float yf[8], yb[8];
            unpack8(YF + (size_t)m * DRW + c0, yf); unpack8(YB + (size_t)m * DRW + c0, yb);
#pragma unroll
            for (int j = 0; j < 8; ++j) y[j] = yf[j] + yb[j];
        }
        float s1 = 0.f;
#pragma unroll
        for (int j = 0; j < 8; ++j) s1 += y[j];
        s1 += __shfl_xor(s1, 1); s1 += __shfl_xor(s1, 2); s1 += __shfl_xor(s1, 4);
        const float mean = s1 * (1.0f / 64.0f);
        float s2 = 0.f;
#pragma unroll
        for (int j = 0; j < 8; ++j) { const float dd = y[j] - mean; s2 += dd * dd; }
        s2 += __shfl_xor(s2, 1); s2 += __shfl_xor(s2, 2); s2 += __shfl_xor(s2, 4);
        const float rstd = 1.0f / sqrtf(s2 * (1.0f / 64.0f) + GN_EPS);
        float bon[8];
        unpack8(BON + (size_t)m * DRW + c0, bon);
#pragma unroll
        for (int j = 0; j < 8; ++j) o[j] = (y[j] - mean) * rstd * lnw[j] + lnb[j] + bon[j];
        pack8(YF + (size_t)m * DRW + c0, o);
    }
}

__device__ __forceinline__ void p12_final(const Args& a, const bf16* OUTB, int gw, int NGW, int lane) {
    const float* g = a.in[3];
    f32x4 gv[8];
#pragma unroll
    for (int j = 0; j < 8; ++j) gv[j] = ((const f32x4*)g)[lane + 64 * j];
    for (int m = gw; m < M; m += NGW) {
        const f32x4* xr = (const f32x4*)xrow_ptr(a.in[0], a.in[1], m) + lane;
        f32x4* orow = (f32x4*)(a.out + (size_t)m * D) + lane;
        const v2u* brow = (const v2u*)(OUTB + (size_t)m * D) + lane;
        f32x4 v[8]; float s = 0.f;
#pragma unroll
        for (int j = 0; j < 8; ++j) { const v2u b = __builtin_nontemporal_load(brow + 64 * j); v[j] = (f32x4){blo(b.x), bhi(b.x), blo(b.y), bhi(b.y)}; s += (v[j].x * v[j].x + v[j].y * v[j].y) + (v[j].z * v[j].z + v[j].w * v[j].w); }
        const float rstd = 1.0f / sqrtf(wave_sum(s) * (1.0f / D) + RMS_EPS);
#pragma unroll
#ifdef PROBE_DMG
        for (int j = 0; j < 8; ++j) { const f32x4 xv = __builtin_nontemporal_load(xr + 64 * j); __builtin_nontemporal_store(xv, orow + 64 * j); }
#else
        for (int j = 0; j < 8; ++j) { const f32x4 xv = __builtin_nontemporal_load(xr + 64 * j); __builtin_nontemporal_store(xv + v[j] * rstd * gv[j], orow + 64 * j); }
#endif
    }
}

#ifndef RW_UA
#define RW_UA 10
#define RW_UB 18
#endif
static_assert(64 * RW_UA + 192 * RW_UB == 4096, "RWKV unit split");
__global__ void __launch_bounds__(NWAVES * 64, 2) mk_fwd(Args args) {
    extern __shared__ __attribute__((aligned(16))) unsigned char lds_raw[];
    LAS unsigned char* lds = (LAS unsigned char*)lds_raw;
    volatile LAS unsigned* MISC = (volatile LAS unsigned*)(lds + MISC_OFF);
    const int wave = __builtin_amdgcn_readfirstlane((int)threadIdx.x >> 6);
#define lane mk_lane()
    const int tid0 = threadIdx.x;
    const int G = gridDim.x; const int bx = blockIdx.x; const int vcu = (G % 8 == 0) ? (bx % 8) * (G / 8) + bx / 8 : bx;
    unsigned char* ws = args.ws;
    unsigned* ctl = (unsigned*)(ws + WS_CTL);
    for (int u = tid0; u < (LDS_BYTES - MISC_OFF) / 4; u += NWAVES * 64) ((LAS unsigned*)(lds + MISC_OFF))[u] = 0u;
    __syncthreads();
    XcdBarrier bar = xcd_barrier_post(ctl + CW_BAR, MISC + 8, wave);
#ifdef PROBE_A
    int nstamp = 0;
#define STAMP() do { if (bx == 0 && tid0 == 0) MISC[32 + nstamp] = (unsigned)__builtin_amdgcn_s_memrealtime(); ++nstamp; } while (0)
#else
#define STAMP() do { } while (0)
#endif
    STAMP();
#define GRID_BAR() do { xcd_barrier(bar, wave); STAMP(); } while (0)
#ifndef ONLY_PHASE
#define ONLY_PHASE -1
#endif
#ifndef REP_PHASE
#define REP_PHASE -1
#endif
#define IN(k) (ONLY_PHASE < 0 || ONLY_PHASE == (k))
#define REPS(k) _Pragma("unroll 1") for (int rep_ = 0; rep_ < ((REP_PHASE == (k)) ? 2 : 1); ++rep_)
    const int gw = vcu * NWAVES + wave, NGW = G * NWAVES;
#ifdef GEMM_WAVE_PERM
    const int gwave = ((wave & 1) << 2) | (wave >> 1);
#else
    const int gwave = wave;
#endif
    bf16* WT = (bf16*)(ws + WS_WT); bf16* HN = (bf16*)(ws + WS_HN); bf16* RWIN = (bf16*)(ws + WS_RWIN); bf16* Z = (bf16*)(ws + WS_Z); bf16* ZG = (bf16*)(ws + WS_ZG);
    bf16* A2 = (bf16*)((unsigned char*)args.out + DO_A2);
    bf16* YN = (bf16*)((unsigned char*)args.out + DO_YF); bf16* Q = (bf16*)((unsigned char*)args.out + DO_Q); bf16* P = RWIN;

#if defined(PROBE_SPIN) && !defined(PROBE_SPIN_END)
    if (bx == 0 && tid0 == 0) { const unsigned long long t0_ = __builtin_amdgcn_s_memrealtime(); while (__builtin_amdgcn_s_memrealtime() - t0_ < (unsigned long long)PROBE_SPIN) __builtin_amdgcn_s_sleep(8); }
    __syncthreads();
#endif
    if (IN(0)) REPS(0) { p0_prologue(args, ws, lds, gw, NGW, wave, lane); GRID_BAR(); }
    if (IN(1)) REPS(1) {
        s5k::fill_weights(args, ws, gw, NGW, lane, 0);
        pg8::Gemm g{HN, WT, M, 4352, D, D}; pg8::StaticOrder S; S.init(M, 4352, G, bx);
        pg8::EpiG1 E{A2, RWIN};
        pg8::gemm_phase<pg8::EpiG1, pg8::StaticOrder, PG8_ALIGN, PG8_SP2>(lds, g, S, E, gwave);
        GRID_BAR();
    }
#ifdef PROBE_GEMM
    {
        pg8::Gemm g{HN, WT, M, 4352, D, D}; pg8::WrapOrder S; S.init(M, 4352, G, bx); S.wrap = (PROBE_GEMM == 2) ? 15 : 0xffff;
        pg8::EpiNull E{};
        pg8::gemm_phase<pg8::EpiNull, pg8::WrapOrder, PG8_ALIGN, PG8_SP2>(lds, g, S, E, gwave);
        GRID_BAR();
    }
#endif
    if (IN(2)) REPS(2) {
        pg8::Gemm g{A2, (const bf16*)(ws + WS_S5E), 131072, 256, s5k::KU, s5k::K2}; pg8::S5Order S{G, bx, 512, 1};
        pg8::EpiS5X E{(bf16*)(ws + WS_S5XL)};
        pg8::gemm_phase<pg8::EpiS5X, pg8::S5Order, PG8_ALIGN, PG8_SP2>(lds, g, S, E, gwave);
        GRID_BAR();
    }
    if (IN(3)) REPS(3) {
        const int gwt = wave * G + vcu;
        for (int j = gwt; j < 2304; j += NGW) s5k::chain_job(ws, A2, j, lane);
        if (wave > 0) s5k::fill_weights(args, ws, vcu * (NWAVES - 1) + (wave - 1), G * (NWAVES - 1), lane, 1);
        if (wave > 0) rwk::rw_tw_prepass(args, ws, vcu * (NWAVES - 1) + (wave - 1), G * (NWAVES - 1), lane);
        GRID_BAR();
    }
    if (IN(4)) REPS(4) {
        pg8::Gemm g{A2, (const bf16*)(ws + WS_S5W2), 131072, 512, s5k::K2, s5k::K2}; pg8::S5Order S{G, bx, 1024, 2};
        pg8::EpiS5Y E{Z};
        pg8::gemm_phase<pg8::EpiS5Y, pg8::S5Order, PG8_ALIGN, PG8_SP2>(lds, g, S, E, gwave);
        GRID_BAR();
    }
    if (IN(5)) REPS(5) {
#if REP_PHASE == 5
        if (rep_ > 0) { if (bx == 0 && tid0 < rwk::NSEG) __hip_atomic_store(ctl + CW_QUEUE + tid0 * 64, 0u, __ATOMIC_RELAXED, __HIP_MEMORY_SCOPE_AGENT); GRID_BAR(); }
#endif
        for (int e = tid0; e < 3328; e += NWAVES * 64) ((LAS float*)(lds + rwk::O_MU))[e] = args.in[15][e];
        __syncthreads();
        for (int k = 0; k <= rwk::NSEG; ++k) {
            if (k >= 1) {
                const int seg = k - 1;
                int J, Jstride;
                if (bx < 32) { J = bx * 8 + wave; Jstride = 1 << 20; }
                else { J = 256 + (bx - 32) * 8 + wave; Jstride = 1792; }
                for (; J < 2304; J += Jstride) {
                    const int chain = J < 256 ? (J >> 2) : 64 + ((J - 256) >> 2);
                    rwk::rw_chain_job(args, ws, lds, seg, chain, wave, lane);
                }
                VM_WAIT(); __syncthreads();
            }
            if (k < rwk::NSEG) {
                const int seg = k;
                const int q = bx & 31;
                unsigned* qc = ctl + CW_QUEUE + (k * 32 + q) * 16;
                volatile LAS unsigned* qs = MISC + 16;
                if (wave == 0 && lane == 0) { qs[0] = __hip_atomic_fetch_add(qc, 1u, __ATOMIC_RELAXED, __HIP_MEMORY_SCOPE_AGENT); qs[1] = __hip_atomic_fetch_add(qc, 1u, __ATOMIC_RELAXED, __HIP_MEMORY_SCOPE_AGENT); }
                __syncthreads();
                int ucur = __builtin_amdgcn_readfirstlane((int)qs[0]), unxt = __builtin_amdgcn_readfirstlane((int)qs[1]);
                rwk::RawUnit R;
                rwk::rw_load_unit<true>(args, ws, seg, rwk::unit_from_queue(q, ucur < rwk::QUNITS ? ucur : 0), wave, lane, R);
                rwk::rw_pin_unit(R);
                while (ucur < rwk::QUNITS) {
                    unsigned pulled = 0u;
                    if (wave == 0 && lane == 0) { GAS unsigned* qcv = (GAS unsigned*)qc; asm volatile("" : "+v"(qcv)); pulled = __hip_atomic_fetch_add(qcv, 1u, __ATOMIC_RELAXED, __HIP_MEMORY_SCOPE_AGENT); }
                    int unn;
                    rwk::rw_precompute_unit(args, ws, lds, seg, q, ucur, unxt, wave, lane, R, qs + 2, pulled, unn);
                    ucur = unxt; unxt = unn;
                }
            }
            GRID_BAR();
        }
    }
    if (IN(6)) REPS(6) { p3_finalize(args, ws, gw, NGW, lane); GRID_BAR(); }
    if (IN(7)) REPS(7) {
        pg8::Gemm g{Z, (const bf16*)(ws + WS_GLUT), M, 1024, 1024, 1024}; pg8::StaticOrder S; S.init(M, 1024, G, bx);
        pg8::EpiMix<1> E{ZG, Z, nullptr, 1024};
        pg8::gemm_phase<pg8::EpiMix<1>, pg8::StaticOrder, PG8_ALIGN, PG8_SP2>(lds, g, S, E, gwave);
    }
    if (IN(8)) REPS(8) {
        pg8::Gemm g{HN, WT + (size_t)4352 * D, M, 2048, D, D}; pg8::StaticOrder S; S.init(M, 2048, G, bx);
        pg8::EpiSplit<2, 2> E{{ZG, ZG, nullptr, 1024}, {YN, YN, nullptr, 1024}, 4};
        pg8::gemm_phase<pg8::EpiSplit<2, 2>, pg8::StaticOrder, PG8_ALIGN, PG8_SP2>(lds, g, S, E, gwave);
        GRID_BAR();
    }
    if (IN(10)) REPS(10) {
        pg8::Gemm g{ZG, (const bf16*)(ws + WS_S5OT), M, 2048, 1024, 1024}; pg8::StaticOrder S; S.init(M, 2048, G, bx);
        pg8::EpiMix<0> E{P, nullptr, nullptr, 2048};
        pg8::gemm_phase<pg8::EpiMix<0>, pg8::StaticOrder, PG8_ALIGN, PG8_SP2>(lds, g, S, E, gwave);
    }
    if (IN(12)) REPS(12) {
        pg8::Gemm g{YN, (const bf16*)(ws + WS_RWOT), M, 2048, 1024, 1024}; pg8::StaticOrder S; S.init(M, 2048, G, bx);
        pg8::EpiMix<0> E{Q, nullptr, nullptr, 2048};
        pg8::gemm_phase<pg8::EpiMix<0>, pg8::StaticOrder, PG8_ALIGN, PG8_SP2>(lds, g, S, E, gwave);
    }
    if (IN(13)) REPS(13) {
        pg8::Gemm g{HN, WT + (size_t)6400 * D, M, 4096, D, D}; pg8::StaticOrder S; S.init(M, 4096, G, bx);
        pg8::EpiSplit<1, 3> E{{P, P, nullptr, 2048}, {P, Q, P, 2048}, 8};
        pg8::gemm_phase<pg8::EpiSplit<1, 3>, pg8::StaticOrder, PG8_ALIGN, PG8_SP2>(lds, g, S, E, gwave);
        GRID_BAR();
    }
    if (IN(14)) REPS(14) {
        pg8::Gemm g{P, (const bf16*)(ws + WS_WOT), M, 2048, D, D}; pg8::StaticOrder S; S.init(M, 2048, G, bx);
        pg8::EpiMix<0> E{HN, nullptr, nullptr, 2048};
        pg8::gemm_phase<pg8::EpiMix<0>, pg8::StaticOrder, PG8_ALIGN, PG8_SP2>(lds, g, S, E, gwave);
        GRID_BAR();
    }
#ifdef PROBE_BARS
    _Pragma("unroll 1") for (int pb_ = 0; pb_ < PROBE_BARS; ++pb_) GRID_BAR();
#endif
    if (IN(15)) REPS(15) { p12_final(args, HN, gw, NGW, lane); }
#ifdef PROBE_SPIN_END
    if (bx == 0 && tid0 == 0) { const unsigned long long t0_ = __builtin_amdgcn_s_memrealtime(); while (__builtin_amdgcn_s_memrealtime() - t0_ < (unsigned long long)PROBE_SPIN) __builtin_amdgcn_s_sleep(8); }
#endif
#ifdef PROBE_A
#ifdef PROBE_ENDBAR
    GRID_BAR();
#else
    STAMP();
#endif
    if (bx == 0 && tid0 == 0) {
        VM_WAIT();
        const float dt = (float)(MISC[32 + PROBE_B] - MISC[32 + PROBE_A]) * 0.01f;
#ifdef PROBE_DMG
        args.out[0] += 20.0f + rintf((dt - (float)PROBE_C) / (float)PROBE_D);
#else
        args.out[0] += 10.0f + rintf((dt - (float)PROBE_C) / (float)PROBE_D);
#endif
    }
#endif
#undef IN
#undef lane
}

extern "C" void kernel_launch(void* const* d_in, const int* in_sizes, int n_in, void* d_out, int out_size, void* d_ws, size_t ws_size, hipStream_t stream) {
    static int grid = 0;
    if (grid == 0) {
        if (n_in != 27 || out_size != 2 * 32768 * D || ws_size < WS_END) { fprintf(stderr, "kernel_launch: unexpected shapes (n_in %d out %d ws %zu)\n", n_in, out_size, ws_size); grid = -1; return; }
        int dev = 0, cus = 0, per_cu = 0;
        if (hipGetDevice(&dev) != hipSuccess || hipDeviceGetAttribute(&cus, hipDeviceAttributeMultiprocessorCount, dev) != hipSuccess) { grid = -1; return; }
        if (hipFuncSetAttribute((const void*)mk_fwd, hipFuncAttributeMaxDynamicSharedMemorySize, LDS_BYTES) != hipSuccess) { fprintf(stderr, "kernel_launch: hipFuncSetAttribute failed\n"); grid = -1; return; }
        if (hipOccupancyMaxActiveBlocksPerMultiprocessor(&per_cu, (const void*)mk_fwd, NWAVES * 64, LDS_BYTES) != hipSuccess || per_cu < 1)
            fprintf(stderr, "kernel_launch: note: occupancy query reports %d workgroups per CU\n", per_cu);
        (void)hipGetLastError();
        if (cus < 256) fprintf(stderr, "kernel_launch: note: %d CUs; the phase program is written for 256 resident workgroups\n", cus);
        grid = 256;
    }
    if (grid < 0) return;
    if (hipMemsetAsync((char*)d_ws + WS_CTL, 0, CTL_ZERO_BYTES, stream) != hipSuccess) return;
    Args a{};
    for (int i = 0; i < 27; ++i) a.in[i] = (const float*)d_in[i];
    a.out = (float*)d_out; a.ws = (unsigned char*)d_ws; a.pad = 0;
    { const int li = 0; a.ph_lo = 0; a.ph_hi = N_PHASES; a.li = 0;
        hipLaunchKernelGGL(mk_fwd, dim3(grid), dim3(NWAVES * 64), LDS_BYTES, stream, a);
        const hipError_t le = hipPeekAtLastError();
        if (le != hipSuccess) { fprintf(stderr, "kernel_launch: launch %d failed: %s\n", li, hipGetErrorName(le)); }
    }
}
```

```cpp
#include <hip/hip_runtime.h>
#include <cstdio>
#include <cstdint>
#define MK_N_LAUNCHES 1

__device__ __forceinline__ int mk_lane() { int l; asm volatile("v_mbcnt_lo_u32_b32 %0, -1, 0\n\tv_mbcnt_hi_u32_b32 %0, -1, %0" : "=v"(l)); return l; }
namespace pg8 {
#define PG8_LAS __attribute__((address_space(3)))
typedef unsigned short bf16_t;
typedef short bf16x8 __attribute__((ext_vector_type(8)));
typedef float f32x4 __attribute__((ext_vector_type(4)));
typedef unsigned u32x4 __attribute__((ext_vector_type(4)));
constexpr int BM = 256, BK = 64, HALF = 128, HTB = HALF * BK * 2  , STAGE_BYTES = 8 * HTB, NXCD = 8, WGM = 8;

__host__ __device__ __forceinline__ int lds_byte(int r, int c) { const int st = (r >> 4) * 2 + (c >> 5), rr = r & 15, cc = c & 31, ob = rr * 64 + cc * 2; return st * 1024 + (ob ^ (((ob >> 9) & 1) << 5)); }
__host__ __device__ __forceinline__ void stage_rc(int b, int& R, int& C) { const int st = b / 1024, sb = b % 1024, swz = sb ^ (((sb >> 9) & 1) << 5); R = (st >> 1) * 16 + swz / 64; C = (st & 1) * 32 + (swz % 64) / 2; }
__host__ __device__ __forceinline__ int perm32(int rho) { const int n = rho >> 4, i = rho & 15; return 8 * (i >> 2) + 4 * n + (i & 3); }

struct Unit { int pm, pn; };
struct Gemm { const bf16_t* A; const bf16_t* Bt; int M, N, K, lda; };

struct StaticOrder {
    int nM, nN, nwg, G, c;
    __host__ __device__ void init(int M, int N, int G_, int c_) { nM = M / BM; nN = N / BM; nwg = nM * nN; G = G_; c = c_; }
    __host__ __device__ bool next(int i, Unit& u) const {
        const long L = (long)i * G + c; if (L >= nwg) return false;
        int wgid = (int)L; { const int q = nwg / NXCD, r = nwg % NXCD, xcd = wgid % NXCD, off = wgid / NXCD; wgid = (xcd < r ? xcd * (q + 1) : r * (q + 1) + (xcd - r) * q) + off; }
        const int nig = WGM * nN, gid = wgid / nig, fm = gid * WGM, gsz = (nM - fm) < WGM ? (nM - fm) : WGM;
        u.pm = fm + ((wgid % nig) % gsz); u.pn = (wgid % nig) / gsz; return true;
    }
    __device__ __forceinline__ void a_ready(const Unit&) const {}
    __device__ __forceinline__ void done(const Unit&) const {}
};

__device__ __forceinline__ unsigned cvt_pk_bf16(float lo, float hi) { unsigned r; asm volatile("v_cvt_pk_bf16_f32 %0, %1, %2" : "=v"(r) : "v"(lo), "v"(hi)); return r; }

__device__ __forceinline__ float bf_lo(unsigned u) { return __uint_as_float(u << 16); }
__device__ __forceinline__ float bf_hi(unsigned u) { return __uint_as_float(u & 0xffff0000u); }
__device__ __forceinline__ float sigmoid_f(float v) { return __builtin_amdgcn_rcpf(1.0f + __expf(-v)); }

struct EpiG1 {
    static constexpr bool PERM = true, AFTER_DRAIN = false;
    bf16_t* a2; bf16_t* rwin;
    __device__ __forceinline__ void operator()(const f32x4 (&acc)[2][2][4][2], const Unit& u, int wr, int wc, int fr, int fq) const {
        const int row0 = u.pm * BM + wr * 64 + fr; const int colt = u.pn * BM; const bool s5 = colt < 1024;
        const int col0 = colt + wc * 32 + 8 * fq;
#ifndef EPI_REP
#define EPI_REP 1
#endif
        _Pragma("unroll 1") for (int er_ = 0; er_ < EPI_REP; ++er_)
#pragma unroll
        for (int ai = 0; ai < 2; ++ai)
#pragma unroll
            for (int m = 0; m < 4; ++m) { const int row = row0 + ai * HALF + m * 16;
#pragma unroll
                for (int bj = 0; bj < 2; ++bj) { const f32x4 v0 = acc[ai][bj][m][0], v1 = acc[ai][bj][m][1]; const int col = col0 + bj * HALF;
                    u32x4 w; w.x = cvt_pk_bf16(v0[0], v0[1]); w.y = cvt_pk_bf16(v0[2], v0[3]); w.z = cvt_pk_bf16(v1[0], v1[1]); w.w = cvt_pk_bf16(v1[2], v1[3]);
                    bf16_t* dst = s5 ? a2 + ((size_t)((col >> 4) * 2048 + (row >> 5)) * 768 + (row & 31) * 16 + (col & 15))
                                     : rwin + (size_t)row * 3328 + (col - 1024);
                    *(u32x4*)dst = w; } }
    }
};
template <int MODE> struct EpiMix {
    static constexpr bool PERM = true, AFTER_DRAIN = false;
    bf16_t* O; const bf16_t* S; const bf16_t* Add; int ld;
    __device__ __forceinline__ void operator()(const f32x4 (&acc)[2][2][4][2], const Unit& u, int wr, int wc, int fr, int fq) const {
        const int row0 = u.pm * BM + wr * 64 + fr, col0 = u.pn * BM + wc * 32 + 8 * fq;
#pragma unroll
        for (int ai = 0; ai < 2; ++ai) {
            u32x4 sv4[4][2], av4[4][2];
            if (MODE >= 1) {
#pragma unroll
                for (int m = 0; m < 4; ++m)
#pragma unroll
                    for (int bj = 0; bj < 2; ++bj) { const size_t off = (size_t)(row0 + ai * HALF + m * 16) * ld + col0 + bj * HALF;
                        sv4[m][bj] = *(const u32x4*)(S + off); if (MODE == 3) av4[m][bj] = *(const u32x4*)(Add + off); }
            }
#pragma unroll
            for (int m = 0; m < 4; ++m) {
#pragma unroll
                for (int bj = 0; bj < 2; ++bj) {
                    const size_t off = (size_t)(row0 + ai * HALF + m * 16) * ld + col0 + bj * HALF;
                    float v[8];
#pragma unroll
                    for (int j = 0; j < 4; ++j) { v[j] = acc[ai][bj][m][0][j]; v[4 + j] = acc[ai][bj][m][1][j]; }
                    if (MODE >= 1) {
                        const u32x4 s = sv4[m][bj];
                        const float sv[8] = {bf_lo(s.x), bf_hi(s.x), bf_lo(s.y), bf_hi(s.y), bf_lo(s.z), bf_hi(s.z), bf_lo(s.w), bf_hi(s.w)};
#pragma unroll
                        for (int j = 0; j < 8; ++j) { const float sg = sigmoid_f(v[j]); v[j] = (MODE == 2) ? sv[j] * v[j] * sg : sv[j] * sg; }
                    }
                    if (MODE == 3) {
                        const u32x4 a = av4[m][bj];
                        const float av[8] = {bf_lo(a.x), bf_hi(a.x), bf_lo(a.y), bf_hi(a.y), bf_lo(a.z), bf_hi(a.z), bf_lo(a.w), bf_hi(a.w)};
#pragma unroll
                        for (int j = 0; j < 8; ++j) v[j] += av[j];
                    }
                    u32x4 w; w.x = cvt_pk_bf16(v[0], v[1]); w.y = cvt_pk_bf16(v[2], v[3]); w.z = cvt_pk_bf16(v[4], v[5]); w.w = cvt_pk_bf16(v[6], v[7]);
                    *(u32x4*)(O + off) = w;
                }
            }
        }
    }
};
template <int MLO, int MHI> struct EpiSplit {
    static constexpr bool PERM = true, AFTER_DRAIN = false;
    EpiMix<MLO> lo; EpiMix<MHI> hi; int split;
    __device__ __forceinline__ void operator()(const f32x4 (&acc)[2][2][4][2], const Unit& u, int wr, int wc, int fr, int fq) const {
        if (u.pn < split) lo(acc, u, wr, wc, fr, fq);
        else { const Unit v{u.pm, u.pn - split}; hi(acc, v, wr, wc, fr, fq); }
    }
};
struct EpiF32 {
    static constexpr bool PERM = false, AFTER_DRAIN = false;
    float* C; int ldc;
    __device__ __forceinline__ void operator()(const f32x4 (&acc)[2][2][4][2], const Unit& u, int wr, int wc, int fr, int fq) const {
        const int row0 = u.pm * BM + wr * 64 + fr, col0 = u.pn * BM + wc * 32 + 4 * fq;
#pragma unroll
        for (int ai = 0; ai < 2; ++ai)
#pragma unroll
            for (int m = 0; m < 4; ++m) { float* rowp = C + (size_t)(row0 + ai * HALF + m * 16) * ldc + col0;
#pragma unroll
                for (int bj = 0; bj < 2; ++bj)
#pragma unroll
                    for (int n = 0; n < 2; ++n) *(f32x4*)(rowp + bj * HALF + n * 16) = acc[ai][bj][m][n]; }
    }
};
template <class Epi, class Sched, bool ALIGN_EPI = false, bool SP2 = false>
__device__ __forceinline__ void gemm_phase(PG8_LAS unsigned char* lds, const Gemm g, const Sched& S, const Epi& E, const int mk_wave) {
    const int lane = mk_lane(), wid = mk_wave, tid = wid * 64 + lane, wr = wid >> 2, wc = wid & 3, fr = lane & 15, fq = lane >> 4;
    const int K = g.K, nt = K / BK;
    unsigned voffA[2], voffB[2];
#pragma unroll
    for (int i = 0; i < 2; ++i) { int R, C; stage_rc(tid * 16 + i * 8192, R, C); const int Rb = Epi::PERM ? ((R & ~31) + perm32(R & 31)) : R;
        voffA[i] = (unsigned)(R * g.lda + C) * 2u; voffB[i] = (unsigned)(Rb * K + C) * 2u; }
    const size_t kstep = (size_t)(BK * 2);
    const size_t hstep = (size_t)HALF * K * 2;
    const size_t tstep = 2 * hstep;
    const size_t hstepA = (size_t)HALF * g.lda * 2, tstepA = 2 * hstepA;
    const unsigned ldsw = (unsigned)wid * 1024u;
    const int aoff = lds_byte(wr * 64 + fr, fq * 8), boff = lds_byte(wc * 32 + fr, fq * 8);
#define PG8_SA(b, h) (((b) * 2 + (h)) * HTB)
#define PG8_SB(b, h) ((4 + (b) * 2 + (h)) * HTB)
#define PG8_STAGE(bufoff, gbase, voff) do { _Pragma("unroll") for (int _i = 0; _i < 2; ++_i) \
        __builtin_amdgcn_global_load_lds((const unsigned*)((const char*)(gbase) + (voff)[_i]), (PG8_LAS unsigned*)(lds + (bufoff) + ldsw + _i * 8192), 16, 0, 0); } while (0)
#define PG8_LDA(dst, b, h) do { _Pragma("unroll") for (int m = 0; m < 4; ++m) _Pragma("unroll") for (int k = 0; k < 2; ++k) dst[m][k] = *(const PG8_LAS bf16x8*)(lds + PG8_SA(b, h) + aoff + m * 2048 + k * 1024); } while (0)
#define PG8_LDB(dst, b, h) do { _Pragma("unroll") for (int n = 0; n < 2; ++n) _Pragma("unroll") for (int k = 0; k < 2; ++k) dst[n][k] = *(const PG8_LAS bf16x8*)(lds + PG8_SB(b, h) + boff + n * 2048 + k * 1024); } while (0)
#define PG8_MMA(ai, bj, At, Bt) do { __builtin_amdgcn_s_setprio(1); _Pragma("unroll") for (int m = 0; m < 4; ++m) _Pragma("unroll") for (int n = 0; n < 2; ++n) _Pragma("unroll") for (int k = 0; k < 2; ++k) \
        acc[ai][bj][m][n] = __builtin_amdgcn_mfma_f32_16x16x32_bf16(Bt[n][k], At[m][k], acc[ai][bj][m][n], 0, 0, 0); __builtin_amdgcn_s_setprio(0); } while (0)
#define PG8_WAIT_V(n) asm volatile("s_waitcnt vmcnt(" #n ")" ::: "memory")
#define PG8_WAIT_L(n) asm volatile("s_waitcnt lgkmcnt(" #n ")" ::: "memory")
#define PG8_BAR __builtin_amdgcn_s_barrier()
#define PG8_SCHED __builtin_amdgcn_sched_barrier(0)
    Unit cur, nxt; int ui = 0;
    if (!S.next(0, cur)) return;
    f32x4 acc[2][2][4][2];
#pragma unroll
    for (int a = 0; a < 2; ++a)
#pragma unroll
        for (int b = 0; b < 2; ++b)
#pragma unroll
            for (int m = 0; m < 4; ++m)
#pragma unroll
                for (int n = 0; n < 2; ++n) acc[a][b][m][n] = (f32x4){0.f, 0.f, 0.f, 0.f};
    bf16x8 At[4][2], B0[2][2], B1[2][2];
    const char* cA = (const char*)g.A + (size_t)cur.pm * tstepA; const char* cB = (const char*)g.Bt + (size_t)cur.pn * tstep;
    S.a_ready(cur);
    if constexpr (SP2) {
        PG8_STAGE(PG8_SB(0, 0), cB, voffB); PG8_STAGE(PG8_SB(0, 1), cB + hstep, voffB); PG8_STAGE(PG8_SA(0, 0), cA, voffA); PG8_STAGE(PG8_SA(0, 1), cA + hstepA, voffA);
        if (wr == 1) PG8_BAR;
        PG8_WAIT_V(2); PG8_BAR;
        PG8_STAGE(PG8_SB(1, 0), cB + kstep, voffB); PG8_STAGE(PG8_SA(1, 0), cA + kstep, voffA); PG8_STAGE(PG8_SB(1, 1), cB + hstep + kstep, voffB);
        PG8_WAIT_V(6); PG8_BAR;
    } else {
        PG8_STAGE(PG8_SB(0, 0), cB, voffB); PG8_STAGE(PG8_SA(0, 0), cA, voffA); PG8_STAGE(PG8_SB(0, 1), cB + hstep, voffB); PG8_STAGE(PG8_SA(0, 1), cA + hstepA, voffA);
        if (wr == 1) PG8_BAR;
        PG8_WAIT_V(4); PG8_BAR;
        PG8_STAGE(PG8_SB(1, 0), cB + kstep, voffB); PG8_STAGE(PG8_SA(1, 0), cA + kstep, voffA); PG8_STAGE(PG8_SB(1, 1), cB + hstep + kstep, voffB);
        PG8_WAIT_V(6); PG8_BAR;
    }
    for (;;) {
        const bool has_next = S.next(ui + 1, nxt);
        const char* nA = has_next ? (const char*)g.A + (size_t)nxt.pm * tstepA : cA; const char* nB = has_next ? (const char*)g.Bt + (size_t)nxt.pn * tstep : cB;
        for (int t = 0; t < nt; t += 2) {
            const bool last = (t == nt - 2);
            const char* a1 = cA + (size_t)(t + 1) * kstep;
            const char* a2 = last ? nA : cA + (size_t)(t + 2) * kstep; const char* b2 = last ? nB : cB + (size_t)(t + 2) * kstep;
            const char* a3 = a2 + kstep; const char* b3 = b2 + kstep;
            if (last && has_next) S.a_ready(nxt);
            if constexpr (SP2) {
            PG8_LDB(B0, 0, 0); PG8_LDB(B1, 0, 1); PG8_SCHED; PG8_LDA(At, 0, 0); PG8_STAGE(PG8_SA(1, 1), a1 + hstepA, voffA);
            PG8_WAIT_V(8); PG8_WAIT_L(0); PG8_BAR; PG8_MMA(0, 0, At, B0); PG8_MMA(0, 1, At, B1); PG8_BAR; PG8_SCHED;
            PG8_LDA(At, 0, 1); PG8_STAGE(PG8_SB(0, 0), b2, voffB); PG8_STAGE(PG8_SB(0, 1), b2 + hstep, voffB); PG8_STAGE(PG8_SA(0, 0), a2, voffA);
            PG8_WAIT_V(8); PG8_WAIT_L(0); PG8_BAR; PG8_MMA(1, 0, At, B0); PG8_MMA(1, 1, At, B1); PG8_BAR; PG8_SCHED;
            PG8_LDB(B0, 1, 0); PG8_LDB(B1, 1, 1); PG8_SCHED; PG8_LDA(At, 1, 0); PG8_STAGE(PG8_SA(0, 1), a2 + hstepA, voffA);
            PG8_WAIT_V(8); PG8_WAIT_L(0); PG8_BAR; PG8_MMA(0, 0, At, B0); PG8_MMA(0, 1, At, B1); PG8_BAR; PG8_SCHED;
            PG8_LDA(At, 1, 1); PG8_STAGE(PG8_SB(1, 0), b3, voffB); PG8_STAGE(PG8_SB(1, 1), b3 + hstep, voffB); PG8_STAGE(PG8_SA(1, 0), a3, voffA);
            PG8_WAIT_V(8); PG8_WAIT_L(0); PG8_BAR; PG8_MMA(1, 0, At, B0); PG8_MMA(1, 1, At, B1); PG8_BAR; PG8_SCHED;
            } else {
            PG8_LDB(B0, 0, 0); PG8_SCHED; PG8_LDA(At, 0, 0); PG8_STAGE(PG8_SA(1, 1), a1 + hstepA, voffA);
            PG8_WAIT_L(8); PG8_BAR; PG8_WAIT_L(0); PG8_MMA(0, 0, At, B0); PG8_BAR; PG8_SCHED;
            PG8_LDB(B1, 0, 1); PG8_STAGE(PG8_SB(0, 0), b2, voffB);
            PG8_BAR; PG8_WAIT_L(0); PG8_MMA(0, 1, At, B1); PG8_BAR;
            PG8_LDA(At, 0, 1); PG8_STAGE(PG8_SA(0, 0), a2, voffA);
            PG8_BAR; PG8_WAIT_L(0); PG8_MMA(1, 0, At, B0); PG8_BAR; PG8_SCHED;
            PG8_STAGE(PG8_SB(0, 1), b2 + hstep, voffB);
            PG8_WAIT_V(6); PG8_BAR; PG8_MMA(1, 1, At, B1); PG8_BAR;
            PG8_LDB(B0, 1, 0); PG8_SCHED; PG8_LDA(At, 1, 0); PG8_STAGE(PG8_SA(0, 1), a2 + hstepA, voffA);
            PG8_WAIT_L(8); PG8_BAR; PG8_WAIT_L(0); PG8_MMA(0, 0, At, B0); PG8_BAR; PG8_SCHED;
            PG8_LDB(B1, 1, 1); PG8_STAGE(PG8_SB(1, 0), b3, voffB);
            PG8_BAR; PG8_WAIT_L(0); PG8_MMA(0, 1, At, B1); PG8_BAR;
            PG8_LDA(At, 1, 1); PG8_STAGE(PG8_SA(1, 0), a3, voffA);
            PG8_BAR; PG8_WAIT_L(0); PG8_MMA(1, 0, At, B0); PG8_BAR; PG8_SCHED;
            PG8_STAGE(PG8_SB(1, 1), b3 + hstep, voffB);
            PG8_WAIT_V(6); PG8_BAR; PG8_MMA(1, 1, At, B1); PG8_BAR;
            }
        }
        if constexpr (ALIGN_EPI) { if (wr == 0) PG8_BAR; }
        if constexpr (!Epi::AFTER_DRAIN) { E(acc, cur, wr, wc, fr, fq); S.done(cur); }
        if (!has_next) break;
#pragma unroll
        for (int a = 0; a < 2; ++a)
#pragma unroll
            for (int b = 0; b < 2; ++b)
#pragma unroll
                for (int m = 0; m < 4; ++m)
#pragma unroll
                    for (int n = 0; n < 2; ++n) acc[a][b][m][n] = (f32x4){0.f, 0.f, 0.f, 0.f};
        cur = nxt; cA = nA; cB = nB; ++ui;
        if constexpr (ALIGN_EPI) { if (wr == 1) PG8_BAR; }
    }
    PG8_WAIT_V(0);
    if constexpr (!ALIGN_EPI) { if (wr == 0) PG8_BAR; }
    PG8_BAR;
    if constexpr (Epi::AFTER_DRAIN) { E.fused(acc, cur, wr, wc, fr, fq, lds, wid, lane); S.done(cur); }
#undef PG8_SA
#undef PG8_SB
#undef PG8_STAGE
#undef PG8_LDA
#undef PG8_LDB
#undef PG8_MMA
#undef PG8_WAIT_V
#undef PG8_WAIT_L
#undef PG8_BAR
#undef PG8_SCHED
}
}

#ifndef PG8_SP2
#define PG8_SP2 true
#endif
#ifndef PG8_ALIGN
#define PG8_ALIGN true
#endif

constexpr int NWAVES = 8;
constexpr int N_PHASES = 16;
#ifndef MK_N_LAUNCHES
#define MK_N_LAUNCHES 1
#endif
constexpr int N_LAUNCHES = MK_N_LAUNCHES;

constexpr int D = 2048, M = 65536, NIN = 10496;
constexpr int LP = 16384, LS = 2048;
constexpr int DS5 = 1024, DRW = 1024, DRWIN = 3328;
constexpr float RMS_EPS = 1e-6f, GN_EPS = 64e-5f, L2_EPS = 1e-12f;

constexpr size_t MiB = 1u << 20;
constexpr size_t WS_CTL = 0, CTL_ZERO_BYTES = 128 * 1024;
constexpr size_t WS_ZROW = 96 * 1024;
constexpr size_t WS_WT = 1 * MiB;
constexpr size_t WS_TWB = 1 * MiB;
constexpr size_t WS_GLUT = 42 * MiB;
constexpr size_t WS_S5OT = 44 * MiB;
constexpr size_t WS_RWOT = 48 * MiB;
constexpr size_t WS_WOT = 52 * MiB;
constexpr size_t WS_HN = 60 * MiB;
constexpr size_t WS_RWIN = 316 * MiB;
constexpr size_t WS_Z = 732 * MiB;
constexpr size_t WS_LUT = 860 * MiB;
constexpr size_t WS_STATE = 862 * MiB;
constexpr size_t WS_S5TAB = 872 * MiB;
constexpr size_t WS_S5XL = 882 * MiB;
constexpr size_t WS_S5W2 = 946 * MiB;
constexpr size_t WS_S5E = 994 * MiB;
constexpr size_t WS_ZG = 882 * MiB;
constexpr size_t WS_XA0 = 1010 * MiB;
constexpr size_t WS_XA1 = 879 * MiB;
constexpr int XA_SPLIT = 57344;
constexpr size_t WS_END = 1024 * MiB;
constexpr size_t DO_YF = 0, DO_YB = 128 * MiB, DO_A2 = 256 * MiB, DO_INT = 256 * MiB, DO_Q = 256 * MiB;
constexpr int CW_BAR = 4096;
constexpr int CW_QUEUE = 16384;

constexpr int LDS_BYTES = 147456;
constexpr int MISC_OFF = LDS_BYTES - 512;
constexpr int WAVE_SCR = 18176;
static_assert(NWAVES * WAVE_SCR <= MISC_OFF && pg8::STAGE_BYTES <= MISC_OFF, "LDS map");

#define GAS __attribute__((address_space(1)))
#define LAS __attribute__((address_space(3)))
typedef unsigned short bf16;
typedef unsigned v4u __attribute__((ext_vector_type(4)));
typedef unsigned v2u __attribute__((ext_vector_type(2)));
typedef float f32x4 __attribute__((ext_vector_type(4)));
#define LDS_WAIT() asm volatile("s_waitcnt lgkmcnt(0)" ::: "memory")
#define VM_WAIT() asm volatile("s_waitcnt vmcnt(0)" ::: "memory")
typedef __bf16 mk_bf2 __attribute__((ext_vector_type(2)));
typedef float mk_f2 __attribute__((ext_vector_type(2)));
__device__ __forceinline__ unsigned pk2(float lo, float hi) { const mk_f2 v = {lo, hi}; return __builtin_bit_cast(unsigned, __builtin_convertvector(v, mk_bf2)); }
__device__ __forceinline__ unsigned f2bf(float f) { return pk2(f, f) & 0xffffu; }
__device__ __forceinline__ float bf2f(bf16 b) { return __uint_as_float(((unsigned)b) << 16); }
__device__ __forceinline__ float blo(unsigned u) { return __uint_as_float(u << 16); }
__device__ __forceinline__ float bhi(unsigned u) { return __uint_as_float(u & 0xffff0000u); }
__device__ __forceinline__ float wave_sum(float v) {
#pragma unroll
    for (int o = 1; o < 64; o <<= 1) v += __shfl_xor(v, o);
    return v;
}
__device__ __forceinline__ float sigm(float v) { return __builtin_amdgcn_rcpf(1.0f + __expf(-v)); }
__device__ __forceinline__ float gelu_tanh(float x) { const float u = 0.7978845608028654f * (x + 0.044715f * x * x * x); return 0.5f * x * (1.0f + tanhf(u)); }

#define XB_TMO      128
#define XB_XCNT(j)  (256  + 64 * (j))
#define XB_XSUB(j)  (1280 + 64 * (j))
#define XB_XGEN(j)  (2304 + 64 * (j))
#define XB_TOP      3328
#define XB_TOPGEN   3392
#define XCD_BAR_WORDS 3456
#define XB_SPIN_CAP (1u << 18)

__device__ __forceinline__ unsigned xb_ld(unsigned* p)              { return __hip_atomic_load(p, __ATOMIC_RELAXED, __HIP_MEMORY_SCOPE_AGENT); }
__device__ __forceinline__ unsigned xb_add(unsigned* p, unsigned v) { return __hip_atomic_fetch_add(p, v, __ATOMIC_RELAXED, __HIP_MEMORY_SCOPE_AGENT); }
__device__ __forceinline__ unsigned xb_xcc_id() { return (unsigned)__builtin_amdgcn_s_getreg((3 << 11) | 20) & 0xFu; }
#define XB_SPIN(cond, bar) do { unsigned _sp = 0; while (cond) { __builtin_amdgcn_s_sleep(1); \
    if ((++_sp & 255u) == 0u) { if (xb_ld(&(bar)[XB_TMO])) break; if (_sp > XB_SPIN_CAP) { atomicAdd(&(bar)[XB_TMO], 1u); break; } } } } while (0)

struct XcdBarrier {
    unsigned* bar; unsigned x;
    volatile LAS unsigned* st;
};

__device__ __forceinline__ XcdBarrier xcd_barrier_post(unsigned* bar, volatile LAS unsigned* st, const int mk_wave) {
    XcdBarrier b; b.bar = bar; b.x = xb_xcc_id(); b.st = st;
    if (mk_wave == 0 && mk_lane() == 0) (void)xb_add(&bar[XB_XCNT(b.x)], 1u);
    return b;
}
__device__ __forceinline__ void xcd_barrier_complete(unsigned* bar, unsigned x, unsigned& nloc, unsigned& nx) {
    const unsigned G = gridDim.x * gridDim.y * gridDim.z;
    unsigned sum, cnt, mine, sp = 0u;
    for (;;) {
        sum = 0u; cnt = 0u; mine = 0u;
#pragma unroll
        for (unsigned j = 0; j < 16; ++j) { const unsigned c = xb_ld(&bar[XB_XCNT(j)]); sum += c; cnt += (c > 0u) ? 1u : 0u; mine = (j == x) ? c : mine; }
        if (sum == G) break;
        __builtin_amdgcn_s_sleep(1);
        if ((++sp & 255u) == 0u) { if (xb_ld(&bar[XB_TMO])) break; if (sp > XB_SPIN_CAP) { atomicAdd(&bar[XB_TMO], 1u); break; } }
    }
    nloc = mine > 0u ? mine : 1u; nx = cnt > 0u ? cnt : 1u;
}

__device__ __forceinline__ void xcd_barrier(const XcdBarrier& b, const int mk_wave) {
    asm volatile("s_waitcnt vmcnt(0)" ::: "memory");
    __syncthreads();
    if (mk_wave == 0 && mk_lane() == 0) {
        unsigned* bar = b.bar;
        __builtin_amdgcn_s_waitcnt(0);
        unsigned nloc = b.st[0], nx = b.st[1];
        if (nloc == 0u) { xcd_barrier_complete(bar, b.x, nloc, nx); b.st[0] = nloc; b.st[1] = nx; }
        const unsigned old = xb_add(&bar[XB_XSUB(b.x)], 1u);
        const unsigned gen = old / nloc;
        if (old + 1u == (gen + 1u) * nloc) {
            __builtin_amdgcn_fence(__ATOMIC_RELEASE, "agent");
            asm volatile("s_waitcnt vmcnt(0)" ::: "memory");
            const unsigned og = xb_add(&bar[XB_TOP], 1u);
            const unsigned tg = og / nx;
            if (og + 1u == (tg + 1u) * nx) xb_add(&bar[XB_TOPGEN], 1u);
            else XB_SPIN(xb_ld(&bar[XB_TOPGEN]) == tg, bar);
            __builtin_amdgcn_fence(__ATOMIC_ACQUIRE, "agent");
            xb_add(&bar[XB_XGEN(b.x)], 1u);
            asm volatile("s_waitcnt vmcnt(0)" ::: "memory");
        } else {
            XB_SPIN(xb_ld(&bar[XB_XGEN(b.x)]) == gen, bar);
            __builtin_amdgcn_fence(__ATOMIC_ACQUIRE, "agent");
            asm volatile("s_waitcnt vmcnt(0)" ::: "memory");
        }
    }
    __syncthreads();
}


struct Args { const float* in[27]; float* out; unsigned char* ws; int ph_lo, ph_hi, li, pad; };

namespace rwk {
typedef short s16x4 __attribute__((ext_vector_type(4)));
typedef short s16x8 __attribute__((ext_vector_type(8)));
constexpr int NSEG = 8;
constexpr int UNITS_PER_SEG = 4096;
constexpr int LDW = 72;
constexpr int MATB = 64 * LDW * 2;
constexpr int O_AB = 0, O_BT = 1 * MATB, O_KT = 2 * MATB, O_RB = 3 * MATB, O_BHT = 4 * MATB, O_KHT = 5 * MATB, O_VT = 6 * MATB;
constexpr int O_MAB = 7 * MATB, O_MAK = 8 * MATB, O_NRB = 9 * MATB, O_NRK = 10 * MATB, O_XT = 11 * MATB  , O_NP = 13 * MATB, O_GT = 14 * MATB;
constexpr int O_TW = O_MAB, O_XA = O_MAK;
constexpr int LDC = 68;
constexpr int O_CL = O_NRB, O_AS = O_NRB + 64 * LDC * 4;
constexpr int NPS = 24;
static_assert(O_AS + 64 * LDC * 4 <= O_NP && O_GT + 256 <= 146944, "rwkv LDS map");
constexpr size_t UNIT_ELEMS = 16384;

__device__ __forceinline__ f32x4 mfma32(s16x8 a, s16x8 b, f32x4 c) { return __builtin_amdgcn_mfma_f32_16x16x32_bf16(a, b, c, 0, 0, 0); }
__device__ __forceinline__ f32x4 mfma16(s16x4 a, s16x4 b, f32x4 c) { return __builtin_amdgcn_mfma_f32_16x16x16bf16_1k(a, b, c, 0, 0, 0); }
__device__ __forceinline__ s16x4 pack4(f32x4 v) { v2u p; p.x = pk2(v[0], v[1]); p.y = pk2(v[2], v[3]); return __builtin_bit_cast(s16x4, p); }
__device__ __forceinline__ f32x4 unpack4(v2u p) { return (f32x4){blo(p.x), bhi(p.x), blo(p.y), bhi(p.y)}; }
__device__ __forceinline__ void up8(v4u a, float (&o)[8]) { o[0] = blo(a.x); o[1] = bhi(a.x); o[2] = blo(a.y); o[3] = bhi(a.y); o[4] = blo(a.z); o[5] = bhi(a.z); o[6] = blo(a.w); o[7] = bhi(a.w); }
__device__ __forceinline__ v4u pk8(const float (&v)[8]) { v4u a; a.x = pk2(v[0], v[1]); a.y = pk2(v[2], v[3]); a.z = pk2(v[4], v[5]); a.w = pk2(v[6], v[7]); return a; }

constexpr int O_MU = 131072;
static_assert(O_MU + 3328 * 4 <= 146944, "rwkv LDS map (mu)");
__device__ __forceinline__ int swz_chunk(int row, int tc) { return (row * LDW + ((tc ^ ((row >> 3) & 7)) << 3)) * 2; }
__device__ __forceinline__ float tanh_fast(float x) { return 1.0f - 2.0f * __builtin_amdgcn_rcpf(1.0f + __expf(2.0f * x)); }
__device__ __forceinline__ mk_f2 upf2(unsigned w) { return (mk_f2){blo(w), bhi(w)}; }
__device__ __forceinline__ v4u pk8v(const mk_f2 (&v)[4]) { v4u a; a.x = pk2(v[0].x, v[0].y); a.y = pk2(v[1].x, v[1].y); a.z = pk2(v[2].x, v[2].y); a.w = pk2(v[3].x, v[3].y); return a; }
struct RawUnit { v4u cur[5], prv[5], nxt[5]; f32x4 kk0, kk1, ka0, ka1, rk0, rk1; s16x8 lb0, lb1; float bias; };
struct UnitId { int h, d, base, L, gchunk, chain; };
__device__ __forceinline__ UnitId decode_unit(int seg, int u) {
    UnitId o; int c, jc, nch;
    if (u < 2048) { c = u >> 5; jc = u & 31; nch = 32; } else { c = 64 + ((u - 2048) >> 2); jc = (u - 2048) & 3; nch = 4; }
    int s, rem; if (c < 64) { s = c >> 5; rem = c & 31; } else { s = 2 + ((c - 64) >> 5); rem = (c - 64) & 31; }
    o.h = rem >> 1; o.d = rem & 1; o.base = s < 2 ? s * LP : 32768 + (s - 2) * LS; o.L = s < 2 ? LP : LS; o.gchunk = seg * nch + jc; o.chain = c;
    return o;
}
__device__ __forceinline__ int unit_of(int chain, int jc) { return chain < 64 ? chain * 32 + jc : 2048 + (chain - 64) * 4 + jc; }
constexpr int QUNITS = 128;
__device__ __forceinline__ int unit_from_queue(int q, int i) { return i < 64 ? unit_of((i >> 5) * 32 + q, i & 31) : unit_of(64 + ((i - 64) >> 2) * 32 + q, (i - 64) & 3); }

template <bool WITH_WEIGHTS> __device__ __forceinline__ void rw_load_unit(const Args& a, unsigned char* ws, int seg, int u, int wave, int lane, RawUnit& R) {
    const UnitId id = decode_unit(seg, u);
    const int h = id.h, d = id.d, tid = wave * 64 + lane, t = tid >> 3, cg = tid & 7;
    const int pos = d ? id.L - 1 - 64 * id.gchunk - t : 64 * id.gchunk + t;
    const unsigned rowA = (unsigned)WS_RWIN + (unsigned)(id.base + pos) * (unsigned)(DRWIN * 2) + (unsigned)(h * 128 + 2048) + 16u * (unsigned)cg;
    const unsigned zA = (unsigned)WS_ZROW + 2048u + 16u * (unsigned)cg;
    const unsigned prvA = pos > 0 ? rowA - (unsigned)(DRWIN * 2) : zA, nxtA = pos < id.L - 1 ? rowA + (unsigned)(DRWIN * 2) : zA;
    const unsigned twoff = (unsigned)WS_TWB + (unsigned)(id.base + pos) * 256u + (unsigned)(d * 128) + 16u * (unsigned)cg;
    const unsigned xaoff = (id.base < XA_SPLIT ? (unsigned)WS_XA0 : (unsigned)WS_XA1 - (unsigned)XA_SPLIT * 256u) + (unsigned)(id.base + pos) * 256u + (unsigned)(d * 128) + 16u * (unsigned)cg;
#define RW_LD(off, imm) (*(const v4u*)(ws + (size_t)(off) + (imm)))
#if defined(PROBE_X) && (PROBE_X & 2)
    R.cur[0] = RW_LD(rowA, -2048); R.cur[1] = RW_LD(rowA, 0); R.cur[2] = RW_LD(rowA, 2048); R.cur[3] = RW_LD(twoff, 0); R.cur[4] = RW_LD(xaoff, 0);
#else
    R.cur[0] = RW_LD(rowA, -2048); R.prv[0] = RW_LD(prvA, -2048); R.nxt[0] = RW_LD(nxtA, -2048);
    R.cur[1] = RW_LD(rowA, 0);     R.prv[1] = RW_LD(prvA, 0);     R.nxt[1] = RW_LD(nxtA, 0);
    R.cur[2] = RW_LD(rowA, 2048);  R.prv[2] = RW_LD(prvA, 2048);  R.nxt[2] = RW_LD(nxtA, 2048);
    R.cur[3] = RW_LD(twoff, 0);
    R.cur[4] = RW_LD(xaoff, 0);
#endif
#undef RW_LD
#if defined(PROBE_X) && (PROBE_X & 1)
    return;
#endif
    if (!WITH_WEIGHTS) return;
    const unsigned wo = (unsigned)(h * 256) + 32u * (unsigned)cg;
    R.kk0 = *(const f32x4*)((const unsigned char*)a.in[20] + (size_t)wo); R.kk1 = *(const f32x4*)((const unsigned char*)a.in[20] + (size_t)wo + 16);
    R.ka0 = *(const f32x4*)((const unsigned char*)a.in[21] + (size_t)wo); R.ka1 = *(const f32x4*)((const unsigned char*)a.in[21] + (size_t)wo + 16);
    R.rk0 = *(const f32x4*)((const unsigned char*)a.in[22] + (size_t)wo); R.rk1 = *(const f32x4*)((const unsigned char*)a.in[22] + (size_t)wo + 16);
    const int r = lane & 15, g = lane >> 4, ct = wave & 3, role = wave >> 2;
    const unsigned lo = (unsigned)WS_LUT + (unsigned)((((role * 2 + d) * 16 + h) * 64 + 16 * ct) * 128) + 128u * (unsigned)r + 16u * (unsigned)g;
    R.lb0 = *(const s16x8*)(ws + (size_t)lo); R.lb1 = *(const s16x8*)(ws + (size_t)lo + 64);
    R.bias = *(const float*)((const unsigned char*)(role ? a.in[18] : a.in[16]) + (size_t)((unsigned)((d * 1024 + h * 64 + 16 * ct) * 4) + 4u * (unsigned)r));
}
template <int NT, int PR> __device__ __forceinline__ void rw_s1_wave(LAS unsigned char* lds, int r, int g, int lane) {
    constexpr int OM = PR ? O_MAK : O_MAB, ON = PR ? O_NRK : O_NRB, OX = PR ? O_KT : O_BT;
    const f32x4 z4 = (f32x4){0.f, 0.f, 0.f, 0.f};
    const int boff = ((16 * NT + r) * LDW + 8 * g) * 2;
    const s16x8 ab0 = *(const LAS s16x8*)(lds + O_AB + boff), ab1 = *(const LAS s16x8*)(lds + O_AB + boff + 64);
    const s16x8 rb0 = *(const LAS s16x8*)(lds + O_RB + boff), rb1 = *(const LAS s16x8*)(lds + O_RB + boff + 64);
    const int xoff = OX + (r * LDW + 8 * g) * 2;
    const int srow = ((16 * NT + r) * LDW + 4 * g) * 2;
    const s16x8 d0 = *(const LAS s16x8*)(lds + xoff + NT * 16 * LDW * 2), d1 = *(const LAS s16x8*)(lds + xoff + NT * 16 * LDW * 2 + 64);
    {
        f32x4 m = mfma32(d0, ab0, z4); m = mfma32(d1, ab1, m);
        f32x4 n = mfma32(d0, rb0, z4); n = mfma32(d1, rb1, n);
#pragma unroll
        for (int i = 0; i < 4; ++i) { const int j = 4 * g + i; m[i] = j < r ? m[i] : 0.f; n[i] = j <= r ? n[i] : 0.f; }
        *(LAS s16x4*)(lds + OM + srow + 32 * NT) = pack4(m);
        *(LAS s16x4*)(lds + ON + srow + 32 * NT) = pack4(n);
        if (PR == 0) {
            f32x4 bn = mfma32(ab0, d0, z4); bn = mfma32(ab1, d1, bn);
#pragma unroll
            for (int i = 0; i < 4; ++i) bn[i] = r < 4 * g + i ? bn[i] : 0.f;
            const s16x4 aN = pack4(m), bN = pack4(bn);
            f32x4 G = m;
#pragma unroll
            for (int i = 0; i < 4; ++i) G[i] += (4 * g + i == r) ? 1.0f : 0.0f;
            f32x4 pb = mfma16(aN, bN, z4), pa = mfma16(bN, aN, z4);
            G = mfma16(pack4(pb), pack4(G), G);
            { const f32x4 pb4 = mfma16(pack4(pa), pack4(pb), z4), pa4 = mfma16(pack4(pb), pack4(pa), z4); pb = pb4; pa = pa4; }
            G = mfma16(pack4(pb), pack4(G), G);
            pb = mfma16(pack4(pa), pack4(pb), z4);
            G = mfma16(pack4(pb), pack4(G), G);
            *(LAS s16x4*)(lds + O_NP + (NT * 64 + lane) * 8) = pack4(G);
        }
    }
#pragma unroll
    for (int mt = NT - 1; mt >= (NT == 3 ? 1 : 0); --mt) {
        const s16x8 x0 = *(const LAS s16x8*)(lds + xoff + mt * 16 * LDW * 2), x1 = *(const LAS s16x8*)(lds + xoff + mt * 16 * LDW * 2 + 64);
        f32x4 m = mfma32(x0, ab0, z4); m = mfma32(x1, ab1, m);
        f32x4 n = mfma32(x0, rb0, z4); n = mfma32(x1, rb1, n);
        *(LAS s16x4*)(lds + OM + srow + 32 * mt) = pack4(m);
        *(LAS s16x4*)(lds + ON + srow + 32 * mt) = pack4(n);
    }
#pragma unroll
    for (int mt = NT + 1; mt < 4; ++mt) {
        *(LAS s16x4*)(lds + OM + srow + 32 * mt) = (s16x4){0, 0, 0, 0};
        *(LAS s16x4*)(lds + ON + srow + 32 * mt) = (s16x4){0, 0, 0, 0};
    }
    if (NT == 0) {
        const int b3 = ((48 + r) * LDW + 8 * g) * 2, s3 = ((48 + r) * LDW + 4 * g) * 2;
        const s16x8 a0 = *(const LAS s16x8*)(lds + O_AB + b3), a1 = *(const LAS s16x8*)(lds + O_AB + b3 + 64);
        const s16x8 q0 = *(const LAS s16x8*)(lds + O_RB + b3), q1 = *(const LAS s16x8*)(lds + O_RB + b3 + 64);
        f32x4 m = mfma32(d0, a0, z4); m = mfma32(d1, a1, m);
        f32x4 n = mfma32(d0, q0, z4); n = mfma32(d1, q1, n);
        *(LAS s16x4*)(lds + OM + s3) = pack4(m);
        *(LAS s16x4*)(lds + ON + s3) = pack4(n);
    }
}
__device__ __forceinline__ void rw_tw_prepass(const Args& a, unsigned char* ws, int wv, int nwv, int lane) {
    const int sub = lane >> 4, c16 = lane & 15;
    const float* mu = a.in[15] + 3072 + 8 * c16;
    const f32x4 m0 = *(const f32x4*)mu, m1 = *(const f32x4*)(mu + 4);
    const mk_f2 mv[4] = {(mk_f2){m0[0], m0[1]}, (mk_f2){m0[2], m0[3]}, (mk_f2){m1[0], m1[1]}, (mk_f2){m1[2], m1[3]}};
    const f32x4 a0 = *(const f32x4*)(mu + 128), a1 = *(const f32x4*)(mu + 132);
    const mk_f2 mva[4] = {(mk_f2){a0[0], a0[1]}, (mk_f2){a0[2], a0[3]}, (mk_f2){a1[0], a1[1]}, (mk_f2){a1[2], a1[3]}};
    const v4u z4 = (v4u){0u, 0u, 0u, 0u};
    for (int m4 = wv; m4 < M / 4; m4 += nwv) {
        const int m = 4 * m4 + sub;
        const int pos = m < 32768 ? (m & (LP - 1)) : ((m - 32768) & (LS - 1)), L = m < 32768 ? LP : LS;
        const bf16* row = (const bf16*)(ws + WS_RWIN) + (size_t)m * DRWIN + 3072 + 8 * c16;
        const v4u C = *(const v4u*)row;
        const v4u P = pos > 0 ? *(const v4u*)(row - DRWIN) : z4, N = pos < L - 1 ? *(const v4u*)(row + DRWIN) : z4;
        mk_f2 zw[4];
#pragma unroll
        for (int q = 0; q < 4; ++q) {
            const mk_f2 cc = upf2(C[q]), zz = cc + ((upf2(P[q]) + upf2(N[q])) * 0.5f - cc) * mv[q];
            const mk_f2 e2 = zz * 2.885390081777927f; mk_f2 dn; dn.x = __builtin_amdgcn_exp2f(e2.x); dn.y = __builtin_amdgcn_exp2f(e2.y); dn = dn + 1.0f;
            mk_f2 rc; rc.x = __builtin_amdgcn_rcpf(dn.x); rc.y = __builtin_amdgcn_rcpf(dn.y); zw[q] = 1.0f - rc * 2.0f;
        }
        *(v4u*)((bf16*)(ws + WS_TWB) + (size_t)m * 128 + 8 * c16) = pk8v(zw);
        const v4u C2 = *(const v4u*)(row + 128);
        const v4u P2 = pos > 0 ? *(const v4u*)(row - DRWIN + 128) : z4, N2 = pos < L - 1 ? *(const v4u*)(row + DRWIN + 128) : z4;
        mk_f2 za[4];
#pragma unroll
        for (int q = 0; q < 4; ++q) { const mk_f2 cc = upf2(C2[q]); za[q] = cc + ((upf2(P2[q]) + upf2(N2[q])) * 0.5f - cc) * mva[q]; }
        bf16* xa = m < XA_SPLIT ? (bf16*)(ws + WS_XA0) + (size_t)m * 128 : (bf16*)(ws + WS_XA1) + (size_t)(m - XA_SPLIT) * 128;
        *(v4u*)(xa + 8 * c16) = pk8v(za);
    }
}
__device__ __forceinline__ void rw_pin_unit(RawUnit& R) {
#pragma unroll
    for (int c = 0; c < 5; ++c) { if (c >= 3) asm volatile("" : "+v"(R.cur[c])); else asm volatile("" : "+v"(R.cur[c]), "+v"(R.prv[c]), "+v"(R.nxt[c])); }
    asm volatile("" : "+v"(R.kk0), "+v"(R.kk1), "+v"(R.ka0), "+v"(R.ka1), "+v"(R.rk0), "+v"(R.rk1), "+v"(R.lb0), "+v"(R.lb1), "+v"(R.bias));
}
__device__ __forceinline__ void rw_precompute_unit(const Args& a, unsigned char* ws, LAS unsigned char* lds, int seg, int q, int qi, int qnext, int wave, int lane, RawUnit& R, volatile LAS unsigned* qslot, unsigned qval, int& unext) {
    const int u = unit_from_queue(q, qi);
    const UnitId id = decode_unit(seg, u);
    const int h = id.h, d = id.d;
    const int tid = wave * 64 + lane;
    const int r = lane & 15, g = lane >> 4;
#ifndef RP_S0
#define RP_S0 1
#endif
#ifndef RQ_A
#define RQ_A 1
#endif
#ifndef RQ_B
#define RQ_B 1
#endif
#ifndef RQ_C
#define RQ_C 1
#endif
#ifndef RQ_1
#define RQ_1 1
#endif
#ifndef RQ_23
#define RQ_23 1
#endif
#ifndef RQ_4
#define RQ_4 1
#endif
#ifndef RP_S1
#define RP_S1 1
#endif
    const int t = tid >> 3, cg = tid & 7, c8 = h * 64 + 8 * cg;
    _Pragma("unroll 1") for (int rp0_ = 0; rp0_ < RP_S0; ++rp0_) {
#ifdef PROBE_USPIN
    if (wave == 0 && lane == 0) { const unsigned long long t0_ = __builtin_amdgcn_s_memrealtime(); while (__builtin_amdgcn_s_memrealtime() - t0_ < (unsigned long long)PROBE_USPIN) __builtin_amdgcn_s_sleep(2); }
#endif
    mk_f2 zr[4], zk[4], kk[4], zv[4];
    _Pragma("unroll 1") for (int rq_RQ_A = 0; rq_RQ_A < RQ_A; ++rq_RQ_A) {
    {
        const LAS float* mu = (const LAS float*)(lds + O_MU);
#pragma unroll
        for (int comp = 0; comp < 5; ++comp) {
            if (comp >= 3) continue;
            const int col = comp < 3 ? comp * 1024 + c8 : (comp == 3 ? 3072 + d * 64 + 8 * cg : 3200 + d * 64 + 8 * cg);
            const f32x4 m0 = *(const LAS f32x4*)(mu + col), m1 = *(const LAS f32x4*)(mu + col + 4);
            const mk_f2 mv[4] = {(mk_f2){m0[0], m0[1]}, (mk_f2){m0[2], m0[3]}, (mk_f2){m1[0], m1[1]}, (mk_f2){m1[2], m1[3]}};
            const v4u C = R.cur[comp], P = R.prv[comp], N = R.nxt[comp];
#pragma unroll
            for (int q = 0; q < 4; ++q) {
                const mk_f2 cc = upf2(C[q]), zz = cc + ((upf2(P[q]) + upf2(N[q])) * 0.5f - cc) * mv[q];
                if (comp == 0) zr[q] = zz; else if (comp == 1) zk[q] = zz; else zv[q] = zz;
            }
        }
        if (d == 0) {
            const mk_f2 rkw[4] = {(mk_f2){R.rk0[0], R.rk0[1]}, (mk_f2){R.rk0[2], R.rk0[3]}, (mk_f2){R.rk1[0], R.rk1[1]}, (mk_f2){R.rk1[2], R.rk1[3]}};
            mk_f2 d2 = zr[0] * zk[0] * rkw[0];
#pragma unroll
            for (int q = 1; q < 4; ++q) d2 = d2 + zr[q] * zk[q] * rkw[q];
            float dot = d2.x + d2.y;
            dot += __shfl_xor(dot, 1); dot += __shfl_xor(dot, 2); dot += __shfl_xor(dot, 4);
            mk_f2 bo[4];
#pragma unroll
            for (int q = 0; q < 4; ++q) bo[q] = zv[q] * dot;
            *(v4u*)((bf16*)(ws + WS_ZG) + (size_t)(id.base + 64 * id.gchunk + t) * DRW + c8) = pk8v(bo);
        }
        const mk_f2 kkw[4] = {(mk_f2){R.kk0[0], R.kk0[1]}, (mk_f2){R.kk0[2], R.kk0[3]}, (mk_f2){R.kk1[0], R.kk1[1]}, (mk_f2){R.kk1[2], R.kk1[3]}};
        mk_f2 s2 = (mk_f2){0.f, 0.f};
#pragma unroll
        for (int q = 0; q < 4; ++q) { kk[q] = zk[q] * kkw[q]; s2 = s2 + kk[q] * kk[q]; }
        float ss = s2.x + s2.y;
        ss += __shfl_xor(ss, 1); ss += __shfl_xor(ss, 2); ss += __shfl_xor(ss, 4);
        const float inv = __builtin_amdgcn_rsqf(ss + L2_EPS);
#pragma unroll
        for (int q = 0; q < 4; ++q) kk[q] = kk[q] * inv;
        *(LAS v4u*)(lds + O_TW + (t * LDW + 8 * cg) * 2) = R.cur[3];
        *(LAS v4u*)(lds + O_XA + (t * LDW + 8 * cg) * 2) = R.cur[4];
    }
#if RP_S0 == 1 && RQ_A == 1
    rw_load_unit<false>(a, ws, seg, unit_from_queue(q, qnext < QUNITS ? qnext : qi), wave, lane, R);
#endif
    __syncthreads();
    }
    _Pragma("unroll 1") for (int rq_RQ_B = 0; rq_RQ_B < RQ_B; ++rq_RQ_B) {
    {
        const int ct = wave & 3, role = wave >> 2;
        const s16x8 b0 = R.lb0, b1 = R.lb1;
        const int aoff = (role ? O_XA : O_TW) + (r * LDW + 8 * g) * 2;
        f32x4 acc[4];
#pragma unroll
        for (int mt = 0; mt < 4; ++mt) {
            const s16x8 a0 = *(const LAS s16x8*)(lds + aoff + mt * 16 * LDW * 2), a1 = *(const LAS s16x8*)(lds + aoff + mt * 16 * LDW * 2 + 64);
            acc[mt] = mfma32(a0, b0, (f32x4){0.f, 0.f, 0.f, 0.f}); acc[mt] = mfma32(a1, b1, acc[mt]);
        }
        const int cch = 16 * ct + r;
        if (role == 0) {
            const float w0v = R.bias;
            float carry = 0.f;
#pragma unroll
            for (int mt = 0; mt < 4; ++mt) {
                float s[4];
#pragma unroll
                for (int i = 0; i < 4; ++i) { const float lw = -0.8750343827198594f * sigm(acc[mt][i] + w0v); s[i] = (i ? s[i - 1] : 0.f) + lw; }
                const float tot = s[3];
                const float e1 = __shfl(tot, (lane + 48) & 63), e2 = __shfl(tot, (lane + 32) & 63), e3 = __shfl(tot, (lane + 16) & 63);
                const float excl = (g >= 1 ? e1 : 0.f) + (g >= 2 ? e2 : 0.f) + (g >= 3 ? e3 : 0.f);
                const float all = __shfl(tot + excl, 48 + r);
#pragma unroll
                for (int i = 0; i < 4; ++i) *(LAS float*)(lds + O_CL + ((16 * mt + 4 * g + i) * LDC + cch) * 4) = carry + excl + s[i];
                carry += all;
            }
            if (g == 0) *(LAS float*)(lds + O_GT + cch * 4) = __builtin_amdgcn_exp2f(carry);
        } else {
            const float a0v = R.bias;
#pragma unroll
            for (int mt = 0; mt < 4; ++mt)
#pragma unroll
                for (int i = 0; i < 4; ++i) *(LAS float*)(lds + O_AS + ((16 * mt + 4 * g + i) * LDC + cch) * 4) = sigm(acc[mt][i] + a0v);
        }
        if (wave == 0 && lane == 0) *qslot = qval;
    }
    __syncthreads();
    }
    _Pragma("unroll 1") for (int rq_RQ_C = 0; rq_RQ_C < RQ_C; ++rq_RQ_C) {
    {
        const f32x4 x0 = *(const LAS f32x4*)(lds + O_CL + (t * LDC + 8 * cg) * 4), x1 = *(const LAS f32x4*)(lds + O_CL + (t * LDC + 8 * cg + 4) * 4);
        const f32x4 e0 = *(const LAS f32x4*)(lds + O_GT + (8 * cg) * 4), e1 = *(const LAS f32x4*)(lds + O_GT + (8 * cg + 4) * 4);
        const f32x4 s0 = *(const LAS f32x4*)(lds + O_AS + (t * LDC + 8 * cg) * 4), s1 = *(const LAS f32x4*)(lds + O_AS + (t * LDC + 8 * cg + 4) * 4);
        f32x4 p0 = (f32x4){0.f, 0.f, 0.f, 0.f}, p1 = p0;
        if (t > 0) { p0 = *(const LAS f32x4*)(lds + O_CL + ((t - 1) * LDC + 8 * cg) * 4); p1 = *(const LAS f32x4*)(lds + O_CL + ((t - 1) * LDC + 8 * cg + 4) * 4); }
        const mk_f2 cl[4] = {(mk_f2){x0[0], x0[1]}, (mk_f2){x0[2], x0[3]}, (mk_f2){x1[0], x1[1]}, (mk_f2){x1[2], x1[3]}};
        const mk_f2 clp[4] = {(mk_f2){p0[0], p0[1]}, (mk_f2){p0[2], p0[3]}, (mk_f2){p1[0], p1[1]}, (mk_f2){p1[2], p1[3]}};
        const mk_f2 gte[4] = {(mk_f2){e0[0], e0[1]}, (mk_f2){e0[2], e0[3]}, (mk_f2){e1[0], e1[1]}, (mk_f2){e1[2], e1[3]}};
        const mk_f2 as[4] = {(mk_f2){s0[0], s0[1]}, (mk_f2){s0[2], s0[3]}, (mk_f2){s1[0], s1[1]}, (mk_f2){s1[2], s1[3]}};
        const mk_f2 kaw[4] = {(mk_f2){R.ka0[0], R.ka0[1]}, (mk_f2){R.ka0[2], R.ka0[3]}, (mk_f2){R.ka1[0], R.ka1[1]}, (mk_f2){R.ka1[2], R.ka1[3]}};
        mk_f2 ab[4], bt[4], kt[4], rb[4], bh[4], kh[4];
#pragma unroll
        for (int q = 0; q < 4; ++q) {
            mk_f2 gt, gi, gp;
            gt.x = __builtin_amdgcn_exp2f(cl[q].x); gt.y = __builtin_amdgcn_exp2f(cl[q].y);
            gi.x = __builtin_amdgcn_exp2f(-cl[q].x); gi.y = __builtin_amdgcn_exp2f(-cl[q].y);
            gp.x = __builtin_amdgcn_exp2f(clp[q].x); gp.y = __builtin_amdgcn_exp2f(clp[q].y);
            const mk_f2 ge = gte[q] * gi;
            const mk_f2 kd = zk[q] * ((as[q] - 1.0f) * kaw[q] + 1.0f), kb = kk[q] * as[q];
            ab[q] = -(kk[q] * gp); bt[q] = kb * gi; kt[q] = kd * gi; rb[q] = zr[q] * gt; bh[q] = kb * ge; kh[q] = kd * ge;
        }
        *(LAS v4u*)(lds + O_AB + (t * LDW + 8 * cg) * 2) = pk8v(ab);
        *(LAS v4u*)(lds + O_BT + (t * LDW + 8 * cg) * 2) = pk8v(bt);
        *(LAS v4u*)(lds + O_KT + (t * LDW + 8 * cg) * 2) = pk8v(kt);
        *(LAS v4u*)(lds + O_RB + (t * LDW + 8 * cg) * 2) = pk8v(rb);
#pragma unroll
        for (int q = 0; q < 4; ++q) {
            const unsigned wb = pk2(bh[q].x, bh[q].y), wk = pk2(kh[q].x, kh[q].y), wv = pk2(zv[q].x, zv[q].y);
            const int so0 = swz_chunk(8 * cg + 2 * q, t >> 3) + (t & 7) * 2, so1 = swz_chunk(8 * cg + 2 * q + 1, t >> 3) + (t & 7) * 2;
            *(LAS bf16*)(lds + O_BHT + so0) = (bf16)(wb & 0xffffu); *(LAS bf16*)(lds + O_BHT + so1) = (bf16)(wb >> 16);
            *(LAS bf16*)(lds + O_KHT + so0) = (bf16)(wk & 0xffffu); *(LAS bf16*)(lds + O_KHT + so1) = (bf16)(wk >> 16);
            *(LAS bf16*)(lds + O_VT + so0) = (bf16)(wv & 0xffffu); *(LAS bf16*)(lds + O_VT + so1) = (bf16)(wv >> 16);
        }
    }
    __syncthreads();
    }
    }
    unext = __builtin_amdgcn_readfirstlane((int)*qslot);
#ifndef PROBE_NOLD
#if !(RP_S0 == 1 && RQ_A == 1)
    rw_load_unit<false>(a, ws, seg, unit_from_queue(q, qnext < QUNITS ? qnext : qi), wave, lane, R);
#endif
#endif
    _Pragma("unroll 1") for (int rp1_ = 0; rp1_ < RP_S1; ++rp1_) {
    _Pragma("unroll 1") for (int rq_RQ_1 = 0; rq_RQ_1 < RQ_1; ++rq_RQ_1) {
    switch (wave) {
        case 0: rw_s1_wave<0, 0>(lds, r, g, lane); break;
        case 1: rw_s1_wave<0, 1>(lds, r, g, lane); break;
        case 2: rw_s1_wave<1, 0>(lds, r, g, lane); break;
        case 3: rw_s1_wave<1, 1>(lds, r, g, lane); break;
        case 4: rw_s1_wave<2, 0>(lds, r, g, lane); break;
        case 5: rw_s1_wave<2, 1>(lds, r, g, lane); break;
        case 6: rw_s1_wave<3, 0>(lds, r, g, lane); break;
        default: rw_s1_wave<3, 1>(lds, r, g, lane); break;
    }
    __syncthreads();
    }
    _Pragma("unroll 1") for (int rq_RQ_23 = 0; rq_RQ_23 < RQ_23; ++rq_RQ_23) {
    f32x4 rhs[4];
    if (wave < 4) {
#pragma unroll
        for (int mt = 0; mt < 4; ++mt)
#pragma unroll
            for (int i = 0; i < 4; ++i) rhs[mt][i] = bf2f(*(const LAS bf16*)(lds + O_AB + ((16 * mt + 4 * g + i) * LDW + 16 * wave + r) * 2));
    } else {
        const int vt = wave - 4;
        const s16x8 v0 = *(const LAS s16x8*)(lds + O_VT + swz_chunk(16 * vt + r, g)), v1 = *(const LAS s16x8*)(lds + O_VT + swz_chunk(16 * vt + r, g + 4));
#pragma unroll
        for (int mt = 0; mt < 4; ++mt) {
            const int ao = O_MAK + ((16 * mt + r) * LDW + 8 * g) * 2;
            const s16x8 x0 = *(const LAS s16x8*)(lds + ao), x1 = *(const LAS s16x8*)(lds + ao + 64);
            rhs[mt] = mfma32(x0, v0, (f32x4){0.f, 0.f, 0.f, 0.f}); rhs[mt] = mfma32(x1, v1, rhs[mt]);
        }
    }
    {
        f32x4 xb[4];
#pragma unroll
        for (int bi = 0; bi < 4; ++bi) {
            f32x4 acc = rhs[bi];
#pragma unroll
            for (int bj = 0; bj < 4; ++bj) if (bj < bi) {
                const s16x4 am = *(const LAS s16x4*)(lds + O_MAB + ((16 * bi + r) * LDW + 16 * bj + 4 * g) * 2);
                acc = mfma16(am, pack4(xb[bj]), acc);
            }
            acc = mfma16(*(const LAS s16x4*)(lds + O_NP + (bi * 64 + lane) * 8), pack4(acc), (f32x4){0.f, 0.f, 0.f, 0.f});
            xb[bi] = acc;
            *(LAS s16x4*)(lds + O_XT + ((16 * wave + r) * LDW + 16 * bi + 4 * g) * 2) = pack4(acc);
        }
    }
    __syncthreads();
    }
    _Pragma("unroll 1") for (int rq_RQ_4 = 0; rq_RQ_4 < RQ_4; ++rq_RQ_4) {
    {
        rw_pin_unit(R);
        const int nt = wave & 3;
        bf16* ug = (bf16*)((unsigned char*)a.out + DO_INT + (size_t)(seg & 1) * (128u << 20)) + (size_t)u * UNIT_ELEMS;
        const int boff = ((16 * nt + r) * LDW + 8 * g) * 2;
        const s16x8 u0 = *(const LAS s16x8*)(lds + O_XT + 64 * LDW * 2 + boff), u1 = *(const LAS s16x8*)(lds + O_XT + 64 * LDW * 2 + boff + 64);
        const s16x8 v0 = *(const LAS s16x8*)(lds + O_VT + swz_chunk(16 * nt + r, g)), v1 = *(const LAS s16x8*)(lds + O_VT + swz_chunk(16 * nt + r, g + 4));
        v2u yo[2];
#pragma unroll
        for (int my = 0; my < 2; ++my) {
            const int mt = 2 * (wave >> 2) + my, ro_ = ((16 * mt + r) * LDW + 8 * g) * 2;
            const s16x8 n0 = *(const LAS s16x8*)(lds + O_NRB + ro_), n1 = *(const LAS s16x8*)(lds + O_NRB + ro_ + 64);
            const s16x8 m0 = *(const LAS s16x8*)(lds + O_NRK + ro_), m1 = *(const LAS s16x8*)(lds + O_NRK + ro_ + 64);
            f32x4 y = mfma32(n0, u0, (f32x4){0.f, 0.f, 0.f, 0.f}); y = mfma32(n1, u1, y); y = mfma32(m0, v0, y); y = mfma32(m1, v1, y);
            yo[my] = __builtin_bit_cast(v2u, pack4(y));
        }
#ifdef PROBE_NOST
#define RW_ST(p, v) asm volatile("" :: "v"(v))
#else
#define RW_ST(p, v) (p) = (v)
#endif
        RW_ST(*((v4u*)(ug + 12288 + (size_t)(nt * 64 + lane) * 16) + (wave >> 2)), ((v4u){yo[0].x, yo[0].y, yo[1].x, yo[1].y}));
        if (wave < 4) {
            const s16x8 bh0 = *(const LAS s16x8*)(lds + O_BHT + swz_chunk(16 * nt + r, g)), bh1 = *(const LAS s16x8*)(lds + O_BHT + swz_chunk(16 * nt + r, g + 4));
            const s16x8 nb0 = *(const LAS s16x8*)(lds + O_NRB + boff), nb1 = *(const LAS s16x8*)(lds + O_NRB + boff + 64);
            v2u po[4], ro[4];
#pragma unroll
            for (int mt = 0; mt < 4; ++mt) {
                const int ao = O_XT + ((16 * mt + r) * LDW + 8 * g) * 2;
                const s16x8 x0 = *(const LAS s16x8*)(lds + ao), x1 = *(const LAS s16x8*)(lds + ao + 64);
                f32x4 p = mfma32(x0, bh0, (f32x4){0.f, 0.f, 0.f, 0.f}); p = mfma32(x1, bh1, p);
                if (mt == nt) { const float gt = *(const LAS float*)(lds + O_GT + (16 * mt + r) * 4);
#pragma unroll
                    for (int i = 0; i < 4; ++i) p[i] += (4 * g + i == r) ? gt : 0.f; }
                const f32x4 rbv = unpack4(*(const LAS v2u*)(lds + O_RB + ((16 * nt + r) * LDW + 16 * mt + 4 * g) * 2));
                f32x4 q = mfma32(x0, nb0, rbv); q = mfma32(x1, nb1, q);
                po[mt] = __builtin_bit_cast(v2u, pack4(p)); ro[mt] = __builtin_bit_cast(v2u, pack4(q));
            }
            v4u* pg = (v4u*)(ug + (size_t)(nt * 64 + lane) * 16);
            RW_ST(pg[0], ((v4u){po[0].x, po[0].y, po[1].x, po[1].y})); RW_ST(pg[1], ((v4u){po[2].x, po[2].y, po[3].x, po[3].y}));
            v4u* rg = (v4u*)(ug + 4096 + (size_t)(nt * 64 + lane) * 16);
            RW_ST(rg[0], ((v4u){ro[0].x, ro[0].y, ro[1].x, ro[1].y})); RW_ST(rg[1], ((v4u){ro[2].x, ro[2].y, ro[3].x, ro[3].y}));
        } else {
            v2u qo[4];
#pragma unroll
            for (int mt = 0; mt < 4; ++mt) {
                const int sw0 = swz_chunk(16 * mt + r, g), sw1 = swz_chunk(16 * mt + r, g + 4);
                const s16x8 b0 = *(const LAS s16x8*)(lds + O_BHT + sw0), b1 = *(const LAS s16x8*)(lds + O_BHT + sw1);
                const s16x8 k0 = *(const LAS s16x8*)(lds + O_KHT + sw0), k1 = *(const LAS s16x8*)(lds + O_KHT + sw1);
                f32x4 q = mfma32(b0, u0, (f32x4){0.f, 0.f, 0.f, 0.f}); q = mfma32(b1, u1, q); q = mfma32(k0, v0, q); q = mfma32(k1, v1, q);
                qo[mt] = __builtin_bit_cast(v2u, pack4(q));
            }
            v4u* qg = (v4u*)(ug + 8192 + (size_t)(nt * 64 + lane) * 16);
            RW_ST(qg[0], ((v4u){qo[0].x, qo[0].y, qo[1].x, qo[1].y})); RW_ST(qg[1], ((v4u){qo[2].x, qo[2].y, qo[3].x, qo[3].y}));
        }
    }
    }
    }
}

__device__ __forceinline__ void rw_chain_job(const Args& a, unsigned char* ws, LAS unsigned char* lds, int seg, int chain, int wave, int lane) {
    const int vt = wave & 3;
    LAS unsigned char* cl = lds + (wave >> 2) * 65536;
    int s, rem; if (chain < 64) { s = chain >> 5; rem = chain & 31; } else { s = 2 + ((chain - 64) >> 5); rem = (chain - 64) & 31; }
    const int h = rem >> 1, d = rem & 1, base = s < 2 ? s * LP : 32768 + (s - 2) * LS, L = s < 2 ? LP : LS, nch = chain < 64 ? 32 : 4;
    const int r = lane & 15, g = lane >> 4;
    f32x4* stp = (f32x4*)(ws + WS_STATE) + ((size_t)(chain * 4 + vt) * 4) * 64 + lane;
    f32x4 st[4];
#pragma unroll
    for (int i = 0; i < 4; ++i) st[i] = seg == 0 ? (f32x4){0.f, 0.f, 0.f, 0.f} : stp[i * 64];
#pragma unroll
    for (int i = 0; i < 4; ++i) asm volatile("" : "+v"(st[i]));
    const bf16* ub = (const bf16*)((unsigned char*)a.out + DO_INT + (size_t)(seg & 1) * (128u << 20));
#define RW_DMA(ug, buf) do { LAS unsigned char* b_ = cl + (buf) * 32768; \
        _Pragma("unroll") for (int _i = 0; _i < 4; ++_i) { const int pc_ = 4 * vt + _i; \
            __builtin_amdgcn_global_load_lds((const unsigned*)((ug) + (size_t)((pc_ >> 1) * 64 + lane) * 16 + (pc_ & 1) * 8), (LAS unsigned*)(b_ + pc_ * 1024), 16, 0, 0); } \
        _Pragma("unroll") for (int _i = 0; _i < 4; ++_i) \
            __builtin_amdgcn_global_load_lds((const unsigned*)((ug) + 8192 + (_i >> 1) * 4096 + (size_t)(vt * 64 + lane) * 16 + (_i & 1) * 8), (LAS unsigned*)(b_ + 16384 + vt * 4096 + _i * 1024), 16, 0, 0); } while (0)
    RW_DMA(ub + (size_t)unit_of(chain, 0) * UNIT_ELEMS, 0);
    for (int jc = 0; jc < nch; ++jc) {
#if defined(PROBE_X) && (PROBE_X & 8)
        if (jc == 0) VM_WAIT();
#else
        if (jc == 0) VM_WAIT(); else asm volatile("s_waitcnt vmcnt(16)" ::: "memory");
#endif
        __builtin_amdgcn_s_barrier();
        asm volatile("" ::: "memory");
        if (jc + 1 < nch) RW_DMA(ub + (size_t)unit_of(chain, jc + 1) * UNIT_ELEMS, (jc + 1) & 1);
        const LAS unsigned char* b = cl + (jc & 1) * 32768 + lane * 16;
        v4u pf[4][2], rf[4][2];
#pragma unroll
        for (int i = 0; i < 4; ++i) { pf[i][0] = *(const LAS v4u*)(b + (2 * i) * 1024); pf[i][1] = *(const LAS v4u*)(b + (2 * i + 1) * 1024);
                                      rf[i][0] = *(const LAS v4u*)(b + (8 + 2 * i) * 1024); rf[i][1] = *(const LAS v4u*)(b + (9 + 2 * i) * 1024); }
        const LAS unsigned char* bq = b + 16384 + vt * 4096;
        const v4u cq0 = *(const LAS v4u*)(bq), cq1 = *(const LAS v4u*)(bq + 1024), cy0 = *(const LAS v4u*)(bq + 2048), cy1 = *(const LAS v4u*)(bq + 3072);
        s16x4 sb[4];
#pragma unroll
        for (int kt = 0; kt < 4; ++kt) sb[kt] = pack4(st[kt]);
        const int gchunk = seg * nch + jc;
        const unsigned ystep = d ? 0u - (unsigned)(DRW * 2) : (unsigned)(DRW * 2);
        const unsigned yoff0 = (unsigned)(d ? DO_YB : DO_YF) + (unsigned)(((base + (d ? L - 1 - 64 * gchunk : 64 * gchunk)) * DRW + h * 64 + 16 * vt) * 2) + (unsigned)(4 * g) * ystep + 2u * (unsigned)r;
#pragma unroll
        for (int tt = 0; tt < 4; ++tt) {
            const v2u yi = tt == 0 ? (v2u){cy0.x, cy0.y} : tt == 1 ? (v2u){cy0.z, cy0.w} : tt == 2 ? (v2u){cy1.x, cy1.y} : (v2u){cy1.z, cy1.w};
            f32x4 acc = unpack4(yi);
            acc = mfma16(__builtin_bit_cast(s16x4, (v2u){rf[tt][0].x, rf[tt][0].y}), sb[0], acc);
            acc = mfma16(__builtin_bit_cast(s16x4, (v2u){rf[tt][0].z, rf[tt][0].w}), sb[1], acc);
            acc = mfma16(__builtin_bit_cast(s16x4, (v2u){rf[tt][1].x, rf[tt][1].y}), sb[2], acc);
            acc = mfma16(__builtin_bit_cast(s16x4, (v2u){rf[tt][1].z, rf[tt][1].w}), sb[3], acc);
#pragma unroll
            for (int i = 0; i < 4; ++i) *(bf16*)((unsigned char*)a.out + (size_t)(yoff0 + (unsigned)(16 * tt + i) * ystep)) = (bf16)f2bf(acc[i]);
        }
        f32x4 sn[4];
#pragma unroll
        for (int i = 0; i < 4; ++i) {
            const v2u qi = i == 0 ? (v2u){cq0.x, cq0.y} : i == 1 ? (v2u){cq0.z, cq0.w} : i == 2 ? (v2u){cq1.x, cq1.y} : (v2u){cq1.z, cq1.w};
            f32x4 acc = unpack4(qi);
            acc = mfma16(__builtin_bit_cast(s16x4, (v2u){pf[i][0].x, pf[i][0].y}), sb[0], acc);
            acc = mfma16(__builtin_bit_cast(s16x4, (v2u){pf[i][0].z, pf[i][0].w}), sb[1], acc);
            acc = mfma16(__builtin_bit_cast(s16x4, (v2u){pf[i][1].x, pf[i][1].y}), sb[2], acc);
            acc = mfma16(__builtin_bit_cast(s16x4, (v2u){pf[i][1].z, pf[i][1].w}), sb[3], acc);
            sn[i] = acc;
        }
#pragma unroll
        for (int i = 0; i < 4; ++i) st[i] = sn[i];
    }
#undef RW_DMA
#pragma unroll
    for (int i = 0; i < 4; ++i) stp[i * 64] = st[i];
}
}


namespace s5k {
constexpr int ST = 32, NCH = M / ST, K2 = 768, KU = 512;
constexpr size_t POW_ELEMS = (size_t)128 * 33 * 64 * 2, BB_ELEMS = (size_t)128 * 64 * 16 * 2, KTAB_ELEMS = (size_t)64 * 63 * 256;
__device__ __forceinline__ void tables_group(const Args& a, unsigned char* ws, LAS unsigned char* lds, int g, int quarter, int tid) {
    float* POW = (float*)(ws + WS_S5TAB); float* BB = POW + POW_ELEMS; float* KTAB = BB + BB_ELEMS;
    LAS float* lam = (LAS float*)lds;
    LAS float* bbl = lam + 256;
    LAS float* cl = bbl + 4096;
    LAS float* pwl = cl + 4096;
    __syncthreads();
    if (tid < 128) {
        const int d = tid >> 6, p = tid & 63, gi = d * 64 + g;
        const float lre = a.in[5][gi * 64 + p], lim = a.in[6][gi * 64 + p], dt = expf(a.in[7][gi]);
        const float er = expf(lre * dt); float sn, cs; sincosf(lim * dt, &sn, &cs);
        const float lbr = er * cs, lbi = er * sn;
        const float nr = lbr - 1.0f, ni = lbi, den = lre * lre + lim * lim;
        const float cfr = (nr * lre + ni * lim) / den, cfi = (ni * lre - nr * lim) / den;
        lam[(d * 64 + p) * 2] = lre * dt; lam[(d * 64 + p) * 2 + 1] = lim * dt;
        for (int h = 0; h < 16; ++h) {
            const float br = a.in[8][((size_t)gi * 64 + p) * 16 + h], bi = a.in[9][((size_t)gi * 64 + p) * 16 + h];
            const float xr = cfr * br - cfi * bi, xi = cfr * bi + cfi * br;
            bbl[((d * 64 + p) * 16 + h) * 2] = xr; bbl[((d * 64 + p) * 16 + h) * 2 + 1] = xi;
            if (quarter == 0) { BB[(((size_t)gi * 64 + p) * 16 + h) * 2] = xr; BB[(((size_t)gi * 64 + p) * 16 + h) * 2 + 1] = xi; }
            cl[((d * 16 + h) * 64 + p) * 2] = a.in[10][((size_t)gi * 16 + h) * 64 + p]; cl[((d * 16 + h) * 64 + p) * 2 + 1] = a.in[11][((size_t)gi * 16 + h) * 64 + p];
        }
    }
    __syncthreads();
    for (int e = tid; e < 2 * 33 * 64; e += NWAVES * 64) {
        const int p = e & 63, tau = (e >> 6) % 33, d = e / (33 * 64), gi = d * 64 + g;
        const float er = expf(lam[(d * 64 + p) * 2] * (float)tau); float sn, cs; sincosf(lam[(d * 64 + p) * 2 + 1] * (float)tau, &sn, &cs);
        pwl[e * 2] = er * cs; pwl[e * 2 + 1] = er * sn;
        if (quarter == 0) { POW[(((size_t)gi * 33 + tau) * 64 + p) * 2] = er * cs; POW[(((size_t)gi * 33 + tau) * 64 + p) * 2 + 1] = er * sn; }
    }
    __syncthreads();
    for (int o = quarter * (NWAVES * 64) + tid; o < 63 * 256; o += 4 * NWAVES * 64) {
        const int hh = o & 255, h = hh >> 4, h2 = hh & 15, lag = (o >> 8) - 31;
        float acc = 0.f;
#pragma unroll
        for (int d = 0; d < 2; ++d) {
            if ((d == 0 && lag >= 0) || (d == 1 && lag <= 0)) {
                const int tau = lag >= 0 ? lag : -lag;
                for (int p = 0; p < 64; ++p) {
                    const float cr = cl[((d * 16 + h) * 64 + p) * 2], ci = cl[((d * 16 + h) * 64 + p) * 2 + 1];
                    const float pr = pwl[((d * 33 + tau) * 64 + p) * 2], pi = pwl[((d * 33 + tau) * 64 + p) * 2 + 1];
                    const float br = bbl[((d * 64 + p) * 16 + h2) * 2], bi = bbl[((d * 64 + p) * 16 + h2) * 2 + 1];
                    const float qr = pr * br - pi * bi, qi = pr * bi + pi * br;
                    acc += cr * qr - ci * qi;
                }
            }
        }
        KTAB[(size_t)g * 63 * 256 + o] = acc;
    }
    __syncthreads();
}
__device__ __forceinline__ void fill_weights(const Args& a, unsigned char* ws, int gw, int NGW, int lane, int part) {
    const float* POW = (const float*)(ws + WS_S5TAB); const float* BB = POW + POW_ELEMS; const float* KTAB = BB + BB_ELEMS;
    bf16* W2 = (bf16*)(ws + WS_S5W2); bf16* E = (bf16*)(ws + WS_S5E);
    const size_t n_w2 = (size_t)64 * 512 * 96, n_e = (size_t)64 * 256 * 64, stride = (size_t)NGW * 64;
    const size_t it0 = part ? 0 : n_w2, it1 = part ? n_w2 : n_w2 + n_e;
    for (size_t it = it0 + (size_t)gw * 64 + lane; it < it1; it += stride) {
        float v[8];
        if (it < n_w2) {
            const int kc = (int)(it % 96), n = (int)((it / 96) % 512), g = (int)(it / (96 * 512)), t = n >> 4, h = n & 15, k0 = kc * 8;
            if (k0 < KU) {
                const int s = k0 >> 4, h0 = k0 & 15, lag = t - s;
                const float* kt = KTAB + ((size_t)(g * 63 + lag + 31) * 16 + h) * 16 + h0;
#pragma unroll
                for (int j = 0; j < 8; ++j) v[j] = kt[j] + ((lag == 0 && h0 + j == h) ? a.in[12][g * 16 + h] : 0.f);
            } else {
                const int kk = k0 - KU, d = kk >> 7, ri = (kk >> 6) & 1, p0 = kk & 63, gi = d * 64 + g, tau = d == 0 ? t + 1 : ST - t;
#pragma unroll
                for (int j = 0; j < 8; ++j) {
                    const int p = p0 + j;
                    const float cr = a.in[10][((size_t)gi * 16 + h) * 64 + p], ci = a.in[11][((size_t)gi * 16 + h) * 64 + p];
                    const float pr = POW[(((size_t)gi * 33 + tau) * 64 + p) * 2], pi = POW[(((size_t)gi * 33 + tau) * 64 + p) * 2 + 1];
                    v[j] = ri == 0 ? (cr * pr - ci * pi) : -(cr * pi + ci * pr);
                }
            }
            *(v4u*)(W2 + ((size_t)(g * 512 + n)) * K2 + k0) = rwk::pk8(v);
        } else {
            const size_t ie = it - n_w2;
            const int kc = (int)(ie % 64), n = (int)((ie / 64) % 256), g = (int)(ie / (64 * 256)), d = n >> 7, ri = (n >> 6) & 1, p = n & 63, gi = d * 64 + g;
            const int k0 = kc * 8, s = k0 >> 4, h0 = k0 & 15, tau = d == 0 ? ST - 1 - s : s;
            const float pr = POW[(((size_t)gi * 33 + tau) * 64 + p) * 2], pi = POW[(((size_t)gi * 33 + tau) * 64 + p) * 2 + 1];
#pragma unroll
            for (int j = 0; j < 8; ++j) {
                const float br = BB[(((size_t)gi * 64 + p) * 16 + h0 + j) * 2], bi = BB[(((size_t)gi * 64 + p) * 16 + h0 + j) * 2 + 1];
                v[j] = ri == 0 ? (pr * br - pi * bi) : (pr * bi + pi * br);
            }
            *(v4u*)(E + ((size_t)(g * 256 + n)) * KU + k0) = rwk::pk8(v);
        }
    }
}
__device__ __forceinline__ void chain_job(unsigned char* ws, bf16* A2, int job, int lane) {
    int s, rem; if (job < 256) { s = job / 128; rem = job % 128; } else { s = 2 + (job - 256) / 128; rem = (job - 256) % 128; }
    const int g = rem >> 1, d = rem & 1, p = lane, gi = d * 64 + g;
    const int c0 = s < 2 ? s * (LP / ST) : 2 * (LP / ST) + (s - 2) * (LS / ST), nc = s < 2 ? LP / ST : LS / ST;
    const float* POW = (const float*)(ws + WS_S5TAB);
    const float lr = POW[(((size_t)gi * 33 + 32) * 64 + p) * 2], li = POW[(((size_t)gi * 33 + 32) * 64 + p) * 2 + 1];
    const bf16* XL = (const bf16*)(ws + WS_S5XL);
    const int step = d ? -1 : 1, cfirst = d ? c0 + nc - 1 : c0;
    const int xcol = d * 128 + p, scol = KU + d * 128 + p;
    float xr = 0.f, xi = 0.f;
    { bf16* row = A2 + ((size_t)g * NCH + cfirst) * K2 + scol; row[0] = 0; row[64] = 0; }
    for (int n = 0; n < nc; n += 32) {
        float lr_[32], li_[32];
#pragma unroll
        for (int j = 0; j < 32; ++j) { const bf16* xrow = XL + ((size_t)g * NCH + cfirst + (n + j) * step) * 256 + xcol; lr_[j] = bf2f(xrow[0]); li_[j] = bf2f(xrow[64]); }
#pragma unroll
        for (int j = 0; j < 32; ++j) {
            const float nr = lr * xr - li * xi + lr_[j], ni = lr * xi + li * xr + li_[j]; xr = nr; xi = ni;
            if (n + j + 1 < nc) { bf16* row = A2 + ((size_t)g * NCH + cfirst + (n + j + 1) * step) * K2 + scol; row[0] = (bf16)f2bf(xr); row[64] = (bf16)f2bf(xi); }
        }
    }
}
}
namespace pg8 {
struct S5Order {
    int G, c, nun, mode;
    __device__ bool next(int i, Unit& u) const {
        const int L = i * G + c; if (L >= nun) return false;
        if (mode == 1) { u.pm = L; u.pn = L >> 3; } else { const int g = L >> 4; u.pm = g * 8 + ((L & 15) >> 1); u.pn = g * 2 + (L & 1); }
        return true;
    }
    __device__ __forceinline__ void a_ready(const Unit&) const {}
    __device__ __forceinline__ void done(const Unit&) const {}
};
struct WrapOrder : StaticOrder { int wrap; __device__ bool next(int i, Unit& u) const { const bool ok = StaticOrder::next(i, u); u.pm &= wrap; return ok; } };
struct EpiNull { static constexpr bool PERM = true, AFTER_DRAIN = false;
    __device__ __forceinline__ void operator()(const f32x4 (&acc)[2][2][4][2], const Unit& u, int wr, int wc, int fr, int fq) const {
#pragma unroll
        for (int a = 0; a < 2; ++a)
#pragma unroll
            for (int b = 0; b < 2; ++b)
#pragma unroll
                for (int m = 0; m < 4; ++m)
#pragma unroll
                    for (int n = 0; n < 2; ++n) asm volatile("" :: "v"(acc[a][b][m][n]));
    } };
struct EpiS5X {
    static constexpr bool PERM = true, AFTER_DRAIN = false;
    bf16_t* O;
    __device__ __forceinline__ void operator()(const f32x4 (&acc)[2][2][4][2], const Unit& u, int wr, int wc, int fr, int fq) const {
        const int row0 = u.pm * BM + wr * 64 + fr, col0 = wc * 32 + 8 * fq;
#pragma unroll
        for (int ai = 0; ai < 2; ++ai)
#pragma unroll
            for (int m = 0; m < 4; ++m) { bf16_t* rowp = O + (size_t)(row0 + ai * HALF + m * 16) * 256 + col0;
#pragma unroll
                for (int bj = 0; bj < 2; ++bj) { const f32x4 v0 = acc[ai][bj][m][0], v1 = acc[ai][bj][m][1];
                    u32x4 w; w.x = cvt_pk_bf16(v0[0], v0[1]); w.y = cvt_pk_bf16(v0[2], v0[3]); w.z = cvt_pk_bf16(v1[0], v1[1]); w.w = cvt_pk_bf16(v1[2], v1[3]);
                    *(u32x4*)(rowp + bj * HALF) = w; } }
    }
};
struct EpiS5Y {
    static constexpr bool PERM = true, AFTER_DRAIN = false;
    bf16_t* Zp;
    __device__ __forceinline__ void operator()(const f32x4 (&acc)[2][2][4][2], const Unit& u, int wr, int wc, int fr, int fq) const {
        const int row0 = u.pm * BM + wr * 64 + fr, col0 = (u.pn & 1) * BM + wc * 32 + 8 * fq;
#pragma unroll
        for (int ai = 0; ai < 2; ++ai)
#pragma unroll
            for (int m = 0; m < 4; ++m) {
                const int row = row0 + ai * HALF + m * 16, g = row >> 11, c = row & 2047;
#pragma unroll
                for (int bj = 0; bj < 2; ++bj) {
                    const int col = col0 + bj * HALF, t = col >> 4, h0 = col & 15;
                    float v[8];
#pragma unroll
                    for (int j = 0; j < 4; ++j) { v[j] = acc[ai][bj][m][0][j]; v[4 + j] = acc[ai][bj][m][1][j]; }
#pragma unroll
                    for (int j = 0; j < 8; ++j) { const float x = v[j]; v[j] = x * sigmoid_f(1.5957691216057308f * (x + 0.044715f * x * x * x)); }
                    u32x4 w; w.x = cvt_pk_bf16(v[0], v[1]); w.y = cvt_pk_bf16(v[2], v[3]); w.z = cvt_pk_bf16(v[4], v[5]); w.w = cvt_pk_bf16(v[6], v[7]);
                    *(u32x4*)(Zp + (size_t)(c * 32 + t) * 1024 + g * 16 + h0) = w;
                }
            }
    }
};
}


__device__ __forceinline__ void transpose_item(const float* W, int ldw, int K, bf16* WT, int drow0, LAS float* scr, int k0, int n0, int lane) {
#pragma unroll 8
    for (int i = 0; i < 32; ++i) { const int kk = 2 * i + (lane >> 5); scr[kk * 33 + (lane & 31)] = W[(size_t)(k0 + kk) * ldw + n0 + (lane & 31)]; }
    LDS_WAIT();
    const int c = lane & 7;
#pragma unroll
    for (int j = 0; j < 4; ++j) { const int n = (lane >> 3) + 8 * j; const LAS float* s = scr + (8 * c) * 33 + n;
        v4u o; o.x = pk2(s[0 * 33], s[1 * 33]); o.y = pk2(s[2 * 33], s[3 * 33]); o.z = pk2(s[4 * 33], s[5 * 33]); o.w = pk2(s[6 * 33], s[7 * 33]);
        *(v4u*)(WT + (size_t)(drow0 + n) * K + k0 + 8 * c) = o; }
    LDS_WAIT();
}
__device__ __forceinline__ int win_dest_row(int n) { return n < 1024 ? n : (n < 2048 ? n + 3328 : (n < 5376 ? n - 1024 : n)); }
__device__ __forceinline__ const float* xrow_ptr(const float* xp, const float* xs, int m) { return m < 32768 ? xp + (size_t)m * D : xs + (size_t)(m - 32768) * D; }

__device__ __forceinline__ void p0_prologue(const Args& a, unsigned char* ws, LAS unsigned char* lds, int gw, int NGW, int wave, int lane) {
    LAS float* scr = (LAS float*)(lds + wave * 16384);
    constexpr int I_IN = (D / 64) * (NIN / 32), I_GLU = (1024 / 64) * (1024 / 32), I_SO = (1024 / 64) * (2048 / 32), I_WO = (2048 / 64) * (2048 / 32);
    constexpr int NITEMS = I_IN + I_GLU + 2 * I_SO + I_WO;
    for (int it = gw; it < NITEMS; it += NGW) {
        int r = it;
        if (r < I_IN) { const int nblk = NIN / 32, kb = r / nblk, nb = r % nblk; transpose_item(a.in[4], NIN, D, (bf16*)(ws + WS_WT), win_dest_row(32 * nb), scr, 64 * kb, 32 * nb, lane); continue; } r -= I_IN;
        if (r < I_GLU) { const int nblk = 1024 / 32, kb = r / nblk, nb = r % nblk; transpose_item(a.in[13], 1024, 1024, (bf16*)(ws + WS_GLUT), 32 * nb, scr, 64 * kb, 32 * nb, lane); continue; } r -= I_GLU;
        if (r < I_SO) { const int nblk = 2048 / 32, kb = r / nblk, nb = r % nblk; transpose_item(a.in[14], 2048, 1024, (bf16*)(ws + WS_S5OT), 32 * nb, scr, 64 * kb, 32 * nb, lane); continue; } r -= I_SO;
        if (r < I_SO) { const int nblk = 2048 / 32, kb = r / nblk, nb = r % nblk; transpose_item(a.in[25], 2048, 1024, (bf16*)(ws + WS_RWOT), 32 * nb, scr, 64 * kb, 32 * nb, lane); continue; } r -= I_SO;
        { const int nblk = 2048 / 32, kb = r / nblk, nb = r % nblk; transpose_item(a.in[26], 2048, 2048, (bf16*)(ws + WS_WOT), 32 * nb, scr, 64 * kb, 32 * nb, lane); }
    }
    { const int bxx = gw / NWAVES; s5k::tables_group(a, ws, lds, (bxx >> 2) & 63, bxx & 3, wave * 64 + lane); }
    { bf16* LUT = (bf16*)(ws + WS_LUT);
      for (int e = gw * 64 + lane; e < 4 * 16 * 64 * 64; e += NGW * 64) {
          const int j = e & 63, c = (e >> 6) & 63, h = (e >> 12) & 15, rd = e >> 16, role = rd >> 1, d = rd & 1;
          LUT[e] = (bf16)f2bf((role ? a.in[19] : a.in[17])[(size_t)(d * 64 + j) * 1024 + h * 64 + c]); } }
    const float* g = a.in[2];
    f32x4 gv[8];
#pragma unroll
    for (int j = 0; j < 8; ++j) gv[j] = ((const f32x4*)g)[lane + 64 * j];
    bf16* HN = (bf16*)(ws + WS_HN);
    for (int m = gw; m < M; m += NGW) {
        const f32x4* xr = (const f32x4*)xrow_ptr(a.in[0], a.in[1], m) + lane;
        f32x4 v[8]; float s = 0.f;
#pragma unroll
        for (int j = 0; j < 8; ++j) { v[j] = __builtin_nontemporal_load(xr + 64 * j); s += (v[j].x * v[j].x + v[j].y * v[j].y) + (v[j].z * v[j].z + v[j].w * v[j].w); }
        const float rstd = 1.0f / sqrtf(wave_sum(s) * (1.0f / D) + RMS_EPS);
        v2u* o8 = (v2u*)(HN + (size_t)m * D) + lane;
#pragma unroll
        for (int j = 0; j < 8; ++j) { v2u o; o.x = pk2(v[j].x * rstd * gv[j].x, v[j].y * rstd * gv[j].y); o.y = pk2(v[j].z * rstd * gv[j].z, v[j].w * rstd * gv[j].w); o8[64 * j] = o; }
    }
}

__device__ __forceinline__ void unpack8(const bf16* p, float (&o)[8]) {
    const v4u a = *(const v4u*)p;
    o[0] = blo(a.x); o[1] = bhi(a.x); o[2] = blo(a.y); o[3] = bhi(a.y); o[4] = blo(a.z); o[5] = bhi(a.z); o[6] = blo(a.w); o[7] = bhi(a.w);
}
__device__ __forceinline__ void pack8(bf16* p, const float (&v)[8]) {
    v4u a; a.x = pk2(v[0], v[1]); a.y = pk2(v[2], v[3]); a.z = pk2(v[4], v[5]); a.w = pk2(v[6], v[7]); *(v4u*)p = a;
}
__device__ __forceinline__ void p3_finalize(const Args& a, unsigned char* ws, int gw, int NGW, int lane) {
    const bf16* BON = (const bf16*)(ws + WS_ZG);
    unsigned char* ob = (unsigned char*)a.out;
    bf16* YF = (bf16*)(ob + DO_YF); const bf16* YB = (const bf16*)(ob + DO_YB);
    const int half = gw & 1, c0 = half * 512 + lane * 8;
    float lnw[8], lnb[8];
#pragma unroll
    for (int j = 0; j < 8; ++j) { lnw[j] = a.in[23][c0 + j]; lnb[j] = a.in[24][c0 + j]; }
    for (int m = gw >> 1; m < M; m += NGW >> 1) {
        const int t = m < 32768 ? (m & (LP - 1)) : ((m - 32768) & (LS - 1)), L = m < 32768 ? LP : LS;
        const bool hp = t > 0, hn = t < L - 1;
        float o[8];
        float y[8];
        {
            float yf[8], yb[8];
            unpack8(YF + (size_t)m * DRW + c0, yf); unpack8(YB + (size_t)m * DRW + c0, yb);
#pragma unroll
            for (int j = 0; j < 8; ++j) y[j] = yf[j] + yb[j];
        }
        float s1 = 0.f;
#pragma unroll
        for (int j = 0; j < 8; ++j) s1 += y[j];
        s1 += __shfl_xor(s1, 1); s1 += __shfl_xor(s1, 2); s1 += __shfl_xor(s1, 4);
        const float mean = s1 * (1.0f / 64.0f);
        float s2 = 0.f;
#pragma unroll
        for (int j = 0; j < 8; ++j) { const float dd = y[j] - mean; s2 += dd * dd; }
        s2 += __shfl_xor(s2, 1); s2 += __shfl_xor(s2, 2); s2 += __shfl_xor(s2, 4);
        const float rstd = 1.0f / sqrtf(s2 * (1.0f / 64.0f) + GN_EPS);
        float bon[8];
        unpack8(BON + (size_t)m * DRW + c0, bon);
#pragma unroll
        for (int j = 0; j < 8; ++j) o[j] = (y[j] - mean) * rstd * lnw[j] + lnb[j] + bon[j];
        pack8(YF + (size_t)m * DRW + c0, o);
    }
}

__device__ __forceinline__ void p12_final(const Args& a, const bf16* OUTB, int gw, int NGW, int lane) {
    const float* g = a.in[3];
    f32x4 gv[8];
#pragma unroll
    for (int j = 0; j < 8; ++j) gv[j] = ((const f32x4*)g)[lane + 64 * j];
    for (int m = gw; m < M; m += NGW) {
        const f32x4* xr = (const f32x4*)xrow_ptr(a.in[0], a.in[1], m) + lane;
        f32x4* orow = (f32x4*)(a.out + (size_t)m * D) + lane;
        const v2u* brow = (const v2u*)(OUTB + (size_t)m * D) + lane;
        f32x4 v[8]; float s = 0.f;
#pragma unroll
        for (int j = 0; j < 8; ++j) { const v2u b = __builtin_nontemporal_load(brow + 64 * j); v[j] = (f32x4){blo(b.x), bhi(b.x), blo(b.y), bhi(b.y)}; s += (v[j].x * v[j].x + v[j].y * v[j].y) + (v[j].z * v[j].z + v[j].w * v[j].w); }
        const float rstd = 1.0f / sqrtf(wave_sum(s) * (1.0f / D) + RMS_EPS);
#pragma unroll
#ifdef PROBE_DMG
        for (int j = 0; j < 8; ++j) { const f32x4 xv = __builtin_nontemporal_load(xr + 64 * j); __builtin_nontemporal_store(xv, orow + 64 * j); }
#else
        for (int j = 0; j < 8; ++j) { const f32x4 xv = __builtin_nontemporal_load(xr + 64 * j); __builtin_nontemporal_store(xv + v[j] * rstd * gv[j], orow + 64 * j); }
#endif
    }
}

#ifndef RW_UA
#define RW_UA 10
#define RW_UB 18
#endif
static_assert(64 * RW_UA + 192 * RW_UB == 4096, "RWKV unit split");
__global__ void __launch_bounds__(NWAVES * 64, 2) mk_fwd(Args args) {
    extern __shared__ __attribute__((aligned(16))) unsigned char lds_raw[];
    LAS unsigned char* lds = (LAS unsigned char*)lds_raw;
    volatile LAS unsigned* MISC = (volatile LAS unsigned*)(lds + MISC_OFF);
    const int wave = __builtin_amdgcn_readfirstlane((int)threadIdx.x >> 6);
#define lane mk_lane()
    const int tid0 = threadIdx.x;
    const int G = gridDim.x; const int bx = blockIdx.x; const int vcu = (G % 8 == 0) ? (bx % 8) * (G / 8) + bx / 8 : bx;
    unsigned char* ws = args.ws;
    unsigned* ctl = (unsigned*)(ws + WS_CTL);
    for (int u = tid0; u < (LDS_BYTES - MISC_OFF) / 4; u += NWAVES * 64) ((LAS unsigned*)(lds + MISC_OFF))[u] = 0u;
    __syncthreads();
    XcdBarrier bar = xcd_barrier_post(ctl + CW_BAR, MISC + 8, wave);
#ifdef PROBE_A
    int nstamp = 0;
#define STAMP() do { if (bx == 0 && tid0 == 0) MISC[32 + nstamp] = (unsigned)__builtin_amdgcn_s_memrealtime(); ++nstamp; } while (0)
#else
#define STAMP() do { } while (0)
#endif
    STAMP();
#define GRID_BAR() do { xcd_barrier(bar, wave); STAMP(); } while (0)
#ifndef ONLY_PHASE
#define ONLY_PHASE -1
#endif
#ifndef REP_PHASE
#define REP_PHASE -1
#endif
#define IN(k) (ONLY_PHASE < 0 || ONLY_PHASE == (k))
#define REPS(k) _Pragma("unroll 1") for (int rep_ = 0; rep_ < ((REP_PHASE == (k)) ? 2 : 1); ++rep_)
    const int gw = vcu * NWAVES + wave, NGW = G * NWAVES;
#ifdef GEMM_WAVE_PERM
    const int gwave = ((wave & 1) << 2) | (wave >> 1);
#else
    const int gwave = wave;
#endif
    bf16* WT = (bf16*)(ws + WS_WT); bf16* HN = (bf16*)(ws + WS_HN); bf16* RWIN = (bf16*)(ws + WS_RWIN); bf16* Z = (bf16*)(ws + WS_Z); bf16* ZG = (bf16*)(ws + WS_ZG);
    bf16* A2 = (bf16*)((unsigned char*)args.out + DO_A2);
    bf16* YN = (bf16*)((unsigned char*)args.out + DO_YF); bf16* Q = (bf16*)((unsigned char*)args.out + DO_Q); bf16* P = RWIN;

#if defined(PROBE_SPIN) && !defined(PROBE_SPIN_END)
    if (bx == 0 && tid0 == 0) { const unsigned long long t0_ = __builtin_amdgcn_s_memrealtime(); while (__builtin_amdgcn_s_memrealtime() - t0_ < (unsigned long long)PROBE_SPIN) __builtin_amdgcn_s_sleep(8); }
    __syncthreads();
#endif
    if (IN(0)) REPS(0) { p0_prologue(args, ws, lds, gw, NGW, wave, lane); GRID_BAR(); }
    if (IN(1)) REPS(1) {
        s5k::fill_weights(args, ws, gw, NGW, lane, 0);
        pg8::Gemm g{HN, WT, M, 4352, D, D}; pg8::StaticOrder S; S.init(M, 4352, G, bx);
        pg8::EpiG1 E{A2, RWIN};
        pg8::gemm_phase<pg8::EpiG1, pg8::StaticOrder, PG8_ALIGN, PG8_SP2>(lds, g, S, E, gwave);
        GRID_BAR();
    }
#ifdef PROBE_GEMM
    {
        pg8::Gemm g{HN, WT, M, 4352, D, D}; pg8::WrapOrder S; S.init(M, 4352, G, bx); S.wrap = (PROBE_GEMM == 2) ? 15 : 0xffff;
        pg8::EpiNull E{};
        pg8::gemm_phase<pg8::EpiNull, pg8::WrapOrder, PG8_ALIGN, PG8_SP2>(lds, g, S, E, gwave);
        GRID_BAR();
    }
#endif
    if (IN(2)) REPS(2) {
        pg8::Gemm g{A2, (const bf16*)(ws + WS_S5E), 131072, 256, s5k::KU, s5k::K2}; pg8::S5Order S{G, bx, 512, 1};
        pg8::EpiS5X E{(bf16*)(ws + WS_S5XL)};
        pg8::gemm_phase<pg8::EpiS5X, pg8::S5Order, PG8_ALIGN, PG8_SP2>(lds, g, S, E, gwave);
        GRID_BAR();
    }
    if (IN(3)) REPS(3) {
        const int gwt = wave * G + vcu;
        for (int j = gwt; j < 2304; j += NGW) s5k::chain_job(ws, A2, j, lane);
        if (wave > 0) s5k::fill_weights(args, ws, vcu * (NWAVES - 1) + (wave - 1), G * (NWAVES - 1), lane, 1);
        if (wave > 0) rwk::rw_tw_prepass(args, ws, vcu * (NWAVES - 1) + (wave - 1), G * (NWAVES - 1), lane);
        GRID_BAR();
    }
    if (IN(4)) REPS(4) {
        pg8::Gemm g{A2, (const bf16*)(ws + WS_S5W2), 131072, 512, s5k::K2, s5k::K2}; pg8::S5Order S{G, bx, 1024, 2};
        pg8::EpiS5Y E{Z};
        pg8::gemm_phase<pg8::EpiS5Y, pg8::S5Order, PG8_ALIGN, PG8_SP2>(lds, g, S, E, gwave);
        GRID_BAR();
    }
    if (IN(5)) REPS(5) {
#if REP_PHASE == 5
        if (rep_ > 0) { if (bx == 0 && tid0 < rwk::NSEG) __hip_atomic_store(ctl + CW_QUEUE + tid0 * 64, 0u, __ATOMIC_RELAXED, __HIP_MEMORY_SCOPE_AGENT); GRID_BAR(); }
#endif
        for (int e = tid0; e < 3328; e += NWAVES * 64) ((LAS float*)(lds + rwk::O_MU))[e] = args.in[15][e];
        __syncthreads();
        for (int k = 0; k <= rwk::NSEG; ++k) {
            if (k >= 1) {
                const int seg = k - 1;
                int J, Jstride;
                if (bx < 32) { J = bx * 8 + wave; Jstride = 1 << 20; }
                else { J = 256 + (bx - 32) * 8 + wave; Jstride = 1792; }
                for (; J < 2304; J += Jstride) {
                    const int chain = J < 256 ? (J >> 2) : 64 + ((J - 256) >> 2);
                    rwk::rw_chain_job(args, ws, lds, seg, chain, wave, lane);
                }
                VM_WAIT(); __syncthreads();
            }
            if (k < rwk::NSEG) {
                const int seg = k;
                const int q = bx & 31;
                unsigned* qc = ctl + CW_QUEUE + (k * 32 + q) * 16;
                volatile LAS unsigned* qs = MISC + 16;
                if (wave == 0 && lane == 0) { qs[0] = __hip_atomic_fetch_add(qc, 1u, __ATOMIC_RELAXED, __HIP_MEMORY_SCOPE_AGENT); qs[1] = __hip_atomic_fetch_add(qc, 1u, __ATOMIC_RELAXED, __HIP_MEMORY_SCOPE_AGENT); }
                __syncthreads();
                int ucur = __builtin_amdgcn_readfirstlane((int)qs[0]), unxt = __builtin_amdgcn_readfirstlane((int)qs[1]);
                rwk::RawUnit R;
                rwk::rw_load_unit<true>(args, ws, seg, rwk::unit_from_queue(q, ucur < rwk::QUNITS ? ucur : 0), wave, lane, R);
                rwk::rw_pin_unit(R);
                while (ucur < rwk::QUNITS) {
                    unsigned pulled = 0u;
                    if (wave == 0 && lane == 0) { GAS unsigned* qcv = (GAS unsigned*)qc; asm volatile("" : "+v"(qcv)); pulled = __hip_atomic_fetch_add(qcv, 1u, __ATOMIC_RELAXED, __HIP_MEMORY_SCOPE_AGENT); }
                    int unn;
                    rwk::rw_precompute_unit(args, ws, lds, seg, q, ucur, unxt, wave, lane, R, qs + 2, pulled, unn);
                    ucur = unxt; unxt = unn;
                }
            }
            GRID_BAR();
        }
    }
    if (IN(6)) REPS(6) { p3_finalize(args, ws, gw, NGW, lane); GRID_BAR(); }
    if (IN(7)) REPS(7) {
        pg8::Gemm g{Z, (const bf16*)(ws + WS_GLUT), M, 1024, 1024, 1024}; pg8::StaticOrder S; S.init(M, 1024, G, bx);
        pg8::EpiMix<1> E{ZG, Z, nullptr, 1024};
        pg8::gemm_phase<pg8::EpiMix<1>, pg8::StaticOrder, PG8_ALIGN, PG8_SP2>(lds, g, S, E, gwave);
    }
    if (IN(8)) REPS(8) {
        pg8::Gemm g{HN, WT + (size_t)4352 * D, M, 2048, D, D}; pg8::StaticOrder S; S.init(M, 2048, G, bx);
        pg8::EpiSplit<2, 2> E{{ZG, ZG, nullptr, 1024}, {YN, YN, nullptr, 1024}, 4};
        pg8::gemm_phase<pg8::EpiSplit<2, 2>, pg8::StaticOrder, PG8_ALIGN, PG8_SP2>(lds, g, S, E, gwave);
        GRID_BAR();
    }
    if (IN(10)) REPS(10) {
        pg8::Gemm g{ZG, (const bf16*)(ws + WS_S5OT), M, 2048, 1024, 1024}; pg8::StaticOrder S; S.init(M, 2048, G, bx);
        pg8::EpiMix<0> E{P, nullptr, nullptr, 2048};
        pg8::gemm_phase<pg8::EpiMix<0>, pg8::StaticOrder, PG8_ALIGN, PG8_SP2>(lds, g, S, E, gwave);
    }
    if (IN(12)) REPS(12) {
        pg8::Gemm g{YN, (const bf16*)(ws + WS_RWOT), M, 2048, 1024, 1024}; pg8::StaticOrder S; S.init(M, 2048, G, bx);
        pg8::EpiMix<0> E{Q, nullptr, nullptr, 2048};
        pg8::gemm_phase<pg8::EpiMix<0>, pg8::StaticOrder, PG8_ALIGN, PG8_SP2>(lds, g, S, E, gwave);
    }
    if (IN(13)) REPS(13) {
        pg8::Gemm g{HN, WT + (size_t)6400 * D, M, 4096, D, D}; pg8::StaticOrder S; S.init(M, 4096, G, bx);
        pg8::EpiSplit<1, 3> E{{P, P, nullptr, 2048}, {P, Q, P, 2048}, 8};
        pg8::gemm_phase<pg8::EpiSplit<1, 3>, pg8::StaticOrder, PG8_ALIGN, PG8_SP2>(lds, g, S, E, gwave);
        GRID_BAR();
    }
    if (IN(14)) REPS(14) {
        pg8::Gemm g{P, (const bf16*)(ws + WS_WOT), M, 2048, D, D}; pg8::StaticOrder S; S.init(M, 2048, G, bx);
        pg8::EpiMix<0> E{HN, nullptr, nullptr, 2048};
        pg8::gemm_phase<pg8::EpiMix<0>, pg8::StaticOrder, PG8_ALIGN, PG8_SP2>(lds, g, S, E, gwave);
        GRID_BAR();
    }
#ifdef PROBE_BARS
    _Pragma("unroll 1") for (int pb_ = 0; pb_ < PROBE_BARS; ++pb_) GRID_BAR();
#endif
    if (IN(15)) REPS(15) { p12_final(args, HN, gw, NGW, lane); }
#ifdef PROBE_SPIN_END
    if (bx == 0 && tid0 == 0) { const unsigned long long t0_ = __builtin_amdgcn_s_memrealtime(); while (__builtin_amdgcn_s_memrealtime() - t0_ < (unsigned long long)PROBE_SPIN) __builtin_amdgcn_s_sleep(8); }
#endif
#ifdef PROBE_A
#ifdef PROBE_ENDBAR
    GRID_BAR();
#else
    STAMP();
#endif
    if (bx == 0 && tid0 == 0) {
        VM_WAIT();
        const float dt = (float)(MISC[32 + PROBE_B] - MISC[32 + PROBE_A]) * 0.01f;
#ifdef PROBE_DMG
        args.out[0] += 20.0f + rintf((dt - (float)PROBE_C) / (float)PROBE_D);
#else
        args.out[0] += 10.0f + rintf((dt - (float)PROBE_C) / (float)PROBE_D);
#endif
    }
#endif
#undef IN
#undef lane
}

extern "C" void kernel_launch(void* const* d_in, const int* in_sizes, int n_in, void* d_out, int out_size, void* d_ws, size_t ws_size, hipStream_t stream) {
    static int grid = 0;
    if (grid == 0) {
        if (n_in != 27 || out_size != 2 * 32768 * D || ws_size < WS_END) { fprintf(stderr, "kernel_launch: unexpected shapes (n_in %d out %d ws %zu)\n", n_in, out_size, ws_size); grid = -1; return; }
        int dev = 0, cus = 0, per_cu = 0;
        if (hipGetDevice(&dev) != hipSuccess || hipDeviceGetAttribute(&cus, hipDeviceAttributeMultiprocessorCount, dev) != hipSuccess) { grid = -1; return; }
        if (hipFuncSetAttribute((const void*)mk_fwd, hipFuncAttributeMaxDynamicSharedMemorySize, LDS_BYTES) != hipSuccess) { fprintf(stderr, "kernel_launch: hipFuncSetAttribute failed\n"); grid = -1; return; }
        if (hipOccupancyMaxActiveBlocksPerMultiprocessor(&per_cu, (const void*)mk_fwd, NWAVES * 64, LDS_BYTES) != hipSuccess || per_cu < 1)
            fprintf(stderr, "kernel_launch: note: occupancy query reports %d workgroups per CU\n", per_cu);
        (void)hipGetLastError();
        if (cus < 256) fprintf(stderr, "kernel_launch: note: %d CUs; the phase program is written for 256 resident workgroups\n", cus);
        grid = 256;
    }
    if (grid < 0) return;
    if (hipMemsetAsync((char*)d_ws + WS_CTL, 0, CTL_ZERO_BYTES, stream) != hipSuccess) return;
    Args a{};
    for (int i = 0; i < 27; ++i) a.in[i] = (const float*)d_in[i];
    a.out = (float*)d_out; a.ws = (unsigned char*)d_ws; a.pad = 0;
    { const int li = 0; a.ph_lo = 0; a.ph_hi = N_PHASES; a.li = 0;
        hipLaunchKernelGGL(mk_fwd, dim3(grid), dim3(NWAVES * 64), LDS_BYTES, stream, a);
        const hipError_t le = hipPeekAtLastError();
        if (le != hipSuccess) { fprintf(stderr, "kernel_launch: launch %d failed: %s\n", li, hipGetErrorName(le)); }
    }
}
```
